# Optimizing an MI355X kernel written in HIP

```python
import jax, jax.numpy as jnp
from jax import lax
import numpy as np

D_MODEL = 1024
BATCH = 4
SEQ = 4096
DEPTH = 1

HEAD_DIM = 64
SB_HEADS = 8
SWA_HEADS = 8
SWA_KV_HEADS = 2
SWA_GROUP = SWA_HEADS // SWA_KV_HEADS
D_SB = SB_HEADS * HEAD_DIM
D_SWA = SWA_HEADS * HEAD_DIM
D_SWA_KV = SWA_KV_HEADS * HEAD_DIM
D_MIX = D_SB + D_SWA
D_IN = 3 * D_SB + D_SWA + 2 * D_SWA_KV
Q_BLOCK = 128
WINDOW = 128
PEER_HEADS = 8
N_KEYS = 128
N_EXPERTS = N_KEYS * N_KEYS
PEER_TOPK = 16
D_KEY = 256
D_HALF = D_KEY // 2
TOKEN_CHUNK = 128
EPS = 1e-6

kernel_name = "hybrid_stickbreak_swa_peer_block"


def rmsnorm(x, g):
    xf = x.astype(jnp.float32)
    y = xf * lax.rsqrt(jnp.mean(xf * xf, axis=-1, keepdims=True) + EPS)
    return (y * g.astype(jnp.float32)).astype(x.dtype)


def head_rmsnorm(o, g, n_heads):
    B, S, _ = o.shape
    of = o.reshape(B, S, n_heads, HEAD_DIM).astype(jnp.float32)
    y = of * lax.rsqrt(jnp.mean(of * of, axis=-1, keepdims=True) + EPS)
    y = y * g.reshape(n_heads, HEAD_DIM).astype(jnp.float32)
    return y.reshape(B, S, n_heads * HEAD_DIM).astype(o.dtype)


def alibi_slopes(n_heads):
    return jnp.exp2(-8.0 * jnp.arange(1, n_heads + 1, dtype=jnp.float32) / n_heads)


def stick_breaking_attention(q, k, v):
    B, S, H, Dh = q.shape
    nblk = S // Q_BLOCK
    scale = Dh ** -0.5
    qb = q.reshape(B, nblk, Q_BLOCK, H, Dh).transpose(1, 0, 3, 2, 4)
    kh = k.transpose(0, 2, 1, 3)
    vh = v.transpose(0, 2, 1, 3)
    key_pos = jnp.arange(S)

    def block(args):
        qi, i = args
        z = jnp.einsum('bhqd,bhkd->bhqk', qi, kh, preferred_element_type=jnp.float32) * scale
        q_pos = i * Q_BLOCK + jnp.arange(Q_BLOCK)
        mask = key_pos[None, :] < q_pos[:, None]
        log_1m = jnp.where(mask, jax.nn.log_sigmoid(-z), 0.0)
        later = lax.cumsum(log_1m, axis=3, reverse=True) - log_1m
        a = jnp.where(mask, jnp.exp(jax.nn.log_sigmoid(z) + later), 0.0)
        return jnp.einsum('bhqk,bhkd->bhqd', a.astype(vh.dtype), vh)

    out = lax.map(block, (qb, jnp.arange(nblk)))
    return out.transpose(1, 0, 3, 2, 4).reshape(B, S, H * Dh)


def sliding_window_attention(q, k, v, sinks):
    B, S, H, Dh = q.shape
    KV = k.shape[2]
    G = H // KV
    n = S // Q_BLOCK
    qb = q.reshape(B, n, Q_BLOCK, KV, G, Dh)

    def with_prev(t):
        tb = t.reshape(B, n, Q_BLOCK, KV, Dh)
        prev = jnp.pad(tb[:, :-1], ((0, 0), (1, 0), (0, 0), (0, 0), (0, 0)))
        return jnp.concatenate([prev, tb], axis=2)

    kb, vb = with_prev(k), with_prev(v)
    s = jnp.einsum('bnqkgd,bnskd->bnkgqs', qb, kb, preferred_element_type=jnp.float32) * Dh ** -0.5
    dist = jnp.arange(Q_BLOCK)[:, None] + Q_BLOCK - jnp.arange(2 * Q_BLOCK)[None, :]
    key_abs = jnp.arange(n)[:, None] * Q_BLOCK + jnp.arange(2 * Q_BLOCK)[None, :] - Q_BLOCK
    mask = ((dist >= 0) & (dist < WINDOW))[None, :, :] & (key_abs >= 0)[:, None, :]
    slopes = alibi_slopes(H).reshape(KV, G)
    s = s - slopes[:, :, None, None] * dist.astype(jnp.float32)
    s = jnp.where(mask[None, :, None, None, :, :], s, -jnp.inf)
    sink = jnp.broadcast_to(sinks.astype(jnp.float32).reshape(KV, G)[None, None, :, :, None, None],
                            s.shape[:-1] + (1,))
    p = jax.nn.softmax(jnp.concatenate([s, sink], axis=-1), axis=-1)[..., :-1]
    out = jnp.einsum('bnkgqs,bnskd->bnqkgd', p.astype(vb.dtype), vb)
    return out.reshape(B, S, H * Dh)


def peer_ffn(x, w_q, keys1, keys2, u, v):
    B, S, D = x.shape
    T = B * S
    xt = x.reshape(T, D)
    q = (xt @ w_q).reshape(T, PEER_HEADS, 2, D_HALF)
    s1 = jnp.einsum('thd,hnd->thn', q[:, :, 0], keys1, preferred_element_type=jnp.float32)
    s2 = jnp.einsum('thd,hnd->thn', q[:, :, 1], keys2, preferred_element_type=jnp.float32)
    v1, i1 = lax.top_k(s1, PEER_TOPK)
    v2, i2 = lax.top_k(s2, PEER_TOPK)
    cand = (v1[..., :, None] + v2[..., None, :]).reshape(T, PEER_HEADS, PEER_TOPK * PEER_TOPK)
    cand_idx = (i1[..., :, None] * N_KEYS + i2[..., None, :]).reshape(T, PEER_HEADS, PEER_TOPK * PEER_TOPK)
    top_s, pos = lax.top_k(cand, PEER_TOPK)
    idx = jnp.take_along_axis(cand_idx, pos, axis=-1)
    gate = jax.nn.softmax(top_s, axis=-1)
    nc = T // TOKEN_CHUNK

    def chunk(args):
        xc, ic, gc = args
        h = jax.nn.gelu(jnp.einsum('cd,chkd->chk', xc, u[ic]))
        return jnp.einsum('chk,chkd->cd', (gc * h).astype(v.dtype), v[ic])

    out = lax.map(chunk, (xt.reshape(nc, TOKEN_CHUNK, D),
                          idx.reshape(nc, TOKEN_CHUNK, PEER_HEADS, PEER_TOPK),
                          gate.reshape(nc, TOKEN_CHUNK, PEER_HEADS, PEER_TOPK)))
    return out.reshape(B, S, D).astype(x.dtype)


def setup_inputs(seed: int = 0) -> dict:
    key = jax.random.key(seed)
    ks = jax.random.split(key, 14)
    f32 = jnp.float32
    L = DEPTH
    return {
        "x": jax.random.normal(ks[0], (BATCH, SEQ, D_MODEL), f32),
        "norm1_g": 1.0 + 0.02 * jax.random.normal(ks[1], (L, D_MODEL), f32),
        "w_in": jax.random.normal(ks[2], (L, D_MODEL, D_IN), f32) * D_MODEL ** -0.5,
        "sb_out_g": 1.0 + 0.02 * jax.random.normal(ks[3], (L, D_SB), f32),
        "swa_out_g": 1.0 + 0.02 * jax.random.normal(ks[4], (L, D_SWA), f32),
        "swa_sinks": 0.5 * jax.random.normal(ks[5], (L, SWA_HEADS), f32),
        "w_out": jax.random.normal(ks[6], (L, D_MIX, D_MODEL), f32) * D_MIX ** -0.5,
        "norm2_g": 1.0 + 0.02 * jax.random.normal(ks[7], (L, D_MODEL), f32),
        "peer_w_q": jax.random.normal(ks[8], (L, D_MODEL, PEER_HEADS * D_KEY), f32) * D_MODEL ** -0.5,
        "peer_keys1": jax.random.normal(ks[9], (L, PEER_HEADS, N_KEYS, D_HALF), f32) * D_HALF ** -0.5,
        "peer_keys2": jax.random.normal(ks[10], (L, PEER_HEADS, N_KEYS, D_HALF), f32) * D_HALF ** -0.5,
        "peer_u": jax.random.normal(ks[11], (L, N_EXPERTS, D_MODEL), f32) * D_MODEL ** -0.5,
        "peer_v": jax.random.normal(ks[12], (L, N_EXPERTS, D_MODEL), f32) * PEER_HEADS ** -0.5,
        "final_g": 1.0 + 0.02 * jax.random.normal(ks[13], (D_MODEL,), f32),
    }


def reference(x, norm1_g, w_in, sb_out_g, swa_out_g, swa_sinks, w_out, norm2_g,
              peer_w_q, peer_keys1, peer_keys2, peer_u, peer_v, final_g):
    B, S, _ = x.shape
    splits = [D_SB, 2 * D_SB, 3 * D_SB, 3 * D_SB + D_SWA, 3 * D_SB + D_SWA + D_SWA_KV]
    for l in range(DEPTH):
        h = rmsnorm(x, norm1_g[l])
        proj = h @ w_in[l]
        sb_q, sb_k, sb_v, sw_q, sw_k, sw_v = jnp.split(proj, splits, axis=-1)
        sb = stick_breaking_attention(sb_q.reshape(B, S, SB_HEADS, HEAD_DIM),
                                      sb_k.reshape(B, S, SB_HEADS, HEAD_DIM),
                                      sb_v.reshape(B, S, SB_HEADS, HEAD_DIM))
        sw = sliding_window_attention(sw_q.reshape(B, S, SWA_HEADS, HEAD_DIM),
                                      sw_k.reshape(B, S, SWA_KV_HEADS, HEAD_DIM),
                                      sw_v.reshape(B, S, SWA_KV_HEADS, HEAD_DIM),
                                      swa_sinks[l])
        mixed = jnp.concatenate([head_rmsnorm(sb, sb_out_g[l], SB_HEADS),
                                 head_rmsnorm(sw, swa_out_g[l], SWA_HEADS)], axis=-1)
        x = x + mixed @ w_out[l]
        x = x + peer_ffn(rmsnorm(x, norm2_g[l]), peer_w_q[l], peer_keys1[l], peer_keys2[l],
                         peer_u[l], peer_v[l])
    return rmsnorm(x, final_g)
```

```cpp
#include <hip/hip_runtime.h>
#include <cstdio>
#include <cstdint>

#ifndef MK_N_LAUNCHES
#define MK_N_LAUNCHES 8
#endif

#define LAS __attribute__((address_space(3)))
#define GAS __attribute__((address_space(1)))
typedef unsigned short bf16;
typedef short bf16x8 __attribute__((ext_vector_type(8)));
typedef float f32x4 __attribute__((ext_vector_type(4)));
typedef float f32x16 __attribute__((ext_vector_type(16)));
typedef unsigned u32x4 __attribute__((ext_vector_type(4)));
typedef unsigned u32x2 __attribute__((ext_vector_type(2)));
typedef short v4i16_t __attribute__((ext_vector_type(4)));
typedef float f32x2_t __attribute__((ext_vector_type(2)));
typedef __bf16 bf16x2_t __attribute__((ext_vector_type(2)));
typedef GAS unsigned gu32;

constexpr int T = 16384, SEQ = 4096, NB = 4, D = 1024, DIN = 2304, DQ = 2048;
constexpr int C_SBQ = 0, C_SBK = 512, C_SBV = 1024, C_SWQ = 1536, C_SWK = 2048, C_SWV = 2176;
constexpr int NEXP = 16384;
constexpr float EPS = 1e-6f;
constexpr float LOG2E = 1.4426950408889634f, LN2 = 0.6931471805599453f;
constexpr float SB_EXIT = -40.0f;

namespace pg8 {
constexpr int BM = 256, BK = 64, HALF = 128, HTB = HALF * BK * 2, STAGE_BYTES = 8 * HTB, NXCD = 8, WGM = 8;
__host__ __device__ __forceinline__ int lds_byte(int r, int c) { const int st = (r >> 4) * 2 + (c >> 5), rr = r & 15, cc = c & 31, ob = rr * 64 + cc * 2; return st * 1024 + (ob ^ (((ob >> 9) & 1) << 5)); }
__host__ __device__ __forceinline__ void stage_rc(int b, int& R, int& C) { const int st = b / 1024, sb = b % 1024, swz = sb ^ (((sb >> 9) & 1) << 5); R = (st >> 1) * 16 + swz / 64; C = (st & 1) * 32 + (swz % 64) / 2; }
__host__ __device__ __forceinline__ int perm32(int rho) { const int n = rho >> 4, i = rho & 15; return 8 * (i >> 2) + 4 * n + (i & 3); }
struct Unit { int pm, pn; };
struct Gemm { const bf16* A; const bf16* Bt; int M, N, K; };
struct StaticOrder {
    int nM, nN, nwg, G, c;
    __host__ __device__ void init(int M, int N, int G_, int c_) { nM = M / BM; nN = N / BM; nwg = nM * nN; G = G_; c = c_; }
    __host__ __device__ bool next(int i, Unit& u) const {
        const long L = (long)i * G + c; if (L >= nwg) return false;
        int wgid = (int)L; { const int q = nwg / NXCD, r = nwg % NXCD, xcd = wgid % NXCD, off = wgid / NXCD; wgid = (xcd < r ? xcd * (q + 1) : r * (q + 1) + (xcd - r) * q) + off; }
        const int nig = WGM * nN, gid = wgid / nig, fm = gid * WGM, gsz = (nM - fm) < WGM ? (nM - fm) : WGM;
        u.pm = fm + ((wgid % nig) % gsz); u.pn = (wgid % nig) / gsz; return true;
    }
};
__device__ __forceinline__ unsigned cvt_pk_bf16(float lo, float hi) { f32x2_t v = {lo, hi}; bf16x2_t b = __builtin_convertvector(v, bf16x2_t); return __builtin_bit_cast(unsigned, b); }

struct EpiBf16 {
    static constexpr bool PERM = true;
    bf16* O; int ldc;
    __device__ __forceinline__ void operator()(const f32x4 (&acc)[2][2][4][2], const Unit& u, int wr, int wc, int fr, int fq) const {
        const int row0 = u.pm * BM + wr * 64 + fr; const int col0 = u.pn * BM + wc * 32 + 8 * fq;
#pragma unroll
        for (int ai = 0; ai < 2; ++ai)
#pragma unroll
            for (int m = 0; m < 4; ++m) { bf16* rowp = O + (size_t)(row0 + ai * HALF + m * 16) * ldc + col0;
#pragma unroll
                for (int bj = 0; bj < 2; ++bj) { const f32x4 v0 = acc[ai][bj][m][0], v1 = acc[ai][bj][m][1];
                    u32x4 w; w.x = cvt_pk_bf16(v0[0], v0[1]); w.y = cvt_pk_bf16(v0[2], v0[3]); w.z = cvt_pk_bf16(v1[0], v1[1]); w.w = cvt_pk_bf16(v1[2], v1[3]);
                    *(u32x4*)(rowp + bj * HALF) = w; } }
    }
};
struct EpiResF32 {
    static constexpr bool PERM = false;
    const float* base; float* out; int ldc;
    __device__ __forceinline__ void operator()(const f32x4 (&acc)[2][2][4][2], const Unit& u, int wr, int wc, int fr, int fq) const {
        const int col0 = u.pn * BM + wc * 32 + 4 * fq;
#pragma unroll
        for (int ai = 0; ai < 2; ++ai)
#pragma unroll
            for (int m = 0; m < 4; ++m) { const size_t off = (size_t)(u.pm * BM + ai * HALF + wr * 64 + m * 16 + fr) * ldc + col0;
#pragma unroll
                for (int bj = 0; bj < 2; ++bj)
#pragma unroll
                    for (int n = 0; n < 2; ++n) { const f32x4 bs = *(const f32x4*)(base + off + bj * HALF + n * 16); *(f32x4*)(out + off + bj * HALF + n * 16) = bs + acc[ai][bj][m][n]; } }
    }
};

template <class Epi, class Sched>
__device__ __forceinline__ void gemm_phase(LAS unsigned char* lds, const Gemm g, const Sched& S, const Epi& E) {
    const int tid = threadIdx.x, wid = __builtin_amdgcn_readfirstlane(tid >> 6), lane = tid & 63, wr = wid >> 2, wc = wid & 3, fr = lane & 15, fq = lane >> 4;
    const int K = g.K, nt = K / BK;
    unsigned voffA[2], voffB[2];
#pragma unroll
    for (int i = 0; i < 2; ++i) { int R, C; stage_rc(tid * 16 + i * 8192, R, C); const int Rb = Epi::PERM ? ((R & ~31) + perm32(R & 31)) : R;
        voffA[i] = (unsigned)(R * K + C) * 2u; voffB[i] = (unsigned)(Rb * K + C) * 2u; }
    const size_t kstep = (size_t)(BK * 2);
    const size_t hstep = (size_t)HALF * K * 2;
    const size_t tstep = 2 * hstep;
    const unsigned ldsw = (unsigned)wid * 1024u;
    const int aoff = lds_byte(wr * 64 + fr, fq * 8), boff = lds_byte(wc * 32 + fr, fq * 8);
#define PG8_SA(b, h) (((b) * 2 + (h)) * HTB)
#define PG8_SB(b, h) ((4 + (b) * 2 + (h)) * HTB)
#define PG8_STAGE(bufoff, gbase, voff) do { _Pragma("unroll") for (int _i = 0; _i < 2; ++_i) \
        __builtin_amdgcn_global_load_lds((const unsigned*)((const char*)(gbase) + (voff)[_i]), (LAS unsigned*)(lds + (bufoff) + ldsw + _i * 8192), 16, 0, 0); } while (0)
#define PG8_LDA(dst, b, h) do { _Pragma("unroll") for (int m = 0; m < 4; ++m) _Pragma("unroll") for (int k = 0; k < 2; ++k) dst[m][k] = *(const LAS bf16x8*)(lds + PG8_SA(b, h) + aoff + m * 2048 + k * 1024); } while (0)
#define PG8_LDB(dst, b, h) do { _Pragma("unroll") for (int n = 0; n < 2; ++n) _Pragma("unroll") for (int k = 0; k < 2; ++k) dst[n][k] = *(const LAS bf16x8*)(lds + PG8_SB(b, h) + boff + n * 2048 + k * 1024); } while (0)
#define PG8_MMA(ai, bj, At, Bt) do { __builtin_amdgcn_s_setprio(1); _Pragma("unroll") for (int m = 0; m < 4; ++m) _Pragma("unroll") for (int n = 0; n < 2; ++n) _Pragma("unroll") for (int k = 0; k < 2; ++k) \
        acc[ai][bj][m][n] = __builtin_amdgcn_mfma_f32_16x16x32_bf16(Bt[n][k], At[m][k], acc[ai][bj][m][n], 0, 0, 0); __builtin_amdgcn_s_setprio(0); } while (0)
#define PG8_WAIT_V(n) asm volatile("s_waitcnt vmcnt(" #n ")" ::: "memory")
#define PG8_WAIT_L(n) asm volatile("s_waitcnt lgkmcnt(" #n ")" ::: "memory")
#define PG8_BAR __builtin_amdgcn_s_barrier()
#define PG8_SCHED __builtin_amdgcn_sched_barrier(0)
    Unit cur, nxt; int ui = 0;
    if (!S.next(0, cur)) return;
    f32x4 acc[2][2][4][2];
#pragma unroll
    for (int a = 0; a < 2; ++a)
#pragma unroll
        for (int b = 0; b < 2; ++b)
#pragma unroll
            for (int m = 0; m < 4; ++m)
#pragma unroll
                for (int n = 0; n < 2; ++n) acc[a][b][m][n] = (f32x4){0.f, 0.f, 0.f, 0.f};
    bf16x8 At[4][2], B0[2][2], B1[2][2];
    const char* cA = (const char*)g.A + (size_t)cur.pm * tstep; const char* cB = (const char*)g.Bt + (size_t)cur.pn * tstep;
    PG8_STAGE(PG8_SB(0, 0), cB, voffB); PG8_STAGE(PG8_SB(0, 1), cB + hstep, voffB); PG8_STAGE(PG8_SA(0, 0), cA, voffA); PG8_STAGE(PG8_SA(0, 1), cA + hstep, voffA);
    if (wr == 1) PG8_BAR;
    PG8_WAIT_V(2); PG8_BAR;
    PG8_STAGE(PG8_SB(1, 0), cB + kstep, voffB); PG8_STAGE(PG8_SA(1, 0), cA + kstep, voffA); PG8_STAGE(PG8_SB(1, 1), cB + hstep + kstep, voffB);
    PG8_WAIT_V(6); PG8_BAR;
    for (;;) {
        const bool has_next = S.next(ui + 1, nxt);
        const char* nA = has_next ? (const char*)g.A + (size_t)nxt.pm * tstep : cA; const char* nB = has_next ? (const char*)g.Bt + (size_t)nxt.pn * tstep : cB;
        for (int t = 0; t < nt; t += 2) {
            const bool last = (t == nt - 2);
            const char* a1 = cA + (size_t)(t + 1) * kstep;
            const char* a2 = last ? nA : cA + (size_t)(t + 2) * kstep; const char* b2 = last ? nB : cB + (size_t)(t + 2) * kstep;
            const char* a3 = a2 + kstep; const char* b3 = b2 + kstep;
            PG8_LDB(B0, 0, 0); PG8_LDB(B1, 0, 1); PG8_SCHED; PG8_LDA(At, 0, 0); PG8_STAGE(PG8_SA(1, 1), a1 + hstep, voffA);
            PG8_WAIT_V(8); PG8_WAIT_L(0); PG8_BAR; PG8_MMA(0, 0, At, B0); PG8_MMA(0, 1, At, B1); PG8_BAR; PG8_SCHED;
            PG8_LDA(At, 0, 1); PG8_STAGE(PG8_SB(0, 0), b2, voffB); PG8_STAGE(PG8_SB(0, 1), b2 + hstep, voffB); PG8_STAGE(PG8_SA(0, 0), a2, voffA);
            PG8_WAIT_V(8); PG8_WAIT_L(0); PG8_BAR; PG8_MMA(1, 0, At, B0); PG8_MMA(1, 1, At, B1); PG8_BAR; PG8_SCHED;
            PG8_LDB(B0, 1, 0); PG8_LDB(B1, 1, 1); PG8_SCHED; PG8_LDA(At, 1, 0); PG8_STAGE(PG8_SA(0, 1), a2 + hstep, voffA);
            PG8_WAIT_V(8); PG8_WAIT_L(0); PG8_BAR; PG8_MMA(0, 0, At, B0); PG8_MMA(0, 1, At, B1); PG8_BAR; PG8_SCHED;
            PG8_LDA(At, 1, 1); PG8_STAGE(PG8_SB(1, 0), b3, voffB); PG8_STAGE(PG8_SB(1, 1), b3 + hstep, voffB); PG8_STAGE(PG8_SA(1, 0), a3, voffA);
            PG8_WAIT_V(8); PG8_WAIT_L(0); PG8_BAR; PG8_MMA(1, 0, At, B0); PG8_MMA(1, 1, At, B1); PG8_BAR; PG8_SCHED;
        }
        if (wr == 0) PG8_BAR;
        E(acc, cur, wr, wc, fr, fq);
        if (!has_next) break;
#pragma unroll
        for (int a = 0; a < 2; ++a)
#pragma unroll
            for (int b = 0; b < 2; ++b)
#pragma unroll
                for (int m = 0; m < 4; ++m)
#pragma unroll
                    for (int n = 0; n < 2; ++n) acc[a][b][m][n] = (f32x4){0.f, 0.f, 0.f, 0.f};
        cur = nxt; cA = nA; cB = nB; ++ui;
        if (wr == 1) PG8_BAR;
    }
    PG8_WAIT_V(0);
    PG8_BAR;
#undef PG8_SA
#undef PG8_SB
#undef PG8_STAGE
#undef PG8_LDA
#undef PG8_LDB
#undef PG8_MMA
#undef PG8_WAIT_V
#undef PG8_WAIT_L
#undef PG8_BAR
#undef PG8_SCHED
}
}

constexpr int NWAVES = 8;
constexpr int N_PHASES = 8;
constexpr size_t MiB = 1u << 20;
constexpr size_t WS_CTL = 0, CTL_ZERO_BYTES = 1 * MiB;
constexpr size_t WS_WIN = 1 * MiB;
constexpr size_t WS_WOUT = 6 * MiB;
constexpr size_t WS_WQ = 8 * MiB;
constexpr size_t WS_KEYS = 12 * MiB;
constexpr size_t WS_IDX = 13 * MiB;
constexpr size_t WS_GATE = 21 * MiB;
constexpr size_t WS_H = 29 * MiB;
constexpr size_t WS_MIX = 61 * MiB;
constexpr size_t WS_QKV = 93 * MiB;
constexpr size_t WS_UB = 165 * MiB;
constexpr size_t WS_VB = 197 * MiB;
constexpr size_t WS_END = 229 * MiB;
constexpr int CW_BAR = 4096;
constexpr int RING_BYTES = 131072;
constexpr int LDSCTL_OFF = RING_BYTES, MISC_OFF = LDSCTL_OFF + 320;
constexpr int LDS_BYTES = 147456;

#define RLX_AGENT __ATOMIC_RELAXED, __HIP_MEMORY_SCOPE_AGENT
#define LDS_WAIT() asm volatile("s_waitcnt lgkmcnt(0)" ::: "memory")
__device__ __forceinline__ unsigned f2bf(float f) { unsigned u = __builtin_bit_cast(unsigned, f); return (u + 0x7fffu + ((u >> 16) & 1u)) >> 16; }
__device__ __forceinline__ unsigned pk2(float lo, float hi) { return pg8::cvt_pk_bf16(lo, hi); }
__device__ __forceinline__ unsigned f_bits(float f) { return __builtin_bit_cast(unsigned, f); }
__device__ __forceinline__ float bits_f(unsigned u) { return __builtin_bit_cast(float, u); }
__device__ __forceinline__ float bf_lo(unsigned w) { return __builtin_bit_cast(float, w << 16); }
__device__ __forceinline__ float bf_hi(unsigned w) { return __builtin_bit_cast(float, w & 0xffff0000u); }

#define XB_TMO      128
#define XB_XCNT(j)  (256  + 64 * (j))
#define XB_XSUB(j)  (1280 + 64 * (j))
#define XB_XGEN(j)  (2304 + 64 * (j))
#define XB_TOP      3328
#define XB_TOPGEN   3392
#define XCD_BAR_WORDS 3456
#define XB_SPIN_CAP (1u << 18)
__device__ __forceinline__ unsigned xb_ld(unsigned* p)              { return __hip_atomic_load(p, __ATOMIC_RELAXED, __HIP_MEMORY_SCOPE_AGENT); }
__device__ __forceinline__ unsigned xb_add(unsigned* p, unsigned v) { return __hip_atomic_fetch_add(p, v, __ATOMIC_RELAXED, __HIP_MEMORY_SCOPE_AGENT); }
__device__ __forceinline__ unsigned xb_xcc_id() { return (unsigned)__builtin_amdgcn_s_getreg((3 << 11) | 20) & 0xFu; }
#define XB_SPIN(cond, bar) do { unsigned _sp = 0; while (cond) { __builtin_amdgcn_s_sleep(1); \
    if ((++_sp & 255u) == 0u) { if (xb_ld(&(bar)[XB_TMO])) break; if (_sp > XB_SPIN_CAP) { atomicAdd(&(bar)[XB_TMO], 1u); break; } } } } while (0)
struct XcdBarrier { unsigned* bar; unsigned x; volatile LAS unsigned* st; };
__device__ __forceinline__ XcdBarrier xcd_barrier_post(unsigned* bar, volatile LAS unsigned* st) {
    XcdBarrier b; b.bar = bar; b.x = xb_xcc_id(); b.st = st;
    if (threadIdx.x == 0) (void)xb_add(&bar[XB_XCNT(b.x)], 1u);
    return b;
}
__device__ __forceinline__ void xcd_barrier_complete(unsigned* bar, unsigned x, unsigned& nloc, unsigned& nx) {
    const unsigned G = gridDim.x * gridDim.y * gridDim.z;
    unsigned sum, cnt, mine, sp = 0u;
    for (;;) {
        sum = 0u; cnt = 0u; mine = 0u;
#pragma unroll
        for (unsigned j = 0; j < 16; ++j) { const unsigned c = xb_ld(&bar[XB_XCNT(j)]); sum += c; cnt += (c > 0u) ? 1u : 0u; mine = (j == x) ? c : mine; }
        if (sum == G) break;
        __builtin_amdgcn_s_sleep(1);
        if ((++sp & 255u) == 0u) { if (xb_ld(&bar[XB_TMO])) break; if (sp > XB_SPIN_CAP) { atomicAdd(&bar[XB_TMO], 1u); break; } }
    }
    nloc = mine > 0u ? mine : 1u; nx = cnt > 0u ? cnt : 1u;
}
__device__ __forceinline__ void xcd_barrier(const XcdBarrier& b) {
    asm volatile("s_waitcnt vmcnt(0)" ::: "memory");
    __syncthreads();
    if (threadIdx.x == 0) {
        unsigned* bar = b.bar;
        __builtin_amdgcn_s_waitcnt(0);
        unsigned nloc = b.st[0], nx = b.st[1];
        if (nloc == 0u) { xcd_barrier_complete(bar, b.x, nloc, nx); b.st[0] = nloc; b.st[1] = nx; }
        const unsigned old = xb_add(&bar[XB_XSUB(b.x)], 1u);
        const unsigned gen = old / nloc;
        if (old + 1u == (gen + 1u) * nloc) {
            __builtin_amdgcn_fence(__ATOMIC_RELEASE, "agent");
            asm volatile("s_waitcnt vmcnt(0)" ::: "memory");
            const unsigned og = xb_add(&bar[XB_TOP], 1u);
            const unsigned tg = og / nx;
            if (og + 1u == (tg + 1u) * nx) xb_add(&bar[XB_TOPGEN], 1u);
            else XB_SPIN(xb_ld(&bar[XB_TOPGEN]) == tg, bar);
            __builtin_amdgcn_fence(__ATOMIC_ACQUIRE, "agent");
            xb_add(&bar[XB_XGEN(b.x)], 1u);
            asm volatile("s_waitcnt vmcnt(0)" ::: "memory");
        } else {
            XB_SPIN(xb_ld(&bar[XB_XGEN(b.x)]) == gen, bar);
            __builtin_amdgcn_fence(__ATOMIC_ACQUIRE, "agent");
            asm volatile("s_waitcnt vmcnt(0)" ::: "memory");
        }
    }
    __syncthreads();
}

struct Frame {
    LAS unsigned char* lds;
    volatile LAS unsigned* MISC;
    gu32* ctl;
    int tid, lane, wave;
    int vcu, G;
    const float *x, *g1, *w_in, *sb_g, *sw_g, *sinks, *w_out, *g2, *w_q, *keys1, *keys2, *pu, *pv, *gf;
    float* out;
    bf16 *Wt_in, *Wt_out, *Wt_q, *KEYS, *H, *MIX, *QKV, *UB, *VB;
    int* IDX; float* GATE;
};

__device__ __forceinline__ float wave_sum(float v) {
#pragma unroll
    for (int o = 1; o < 64; o <<= 1) v += __shfl_xor(v, o);
    return v;
}

__device__ __forceinline__ void p0_transpose_item(const float* W, int K, int N, bf16* WT, LAS float* scr, int item, int lane) {
    const int nblk = N / 32, kb = item / nblk, nb = item % nblk, k0 = 64 * kb, n0 = 32 * nb;
#pragma unroll 8
    for (int i = 0; i < 32; ++i) { const int kk = 2 * i + (lane >> 5); scr[kk * 33 + (lane & 31)] = W[(size_t)(k0 + kk) * N + n0 + (lane & 31)]; }
    LDS_WAIT(); asm volatile("" ::: "memory");
    const int c = lane & 7;
#pragma unroll
    for (int j = 0; j < 4; ++j) { const int n = (lane >> 3) + 8 * j; const LAS float* s = scr + (8 * c) * 33 + n;
        u32x4 o; o.x = pk2(s[0 * 33], s[1 * 33]); o.y = pk2(s[2 * 33], s[3 * 33]); o.z = pk2(s[4 * 33], s[5 * 33]); o.w = pk2(s[6 * 33], s[7 * 33]);
        *(GAS u32x4*)(WT + (size_t)(n0 + n) * K + k0 + 8 * c) = o; }
    LDS_WAIT(); asm volatile("" ::: "memory");
}
__device__ __forceinline__ void rms_row_to_bf16(const float* xrow, const float* g, bf16* orow, int lane) {
    const GAS f32x4* xr = (const GAS f32x4*)xrow + lane; const GAS f32x4* gr = (const GAS f32x4*)g + lane;
    f32x4 v[4]; float s = 0.f;
#pragma unroll
    for (int j = 0; j < 4; ++j) { v[j] = xr[64 * j]; s += (v[j].x * v[j].x + v[j].y * v[j].y) + (v[j].z * v[j].z + v[j].w * v[j].w); }
    const float rs = __builtin_amdgcn_rsqf(wave_sum(s) * (1.f / D) + EPS);
    GAS u32x2* o8 = (GAS u32x2*)orow + lane;
#pragma unroll
    for (int j = 0; j < 4; ++j) { const f32x4 gg = gr[64 * j]; u32x2 w; w.x = pk2(v[j].x * rs * gg.x, v[j].y * rs * gg.y); w.y = pk2(v[j].z * rs * gg.z, v[j].w * rs * gg.w); o8[64 * j] = w; }
}
__device__ __forceinline__ void cvt_array_bf16(const float* src, bf16* dst, size_t n8, int gtid, int gthreads) {
    for (size_t i = gtid; i < n8; i += gthreads) {
        const f32x4 a = *(const GAS f32x4*)(src + i * 8), b = *(const GAS f32x4*)(src + i * 8 + 4);
        u32x4 o; o.x = pk2(a.x, a.y); o.y = pk2(a.z, a.w); o.z = pk2(b.x, b.y); o.w = pk2(b.z, b.w);
        *(GAS u32x4*)(dst + i * 8) = o;
    }
}
__device__ __forceinline__ void p0_prologue(Frame& F) {
    LAS float* scr = (LAS float*)(F.lds + F.wave * 16384);
    const int gw = F.vcu * NWAVES + F.wave, NGW = F.G * NWAVES;
    constexpr int I_IN = (D / 64) * (DIN / 32), I_OUT = (D / 64) * (D / 32), I_Q = (D / 64) * (DQ / 32);
    constexpr int NITEMS = I_IN + I_OUT + I_Q;
    for (int it = gw; it < NITEMS; it += NGW) {
        int r = it;
        if (r < I_IN) { p0_transpose_item(F.w_in, D, DIN, F.Wt_in, scr, r, F.lane); continue; } r -= I_IN;
        if (r < I_OUT) { p0_transpose_item(F.w_out, D, D, F.Wt_out, scr, r, F.lane); continue; } r -= I_OUT;
        p0_transpose_item(F.w_q, D, DQ, F.Wt_q, scr, r, F.lane);
    }
    for (int m = gw; m < T; m += NGW) rms_row_to_bf16(F.x + (size_t)m * D, F.g1, F.H + (size_t)m * D, F.lane);
    const int gtid = F.vcu * NWAVES * 64 + F.tid, gthreads = F.G * NWAVES * 64;
    cvt_array_bf16(F.pu, F.UB, (size_t)NEXP * D / 8, gtid, gthreads);
    cvt_array_bf16(F.pv, F.VB, (size_t)NEXP * D / 8, gtid, gthreads);
    cvt_array_bf16(F.keys1, F.KEYS, (size_t)8 * 128 * 128 / 8, gtid, gthreads);
    cvt_array_bf16(F.keys2, F.KEYS + 8 * 128 * 128, (size_t)8 * 128 * 128 / 8, gtid, gthreads);
}

__device__ __forceinline__ int crow(int r, int hi) { return (r & 3) + 8 * (r >> 2) + 4 * hi; }
constexpr int VPITCH = 192;
__device__ __forceinline__ void stage_v(const bf16* Vt, LAS unsigned char* wl, int lane) {
    const int row = lane >> 1, hf = lane & 1;
    const GAS u32x4* src = (const GAS u32x4*)(Vt + (size_t)row * DIN + 32 * hf);
    const u32x4 a = src[0], b = src[1], c = src[2], d = src[3];
    LAS u32x4* dst = (LAS u32x4*)(wl + row * VPITCH + hf * 64);
    dst[0] = a; dst[1] = b; dst[2] = c; dst[3] = d;
}
__device__ __forceinline__ bf16x8 vfrag(const LAS unsigned char* wl, int dblk, int s, int lane) {
    const int hi = lane >> 5, i = lane & 15, g1 = (lane >> 4) & 1;
    const LAS unsigned char* p = wl + (16 * s + 4 * hi + (i >> 2)) * VPITCH + (32 * dblk + 16 * g1 + 4 * (i & 3)) * 2;
    const v4i16_t lo = __builtin_amdgcn_ds_read_tr16_b64_v4i16((LAS v4i16_t*)p);
    const v4i16_t hh = __builtin_amdgcn_ds_read_tr16_b64_v4i16((LAS v4i16_t*)(p + 8 * VPITCH));
    return (bf16x8){lo[0], lo[1], lo[2], lo[3], hh[0], hh[1], hh[2], hh[3]};
}
__device__ __forceinline__ bf16x8 pack8(const f32x16& a, int s) {
    u32x4 w; w.x = pk2(a[8 * s + 0], a[8 * s + 1]); w.y = pk2(a[8 * s + 2], a[8 * s + 3]); w.z = pk2(a[8 * s + 4], a[8 * s + 5]); w.w = pk2(a[8 * s + 6], a[8 * s + 7]);
    return __builtin_bit_cast(bf16x8, w);
}
__device__ __forceinline__ void head_norm_store(const f32x16& o0, const f32x16& o1, float scale, const float* g, bf16* dstrow, int hi) {
    float ss = 0.f;
#pragma unroll
    for (int r = 0; r < 16; ++r) { const float a = o0[r] * scale, b = o1[r] * scale; ss += a * a + b * b; }
    ss += __shfl_xor(ss, 32);
    const float rs = __builtin_amdgcn_rsqf(ss * (1.f / 64.f) + EPS) * scale;
#pragma unroll
    for (int dblk = 0; dblk < 2; ++dblk)
#pragma unroll
        for (int q4 = 0; q4 < 4; ++q4) { const int d0 = 32 * dblk + 8 * q4 + 4 * hi; const f32x4 gg = *(const GAS f32x4*)(g + d0);
            const f32x16& o = dblk ? o1 : o0;
            u32x2 w; w.x = pk2(o[4 * q4 + 0] * rs * gg.x, o[4 * q4 + 1] * rs * gg.y); w.y = pk2(o[4 * q4 + 2] * rs * gg.z, o[4 * q4 + 3] * rs * gg.w);
            *(GAS u32x2*)(dstrow + d0) = w; }
}

__device__ __forceinline__ void sb_item(Frame& F, int b, int h, int qb, LAS unsigned char* wl) {
    const int lane = F.lane, r32 = lane & 31, hi = lane >> 5;
    const size_t rowbase = (size_t)b * SEQ;
    const bf16* Qp = F.QKV + (rowbase + 32 * qb + r32) * DIN + C_SBQ + h * 64;
    const bf16* Kb = F.QKV + rowbase * DIN + C_SBK + h * 64;
    const bf16* Vb = F.QKV + rowbase * DIN + C_SBV + h * 64;
    bf16x8 qr[4];
#pragma unroll
    for (int d0 = 0; d0 < 4; ++d0) qr[d0] = *(const GAS bf16x8*)(Qp + 16 * d0 + 8 * hi);
    bf16x8 tri[2];
#pragma unroll
    for (int s = 0; s < 2; ++s)
#pragma unroll
        for (int j = 0; j < 8; ++j) tri[s][j] = (16 * s + 8 * (j >> 2) + 4 * hi + (j & 3) >= r32) ? (short)0x3F80 : (short)0;
    f32x16 o0 = {}, o1 = {}; float C = 0.f;
    for (int kt = qb; kt >= 0; --kt) {
        const bf16* Kp = Kb + (size_t)(32 * kt + r32) * DIN;
        bf16x8 kf[4];
#pragma unroll
        for (int d0 = 0; d0 < 4; ++d0) kf[d0] = *(const GAS bf16x8*)(Kp + 16 * d0 + 8 * hi);
        stage_v(Vb + (size_t)(32 * kt) * DIN, wl, lane);
        f32x16 z = {};
#pragma unroll
        for (int d0 = 0; d0 < 4; ++d0) z = __builtin_amdgcn_mfma_f32_32x32x16_bf16(kf[d0], qr[d0], z, 0, 0, 0);
        const int lim = r32 + 32 * (qb - kt);
        f32x16 l, ls;
#pragma unroll
        for (int r = 0; r < 16; ++r) {
            const float zz = z[r] * 0.125f;
            const float e = __builtin_amdgcn_exp2f(-__builtin_fabsf(zz) * LOG2E);
            const float sp = __builtin_fmaxf(zz, 0.f) + LN2 * __builtin_amdgcn_logf(1.0f + e);
            const bool valid = crow(r, hi) < lim;
            l[r] = valid ? -sp : 0.f;
            ls[r] = zz - sp;
        }
        f32x16 lo;
        bf16x8 lh[2], ll[2];
#pragma unroll
        for (int s = 0; s < 2; ++s) {
            u32x4 wh, wlw;
#pragma unroll
            for (int p = 0; p < 4; ++p) { const float a = l[8 * s + 2 * p], c = l[8 * s + 2 * p + 1]; const unsigned w = pk2(a, c); wh[p] = w; lo[8 * s + 2 * p] = a - bf_lo(w); lo[8 * s + 2 * p + 1] = c - bf_hi(w); }
#pragma unroll
            for (int p = 0; p < 4; ++p) wlw[p] = pk2(lo[8 * s + 2 * p], lo[8 * s + 2 * p + 1]);
            lh[s] = __builtin_bit_cast(bf16x8, wh); ll[s] = __builtin_bit_cast(bf16x8, wlw);
        }
        f32x16 Y = {};
        Y = __builtin_amdgcn_mfma_f32_32x32x16_bf16(tri[0], lh[0], Y, 0, 0, 0);
        Y = __builtin_amdgcn_mfma_f32_32x32x16_bf16(tri[1], lh[1], Y, 0, 0, 0);
        Y = __builtin_amdgcn_mfma_f32_32x32x16_bf16(tri[0], ll[0], Y, 0, 0, 0);
        Y = __builtin_amdgcn_mfma_f32_32x32x16_bf16(tri[1], ll[1], Y, 0, 0, 0);
        f32x16 a;
#pragma unroll
        for (int r = 0; r < 16; ++r) {
            const bool valid = crow(r, hi) < lim;
            const float later = C + (Y[r] - l[r]);
            const float av = __builtin_amdgcn_exp2f((ls[r] + later) * LOG2E);
            a[r] = valid ? av : 0.f;
        }
        const float tot = __shfl(Y[0], r32);
        C += tot;
        const bf16x8 a0 = pack8(a, 0), a1 = pack8(a, 1);
        o0 = __builtin_amdgcn_mfma_f32_32x32x16_bf16(vfrag(wl, 0, 0, lane), a0, o0, 0, 0, 0);
        o0 = __builtin_amdgcn_mfma_f32_32x32x16_bf16(vfrag(wl, 0, 1, lane), a1, o0, 0, 0, 0);
        o1 = __builtin_amdgcn_mfma_f32_32x32x16_bf16(vfrag(wl, 1, 0, lane), a0, o1, 0, 0, 0);
        o1 = __builtin_amdgcn_mfma_f32_32x32x16_bf16(vfrag(wl, 1, 1, lane), a1, o1, 0, 0, 0);
        if (__all(C < SB_EXIT)) break;
    }
    head_norm_store(o0, o1, 1.0f, F.sb_g + h * 64, F.MIX + (rowbase + 32 * qb + r32) * D + h * 64, hi);
}

__device__ __forceinline__ void swa_item(Frame& F, int b, int hq, int qb, LAS unsigned char* wl) {
    const int lane = F.lane, r32 = lane & 31, hi = lane >> 5, kv = hq >> 2;
    const size_t rowbase = (size_t)b * SEQ;
    const bf16* Qp = F.QKV + (rowbase + 32 * qb + r32) * DIN + C_SWQ + hq * 64;
    const bf16* Kb = F.QKV + rowbase * DIN + C_SWK + kv * 64;
    const bf16* Vb = F.QKV + rowbase * DIN + C_SWV + kv * 64;
    const float slope = __builtin_amdgcn_exp2f(-(float)(hq + 1));
    const float sink = F.sinks[hq];
    bf16x8 qr[4];
#pragma unroll
    for (int d0 = 0; d0 < 4; ++d0) qr[d0] = *(const GAS bf16x8*)(Qp + 16 * d0 + 8 * hi);
    float mx = sink;
    const int kt0 = qb - 4 < 0 ? 0 : qb - 4;
    for (int kt = kt0; kt <= qb; ++kt) {
        const bf16* Kp = Kb + (size_t)(32 * kt + r32) * DIN;
        f32x16 z = {};
#pragma unroll
        for (int d0 = 0; d0 < 4; ++d0) { const bf16x8 kf = *(const GAS bf16x8*)(Kp + 16 * d0 + 8 * hi); z = __builtin_amdgcn_mfma_f32_32x32x16_bf16(kf, qr[d0], z, 0, 0, 0); }
        const int dq = 32 * (qb - kt) + r32 - 4 * hi;
#pragma unroll
        for (int r = 0; r < 16; ++r) {
            const int dist = dq - ((r & 3) + 8 * (r >> 2));
            const float s = z[r] * 0.125f - slope * (float)dist;
            mx = __builtin_fmaxf(mx, ((unsigned)dist < 128u) ? s : -INFINITY);
        }
    }
    mx = __builtin_fmaxf(mx, __shfl_xor(mx, 32));
    float den = 0.f;
    f32x16 o0 = {}, o1 = {};
    for (int kt = kt0; kt <= qb; ++kt) {
        const bf16* Kp = Kb + (size_t)(32 * kt + r32) * DIN;
        stage_v(Vb + (size_t)(32 * kt) * DIN, wl, lane);
        f32x16 z = {};
#pragma unroll
        for (int d0 = 0; d0 < 4; ++d0) { const bf16x8 kf = *(const GAS bf16x8*)(Kp + 16 * d0 + 8 * hi); z = __builtin_amdgcn_mfma_f32_32x32x16_bf16(kf, qr[d0], z, 0, 0, 0); }
        const int dq = 32 * (qb - kt) + r32 - 4 * hi;
        f32x16 p;
#pragma unroll
        for (int r = 0; r < 16; ++r) {
            const int dist = dq - ((r & 3) + 8 * (r >> 2));
            const float s = z[r] * 0.125f - slope * (float)dist;
            const float e = __builtin_amdgcn_exp2f((s - mx) * LOG2E);
            p[r] = ((unsigned)dist < 128u) ? e : 0.f;
            den += p[r];
        }
        const bf16x8 a0 = pack8(p, 0), a1 = pack8(p, 1);
        o0 = __builtin_amdgcn_mfma_f32_32x32x16_bf16(vfrag(wl, 0, 0, lane), a0, o0, 0, 0, 0);
        o0 = __builtin_amdgcn_mfma_f32_32x32x16_bf16(vfrag(wl, 0, 1, lane), a1, o0, 0, 0, 0);
        o1 = __builtin_amdgcn_mfma_f32_32x32x16_bf16(vfrag(wl, 1, 0, lane), a0, o1, 0, 0, 0);
        o1 = __builtin_amdgcn_mfma_f32_32x32x16_bf16(vfrag(wl, 1, 1, lane), a1, o1, 0, 0, 0);
    }
    den += __shfl_xor(den, 32);
    den += __builtin_amdgcn_exp2f((sink - mx) * LOG2E);
    head_norm_store(o0, o1, 1.0f / den, F.sw_g + hq * 64, F.MIX + (rowbase + 32 * qb + r32) * D + 512 + hq * 64, hi);
}
__device__ __forceinline__ void p2_attention(Frame& F) {
    LAS unsigned char* wl = F.lds + F.wave * 8192;
    const int gw = F.vcu * NWAVES + F.wave, NGW = F.G * NWAVES;
    constexpr int NSB = NB * 8 * 128, NSW = NB * 8 * 128;
    for (int it = gw; it < NSB + NSW; it += NGW) {
        if (it < NSB) { const int qb = it & 127, h = (it >> 7) & 7, b = it >> 10; sb_item(F, b, h, qb, wl); }
        else { const int r = it - NSB; const int qb = r & 127, h = (r >> 7) & 7, b = r >> 10; swa_item(F, b, h, qb, wl); }
    }
}

__device__ __forceinline__ int f2ord(unsigned bits) { int x = (int)bits; return x ^ ((x >> 31) & 0x7fffffff); }
template <int N> __device__ __forceinline__ void bitonic_desc(int (&v)[N]) {
#pragma unroll
    for (int k = 2; k <= N; k <<= 1) {
#pragma unroll
        for (int j = k >> 1; j > 0; j >>= 1) {
#pragma unroll
            for (int i = 0; i < N; ++i) {
                const int l = i ^ j;
                if (l > i) { const bool up = ((i & k) == 0); const int a = v[i], b = v[l]; const int mx = a > b ? a : b, mn = a > b ? b : a; v[i] = up ? mx : mn; v[l] = up ? mn : mx; }
            }
        }
    }
}
template <int N> __device__ __forceinline__ void bitonic_merge_desc(int (&v)[N]) {
#pragma unroll
    for (int j = N >> 1; j > 0; j >>= 1) {
#pragma unroll
        for (int i = 0; i < N; ++i) { const int l = i ^ j; if (l > i) { const int a = v[i], b = v[l]; v[i] = a > b ? a : b; v[l] = a > b ? b : a; } }
    }
}
template <int N> __device__ __forceinline__ void bitonic_desc_kv(int (&k)[N], int (&p)[N]) {
#pragma unroll
    for (int kk = 2; kk <= N; kk <<= 1) {
#pragma unroll
        for (int j = kk >> 1; j > 0; j >>= 1) {
#pragma unroll
            for (int i = 0; i < N; ++i) {
                const int l = i ^ j;
                if (l > i) { const bool up = ((i & kk) == 0); const bool sw = up ? (k[i] < k[l]) : (k[i] > k[l]);
                    const int ka = k[i], kb = k[l], pa = p[i], pb = p[l]; k[i] = sw ? kb : ka; k[l] = sw ? ka : kb; p[i] = sw ? pb : pa; p[l] = sw ? pa : pb; }
            }
        }
    }
}
struct Cand { unsigned char i, j; };
struct CandTable { Cand c[64]; int n; };
constexpr CandTable make_cands() { CandTable t{}; int n = 0; for (int i = 0; i < 16; ++i) for (int j = 0; j < 16; ++j) if ((i + 1) * (j + 1) <= 16) { t.c[n].i = (unsigned char)i; t.c[n].j = (unsigned char)j; ++n; } t.n = n; return t; }
constexpr CandTable CANDS = make_cands();
static_assert(CANDS.n == 50, "candidate count");

__device__ __forceinline__ void p6_item(Frame& F, int tb, int h) {
    const int lane = F.lane, r32 = lane & 31, hi = lane >> 5;
    const bf16* QP = F.QKV;
    const bf16* qrow = QP + (size_t)(32 * tb + r32) * DQ + h * 256;
    int top[2][16];
#pragma unroll
    for (int half = 0; half < 2; ++half) {
        bf16x8 qf[8];
#pragma unroll
        for (int ks = 0; ks < 8; ++ks) qf[ks] = *(const GAS bf16x8*)(qrow + half * 128 + 16 * ks + 8 * hi);
        const bf16* kb = F.KEYS + (size_t)(half * 8 + h) * 128 * 128;
        int v[64];
#pragma unroll
        for (int nt = 0; nt < 4; ++nt) {
            f32x16 acc = {};
#pragma unroll
            for (int ks = 0; ks < 8; ++ks) { const bf16x8 kf = *(const GAS bf16x8*)(kb + (size_t)(32 * nt + r32) * 128 + 16 * ks + 8 * hi); acc = __builtin_amdgcn_mfma_f32_32x32x16_bf16(kf, qf[ks], acc, 0, 0, 0); }
#pragma unroll
            for (int r = 0; r < 16; ++r) { const float av = acc[r]; const unsigned bits = (f_bits(av) & ~0x7Fu) | (unsigned)(32 * nt + crow(r, hi)); v[16 * nt + r] = f2ord(bits); }
        }
        bitonic_desc<64>(v);
        int m[16];
#pragma unroll
        for (int i = 0; i < 16; ++i) { const int o = __shfl_xor(v[15 - i], 32); m[i] = v[i] > o ? v[i] : o; }
        bitonic_merge_desc<16>(m);
#pragma unroll
        for (int i = 0; i < 16; ++i) top[half][i] = m[i];
    }
    float f1[16], f2[16]; int i1[16], i2[16];
#pragma unroll
    for (int i = 0; i < 16; ++i) { const unsigned b1 = (unsigned)f2ord((unsigned)top[0][i]), b2 = (unsigned)f2ord((unsigned)top[1][i]);
        f1[i] = bits_f(b1 & ~0x7Fu); i1[i] = (int)(b1 & 0x7Fu); f2[i] = bits_f(b2 & ~0x7Fu); i2[i] = (int)(b2 & 0x7Fu); }
    int ck[32], cp[32];
#pragma unroll
    for (int s = 0; s < 32; ++s) {
        if (s < 25) { constexpr int dummy = 0; (void)dummy;
            const int ia = CANDS.c[2 * s].i, ja = CANDS.c[2 * s].j, ib = CANDS.c[2 * s + 1].i, jb = CANDS.c[2 * s + 1].j;
            const float sa = f1[ia] + f2[ja], sb = f1[ib] + f2[jb]; const int pa = (i1[ia] << 7) | i2[ja], pb = (i1[ib] << 7) | i2[jb];
            ck[s] = f2ord(f_bits(hi ? sb : sa)); cp[s] = hi ? pb : pa;
        } else { ck[s] = (int)0x80000000; cp[s] = 0; }
    }
    bitonic_desc_kv<32>(ck, cp);
    int wk[16], wp[16];
#pragma unroll
    for (int i = 0; i < 16; ++i) { const int ok = __shfl_xor(ck[15 - i], 32), op = __shfl_xor(cp[15 - i], 32); const bool t = ck[i] >= ok; wk[i] = t ? ck[i] : ok; wp[i] = t ? cp[i] : op; }
    float vals[16]; float mxv = -INFINITY;
#pragma unroll
    for (int i = 0; i < 16; ++i) { vals[i] = bits_f((unsigned)f2ord((unsigned)wk[i])); mxv = __builtin_fmaxf(mxv, vals[i]); }
    float se = 0.f;
#pragma unroll
    for (int i = 0; i < 16; ++i) { vals[i] = __builtin_amdgcn_exp2f((vals[i] - mxv) * LOG2E); se += vals[i]; }
    const float inv = 1.0f / se;
    const size_t ob = (size_t)(32 * tb + r32) * 128 + h * 16 + hi * 8;
    { u32x4 a, b2; a.x = wp[0]; a.y = wp[1]; a.z = wp[2]; a.w = wp[3]; b2.x = wp[4]; b2.y = wp[5]; b2.z = wp[6]; b2.w = wp[7];
      *(GAS u32x4*)(F.IDX + ob) = a; *(GAS u32x4*)(F.IDX + ob + 4) = b2;
      f32x4 ga = {vals[0] * inv, vals[1] * inv, vals[2] * inv, vals[3] * inv}, gb = {vals[4] * inv, vals[5] * inv, vals[6] * inv, vals[7] * inv};
      *(GAS f32x4*)(F.GATE + ob) = ga; *(GAS f32x4*)(F.GATE + ob + 4) = gb; }
}
__device__ __forceinline__ void p6_topk(Frame& F) {
    const int gw = F.vcu * NWAVES + F.wave, NGW = F.G * NWAVES;
    for (int it = gw; it < (T / 32) * 8; it += NGW) p6_item(F, it >> 3, it & 7);
}

__device__ __forceinline__ float dot2(unsigned a, unsigned b, float c) { return __builtin_amdgcn_fdot2_f32_bf16(__builtin_bit_cast(bf16x2_t, a), __builtin_bit_cast(bf16x2_t, b), c, false); }
__device__ __forceinline__ float dot8(const u32x4& r, const u32x4& x, float c) {
    const unsigned r0 = r.x, r1 = r.y, r2 = r.z, r3 = r.w, x0 = x.x, x1 = x.y, x2 = x.z, x3 = x.w;
    c = dot2(r0, x0, c); c = dot2(r1, x1, c); c = dot2(r2, x2, c); c = dot2(r3, x3, c);
    return c;
}
__device__ __forceinline__ void axpy8(float (&acc)[8], const u32x4& r, float c) {
    acc[0] += c * bf_lo(r.x); acc[1] += c * bf_hi(r.x); acc[2] += c * bf_lo(r.y); acc[3] += c * bf_hi(r.y);
    acc[4] += c * bf_lo(r.z); acc[5] += c * bf_hi(r.z); acc[6] += c * bf_lo(r.w); acc[7] += c * bf_hi(r.w);
}
__device__ __forceinline__ float gelu_tanh(float x) {
    const float y2 = 1.5957691216057308f * (x + 0.044715f * x * x * x);
    return x / (1.0f + __builtin_amdgcn_exp2f(-y2 * LOG2E));
}
__device__ __forceinline__ void p7_token(Frame& F, int tok) {
    const int lane = F.lane;
    const bf16* xr = F.H + (size_t)tok * D;
    const u32x4 xa = *(const GAS u32x4*)(xr + 8 * lane), xb = *(const GAS u32x4*)(xr + 512 + 8 * lane);
    const int id0 = F.IDX[(size_t)tok * 128 + lane], id1 = F.IDX[(size_t)tok * 128 + 64 + lane];
    const float g0 = F.GATE[(size_t)tok * 128 + lane], g1 = F.GATE[(size_t)tok * 128 + 64 + lane];
    float d0 = 0.f, d1 = 0.f;
    for (int eb = 0; eb < 128; eb += 8) {
        u32x4 ra[8], rb[8];
#pragma unroll
        for (int j = 0; j < 8; ++j) { const int id = __builtin_amdgcn_readlane(eb < 64 ? id0 : id1, (eb + j) & 63);
            const bf16* p = F.UB + (size_t)id * D; ra[j] = *(const GAS u32x4*)(p + 8 * lane); rb[j] = *(const GAS u32x4*)(p + 512 + 8 * lane); }
#pragma unroll
        for (int j = 0; j < 8; ++j) { float p = dot8(ra[j], xa, 0.f); p = dot8(rb[j], xb, p); p = wave_sum(p);
            if (eb < 64) d0 = (lane == ((eb + j) & 63)) ? p : d0; else d1 = (lane == ((eb + j) & 63)) ? p : d1; }
    }
    const float c0 = g0 * gelu_tanh(d0), c1 = g1 * gelu_tanh(d1);
    float accA[8], accB[8];
#pragma unroll
    for (int i = 0; i < 8; ++i) { accA[i] = 0.f; accB[i] = 0.f; }
    for (int eb = 0; eb < 128; eb += 8) {
        u32x4 ra[8], rb[8];
#pragma unroll
        for (int j = 0; j < 8; ++j) { const int id = __builtin_amdgcn_readlane(eb < 64 ? id0 : id1, (eb + j) & 63);
            const bf16* p = F.VB + (size_t)id * D; ra[j] = *(const GAS u32x4*)(p + 8 * lane); rb[j] = *(const GAS u32x4*)(p + 512 + 8 * lane); }
#pragma unroll
        for (int j = 0; j < 8; ++j) { const float c = bits_f((unsigned)__builtin_amdgcn_readlane((int)f_bits(eb < 64 ? c0 : c1), (eb + j) & 63));
            axpy8(accA, ra[j], c); axpy8(accB, rb[j], c); }
    }
    float* orow = F.out + (size_t)tok * D;
    const f32x4 xa0 = *(const GAS f32x4*)(orow + 8 * lane), xa1 = *(const GAS f32x4*)(orow + 8 * lane + 4), xb0 = *(const GAS f32x4*)(orow + 512 + 8 * lane), xb1 = *(const GAS f32x4*)(orow + 512 + 8 * lane + 4);
    float y[16]; y[0] = xa0.x + accA[0]; y[1] = xa0.y + accA[1]; y[2] = xa0.z + accA[2]; y[3] = xa0.w + accA[3]; y[4] = xa1.x + accA[4]; y[5] = xa1.y + accA[5]; y[6] = xa1.z + accA[6]; y[7] = xa1.w + accA[7];
    y[8] = xb0.x + accB[0]; y[9] = xb0.y + accB[1]; y[10] = xb0.z + accB[2]; y[11] = xb0.w + accB[3]; y[12] = xb1.x + accB[4]; y[13] = xb1.y + accB[5]; y[14] = xb1.z + accB[6]; y[15] = xb1.w + accB[7];
    float ss = 0.f;
#pragma unroll
    for (int i = 0; i < 16; ++i) ss += y[i] * y[i];
    const float rs = __builtin_amdgcn_rsqf(wave_sum(ss) * (1.f / D) + EPS);
    const f32x4 ga0 = *(const GAS f32x4*)(F.gf + 8 * lane), ga1 = *(const GAS f32x4*)(F.gf + 8 * lane + 4), gb0 = *(const GAS f32x4*)(F.gf + 512 + 8 * lane), gb1 = *(const GAS f32x4*)(F.gf + 512 + 8 * lane + 4);
    *(GAS f32x4*)(orow + 8 * lane) = (f32x4){y[0] * rs * ga0.x, y[1] * rs * ga0.y, y[2] * rs * ga0.z, y[3] * rs * ga0.w};
    *(GAS f32x4*)(orow + 8 * lane + 4) = (f32x4){y[4] * rs * ga1.x, y[5] * rs * ga1.y, y[6] * rs * ga1.z, y[7] * rs * ga1.w};
    *(GAS f32x4*)(orow + 512 + 8 * lane) = (f32x4){y[8] * rs * gb0.x, y[9] * rs * gb0.y, y[10] * rs * gb0.z, y[11] * rs * gb0.w};
    *(GAS f32x4*)(orow + 512 + 8 * lane + 4) = (f32x4){y[12] * rs * gb1.x, y[13] * rs * gb1.y, y[14] * rs * gb1.z, y[15] * rs * gb1.w};
}

struct Args { const float* in[14]; float* out; unsigned char* ws; int ph_lo, ph_hi, li, pad; };
__global__ void __launch_bounds__(NWAVES * 64, 2) mk_fwd(Args args) {
    extern __shared__ __attribute__((aligned(16))) unsigned char lds[];
    Frame F;
    F.lds = (LAS unsigned char*)lds;
    F.MISC = (volatile LAS unsigned*)(F.lds + MISC_OFF);
    F.tid = threadIdx.x; F.lane = F.tid & 63; F.wave = __builtin_amdgcn_readfirstlane(F.tid >> 6);
    F.G = gridDim.x; { const int bx = blockIdx.x; F.vcu = (F.G % 8 == 0) ? (bx % 8) * (F.G / 8) + bx / 8 : bx; }
    unsigned char* ws = args.ws;
    F.ctl = (gu32*)(ws + WS_CTL);
    F.x = args.in[0]; F.g1 = args.in[1]; F.w_in = args.in[2]; F.sb_g = args.in[3]; F.sw_g = args.in[4]; F.sinks = args.in[5]; F.w_out = args.in[6]; F.g2 = args.in[7];
    F.w_q = args.in[8]; F.keys1 = args.in[9]; F.keys2 = args.in[10]; F.pu = args.in[11]; F.pv = args.in[12]; F.gf = args.in[13]; F.out = args.out;
    F.Wt_in = (bf16*)(ws + WS_WIN); F.Wt_out = (bf16*)(ws + WS_WOUT); F.Wt_q = (bf16*)(ws + WS_WQ); F.KEYS = (bf16*)(ws + WS_KEYS);
    F.H = (bf16*)(ws + WS_H); F.MIX = (bf16*)(ws + WS_MIX); F.QKV = (bf16*)(ws + WS_QKV); F.UB = (bf16*)(ws + WS_UB); F.VB = (bf16*)(ws + WS_VB);
    F.IDX = (int*)(ws + WS_IDX); F.GATE = (float*)(ws + WS_GATE);
    for (int u = F.tid; u < (LDS_BYTES - LDSCTL_OFF) / 4; u += NWAVES * 64) ((LAS unsigned*)(F.lds + LDSCTL_OFF))[u] = 0u;
    __syncthreads();
    const int lo = args.ph_lo, hi = args.ph_hi;
    const bool use_bar = (hi - lo) > 1;
    XcdBarrier bar; bar.bar = (unsigned*)(F.ctl + CW_BAR) + args.li * XCD_BAR_WORDS; bar.x = 0; bar.st = nullptr;
    if (use_bar) bar = xcd_barrier_post((unsigned*)(F.ctl + CW_BAR) + args.li * XCD_BAR_WORDS, F.MISC + 8);
#ifndef PHMASK
#define PHMASK 255
#endif
#define IN(k) (((PHMASK >> (k)) & 1) && lo <= (k) && (k) < hi)
#define SEAM(k) do { if (IN(k) && IN((k) + 1)) xcd_barrier(bar); } while (0)
    const int gw = F.vcu * NWAVES + F.wave, NGW = F.G * NWAVES;

    if (IN(0)) { p0_prologue(F); } SEAM(0);
    if (IN(1)) { pg8::Gemm g{F.H, F.Wt_in, T, DIN, D}; pg8::StaticOrder S; S.init(T, DIN, F.G, (int)blockIdx.x); pg8::EpiBf16 E{F.QKV, DIN};
        pg8::gemm_phase<pg8::EpiBf16, pg8::StaticOrder>(F.lds, g, S, E); } SEAM(1);
    if (IN(2)) { p2_attention(F); } SEAM(2);
    if (IN(3)) { pg8::Gemm g{F.MIX, F.Wt_out, T, D, D}; pg8::StaticOrder S; S.init(T, D, F.G, (int)blockIdx.x); pg8::EpiResF32 E{F.x, F.out, D};
        pg8::gemm_phase<pg8::EpiResF32, pg8::StaticOrder>(F.lds, g, S, E); } SEAM(3);
    if (IN(4)) { for (int m = gw; m < T; m += NGW) rms_row_to_bf16(F.out + (size_t)m * D, F.g2, F.H + (size_t)m * D, F.lane); } SEAM(4);
    if (IN(5)) { pg8::Gemm g{F.H, F.Wt_q, T, DQ, D}; pg8::StaticOrder S; S.init(T, DQ, F.G, (int)blockIdx.x); pg8::EpiBf16 E{F.QKV, DQ};
        pg8::gemm_phase<pg8::EpiBf16, pg8::StaticOrder>(F.lds, g, S, E); } SEAM(5);
    if (IN(6)) { p6_topk(F); } SEAM(6);
    if (IN(7)) { for (int tok = gw; tok < T; tok += NGW) p7_token(F, tok); }
#undef IN
#undef SEAM
}

extern "C" void kernel_launch(void* const* d_in, const int* in_sizes, int n_in, void* d_out, int out_size, void* d_ws, size_t ws_size, hipStream_t stream) {
    static int grid = 0;
    if (grid == 0) {
        if (n_in != 14 || in_sizes[0] != T * D || out_size != T * D || ws_size < WS_END) { fprintf(stderr, "kernel_launch: unexpected shapes (n_in %d, in0 %d, out %d, ws %zu)\n", n_in, n_in > 0 ? in_sizes[0] : -1, out_size, ws_size); grid = -1; return; }
        int dev = 0, cus = 0, per_cu = 0;
        if (hipGetDevice(&dev) != hipSuccess || hipDeviceGetAttribute(&cus, hipDeviceAttributeMultiprocessorCount, dev) != hipSuccess) { grid = -1; return; }
        if (hipFuncSetAttribute((const void*)mk_fwd, hipFuncAttributeMaxDynamicSharedMemorySize, LDS_BYTES) != hipSuccess) { fprintf(stderr, "kernel_launch: hipFuncSetAttribute failed\n"); grid = -1; return; }
        if (hipOccupancyMaxActiveBlocksPerMultiprocessor(&per_cu, (const void*)mk_fwd, NWAVES * 64, LDS_BYTES) != hipSuccess || per_cu < 1)
            fprintf(stderr, "kernel_launch: note: occupancy query reports %d workgroups per CU\n", per_cu);
        (void)hipGetLastError();
        grid = cus;
    }
    if (grid < 0) return;
    if (hipMemsetAsync((char*)d_ws + WS_CTL, 0, CTL_ZERO_BYTES, stream) != hipSuccess) { fprintf(stderr, "kernel_launch: hipMemsetAsync failed\n"); return; }
    Args a{};
    for (int i = 0; i < 14; ++i) a.in[i] = (const float*)d_in[i];
    a.out = (float*)d_out; a.ws = (unsigned char*)d_ws;
#if MK_N_LAUNCHES == 1
    a.ph_lo = 0; a.ph_hi = N_PHASES; a.li = 0;
    hipLaunchKernelGGL(mk_fwd, dim3(grid), dim3(NWAVES * 64), LDS_BYTES, stream, a);
#else
    for (int li = 0; li < N_PHASES; ++li) { a.ph_lo = li; a.ph_hi = li + 1; a.li = 0; hipLaunchKernelGGL(mk_fwd, dim3(grid), dim3(NWAVES * 64), LDS_BYTES, stream, a); }
#endif
    const hipError_t le = hipPeekAtLastError();
    if (le != hipSuccess) fprintf(stderr, "kernel_launch: launch failed: %s\n", hipGetErrorName(le));
}
```

```cpp
#include <hip/hip_runtime.h>
#include <cstdio>
#include <cstdint>

#ifndef MK_N_LAUNCHES
#define MK_N_LAUNCHES 1
#endif

#define LAS __attribute__((address_space(3)))
#define GAS __attribute__((address_space(1)))
typedef unsigned short bf16;
typedef short bf16x8 __attribute__((ext_vector_type(8)));
typedef float f32x4 __attribute__((ext_vector_type(4)));
typedef float f32x16 __attribute__((ext_vector_type(16)));
typedef unsigned u32x4 __attribute__((ext_vector_type(4)));
typedef unsigned u32x2 __attribute__((ext_vector_type(2)));
typedef short v4i16_t __attribute__((ext_vector_type(4)));
typedef float f32x2_t __attribute__((ext_vector_type(2)));
typedef __bf16 bf16x2_t __attribute__((ext_vector_type(2)));
typedef GAS unsigned gu32;

constexpr int T = 16384, SEQ = 4096, NB = 4, D = 1024, DIN = 2304, DQ = 2048;
constexpr int C_SBQ = 0, C_SBK = 512, C_SBV = 1024, C_SWQ = 1536, C_SWK = 2048, C_SWV = 2176;
constexpr int NEXP = 16384;
constexpr float EPS = 1e-6f;
constexpr float LOG2E = 1.4426950408889634f, LN2 = 0.6931471805599453f;
constexpr float SB_EXIT = -40.0f;

namespace pg8 {
constexpr int BM = 256, BK = 64, HALF = 128, HTB = HALF * BK * 2, STAGE_BYTES = 8 * HTB, NXCD = 8, WGM = 8;
__host__ __device__ __forceinline__ int lds_byte(int r, int c) { const int st = (r >> 4) * 2 + (c >> 5), rr = r & 15, cc = c & 31, ob = rr * 64 + cc * 2; return st * 1024 + (ob ^ (((ob >> 9) & 1) << 5)); }
__host__ __device__ __forceinline__ void stage_rc(int b, int& R, int& C) { const int st = b / 1024, sb = b % 1024, swz = sb ^ (((sb >> 9) & 1) << 5); R = (st >> 1) * 16 + swz / 64; C = (st & 1) * 32 + (swz % 64) / 2; }
__host__ __device__ __forceinline__ int perm32(int rho) { const int n = rho >> 4, i = rho & 15; return 8 * (i >> 2) + 4 * n + (i & 3); }
struct Unit { int pm, pn; };
struct Gemm { const bf16* A; const bf16* Bt; int M, N, K; };
struct StaticOrder {
    int nM, nN, nwg, G, c;
    __host__ __device__ void init(int M, int N, int G_, int c_) { nM = M / BM; nN = N / BM; nwg = nM * nN; G = G_; c = c_; }
    __host__ __device__ bool next(int i, Unit& u) const {
        const long L = (long)i * G + c; if (L >= nwg) return false;
        int wgid = (int)L; { const int q = nwg / NXCD, r = nwg % NXCD, xcd = wgid % NXCD, off = wgid / NXCD; wgid = (xcd < r ? xcd * (q + 1) : r * (q + 1) + (xcd - r) * q) + off; }
        const int nig = WGM * nN, gid = wgid / nig, fm = gid * WGM, gsz = (nM - fm) < WGM ? (nM - fm) : WGM;
        u.pm = fm + ((wgid % nig) % gsz); u.pn = (wgid % nig) / gsz; return true;
    }
};
__device__ __forceinline__ unsigned cvt_pk_bf16(float lo, float hi) { f32x2_t v = {lo, hi}; bf16x2_t b = __builtin_convertvector(v, bf16x2_t); return __builtin_bit_cast(unsigned, b); }

struct EpiBf16 {
    static constexpr bool PERM = true;
    bf16* O; int ldc;
    __device__ __forceinline__ void operator()(const f32x4 (&acc)[2][2][4][2], const Unit& u, int wr, int wc, int fr, int fq) const {
        const int row0 = u.pm * BM + wr * 64 + fr; const int col0 = u.pn * BM + wc * 32 + 8 * fq;
#pragma unroll
        for (int ai = 0; ai < 2; ++ai)
#pragma unroll
            for (int m = 0; m < 4; ++m) { bf16* rowp = O + (size_t)(row0 + ai * HALF + m * 16) * ldc + col0;
#pragma unroll
                for (int bj = 0; bj < 2; ++bj) { const f32x4 v0 = acc[ai][bj][m][0], v1 = acc[ai][bj][m][1];
                    u32x4 w; w.x = cvt_pk_bf16(v0[0], v0[1]); w.y = cvt_pk_bf16(v0[2], v0[3]); w.z = cvt_pk_bf16(v1[0], v1[1]); w.w = cvt_pk_bf16(v1[2], v1[3]);
                    *(u32x4*)(rowp + bj * HALF) = w; } }
    }
};
struct EpiResF32 {
    static constexpr bool PERM = false;
    const float* base; float* out; int ldc;
    __device__ __forceinline__ void operator()(const f32x4 (&acc)[2][2][4][2], const Unit& u, int wr, int wc, int fr, int fq) const {
        const int col0 = u.pn * BM + wc * 32 + 4 * fq;
#pragma unroll
        for (int ai = 0; ai < 2; ++ai)
#pragma unroll
            for (int m = 0; m < 4; ++m) { const size_t off = (size_t)(u.pm * BM + ai * HALF + wr * 64 + m * 16 + fr) * ldc + col0;
#pragma unroll
                for (int bj = 0; bj < 2; ++bj)
#pragma unroll
                    for (int n = 0; n < 2; ++n) { const f32x4 bs = *(const f32x4*)(base + off + bj * HALF + n * 16); *(f32x4*)(out + off + bj * HALF + n * 16) = bs + acc[ai][bj][m][n]; } }
    }
};

template <class Epi, class Sched>
__device__ __forceinline__ void gemm_phase(LAS unsigned char* lds, const Gemm g, const Sched& S, const Epi& E) {
    const int tid = threadIdx.x, wid = __builtin_amdgcn_readfirstlane(tid >> 6), lane = tid & 63, wr = wid >> 2, wc = wid & 3, fr = lane & 15, fq = lane >> 4;
    const int K = g.K, nt = K / BK;
    unsigned voffA[2], voffB[2];
#pragma unroll
    for (int i = 0; i < 2; ++i) { int R, C; stage_rc(tid * 16 + i * 8192, R, C); const int Rb = Epi::PERM ? ((R & ~31) + perm32(R & 31)) : R;
        voffA[i] = (unsigned)(R * K + C) * 2u; voffB[i] = (unsigned)(Rb * K + C) * 2u; }
    const size_t kstep = (size_t)(BK * 2);
    const size_t hstep = (size_t)HALF * K * 2;
    const size_t tstep = 2 * hstep;
    const unsigned ldsw = (unsigned)wid * 1024u;
    const int aoff = lds_byte(wr * 64 + fr, fq * 8), boff = lds_byte(wc * 32 + fr, fq * 8);
#define PG8_SA(b, h) (((b) * 2 + (h)) * HTB)
#define PG8_SB(b, h) ((4 + (b) * 2 + (h)) * HTB)
#define PG8_STAGE(bufoff, gbase, voff) do { _Pragma("unroll") for (int _i = 0; _i < 2; ++_i) \
        __builtin_amdgcn_global_load_lds((const unsigned*)((const char*)(gbase) + (voff)[_i]), (LAS unsigned*)(lds + (bufoff) + ldsw + _i * 8192), 16, 0, 0); } while (0)
#define PG8_LDA(dst, b, h) do { _Pragma("unroll") for (int m = 0; m < 4; ++m) _Pragma("unroll") for (int k = 0; k < 2; ++k) dst[m][k] = *(const LAS bf16x8*)(lds + PG8_SA(b, h) + aoff + m * 2048 + k * 1024); } while (0)
#define PG8_LDB(dst, b, h) do { _Pragma("unroll") for (int n = 0; n < 2; ++n) _Pragma("unroll") for (int k = 0; k < 2; ++k) dst[n][k] = *(const LAS bf16x8*)(lds + PG8_SB(b, h) + boff + n * 2048 + k * 1024); } while (0)
#define PG8_MMA(ai, bj, At, Bt) do { __builtin_amdgcn_s_setprio(1); _Pragma("unroll") for (int m = 0; m < 4; ++m) _Pragma("unroll") for (int n = 0; n < 2; ++n) _Pragma("unroll") for (int k = 0; k < 2; ++k) \
        acc[ai][bj][m][n] = __builtin_amdgcn_mfma_f32_16x16x32_bf16(Bt[n][k], At[m][k], acc[ai][bj][m][n], 0, 0, 0); __builtin_amdgcn_s_setprio(0); } while (0)
#define PG8_WAIT_V(n) asm volatile("s_waitcnt vmcnt(" #n ")" ::: "memory")
#define PG8_WAIT_L(n) asm volatile("s_waitcnt lgkmcnt(" #n ")" ::: "memory")
#define PG8_BAR __builtin_amdgcn_s_barrier()
#define PG8_SCHED __builtin_amdgcn_sched_barrier(0)
    Unit cur, nxt; int ui = 0;
    if (!S.next(0, cur)) return;
    f32x4 acc[2][2][4][2];
#pragma unroll
    for (int a = 0; a < 2; ++a)
#pragma unroll
        for (int b = 0; b < 2; ++b)
#pragma unroll
            for (int m = 0; m < 4; ++m)
#pragma unroll
                for (int n = 0; n < 2; ++n) acc[a][b][m][n] = (f32x4){0.f, 0.f, 0.f, 0.f};
    bf16x8 At[4][2], B0[2][2], B1[2][2];
    const char* cA = (const char*)g.A + (size_t)cur.pm * tstep; const char* cB = (const char*)g.Bt + (size_t)cur.pn * tstep;
    PG8_STAGE(PG8_SB(0, 0), cB, voffB); PG8_STAGE(PG8_SB(0, 1), cB + hstep, voffB); PG8_STAGE(PG8_SA(0, 0), cA, voffA); PG8_STAGE(PG8_SA(0, 1), cA + hstep, voffA);
    if (wr == 1) PG8_BAR;
    PG8_WAIT_V(2); PG8_BAR;
    PG8_STAGE(PG8_SB(1, 0), cB + kstep, voffB); PG8_STAGE(PG8_SA(1, 0), cA + kstep, voffA); PG8_STAGE(PG8_SB(1, 1), cB + hstep + kstep, voffB);
    PG8_WAIT_V(6); PG8_BAR;
    for (;;) {
        const bool has_next = S.next(ui + 1, nxt);
        const char* nA = has_next ? (const char*)g.A + (size_t)nxt.pm * tstep : cA; const char* nB = has_next ? (const char*)g.Bt + (size_t)nxt.pn * tstep : cB;
        for (int t = 0; t < nt; t += 2) {
            const bool last = (t == nt - 2);
            const char* a1 = cA + (size_t)(t + 1) * kstep;
            const char* a2 = last ? nA : cA + (size_t)(t + 2) * kstep; const char* b2 = last ? nB : cB + (size_t)(t + 2) * kstep;
            const char* a3 = a2 + kstep; const char* b3 = b2 + kstep;
            PG8_LDB(B0, 0, 0); PG8_LDB(B1, 0, 1); PG8_SCHED; PG8_LDA(At, 0, 0); PG8_STAGE(PG8_SA(1, 1), a1 + hstep, voffA);
            PG8_WAIT_V(8); PG8_WAIT_L(0); PG8_BAR; PG8_MMA(0, 0, At, B0); PG8_MMA(0, 1, At, B1); PG8_BAR; PG8_SCHED;
            PG8_LDA(At, 0, 1); PG8_STAGE(PG8_SB(0, 0), b2, voffB); PG8_STAGE(PG8_SB(0, 1), b2 + hstep, voffB); PG8_STAGE(PG8_SA(0, 0), a2, voffA);
            PG8_WAIT_V(8); PG8_WAIT_L(0); PG8_BAR; PG8_MMA(1, 0, At, B0); PG8_MMA(1, 1, At, B1); PG8_BAR; PG8_SCHED;
            PG8_LDB(B0, 1, 0); PG8_LDB(B1, 1, 1); PG8_SCHED; PG8_LDA(At, 1, 0); PG8_STAGE(PG8_SA(0, 1), a2 + hstep, voffA);
            PG8_WAIT_V(8); PG8_WAIT_L(0); PG8_BAR; PG8_MMA(0, 0, At, B0); PG8_MMA(0, 1, At, B1); PG8_BAR; PG8_SCHED;
            PG8_LDA(At, 1, 1); PG8_STAGE(PG8_SB(1, 0), b3, voffB); PG8_STAGE(PG8_SB(1, 1), b3 + hstep, voffB); PG8_STAGE(PG8_SA(1, 0), a3, voffA);
            PG8_WAIT_V(8); PG8_WAIT_L(0); PG8_BAR; PG8_MMA(1, 0, At, B0); PG8_MMA(1, 1, At, B1); PG8_BAR; PG8_SCHED;
        }
        if (wr == 0) PG8_BAR;
        E(acc, cur, wr, wc, fr, fq);
        if (!has_next) break;
#pragma unroll
        for (int a = 0; a < 2; ++a)
#pragma unroll
            for (int b = 0; b < 2; ++b)
#pragma unroll
                for (int m = 0; m < 4; ++m)
#pragma unroll
                    for (int n = 0; n < 2; ++n) acc[a][b][m][n] = (f32x4){0.f, 0.f, 0.f, 0.f};
        cur = nxt; cA = nA; cB = nB; ++ui;
        if (wr == 1) PG8_BAR;
    }
    PG8_WAIT_V(0);
    PG8_BAR;
#undef PG8_SA
#undef PG8_SB
#undef PG8_STAGE
#undef PG8_LDA
#undef PG8_LDB
#undef PG8_MMA
#undef PG8_WAIT_V
#undef PG8_WAIT_L
#undef PG8_BAR
#undef PG8_SCHED
}
}

constexpr int NWAVES = 8;
constexpr int N_PHASES = 8;
constexpr size_t MiB = 1u << 20;
constexpr size_t WS_CTL = 0, CTL_ZERO_BYTES = 1 * MiB;
constexpr size_t WS_WIN = 1 * MiB;
constexpr size_t WS_WOUT = 6 * MiB;
constexpr size_t WS_WQ = 8 * MiB;
constexpr size_t WS_KEYS = 12 * MiB;
constexpr size_t WS_IDX = 13 * MiB;
constexpr size_t WS_GATE = 21 * MiB;
constexpr size_t WS_H = 29 * MiB;
constexpr size_t WS_MIX = 61 * MiB;
constexpr size_t WS_QKV = 93 * MiB;
constexpr size_t WS_UB = 165 * MiB;
constexpr size_t WS_VB = 197 * MiB;
constexpr size_t WS_END = 229 * MiB;
constexpr int CW_BAR = 4096;
constexpr int RING_BYTES = 131072;
constexpr int LDSCTL_OFF = RING_BYTES, MISC_OFF = LDSCTL_OFF + 320;
constexpr int LDS_BYTES = 147456;

#define RLX_AGENT __ATOMIC_RELAXED, __HIP_MEMORY_SCOPE_AGENT
#define LDS_WAIT() asm volatile("s_waitcnt lgkmcnt(0)" ::: "memory")
__device__ __forceinline__ unsigned f2bf(float f) { unsigned u = __builtin_bit_cast(unsigned, f); return (u + 0x7fffu + ((u >> 16) & 1u)) >> 16; }
__device__ __forceinline__ unsigned pk2(float lo, float hi) { return pg8::cvt_pk_bf16(lo, hi); }
__device__ __forceinline__ unsigned f_bits(float f) { return __builtin_bit_cast(unsigned, f); }
__device__ __forceinline__ float bits_f(unsigned u) { return __builtin_bit_cast(float, u); }
__device__ __forceinline__ float bf_lo(unsigned w) { return __builtin_bit_cast(float, w << 16); }
__device__ __forceinline__ float bf_hi(unsigned w) { return __builtin_bit_cast(float, w & 0xffff0000u); }

#define XB_TMO      128
#define XB_XCNT(j)  (256  + 64 * (j))
#define XB_XSUB(j)  (1280 + 64 * (j))
#define XB_XGEN(j)  (2304 + 64 * (j))
#define XB_TOP      3328
#define XB_TOPGEN   3392
#define XCD_BAR_WORDS 3456
#define XB_SPIN_CAP (1u << 18)
__device__ __forceinline__ unsigned xb_ld(unsigned* p)              { return __hip_atomic_load(p, __ATOMIC_RELAXED, __HIP_MEMORY_SCOPE_AGENT); }
__device__ __forceinline__ unsigned xb_add(unsigned* p, unsigned v) { return __hip_atomic_fetch_add(p, v, __ATOMIC_RELAXED, __HIP_MEMORY_SCOPE_AGENT); }
__device__ __forceinline__ unsigned xb_xcc_id() { return (unsigned)__builtin_amdgcn_s_getreg((3 << 11) | 20) & 0xFu; }
#define XB_SPIN(cond, bar) do { unsigned _sp = 0; while (cond) { __builtin_amdgcn_s_sleep(1); \
    if ((++_sp & 255u) == 0u) { if (xb_ld(&(bar)[XB_TMO])) break; if (_sp > XB_SPIN_CAP) { atomicAdd(&(bar)[XB_TMO], 1u); break; } } } } while (0)
struct XcdBarrier { unsigned* bar; unsigned x; volatile LAS unsigned* st; };
__device__ __forceinline__ XcdBarrier xcd_barrier_post(unsigned* bar, volatile LAS unsigned* st) {
    XcdBarrier b; b.bar = bar; b.x = xb_xcc_id(); b.st = st;
    if (threadIdx.x == 0) (void)xb_add(&bar[XB_XCNT(b.x)], 1u);
    return b;
}
__device__ __forceinline__ void xcd_barrier_complete(unsigned* bar, unsigned x, unsigned& nloc, unsigned& nx) {
    const unsigned G = gridDim.x * gridDim.y * gridDim.z;
    unsigned sum, cnt, mine, sp = 0u;
    for (;;) {
        sum = 0u; cnt = 0u; mine = 0u;
#pragma unroll
        for (unsigned j = 0; j < 16; ++j) { const unsigned c = xb_ld(&bar[XB_XCNT(j)]); sum += c; cnt += (c > 0u) ? 1u : 0u; mine = (j == x) ? c : mine; }
        if (sum == G) break;
        __builtin_amdgcn_s_sleep(1);
        if ((++sp & 255u) == 0u) { if (xb_ld(&bar[XB_TMO])) break; if (sp > XB_SPIN_CAP) { atomicAdd(&bar[XB_TMO], 1u); break; } }
    }
    nloc = mine > 0u ? mine : 1u; nx = cnt > 0u ? cnt : 1u;
}
__device__ __forceinline__ void xcd_barrier(const XcdBarrier& b) {
    asm volatile("s_waitcnt vmcnt(0)" ::: "memory");
    __syncthreads();
    if (threadIdx.x == 0) {
        unsigned* bar = b.bar;
        __builtin_amdgcn_s_waitcnt(0);
        unsigned nloc = b.st[0], nx = b.st[1];
        if (nloc == 0u) { xcd_barrier_complete(bar, b.x, nloc, nx); b.st[0] = nloc; b.st[1] = nx; }
        const unsigned old = xb_add(&bar[XB_XSUB(b.x)], 1u);
        const unsigned gen = old / nloc;
        if (old + 1u == (gen + 1u) * nloc) {
            __builtin_amdgcn_fence(__ATOMIC_RELEASE, "agent");
            asm volatile("s_waitcnt vmcnt(0)" ::: "memory");
            const unsigned og = xb_add(&bar[XB_TOP], 1u);
            const unsigned tg = og / nx;
            if (og + 1u == (tg + 1u) * nx) xb_add(&bar[XB_TOPGEN], 1u);
            else XB_SPIN(xb_ld(&bar[XB_TOPGEN]) == tg, bar);
            __builtin_amdgcn_fence(__ATOMIC_ACQUIRE, "agent");
            xb_add(&bar[XB_XGEN(b.x)], 1u);
            asm volatile("s_waitcnt vmcnt(0)" ::: "memory");
        } else {
            XB_SPIN(xb_ld(&bar[XB_XGEN(b.x)]) == gen, bar);
            __builtin_amdgcn_fence(__ATOMIC_ACQUIRE, "agent");
            asm volatile("s_waitcnt vmcnt(0)" ::: "memory");
        }
    }
    __syncthreads();
}

struct Frame {
    LAS unsigned char* lds;
    volatile LAS unsigned* MISC;
    gu32* ctl;
    int tid, lane, wave;
    int vcu, G;
    const float *x, *g1, *w_in, *sb_g, *sw_g, *sinks, *w_out, *g2, *w_q, *keys1, *keys2, *pu, *pv, *gf;
    float* out;
    bf16 *Wt_in, *Wt_out, *Wt_q, *KEYS, *H, *MIX, *QKV, *UB, *VB;
    int* IDX; float* GATE;
};

__device__ __forceinline__ float wave_sum(float v) {
#pragma unroll
    for (int o = 1; o < 64; o <<= 1) v += __shfl_xor(v, o);
    return v;
}

__device__ __forceinline__ void p0_transpose_item(const float* W, int K, int N, bf16* WT, LAS float* scr, int item, int lane) {
    const int nblk = N / 32, kb = item / nblk, nb = item % nblk, k0 = 64 * kb, n0 = 32 * nb;
#pragma unroll 8
    for (int i = 0; i < 32; ++i) { const int kk = 2 * i + (lane >> 5); scr[kk * 33 + (lane & 31)] = W[(size_t)(k0 + kk) * N + n0 + (lane & 31)]; }
    LDS_WAIT(); asm volatile("" ::: "memory");
    const int c = lane & 7;
#pragma unroll
    for (int j = 0; j < 4; ++j) { const int n = (lane >> 3) + 8 * j; const LAS float* s = scr + (8 * c) * 33 + n;
        u32x4 o; o.x = pk2(s[0 * 33], s[1 * 33]); o.y = pk2(s[2 * 33], s[3 * 33]); o.z = pk2(s[4 * 33], s[5 * 33]); o.w = pk2(s[6 * 33], s[7 * 33]);
        *(GAS u32x4*)(WT + (size_t)(n0 + n) * K + k0 + 8 * c) = o; }
    LDS_WAIT(); asm volatile("" ::: "memory");
}
__device__ __forceinline__ void rms_row_to_bf16(const float* xrow, const float* g, bf16* orow, int lane) {
    const GAS f32x4* xr = (const GAS f32x4*)xrow + lane; const GAS f32x4* gr = (const GAS f32x4*)g + lane;
    f32x4 v[4]; float s = 0.f;
#pragma unroll
    for (int j = 0; j < 4; ++j) { v[j] = xr[64 * j]; s += (v[j].x * v[j].x + v[j].y * v[j].y) + (v[j].z * v[j].z + v[j].w * v[j].w); }
    const float rs = __builtin_amdgcn_rsqf(wave_sum(s) * (1.f / D) + EPS);
    GAS u32x2* o8 = (GAS u32x2*)orow + lane;
#pragma unroll
    for (int j = 0; j < 4; ++j) { const f32x4 gg = gr[64 * j]; u32x2 w; w.x = pk2(v[j].x * rs * gg.x, v[j].y * rs * gg.y); w.y = pk2(v[j].z * rs * gg.z, v[j].w * rs * gg.w); o8[64 * j] = w; }
}
__device__ __forceinline__ void cvt_array_bf16(const float* src, bf16* dst, size_t n8, int gtid, int gthreads) {
    for (size_t i = gtid; i < n8; i += gthreads) {
        const f32x4 a = *(const GAS f32x4*)(src + i * 8), b = *(const GAS f32x4*)(src + i * 8 + 4);
        u32x4 o; o.x = pk2(a.x, a.y); o.y = pk2(a.z, a.w); o.z = pk2(b.x, b.y); o.w = pk2(b.z, b.w);
        *(GAS u32x4*)(dst + i * 8) = o;
    }
}
__device__ __forceinline__ void p0_prologue(Frame& F) {
    LAS float* scr = (LAS float*)(F.lds + F.wave * 16384);
    const int gw = F.vcu * NWAVES + F.wave, NGW = F.G * NWAVES;
    constexpr int I_IN = (D / 64) * (DIN / 32), I_OUT = (D / 64) * (D / 32), I_Q = (D / 64) * (DQ / 32);
    constexpr int NITEMS = I_IN + I_OUT + I_Q;
    for (int it = gw; it < NITEMS; it += NGW) {
        int r = it;
        if (r < I_IN) { p0_transpose_item(F.w_in, D, DIN, F.Wt_in, scr, r, F.lane); continue; } r -= I_IN;
        if (r < I_OUT) { p0_transpose_item(F.w_out, D, D, F.Wt_out, scr, r, F.lane); continue; } r -= I_OUT;
        p0_transpose_item(F.w_q, D, DQ, F.Wt_q, scr, r, F.lane);
    }
    for (int m = gw; m < T; m += NGW) rms_row_to_bf16(F.x + (size_t)m * D, F.g1, F.H + (size_t)m * D, F.lane);
    const int gtid = F.vcu * NWAVES * 64 + F.tid, gthreads = F.G * NWAVES * 64;
    cvt_array_bf16(F.pu, F.UB, (size_t)NEXP * D / 8, gtid, gthreads);
    cvt_array_bf16(F.pv, F.VB, (size_t)NEXP * D / 8, gtid, gthreads);
    cvt_array_bf16(F.keys1, F.KEYS, (size_t)8 * 128 * 128 / 8, gtid, gthreads);
    cvt_array_bf16(F.keys2, F.KEYS + 8 * 128 * 128, (size_t)8 * 128 * 128 / 8, gtid, gthreads);
}

__device__ __forceinline__ int crow(int r, int hi) { return (r & 3) + 8 * (r >> 2) + 4 * hi; }
constexpr int VPITCH = 192;
__device__ __forceinline__ void stage_v(const bf16* Vt, LAS unsigned char* wl, int lane) {
    const int row = lane >> 1, hf = lane & 1;
    const GAS u32x4* src = (const GAS u32x4*)(Vt + (size_t)row * DIN + 32 * hf);
    const u32x4 a = src[0], b = src[1], c = src[2], d = src[3];
    LAS u32x4* dst = (LAS u32x4*)(wl + row * VPITCH + hf * 64);
    dst[0] = a; dst[1] = b; dst[2] = c; dst[3] = d;
}
__device__ __forceinline__ bf16x8 vfrag(const LAS unsigned char* wl, int dblk, int s, int lane) {
    const int hi = lane >> 5, i = lane & 15, g1 = (lane >> 4) & 1;
    const LAS unsigned char* p = wl + (16 * s + 4 * hi + (i >> 2)) * VPITCH + (32 * dblk + 16 * g1 + 4 * (i & 3)) * 2;
    const v4i16_t lo = __builtin_amdgcn_ds_read_tr16_b64_v4i16((LAS v4i16_t*)p);
    const v4i16_t hh = __builtin_amdgcn_ds_read_tr16_b64_v4i16((LAS v4i16_t*)(p + 8 * VPITCH));
    return (bf16x8){lo[0], lo[1], lo[2], lo[3], hh[0], hh[1], hh[2], hh[3]};
}
__device__ __forceinline__ bf16x8 pack8(const f32x16& a, int s) {
    u32x4 w; w.x = pk2(a[8 * s + 0], a[8 * s + 1]); w.y = pk2(a[8 * s + 2], a[8 * s + 3]); w.z = pk2(a[8 * s + 4], a[8 * s + 5]); w.w = pk2(a[8 * s + 6], a[8 * s + 7]);
    return __builtin_bit_cast(bf16x8, w);
}
__device__ __forceinline__ void head_norm_store(const f32x16& o0, const f32x16& o1, float scale, const float* g, bf16* dstrow, int hi) {
    float ss = 0.f;
#pragma unroll
    for (int r = 0; r < 16; ++r) { const float a = o0[r] * scale, b = o1[r] * scale; ss += a * a + b * b; }
    ss += __shfl_xor(ss, 32);
    const float rs = __builtin_amdgcn_rsqf(ss * (1.f / 64.f) + EPS) * scale;
#pragma unroll
    for (int dblk = 0; dblk < 2; ++dblk)
#pragma unroll
        for (int q4 = 0; q4 < 4; ++q4) { const int d0 = 32 * dblk + 8 * q4 + 4 * hi; const f32x4 gg = *(const GAS f32x4*)(g + d0);
            const f32x16& o = dblk ? o1 : o0;
            u32x2 w; w.x = pk2(o[4 * q4 + 0] * rs * gg.x, o[4 * q4 + 1] * rs * gg.y); w.y = pk2(o[4 * q4 + 2] * rs * gg.z, o[4 * q4 + 3] * rs * gg.w);
            *(GAS u32x2*)(dstrow + d0) = w; }
}

__device__ __forceinline__ void sb_item(Frame& F, int b, int h, int qb, LAS unsigned char* wl) {
    const int lane = F.lane, r32 = lane & 31, hi = lane >> 5;
    const size_t rowbase = (size_t)b * SEQ;
    const bf16* Qp = F.QKV + (rowbase + 32 * qb + r32) * DIN + C_SBQ + h * 64;
    const bf16* Kb = F.QKV + rowbase * DIN + C_SBK + h * 64;
    const bf16* Vb = F.QKV + rowbase * DIN + C_SBV + h * 64;
    bf16x8 qr[4];
#pragma unroll
    for (int d0 = 0; d0 < 4; ++d0) qr[d0] = *(const GAS bf16x8*)(Qp + 16 * d0 + 8 * hi);
    bf16x8 tri[2];
#pragma unroll
    for (int s = 0; s < 2; ++s)
#pragma unroll
        for (int j = 0; j < 8; ++j) tri[s][j] = (16 * s + 8 * (j >> 2) + 4 * hi + (j & 3) >= r32) ? (short)0x3F80 : (short)0;
    f32x16 o0 = {}, o1 = {}; float C = 0.f;
    for (int kt = qb; kt >= 0; --kt) {
        const bf16* Kp = Kb + (size_t)(32 * kt + r32) * DIN;
        bf16x8 kf[4];
#pragma unroll
        for (int d0 = 0; d0 < 4; ++d0) kf[d0] = *(const GAS bf16x8*)(Kp + 16 * d0 + 8 * hi);
        stage_v(Vb + (size_t)(32 * kt) * DIN, wl, lane);
        f32x16 z = {};
#pragma unroll
        for (int d0 = 0; d0 < 4; ++d0) z = __builtin_amdgcn_mfma_f32_32x32x16_bf16(kf[d0], qr[d0], z, 0, 0, 0);
        const int lim = r32 + 32 * (qb - kt);
        f32x16 l, ls;
#pragma unroll
        for (int r = 0; r < 16; ++r) {
            const float zz = z[r] * 0.125f;
            const float e = __builtin_amdgcn_exp2f(-__builtin_fabsf(zz) * LOG2E);
            const float sp = __builtin_fmaxf(zz, 0.f) + LN2 * __builtin_amdgcn_logf(1.0f + e);
            const bool valid = crow(r, hi) < lim;
            l[r] = valid ? -sp : 0.f;
            ls[r] = zz - sp;
        }
        f32x16 lo;
        bf16x8 lh[2], ll[2];
#pragma unroll
        for (int s = 0; s < 2; ++s) {
            u32x4 wh, wlw;
#pragma unroll
            for (int p = 0; p < 4; ++p) { const float a = l[8 * s + 2 * p], c = l[8 * s + 2 * p + 1]; const unsigned w = pk2(a, c); wh[p] = w; lo[8 * s + 2 * p] = a - bf_lo(w); lo[8 * s + 2 * p + 1] = c - bf_hi(w); }
#pragma unroll
            for (int p = 0; p < 4; ++p) wlw[p] = pk2(lo[8 * s + 2 * p], lo[8 * s + 2 * p + 1]);
            lh[s] = __builtin_bit_cast(bf16x8, wh); ll[s] = __builtin_bit_cast(bf16x8, wlw);
        }
        f32x16 Y = {};
        Y = __builtin_amdgcn_mfma_f32_32x32x16_bf16(tri[0], lh[0], Y, 0, 0, 0);
        Y = __builtin_amdgcn_mfma_f32_32x32x16_bf16(tri[1], lh[1], Y, 0, 0, 0);
        Y = __builtin_amdgcn_mfma_f32_32x32x16_bf16(tri[0], ll[0], Y, 0, 0, 0);
        Y = __builtin_amdgcn_mfma_f32_32x32x16_bf16(tri[1], ll[1], Y, 0, 0, 0);
        f32x16 a;
#pragma unroll
        for (int r = 0; r < 16; ++r) {
            const bool valid = crow(r, hi) < lim;
            const float later = C + (Y[r] - l[r]);
            const float av = __builtin_amdgcn_exp2f((ls[r] + later) * LOG2E);
            a[r] = valid ? av : 0.f;
        }
        const float tot = __shfl(Y[0], r32);
        C += tot;
        const bf16x8 a0 = pack8(a, 0), a1 = pack8(a, 1);
        o0 = __builtin_amdgcn_mfma_f32_32x32x16_bf16(vfrag(wl, 0, 0, lane), a0, o0, 0, 0, 0);
        o0 = __builtin_amdgcn_mfma_f32_32x32x16_bf16(vfrag(wl, 0, 1, lane), a1, o0, 0, 0, 0);
        o1 = __builtin_amdgcn_mfma_f32_32x32x16_bf16(vfrag(wl, 1, 0, lane), a0, o1, 0, 0, 0);
        o1 = __builtin_amdgcn_mfma_f32_32x32x16_bf16(vfrag(wl, 1, 1, lane), a1, o1, 0, 0, 0);
        if (__all(C < SB_EXIT)) break;
    }
    head_norm_store(o0, o1, 1.0f, F.sb_g + h * 64, F.MIX + (rowbase + 32 * qb + r32) * D + h * 64, hi);
}

__device__ __forceinline__ void swa_item(Frame& F, int b, int hq, int qb, LAS unsigned char* wl) {
    const int lane = F.lane, r32 = lane & 31, hi = lane >> 5, kv = hq >> 2;
    const size_t rowbase = (size_t)b * SEQ;
    const bf16* Qp = F.QKV + (rowbase + 32 * qb + r32) * DIN + C_SWQ + hq * 64;
    const bf16* Kb = F.QKV + rowbase * DIN + C_SWK + kv * 64;
    const bf16* Vb = F.QKV + rowbase * DIN + C_SWV + kv * 64;
    const float slope = __builtin_amdgcn_exp2f(-(float)(hq + 1));
    const float sink = F.sinks[hq];
    bf16x8 qr[4];
#pragma unroll
    for (int d0 = 0; d0 < 4; ++d0) qr[d0] = *(const GAS bf16x8*)(Qp + 16 * d0 + 8 * hi);
    float mx = sink;
    const int kt0 = qb - 4 < 0 ? 0 : qb - 4;
    for (int kt = kt0; kt <= qb; ++kt) {
        const bf16* Kp = Kb + (size_t)(32 * kt + r32) * DIN;
        f32x16 z = {};
#pragma unroll
        for (int d0 = 0; d0 < 4; ++d0) { const bf16x8 kf = *(const GAS bf16x8*)(Kp + 16 * d0 + 8 * hi); z = __builtin_amdgcn_mfma_f32_32x32x16_bf16(kf, qr[d0], z, 0, 0, 0); }
        const int dq = 32 * (qb - kt) + r32 - 4 * hi;
#pragma unroll
        for (int r = 0; r < 16; ++r) {
            const int dist = dq - ((r & 3) + 8 * (r >> 2));
            const float s = z[r] * 0.125f - slope * (float)dist;
            mx = __builtin_fmaxf(mx, ((unsigned)dist < 128u) ? s : -INFINITY);
        }
    }
    mx = __builtin_fmaxf(mx, __shfl_xor(mx, 32));
    float den = 0.f;
    f32x16 o0 = {}, o1 = {};
    for (int kt = kt0; kt <= qb; ++kt) {
        const bf16* Kp = Kb + (size_t)(32 * kt + r32) * DIN;
        stage_v(Vb + (size_t)(32 * kt) * DIN, wl, lane);
        f32x16 z = {};
#pragma unroll
        for (int d0 = 0; d0 < 4; ++d0) { const bf16x8 kf = *(const GAS bf16x8*)(Kp + 16 * d0 + 8 * hi); z = __builtin_amdgcn_mfma_f32_32x32x16_bf16(kf, qr[d0], z, 0, 0, 0); }
        const int dq = 32 * (qb - kt) + r32 - 4 * hi;
        f32x16 p;
#pragma unroll
        for (int r = 0; r < 16; ++r) {
            const int dist = dq - ((r & 3) + 8 * (r >> 2));
            const float s = z[r] * 0.125f - slope * (float)dist;
            const float e = __builtin_amdgcn_exp2f((s - mx) * LOG2E);
            p[r] = ((unsigned)dist < 128u) ? e : 0.f;
            den += p[r];
        }
        const bf16x8 a0 = pack8(p, 0), a1 = pack8(p, 1);
        o0 = __builtin_amdgcn_mfma_f32_32x32x16_bf16(vfrag(wl, 0, 0, lane), a0, o0, 0, 0, 0);
        o0 = __builtin_amdgcn_mfma_f32_32x32x16_bf16(vfrag(wl, 0, 1, lane), a1, o0, 0, 0, 0);
        o1 = __builtin_amdgcn_mfma_f32_32x32x16_bf16(vfrag(wl, 1, 0, lane), a0, o1, 0, 0, 0);
        o1 = __builtin_amdgcn_mfma_f32_32x32x16_bf16(vfrag(wl, 1, 1, lane), a1, o1, 0, 0, 0);
    }
    den += __shfl_xor(den, 32);
    den += __builtin_amdgcn_exp2f((sink - mx) * LOG2E);
    head_norm_store(o0, o1, 1.0f / den, F.sw_g + hq * 64, F.MIX + (rowbase + 32 * qb + r32) * D + 512 + hq * 64, hi);
}
__device__ __forceinline__ void p2_attention(Frame& F) {
    LAS unsigned char* wl = F.lds + F.wave * 8192;
    const int gw = F.vcu * NWAVES + F.wave, NGW = F.G * NWAVES;
    constexpr int NSB = NB * 8 * 128, NSW = NB * 8 * 128;
    for (int it = gw; it < NSB + NSW; it += NGW) {
        if (it < NSB) { const int qb = it & 127, h = (it >> 7) & 7, b = it >> 10; sb_item(F, b, h, qb, wl); }
        else { const int r = it - NSB; const int qb = r & 127, h = (r >> 7) & 7, b = r >> 10; swa_item(F, b, h, qb, wl); }
    }
}

__device__ __forceinline__ int f2ord(unsigned bits) { int x = (int)bits; return x ^ ((x >> 31) & 0x7fffffff); }
template <int N> __device__ __forceinline__ void bitonic_desc(int (&v)[N]) {
#pragma unroll
    for (int k = 2; k <= N; k <<= 1) {
#pragma unroll
        for (int j = k >> 1; j > 0; j >>= 1) {
#pragma unroll
            for (int i = 0; i < N; ++i) {
                const int l = i ^ j;
                if (l > i) { const bool up = ((i & k) == 0); const int a = v[i], b = v[l]; const int mx = a > b ? a : b, mn = a > b ? b : a; v[i] = up ? mx : mn; v[l] = up ? mn : mx; }
            }
        }
    }
}
template <int N> __device__ __forceinline__ void bitonic_merge_desc(int (&v)[N]) {
#pragma unroll
    for (int j = N >> 1; j > 0; j >>= 1) {
#pragma unroll
        for (int i = 0; i < N; ++i) { const int l = i ^ j; if (l > i) { const int a = v[i], b = v[l]; v[i] = a > b ? a : b; v[l] = a > b ? b : a; } }
    }
}
template <int N> __device__ __forceinline__ void bitonic_desc_kv(int (&k)[N], int (&p)[N]) {
#pragma unroll
    for (int kk = 2; kk <= N; kk <<= 1) {
#pragma unroll
        for (int j = kk >> 1; j > 0; j >>= 1) {
#pragma unroll
            for (int i = 0; i < N; ++i) {
                const int l = i ^ j;
                if (l > i) { const bool up = ((i & kk) == 0); const bool sw = up ? (k[i] < k[l]) : (k[i] > k[l]);
                    const int ka = k[i], kb = k[l], pa = p[i], pb = p[l]; k[i] = sw ? kb : ka; k[l] = sw ? ka : kb; p[i] = sw ? pb : pa; p[l] = sw ? pa : pb; }
            }
        }
    }
}
struct Cand { unsigned char i, j; };
struct CandTable { Cand c[64]; int n; };
constexpr CandTable make_cands() { CandTable t{}; int n = 0; for (int i = 0; i < 16; ++i) for (int j = 0; j < 16; ++j) if ((i + 1) * (j + 1) <= 16) { t.c[n].i = (unsigned char)i; t.c[n].j = (unsigned char)j; ++n; } t.n = n; return t; }
constexpr CandTable CANDS = make_cands();
static_assert(CANDS.n == 50, "candidate count");

__device__ __forceinline__ void p6_item(Frame& F, int tb, int h) {
    const int lane = F.lane, r32 = lane & 31, hi = lane >> 5;
    const bf16* QP = F.QKV;
    const bf16* qrow = QP + (size_t)(32 * tb + r32) * DQ + h * 256;
    int top[2][16];
#pragma unroll
    for (int half = 0; half < 2; ++half) {
        bf16x8 qf[8];
#pragma unroll
        for (int ks = 0; ks < 8; ++ks) qf[ks] = *(const GAS bf16x8*)(qrow + half * 128 + 16 * ks + 8 * hi);
        const bf16* kb = F.KEYS + (size_t)(half * 8 + h) * 128 * 128;
        int v[64];
#pragma unroll
        for (int nt = 0; nt < 4; ++nt) {
            f32x16 acc = {};
#pragma unroll
            for (int ks = 0; ks < 8; ++ks) { const bf16x8 kf = *(const GAS bf16x8*)(kb + (size_t)(32 * nt + r32) * 128 + 16 * ks + 8 * hi); acc = __builtin_amdgcn_mfma_f32_32x32x16_bf16(kf, qf[ks], acc, 0, 0, 0); }
#pragma unroll
            for (int r = 0; r < 16; ++r) { const float av = acc[r]; const unsigned bits = (f_bits(av) & ~0x7Fu) | (unsigned)(32 * nt + crow(r, hi)); v[16 * nt + r] = f2ord(bits); }
        }
        bitonic_desc<64>(v);
        int m[16];
#pragma unroll
        for (int i = 0; i < 16; ++i) { const int o = __shfl_xor(v[15 - i], 32); m[i] = v[i] > o ? v[i] : o; }
        bitonic_merge_desc<16>(m);
#pragma unroll
        for (int i = 0; i < 16; ++i) top[half][i] = m[i];
    }
    float f1[16], f2[16]; int i1[16], i2[16];
#pragma unroll
    for (int i = 0; i < 16; ++i) { const unsigned b1 = (unsigned)f2ord((unsigned)top[0][i]), b2 = (unsigned)f2ord((unsigned)top[1][i]);
        f1[i] = bits_f(b1 & ~0x7Fu); i1[i] = (int)(b1 & 0x7Fu); f2[i] = bits_f(b2 & ~0x7Fu); i2[i] = (int)(b2 & 0x7Fu); }
    int ck[32], cp[32];
#pragma unroll
    for (int s = 0; s < 32; ++s) {
        if (s < 25) { constexpr int dummy = 0; (void)dummy;
            const int ia = CANDS.c[2 * s].i, ja = CANDS.c[2 * s].j, ib = CANDS.c[2 * s + 1].i, jb = CANDS.c[2 * s + 1].j;
            const float sa = f1[ia] + f2[ja], sb = f1[ib] + f2[jb]; const int pa = (i1[ia] << 7) | i2[ja], pb = (i1[ib] << 7) | i2[jb];
            ck[s] = f2ord(f_bits(hi ? sb : sa)); cp[s] = hi ? pb : pa;
        } else { ck[s] = (int)0x80000000; cp[s] = 0; }
    }
    bitonic_desc_kv<32>(ck, cp);
    int wk[16], wp[16];
#pragma unroll
    for (int i = 0; i < 16; ++i) { const int ok = __shfl_xor(ck[15 - i], 32), op = __shfl_xor(cp[15 - i], 32); const bool t = ck[i] >= ok; wk[i] = t ? ck[i] : ok; wp[i] = t ? cp[i] : op; }
    float vals[16]; float mxv = -INFINITY;
#pragma unroll
    for (int i = 0; i < 16; ++i) { vals[i] = bits_f((unsigned)f2ord((unsigned)wk[i])); mxv = __builtin_fmaxf(mxv, vals[i]); }
    float se = 0.f;
#pragma unroll
    for (int i = 0; i < 16; ++i) { vals[i] = __builtin_amdgcn_exp2f((vals[i] - mxv) * LOG2E); se += vals[i]; }
    const float inv = 1.0f / se;
    const size_t ob = (size_t)(32 * tb + r32) * 128 + h * 16 + hi * 8;
    { u32x4 a, b2; a.x = wp[0]; a.y = wp[1]; a.z = wp[2]; a.w = wp[3]; b2.x = wp[4]; b2.y = wp[5]; b2.z = wp[6]; b2.w = wp[7];
      *(GAS u32x4*)(F.IDX + ob) = a; *(GAS u32x4*)(F.IDX + ob + 4) = b2;
      f32x4 ga = {vals[0] * inv, vals[1] * inv, vals[2] * inv, vals[3] * inv}, gb = {vals[4] * inv, vals[5] * inv, vals[6] * inv, vals[7] * inv};
      *(GAS f32x4*)(F.GATE + ob) = ga; *(GAS f32x4*)(F.GATE + ob + 4) = gb; }
}
__device__ __forceinline__ void p6_topk(Frame& F) {
    const int gw = F.vcu * NWAVES + F.wave, NGW = F.G * NWAVES;
    for (int it = gw; it < (T / 32) * 8; it += NGW) p6_item(F, it >> 3, it & 7);
}

__device__ __forceinline__ float dot2(unsigned a, unsigned b, float c) { return __builtin_amdgcn_fdot2_f32_bf16(__builtin_bit_cast(bf16x2_t, a), __builtin_bit_cast(bf16x2_t, b), c, false); }
__device__ __forceinline__ float dot8(const u32x4& r, const u32x4& x, float c) {
    const unsigned r0 = r.x, r1 = r.y, r2 = r.z, r3 = r.w, x0 = x.x, x1 = x.y, x2 = x.z, x3 = x.w;
    c = dot2(r0, x0, c); c = dot2(r1, x1, c); c = dot2(r2, x2, c); c = dot2(r3, x3, c);
    return c;
}
__device__ __forceinline__ void axpy8(float (&acc)[8], const u32x4& r, float c) {
    acc[0] += c * bf_lo(r.x); acc[1] += c * bf_hi(r.x); acc[2] += c * bf_lo(r.y); acc[3] += c * bf_hi(r.y);
    acc[4] += c * bf_lo(r.z); acc[5] += c * bf_hi(r.z); acc[6] += c * bf_lo(r.w); acc[7] += c * bf_hi(r.w);
}
__device__ __forceinline__ float gelu_tanh(float x) {
    const float y2 = 1.5957691216057308f * (x + 0.044715f * x * x * x);
    return x / (1.0f + __builtin_amdgcn_exp2f(-y2 * LOG2E));
}
__device__ __forceinline__ void p7_token(Frame& F, int tok) {
    const int lane = F.lane;
    const bf16* xr = F.H + (size_t)tok * D;
    const u32x4 xa = *(const GAS u32x4*)(xr + 8 * lane), xb = *(const GAS u32x4*)(xr + 512 + 8 * lane);
    const int id0 = F.IDX[(size_t)tok * 128 + lane], id1 = F.IDX[(size_t)tok * 128 + 64 + lane];
    const float g0 = F.GATE[(size_t)tok * 128 + lane], g1 = F.GATE[(size_t)tok * 128 + 64 + lane];
    float d0 = 0.f, d1 = 0.f;
    for (int eb = 0; eb < 128; eb += 8) {
        u32x4 ra[8], rb[8];
#pragma unroll
        for (int j = 0; j < 8; ++j) { const int id = __builtin_amdgcn_readlane(eb < 64 ? id0 : id1, (eb + j) & 63);
            const bf16* p = F.UB + (size_t)id * D; ra[j] = *(const GAS u32x4*)(p + 8 * lane); rb[j] = *(const GAS u32x4*)(p + 512 + 8 * lane); }
#pragma unroll
        for (int j = 0; j < 8; ++j) { float p = dot8(ra[j], xa, 0.f); p = dot8(rb[j], xb, p); p = wave_sum(p);
            if (eb < 64) d0 = (lane == ((eb + j) & 63)) ? p : d0; else d1 = (lane == ((eb + j) & 63)) ? p : d1; }
    }
    const float c0 = g0 * gelu_tanh(d0), c1 = g1 * gelu_tanh(d1);
    float accA[8], accB[8];
#pragma unroll
    for (int i = 0; i < 8; ++i) { accA[i] = 0.f; accB[i] = 0.f; }
    for (int eb = 0; eb < 128; eb += 8) {
        u32x4 ra[8], rb[8];
#pragma unroll
        for (int j = 0; j < 8; ++j) { const int id = __builtin_amdgcn_readlane(eb < 64 ? id0 : id1, (eb + j) & 63);
            const bf16* p = F.VB + (size_t)id * D; ra[j] = *(const GAS u32x4*)(p + 8 * lane); rb[j] = *(const GAS u32x4*)(p + 512 + 8 * lane); }
#pragma unroll
        for (int j = 0; j < 8; ++j) { const float c = bits_f((unsigned)__builtin_amdgcn_readlane((int)f_bits(eb < 64 ? c0 : c1), (eb + j) & 63));
            axpy8(accA, ra[j], c); axpy8(accB, rb[j], c); }
    }
    float* orow = F.out + (size_t)tok * D;
    const f32x4 xa0 = *(const GAS f32x4*)(orow + 8 * lane), xa1 = *(const GAS f32x4*)(orow + 8 * lane + 4), xb0 = *(const GAS f32x4*)(orow + 512 + 8 * lane), xb1 = *(const GAS f32x4*)(orow + 512 + 8 * lane + 4);
    float y[16]; y[0] = xa0.x + accA[0]; y[1] = xa0.y + accA[1]; y[2] = xa0.z + accA[2]; y[3] = xa0.w + accA[3]; y[4] = xa1.x + accA[4]; y[5] = xa1.y + accA[5]; y[6] = xa1.z + accA[6]; y[7] = xa1.w + accA[7];
    y[8] = xb0.x + accB[0]; y[9] = xb0.y + accB[1]; y[10] = xb0.z + accB[2]; y[11] = xb0.w + accB[3]; y[12] = xb1.x + accB[4]; y[13] = xb1.y + accB[5]; y[14] = xb1.z + accB[6]; y[15] = xb1.w + accB[7];
    float ss = 0.f;
#pragma unroll
    for (int i = 0; i < 16; ++i) ss += y[i] * y[i];
    const float rs = __builtin_amdgcn_rsqf(wave_sum(ss) * (1.f / D) + EPS);
    const f32x4 ga0 = *(const GAS f32x4*)(F.gf + 8 * lane), ga1 = *(const GAS f32x4*)(F.gf + 8 * lane + 4), gb0 = *(const GAS f32x4*)(F.gf + 512 + 8 * lane), gb1 = *(const GAS f32x4*)(F.gf + 512 + 8 * lane + 4);
    *(GAS f32x4*)(orow + 8 * lane) = (f32x4){y[0] * rs * ga0.x, y[1] * rs * ga0.y, y[2] * rs * ga0.z, y[3] * rs * ga0.w};
    *(GAS f32x4*)(orow + 8 * lane + 4) = (f32x4){y[4] * rs * ga1.x, y[5] * rs * ga1.y, y[6] * rs * ga1.z, y[7] * rs * ga1.w};
    *(GAS f32x4*)(orow + 512 + 8 * lane) = (f32x4){y[8] * rs * gb0.x, y[9] * rs * gb0.y, y[10] * rs * gb0.z, y[11] * rs * gb0.w};
    *(GAS f32x4*)(orow + 512 + 8 * lane + 4) = (f32x4){y[12] * rs * gb1.x, y[13] * rs * gb1.y, y[14] * rs * gb1.z, y[15] * rs * gb1.w};
}

struct Args { const float* in[14]; float* out; unsigned char* ws; int ph_lo, ph_hi, li, pad; };
__global__ void __launch_bounds__(NWAVES * 64, 2) mk_fwd(Args args) {
    extern __shared__ __attribute__((aligned(16))) unsigned char lds[];
    Frame F;
    F.lds = (LAS unsigned char*)lds;
    F.MISC = (volatile LAS unsigned*)(F.lds + MISC_OFF);
    F.tid = threadIdx.x; F.lane = F.tid & 63; F.wave = __builtin_amdgcn_readfirstlane(F.tid >> 6);
    F.G = gridDim.x; { const int bx = blockIdx.x; F.vcu = (F.G % 8 == 0) ? (bx % 8) * (F.G / 8) + bx / 8 : bx; }
    unsigned char* ws = args.ws;
    F.ctl = (gu32*)(ws + WS_CTL);
    F.x = args.in[0]; F.g1 = args.in[1]; F.w_in = args.in[2]; F.sb_g = args.in[3]; F.sw_g = args.in[4]; F.sinks = args.in[5]; F.w_out = args.in[6]; F.g2 = args.in[7];
    F.w_q = args.in[8]; F.keys1 = args.in[9]; F.keys2 = args.in[10]; F.pu = args.in[11]; F.pv = args.in[12]; F.gf = args.in[13]; F.out = args.out;
    F.Wt_in = (bf16*)(ws + WS_WIN); F.Wt_out = (bf16*)(ws + WS_WOUT); F.Wt_q = (bf16*)(ws + WS_WQ); F.KEYS = (bf16*)(ws + WS_KEYS);
    F.H = (bf16*)(ws + WS_H); F.MIX = (bf16*)(ws + WS_MIX); F.QKV = (bf16*)(ws + WS_QKV); F.UB = (bf16*)(ws + WS_UB); F.VB = (bf16*)(ws + WS_VB);
    F.IDX = (int*)(ws + WS_IDX); F.GATE = (float*)(ws + WS_GATE);
    for (int u = F.tid; u < (LDS_BYTES - LDSCTL_OFF) / 4; u += NWAVES * 64) ((LAS unsigned*)(F.lds + LDSCTL_OFF))[u] = 0u;
    __syncthreads();
    const int lo = args.ph_lo, hi = args.ph_hi;
    const bool use_bar = (hi - lo) > 1;
    XcdBarrier bar; bar.bar = (unsigned*)(F.ctl + CW_BAR) + args.li * XCD_BAR_WORDS; bar.x = 0; bar.st = nullptr;
    if (use_bar) bar = xcd_barrier_post((unsigned*)(F.ctl + CW_BAR) + args.li * XCD_BAR_WORDS, F.MISC + 8);
#ifndef PHMASK
#define PHMASK 255
#endif
#define IN(k) (((PHMASK >> (k)) & 1) && lo <= (k) && (k) < hi)
#define SEAM(k) do { if (IN(k) && IN((k) + 1)) xcd_barrier(bar); } while (0)
    const int gw = F.vcu * NWAVES + F.wave, NGW = F.G * NWAVES;

    if (IN(0)) { p0_prologue(F); } SEAM(0);
    if (IN(1)) { pg8::Gemm g{F.H, F.Wt_in, T, DIN, D}; pg8::StaticOrder S; S.init(T, DIN, F.G, (int)blockIdx.x); pg8::EpiBf16 E{F.QKV, DIN};
        pg8::gemm_phase<pg8::EpiBf16, pg8::StaticOrder>(F.lds, g, S, E); } SEAM(1);
    if (IN(2)) { p2_attention(F); } SEAM(2);
    if (IN(3)) { pg8::Gemm g{F.MIX, F.Wt_out, T, D, D}; pg8::StaticOrder S; S.init(T, D, F.G, (int)blockIdx.x); pg8::EpiResF32 E{F.x, F.out, D};
        pg8::gemm_phase<pg8::EpiResF32, pg8::StaticOrder>(F.lds, g, S, E); } SEAM(3);
    if (IN(4)) { for (int m = gw; m < T; m += NGW) rms_row_to_bf16(F.out + (size_t)m * D, F.g2, F.H + (size_t)m * D, F.lane); } SEAM(4);
    if (IN(5)) { pg8::Gemm g{F.H, F.Wt_q, T, DQ, D}; pg8::StaticOrder S; S.init(T, DQ, F.G, (int)blockIdx.x); pg8::EpiBf16 E{F.QKV, DQ};
        pg8::gemm_phase<pg8::EpiBf16, pg8::StaticOrder>(F.lds, g, S, E); } SEAM(5);
    if (IN(6)) { p6_topk(F); } SEAM(6);
    if (IN(7)) { for (int tok = gw; tok < T; tok += NGW) p7_token(F, tok); }
#undef IN
#undef SEAM
}

extern "C" void kernel_launch(void* const* d_in, const int* in_sizes, int n_in, void* d_out, int out_size, void* d_ws, size_t ws_size, hipStream_t stream) {
    static int grid = 0;
    if (grid == 0) {
        if (n_in != 14 || in_sizes[0] != T * D || out_size != T * D || ws_size < WS_END) { fprintf(stderr, "kernel_launch: unexpected shapes (n_in %d, in0 %d, out %d, ws %zu)\n", n_in, n_in > 0 ? in_sizes[0] : -1, out_size, ws_size); grid = -1; return; }
        int dev = 0, cus = 0, per_cu = 0;
        if (hipGetDevice(&dev) != hipSuccess || hipDeviceGetAttribute(&cus, hipDeviceAttributeMultiprocessorCount, dev) != hipSuccess) { grid = -1; return; }
        if (hipFuncSetAttribute((const void*)mk_fwd, hipFuncAttributeMaxDynamicSharedMemorySize, LDS_BYTES) != hipSuccess) { fprintf(stderr, "kernel_launch: hipFuncSetAttribute failed\n"); grid = -1; return; }
        if (hipOccupancyMaxActiveBlocksPerMultiprocessor(&per_cu, (const void*)mk_fwd, NWAVES * 64, LDS_BYTES) != hipSuccess || per_cu < 1)
            fprintf(stderr, "kernel_launch: note: occupancy query reports %d workgroups per CU\n", per_cu);
        (void)hipGetLastError();
        grid = cus;
    }
    if (grid < 0) return;
    if (hipMemsetAsync((char*)d_ws + WS_CTL, 0, CTL_ZERO_BYTES, stream) != hipSuccess) { fprintf(stderr, "kernel_launch: hipMemsetAsync failed\n"); return; }
    Args a{};
    for (int i = 0; i < 14; ++i) a.in[i] = (const float*)d_in[i];
    a.out = (float*)d_out; a.ws = (unsigned char*)d_ws;
#if MK_N_LAUNCHES == 1
    a.ph_lo = 0; a.ph_hi = N_PHASES; a.li = 0;
    hipLaunchKernelGGL(mk_fwd, dim3(grid), dim3(NWAVES * 64), LDS_BYTES, stream, a);
#else
    for (int li = 0; li < N_PHASES; ++li) { a.ph_lo = li; a.ph_hi = li + 1; a.li = 0; hipLaunchKernelGGL(mk_fwd, dim3(grid), dim3(NWAVES * 64), LDS_BYTES, stream, a); }
#endif
    const hipError_t le = hipPeekAtLastError();
    if (le != hipSuccess) fprintf(stderr, "kernel_launch: launch failed: %s\n", hipGetErrorName(le));
}
```

```cpp
#include <hip/hip_runtime.h>
#include <cstdio>
#include <cstdint>

#ifndef MK_N_LAUNCHES
#define MK_N_LAUNCHES 1
#endif

#define LAS __attribute__((address_space(3)))
#define GAS __attribute__((address_space(1)))
typedef unsigned short bf16;
typedef short bf16x8 __attribute__((ext_vector_type(8)));
typedef float f32x4 __attribute__((ext_vector_type(4)));
typedef float f32x16 __attribute__((ext_vector_type(16)));
typedef unsigned u32x4 __attribute__((ext_vector_type(4)));
typedef unsigned u32x2 __attribute__((ext_vector_type(2)));
typedef short v4i16_t __attribute__((ext_vector_type(4)));
typedef float f32x2_t __attribute__((ext_vector_type(2)));
typedef __bf16 bf16x2_t __attribute__((ext_vector_type(2)));
typedef GAS unsigned gu32;

constexpr int T = 16384, SEQ = 4096, NB = 4, D = 1024, DIN = 2304, DQ = 2048;
constexpr int C_SBQ = 0, C_SBK = 512, C_SBV = 1024, C_SWQ = 1536, C_SWK = 2048, C_SWV = 2176;
constexpr int NEXP = 16384;
constexpr float EPS = 1e-6f;
constexpr float LOG2E = 1.4426950408889634f, LN2 = 0.6931471805599453f;
constexpr float SB_EXIT = -40.0f;

namespace pg8 {
constexpr int BM = 256, BK = 64, HALF = 128, HTB = HALF * BK * 2, STAGE_BYTES = 8 * HTB, NXCD = 8, WGM = 8;
__host__ __device__ __forceinline__ int lds_byte(int r, int c) { const int st = (r >> 4) * 2 + (c >> 5), rr = r & 15, cc = c & 31, ob = rr * 64 + cc * 2; return st * 1024 + (ob ^ (((ob >> 9) & 1) << 5)); }
__host__ __device__ __forceinline__ void stage_rc(int b, int& R, int& C) { const int st = b / 1024, sb = b % 1024, swz = sb ^ (((sb >> 9) & 1) << 5); R = (st >> 1) * 16 + swz / 64; C = (st & 1) * 32 + (swz % 64) / 2; }
__host__ __device__ __forceinline__ int perm32(int rho) { const int n = rho >> 4, i = rho & 15; return 8 * (i >> 2) + 4 * n + (i & 3); }
struct Unit { int pm, pn; };
struct Gemm { const bf16* A; const bf16* Bt; int M, N, K; };
struct StaticOrder {
    int nM, nN, nwg, G, c;
    __host__ __device__ void init(int M, int N, int G_, int c_) { nM = M / BM; nN = N / BM; nwg = nM * nN; G = G_; c = c_; }
    __host__ __device__ bool next(int i, Unit& u) const {
        const long L = (long)i * G + c; if (L >= nwg) return false;
        int wgid = (int)L; { const int q = nwg / NXCD, r = nwg % NXCD, xcd = wgid % NXCD, off = wgid / NXCD; wgid = (xcd < r ? xcd * (q + 1) : r * (q + 1) + (xcd - r) * q) + off; }
        const int nig = WGM * nN, gid = wgid / nig, fm = gid * WGM, gsz = (nM - fm) < WGM ? (nM - fm) : WGM;
        u.pm = fm + ((wgid % nig) % gsz); u.pn = (wgid % nig) / gsz; return true;
    }
};
__device__ __forceinline__ unsigned cvt_pk_bf16(float lo, float hi) { f32x2_t v = {lo, hi}; bf16x2_t b = __builtin_convertvector(v, bf16x2_t); return __builtin_bit_cast(unsigned, b); }

struct EpiBf16 {
    static constexpr bool PERM = true;
    bf16* O; int ldc;
    __device__ __forceinline__ void operator()(const f32x4 (&acc)[2][2][4][2], const Unit& u, int wr, int wc, int fr, int fq) const {
        const int row0 = u.pm * BM + wr * 64 + fr; const int col0 = u.pn * BM + wc * 32 + 8 * fq;
        const auto rsrc = __builtin_amdgcn_make_buffer_rsrc((void*)O, 0, 0x7ffffff0, 0x00020000);
#pragma unroll
        for (int ai = 0; ai < 2; ++ai)
#pragma unroll
            for (int m = 0; m < 4; ++m) { const unsigned boff = (unsigned)(((size_t)(row0 + ai * HALF + m * 16) * ldc + col0) * 2);
#pragma unroll
                for (int bj = 0; bj < 2; ++bj) { const f32x4 v0 = acc[ai][bj][m][0], v1 = acc[ai][bj][m][1];
                    u32x4 w; w.x = cvt_pk_bf16(v0[0], v0[1]); w.y = cvt_pk_bf16(v0[2], v0[3]); w.z = cvt_pk_bf16(v1[0], v1[1]); w.w = cvt_pk_bf16(v1[2], v1[3]);
                    __builtin_amdgcn_raw_buffer_store_b128(w, rsrc, boff + bj * HALF * 2, 0, 16); } }
    }
};
struct EpiBf16RS {
    static constexpr bool PERM = true;
    bf16* O; int ldc; const float* ssqp; float* rs2;
    __device__ __forceinline__ void operator()(const f32x4 (&acc)[2][2][4][2], const Unit& u, int wr, int wc, int fr, int fq) const {
        const int row0 = u.pm * BM + wr * 64 + fr; const int col0 = u.pn * BM + wc * 32 + 8 * fq;
#pragma unroll
        for (int ai = 0; ai < 2; ++ai)
#pragma unroll
            for (int m = 0; m < 4; ++m) { const int row = row0 + ai * HALF + m * 16; bf16* rowp = O + (size_t)row * ldc + col0;
                const f32x4* sp = (const f32x4*)(ssqp + (size_t)row * 16); const f32x4 s0 = sp[0], s1 = sp[1], s2 = sp[2], s3 = sp[3];
                const float ss = ((s0[0] + s0[1]) + (s0[2] + s0[3])) + ((s1[0] + s1[1]) + (s1[2] + s1[3])) + ((s2[0] + s2[1]) + (s2[2] + s2[3])) + ((s3[0] + s3[1]) + (s3[2] + s3[3]));
                const float rs = __builtin_amdgcn_rsqf(ss * (1.0f / 1024.0f) + 1e-6f);
                if (u.pn == 0 && wc == 0 && fq == 0) rs2[row] = rs;
#pragma unroll
                for (int bj = 0; bj < 2; ++bj) { const f32x4 v0 = acc[ai][bj][m][0] * rs, v1 = acc[ai][bj][m][1] * rs;
                    u32x4 w; w.x = cvt_pk_bf16(v0[0], v0[1]); w.y = cvt_pk_bf16(v0[2], v0[3]); w.z = cvt_pk_bf16(v1[0], v1[1]); w.w = cvt_pk_bf16(v1[2], v1[3]);
                    *(u32x4*)(rowp + bj * HALF) = w; } }
    }
};
struct EpiResB {
    static constexpr bool PERM = false;
    const float* base; bf16* xb; int ldc; float* ssqp;
    __device__ __forceinline__ void operator()(const f32x4 (&acc)[2][2][4][2], const Unit& u, int wr, int wc, int fr, int fq) const {
        const int col0 = u.pn * BM + wc * 32 + 4 * fq;
#pragma unroll
        for (int ai = 0; ai < 2; ++ai)
#pragma unroll
            for (int m = 0; m < 4; ++m) { const int row = u.pm * BM + ai * HALF + wr * 64 + m * 16 + fr; const size_t off = (size_t)row * ldc + col0; float sq = 0.f;
#pragma unroll
                for (int bj = 0; bj < 2; ++bj)
#pragma unroll
                    for (int n = 0; n < 2; ++n) { const f32x4 bs = __builtin_nontemporal_load((const f32x4*)(base + off + bj * HALF + n * 16)); const f32x4 y = bs + acc[ai][bj][m][n];
                        sq += (y[0] * y[0] + y[1] * y[1]) + (y[2] * y[2] + y[3] * y[3]);
                        u32x2 w; w.x = cvt_pk_bf16(y[0], y[1]); w.y = cvt_pk_bf16(y[2], y[3]); *(u32x2*)(xb + off + bj * HALF + n * 16) = w; }
                sq += __shfl_xor(sq, 16); sq += __shfl_xor(sq, 32);
                if (fq == 0) ssqp[(size_t)row * 16 + u.pn * 4 + wc] = sq; }
    }
};
struct EpiResF32 {
    static constexpr bool PERM = false;
    const float* base; float* out; int ldc;
    __device__ __forceinline__ void operator()(const f32x4 (&acc)[2][2][4][2], const Unit& u, int wr, int wc, int fr, int fq) const {
        const int col0 = u.pn * BM + wc * 32 + 4 * fq;
#pragma unroll
        for (int ai = 0; ai < 2; ++ai)
#pragma unroll
            for (int m = 0; m < 4; ++m) { const size_t off = (size_t)(u.pm * BM + ai * HALF + wr * 64 + m * 16 + fr) * ldc + col0;
#pragma unroll
                for (int bj = 0; bj < 2; ++bj)
#pragma unroll
                    for (int n = 0; n < 2; ++n) { const f32x4 bs = *(const f32x4*)(base + off + bj * HALF + n * 16); *(f32x4*)(out + off + bj * HALF + n * 16) = bs + acc[ai][bj][m][n]; } }
    }
};

template <class Epi, class Sched>
__device__ __forceinline__ void gemm_phase(LAS unsigned char* lds, const Gemm g, const Sched& S, const Epi& E) {
    const int tid = threadIdx.x, wid = __builtin_amdgcn_readfirstlane(tid >> 6), lane = tid & 63, wr = wid >> 2, wc = wid & 3, fr = lane & 15, fq = lane >> 4;
    const int K = g.K, nt = K / BK;
    unsigned voffA[2], voffB[2];
#pragma unroll
    for (int i = 0; i < 2; ++i) { int R, C; stage_rc(tid * 16 + i * 8192, R, C); const int Rb = Epi::PERM ? ((R & ~31) + perm32(R & 31)) : R;
        voffA[i] = (unsigned)(R * K + C) * 2u; voffB[i] = (unsigned)(Rb * K + C) * 2u; }
    const size_t kstep = (size_t)(BK * 2);
    const size_t hstep = (size_t)HALF * K * 2;
    const size_t tstep = 2 * hstep;
    const unsigned ldsw = (unsigned)wid * 1024u;
    const int aoff = lds_byte(wr * 64 + fr, fq * 8), boff = lds_byte(wc * 32 + fr, fq * 8);
#define PG8_SA(b, h) (((b) * 2 + (h)) * HTB)
#define PG8_SB(b, h) ((4 + (b) * 2 + (h)) * HTB)
#define PG8_STAGE(bufoff, gbase, voff) do { _Pragma("unroll") for (int _i = 0; _i < 2; ++_i) \
        __builtin_amdgcn_global_load_lds((const unsigned*)((const char*)(gbase) + (voff)[_i]), (LAS unsigned*)(lds + (bufoff) + ldsw + _i * 8192), 16, 0, 0); } while (0)
#define PG8_LDA(dst, b, h) do { _Pragma("unroll") for (int m = 0; m < 4; ++m) _Pragma("unroll") for (int k = 0; k < 2; ++k) dst[m][k] = *(const LAS bf16x8*)(lds + PG8_SA(b, h) + aoff + m * 2048 + k * 1024); } while (0)
#define PG8_LDB(dst, b, h) do { _Pragma("unroll") for (int n = 0; n < 2; ++n) _Pragma("unroll") for (int k = 0; k < 2; ++k) dst[n][k] = *(const LAS bf16x8*)(lds + PG8_SB(b, h) + boff + n * 2048 + k * 1024); } while (0)
#define PG8_MMA(ai, bj, At, Bt) do { __builtin_amdgcn_s_setprio(1); _Pragma("unroll") for (int m = 0; m < 4; ++m) _Pragma("unroll") for (int n = 0; n < 2; ++n) _Pragma("unroll") for (int k = 0; k < 2; ++k) \
        acc[ai][bj][m][n] = __builtin_amdgcn_mfma_f32_16x16x32_bf16(Bt[n][k], At[m][k], acc[ai][bj][m][n], 0, 0, 0); __builtin_amdgcn_s_setprio(0); } while (0)
#define PG8_WAIT_V(n) asm volatile("s_waitcnt vmcnt(" #n ")" ::: "memory")
#define PG8_WAIT_L(n) asm volatile("s_waitcnt lgkmcnt(" #n ")" ::: "memory")
#define PG8_BAR __builtin_amdgcn_s_barrier()
#define PG8_SCHED __builtin_amdgcn_sched_barrier(0)
    Unit cur, nxt; int ui = 0;
    if (!S.next(0, cur)) return;
    f32x4 acc[2][2][4][2];
#pragma unroll
    for (int a = 0; a < 2; ++a)
#pragma unroll
        for (int b = 0; b < 2; ++b)
#pragma unroll
            for (int m = 0; m < 4; ++m)
#pragma unroll
                for (int n = 0; n < 2; ++n) acc[a][b][m][n] = (f32x4){0.f, 0.f, 0.f, 0.f};
    bf16x8 At[4][2], B0[2][2], B1[2][2];
    const char* cA = (const char*)g.A + (size_t)cur.pm * tstep; const char* cB = (const char*)g.Bt + (size_t)cur.pn * tstep;
    PG8_STAGE(PG8_SB(0, 0), cB, voffB); PG8_STAGE(PG8_SB(0, 1), cB + hstep, voffB); PG8_STAGE(PG8_SA(0, 0), cA, voffA); PG8_STAGE(PG8_SA(0, 1), cA + hstep, voffA);
    if (wr == 1) PG8_BAR;
    PG8_WAIT_V(2); PG8_BAR;
    PG8_STAGE(PG8_SB(1, 0), cB + kstep, voffB); PG8_STAGE(PG8_SA(1, 0), cA + kstep, voffA); PG8_STAGE(PG8_SB(1, 1), cB + hstep + kstep, voffB);
    PG8_WAIT_V(6); PG8_BAR;
    for (;;) {
        const bool has_next = S.next(ui + 1, nxt);
        const char* nA = has_next ? (const char*)g.A + (size_t)nxt.pm * tstep : cA; const char* nB = has_next ? (const char*)g.Bt + (size_t)nxt.pn * tstep : cB;
        for (int t = 0; t < nt; t += 2) {
            const bool last = (t == nt - 2);
            const char* a1 = cA + (size_t)(t + 1) * kstep;
            const char* a2 = last ? nA : cA + (size_t)(t + 2) * kstep; const char* b2 = last ? nB : cB + (size_t)(t + 2) * kstep;
            const char* a3 = a2 + kstep; const char* b3 = b2 + kstep;
            PG8_LDB(B0, 0, 0); PG8_LDB(B1, 0, 1); PG8_SCHED; PG8_LDA(At, 0, 0); PG8_STAGE(PG8_SA(1, 1), a1 + hstep, voffA);
            PG8_WAIT_V(8); PG8_WAIT_L(0); PG8_BAR; PG8_MMA(0, 0, At, B0); PG8_MMA(0, 1, At, B1); PG8_BAR; PG8_SCHED;
            PG8_LDA(At, 0, 1); PG8_STAGE(PG8_SB(0, 0), b2, voffB); PG8_STAGE(PG8_SB(0, 1), b2 + hstep, voffB); PG8_STAGE(PG8_SA(0, 0), a2, voffA);
            PG8_WAIT_V(8); PG8_WAIT_L(0); PG8_BAR; PG8_MMA(1, 0, At, B0); PG8_MMA(1, 1, At, B1); PG8_BAR; PG8_SCHED;
            PG8_LDB(B0, 1, 0); PG8_LDB(B1, 1, 1); PG8_SCHED; PG8_LDA(At, 1, 0); PG8_STAGE(PG8_SA(0, 1), a2 + hstep, voffA);
            PG8_WAIT_V(8); PG8_WAIT_L(0); PG8_BAR; PG8_MMA(0, 0, At, B0); PG8_MMA(0, 1, At, B1); PG8_BAR; PG8_SCHED;
            PG8_LDA(At, 1, 1); PG8_STAGE(PG8_SB(1, 0), b3, voffB); PG8_STAGE(PG8_SB(1, 1), b3 + hstep, voffB); PG8_STAGE(PG8_SA(1, 0), a3, voffA);
            PG8_WAIT_V(8); PG8_WAIT_L(0); PG8_BAR; PG8_MMA(1, 0, At, B0); PG8_MMA(1, 1, At, B1); PG8_BAR; PG8_SCHED;
        }
        if (wr == 0) PG8_BAR;
        E(acc, cur, wr, wc, fr, fq);
        if (!has_next) break;
#pragma unroll
        for (int a = 0; a < 2; ++a)
#pragma unroll
            for (int b = 0; b < 2; ++b)
#pragma unroll
                for (int m = 0; m < 4; ++m)
#pragma unroll
                    for (int n = 0; n < 2; ++n) acc[a][b][m][n] = (f32x4){0.f, 0.f, 0.f, 0.f};
        cur = nxt; cA = nA; cB = nB; ++ui;
        if (wr == 1) PG8_BAR;
    }
    PG8_WAIT_V(0);
    PG8_BAR;
#undef PG8_SA
#undef PG8_SB
#undef PG8_STAGE
#undef PG8_LDA
#undef PG8_LDB
#undef PG8_MMA
#undef PG8_WAIT_V
#undef PG8_WAIT_L
#undef PG8_BAR
#undef PG8_SCHED
}
}

constexpr int NWAVES = 8;
constexpr int N_PHASES = 11;
constexpr size_t MiB = 1u << 20;
constexpr size_t WS_CTL = 0, CTL_ZERO_BYTES = 32 * 1024;
constexpr size_t WS_WIN = 1 * MiB;
constexpr size_t WS_WOUT = 6 * MiB;
constexpr size_t WS_WQ = 8 * MiB;
constexpr size_t WS_KEYS = 12 * MiB;
constexpr size_t WS_RSU = 12 * MiB + 512 * 1024, WS_RSV = 12 * MiB + 768 * 1024;
constexpr size_t WS_RS2 = 12 * MiB + 896 * 1024;
constexpr size_t WS_IDX = 13 * MiB;
constexpr size_t WS_GATE = 21 * MiB;
constexpr size_t WS_SSQP = WS_GATE;
constexpr size_t WS_H = 29 * MiB;
constexpr size_t WS_MIX = 61 * MiB;
constexpr size_t WS_C = WS_MIX, WS_SSP = WS_MIX + 8 * MiB;
constexpr size_t WS_X2 = 165 * MiB - 32 * MiB;
constexpr size_t WS_QKV = 93 * MiB;
constexpr size_t WS_PD = WS_QKV;
constexpr size_t WS_U8 = 165 * MiB;
constexpr size_t WS_V8 = 181 * MiB;
constexpr size_t WS_END = 197 * MiB;
constexpr size_t TAB8_SLICE = (size_t)NEXP * 128;
constexpr int CW_BAR = 4096;
static_assert((CW_BAR + 3456) * 4 <= 32 * 1024, "barrier words inside the per-call memset");
constexpr int RING_BYTES = 147456;
constexpr int LDSCTL_OFF = RING_BYTES, MISC_OFF = LDSCTL_OFF + 320;
constexpr int LDS_BYTES = 151552;

#define RLX_AGENT __ATOMIC_RELAXED, __HIP_MEMORY_SCOPE_AGENT
#define LDS_WAIT() asm volatile("s_waitcnt lgkmcnt(0)" ::: "memory")
__device__ __forceinline__ unsigned f2bf(float f) { unsigned u = __builtin_bit_cast(unsigned, f); return (u + 0x7fffu + ((u >> 16) & 1u)) >> 16; }
__device__ __forceinline__ unsigned pk2(float lo, float hi) { return pg8::cvt_pk_bf16(lo, hi); }
__device__ __forceinline__ unsigned f_bits(float f) { return __builtin_bit_cast(unsigned, f); }
__device__ __forceinline__ float bits_f(unsigned u) { return __builtin_bit_cast(float, u); }
__device__ __forceinline__ float bf_lo(unsigned w) { return __builtin_bit_cast(float, w << 16); }
__device__ __forceinline__ float bf_hi(unsigned w) { return __builtin_bit_cast(float, w & 0xffff0000u); }

#define XB_TMO      128
#define XB_XCNT(j)  (256  + 64 * (j))
#define XB_XSUB(j)  (1280 + 64 * (j))
#define XB_XGEN(j)  (2304 + 64 * (j))
#define XB_TOP      3328
#define XB_TOPGEN   3392
#define XCD_BAR_WORDS 3456
#define XB_SPIN_CAP (1u << 18)
__device__ __forceinline__ unsigned xb_ld(unsigned* p)              { return __hip_atomic_load(p, __ATOMIC_RELAXED, __HIP_MEMORY_SCOPE_AGENT); }
__device__ __forceinline__ unsigned xb_add(unsigned* p, unsigned v) { return __hip_atomic_fetch_add(p, v, __ATOMIC_RELAXED, __HIP_MEMORY_SCOPE_AGENT); }
__device__ __forceinline__ unsigned xb_xcc_id() { return (unsigned)__builtin_amdgcn_s_getreg((3 << 11) | 20) & 0xFu; }
#define XB_SPIN(cond, bar) do { unsigned _sp = 0; while (cond) { __builtin_amdgcn_s_sleep(1); \
    if ((++_sp & 255u) == 0u) { if (xb_ld(&(bar)[XB_TMO])) break; if (_sp > XB_SPIN_CAP) { atomicAdd(&(bar)[XB_TMO], 1u); break; } } } } while (0)
struct XcdBarrier { unsigned* bar; unsigned x; volatile LAS unsigned* st; };
__device__ __forceinline__ XcdBarrier xcd_barrier_post(unsigned* bar, volatile LAS unsigned* st) {
    XcdBarrier b; b.bar = bar; b.x = xb_xcc_id(); b.st = st;
    if (threadIdx.x == 0) (void)xb_add(&bar[XB_XCNT(b.x)], 1u);
    return b;
}
__device__ __forceinline__ void xcd_barrier_complete(unsigned* bar, unsigned x, unsigned& nloc, unsigned& nx) {
    const unsigned G = gridDim.x * gridDim.y * gridDim.z;
    unsigned sum, cnt, mine, sp = 0u;
    for (;;) {
        sum = 0u; cnt = 0u; mine = 0u;
#pragma unroll
        for (unsigned j = 0; j < 16; ++j) { const unsigned c = xb_ld(&bar[XB_XCNT(j)]); sum += c; cnt += (c > 0u) ? 1u : 0u; mine = (j == x) ? c : mine; }
        if (sum == G) break;
        __builtin_amdgcn_s_sleep(1);
        if ((++sp & 255u) == 0u) { if (xb_ld(&bar[XB_TMO])) break; if (sp > XB_SPIN_CAP) { atomicAdd(&bar[XB_TMO], 1u); break; } }
    }
    nloc = mine > 0u ? mine : 1u; nx = cnt > 0u ? cnt : 1u;
}
__device__ __forceinline__ void xcd_barrier(const XcdBarrier& b) {
    asm volatile("s_waitcnt vmcnt(0)" ::: "memory");
    __syncthreads();
    if (threadIdx.x == 0) {
        unsigned* bar = b.bar;
        __builtin_amdgcn_s_waitcnt(0);
        unsigned nloc = b.st[0], nx = b.st[1];
        if (nloc == 0u) { xcd_barrier_complete(bar, b.x, nloc, nx); b.st[0] = nloc; b.st[1] = nx; }
        const unsigned old = xb_add(&bar[XB_XSUB(b.x)], 1u);
        const unsigned gen = old / nloc;
        if (old + 1u == (gen + 1u) * nloc) {
            __builtin_amdgcn_fence(__ATOMIC_RELEASE, "agent");
            asm volatile("s_waitcnt vmcnt(0)" ::: "memory");
            const unsigned og = xb_add(&bar[XB_TOP], 1u);
            const unsigned tg = og / nx;
            if (og + 1u == (tg + 1u) * nx) xb_add(&bar[XB_TOPGEN], 1u);
            else XB_SPIN(xb_ld(&bar[XB_TOPGEN]) == tg, bar);
            __builtin_amdgcn_fence(__ATOMIC_ACQUIRE, "agent");
            xb_add(&bar[XB_XGEN(b.x)], 1u);
            asm volatile("s_waitcnt vmcnt(0)" ::: "memory");
        } else {
            XB_SPIN(xb_ld(&bar[XB_XGEN(b.x)]) == gen, bar);
            __builtin_amdgcn_fence(__ATOMIC_ACQUIRE, "agent");
            asm volatile("s_waitcnt vmcnt(0)" ::: "memory");
        }
    }
    __syncthreads();
}

struct Frame {
    LAS unsigned char* lds;
    volatile LAS unsigned* MISC;
    gu32* ctl;
    int tid, lane, wave;
    int vcu, G;
    const float *x, *g1, *w_in, *sb_g, *sw_g, *sinks, *w_out, *g2, *w_q, *keys1, *keys2, *pu, *pv, *gf;
    float* out;
    bf16 *Wt_in, *Wt_out, *Wt_q, *KEYS, *H, *MIX, *QKV;
    unsigned char *U8, *V8; float *RSU, *RSV, *SSP, *SSQP, *RS2; bf16 *PD, *X2, *C;
    unsigned short* IDX; float* GATE;
};

__device__ __forceinline__ float wave_sum(float v) {
#pragma unroll
    for (int o = 1; o < 64; o <<= 1) v += __shfl_xor(v, o);
    return v;
}

__device__ __forceinline__ void p0_transpose_item(const float* W, int K, int N, bf16* WT, LAS float* scr, int item, int lane, const float* gk = nullptr) {
    const int nblk = N / 32, kb = item / nblk, nb = item % nblk, k0 = 64 * kb, n0 = 32 * nb;
#pragma unroll 8
    for (int i = 0; i < 32; ++i) { const int kk = 2 * i + (lane >> 5); const float gq = gk ? gk[k0 + kk] : 1.0f; scr[kk * 33 + (lane & 31)] = __builtin_nontemporal_load(W + (size_t)(k0 + kk) * N + n0 + (lane & 31)) * gq; }
    LDS_WAIT(); asm volatile("" ::: "memory");
    const int c = lane & 7;
#pragma unroll
    for (int j = 0; j < 4; ++j) { const int n = (lane >> 3) + 8 * j; const LAS float* s = scr + (8 * c) * 33 + n;
        u32x4 o; o.x = pk2(s[0 * 33], s[1 * 33]); o.y = pk2(s[2 * 33], s[3 * 33]); o.z = pk2(s[4 * 33], s[5 * 33]); o.w = pk2(s[6 * 33], s[7 * 33]);
        *(GAS u32x4*)(WT + (size_t)(n0 + n) * K + k0 + 8 * c) = o; }
    LDS_WAIT(); asm volatile("" ::: "memory");
}
template <int NR> __device__ __forceinline__ void rms_rows_to_bf16(const float* xbase, const float* g, bf16* obase, int m0, int mstride, int lane) {
    f32x4 v[NR][4];
#pragma unroll
    for (int i = 0; i < NR; ++i) { const int m = m0 + i * mstride; const GAS f32x4* xr = (const GAS f32x4*)(xbase + (size_t)(m < T ? m : m0) * D) + lane;
#pragma unroll
        for (int j = 0; j < 4; ++j) v[i][j] = __builtin_nontemporal_load(xr + 64 * j); }
    const GAS f32x4* gr = (const GAS f32x4*)g + lane;
    f32x4 gg[4];
#pragma unroll
    for (int j = 0; j < 4; ++j) gg[j] = gr[64 * j];
#pragma unroll
    for (int i = 0; i < NR; ++i) { const int m = m0 + i * mstride;
        float s = 0.f;
#pragma unroll
        for (int j = 0; j < 4; ++j) s += (v[i][j].x * v[i][j].x + v[i][j].y * v[i][j].y) + (v[i][j].z * v[i][j].z + v[i][j].w * v[i][j].w);
        const float rs = __builtin_amdgcn_rsqf(wave_sum(s) * (1.f / D) + EPS);
        if (m < T) { GAS u32x2* o8 = (GAS u32x2*)(obase + (size_t)m * D) + lane;
#pragma unroll
            for (int j = 0; j < 4; ++j) { u32x2 w; w.x = pk2(v[i][j].x * rs * gg[j].x, v[i][j].y * rs * gg[j].y); w.y = pk2(v[i][j].z * rs * gg[j].z, v[i][j].w * rs * gg[j].w); o8[64 * j] = w; } } }
}
__device__ __forceinline__ void cvt_array_bf16(const float* src, bf16* dst, size_t n8, int gtid, int gthreads) {
    for (size_t i = gtid; i < n8; i += gthreads) {
        const f32x4 a = __builtin_nontemporal_load((const GAS f32x4*)(src + i * 8)), b = __builtin_nontemporal_load((const GAS f32x4*)(src + i * 8 + 4));
        u32x4 o; o.x = pk2(a.x, a.y); o.y = pk2(a.z, a.w); o.z = pk2(b.x, b.y); o.w = pk2(b.z, b.w);
        *(GAS u32x4*)(dst + i * 8) = o;
    }
}
__device__ __forceinline__ void p0_prologue(Frame& F) {
    LAS float* scr = (LAS float*)(F.lds + F.wave * 16384);
    const int gw = F.vcu * NWAVES + F.wave, NGW = F.G * NWAVES;
    constexpr int I_IN = (D / 64) * (DIN / 32), I_OUT = (D / 64) * (D / 32), I_Q = (D / 64) * (DQ / 32);
    constexpr int NITEMS = I_IN + I_OUT + I_Q;
    for (int it = gw; it < NITEMS; it += NGW) {
        int r = it;
        if (r < I_IN) { p0_transpose_item(F.w_in, D, DIN, F.Wt_in, scr, r, F.lane); continue; } r -= I_IN;
        if (r < I_OUT) { p0_transpose_item(F.w_out, D, D, F.Wt_out, scr, r, F.lane); continue; } r -= I_OUT;
        p0_transpose_item(F.w_q, D, DQ, F.Wt_q, scr, r, F.lane, F.g2);
    }
    for (int m = gw; m < T; m += 4 * NGW) rms_rows_to_bf16<4>(F.x, F.g1, F.H, m, NGW, F.lane);
    const int gtid = F.vcu * NWAVES * 64 + F.tid, gthreads = F.G * NWAVES * 64;
    cvt_array_bf16(F.keys1, F.KEYS, (size_t)8 * 128 * 128 / 8, gtid, gthreads);
    cvt_array_bf16(F.keys2, F.KEYS + 8 * 128 * 128, (size_t)8 * 128 * 128 / 8, gtid, gthreads);
}

__device__ __forceinline__ int pack_i8(float a, float b, float c, float d) {
    const int qa = (int)__builtin_rintf(a), qb = (int)__builtin_rintf(b), qc = (int)__builtin_rintf(c), qd = (int)__builtin_rintf(d);
    return (qa & 0xff) | ((qb & 0xff) << 8) | ((qc & 0xff) << 16) | (qd << 24);
}
__device__ __forceinline__ float wave_max(float v) {
#pragma unroll
    for (int o = 1; o < 64; o <<= 1) v = __builtin_fmaxf(v, __shfl_xor(v, o));
    return v;
}
template <int NR> __device__ __forceinline__ void cvt_rows_fp8(Frame& F, int r0, int rstride, int rlimit, int lane) {
    f32x4 v[NR][4];
#pragma unroll
    for (int i = 0; i < NR; ++i) { int r = r0 + i * rstride; r = r < rlimit ? r : r0; const float* src = r < NEXP ? F.pu + (size_t)r * D : F.pv + (size_t)(r - NEXP) * D;
        const GAS f32x4* xr = (const GAS f32x4*)src + lane;
#pragma unroll
        for (int j = 0; j < 4; ++j) v[i][j] = __builtin_nontemporal_load(xr + 64 * j); }
    f32x4 g2v[4];
#pragma unroll
    for (int j = 0; j < 4; ++j) g2v[j] = ((const GAS f32x4*)F.g2)[lane + 64 * j];
#pragma unroll
    for (int i = 0; i < NR; ++i) { const int r = r0 + i * rstride;
        if (r < NEXP) {
#pragma unroll
            for (int j = 0; j < 4; ++j) v[i][j] = v[i][j] * g2v[j]; }
        float amax = 0.f;
#pragma unroll
        for (int j = 0; j < 4; ++j) amax = __builtin_fmaxf(amax, __builtin_fmaxf(__builtin_fmaxf(__builtin_fabsf(v[i][j].x), __builtin_fabsf(v[i][j].y)), __builtin_fmaxf(__builtin_fabsf(v[i][j].z), __builtin_fabsf(v[i][j].w))));
        amax = wave_max(amax);
        int k = 6 - ((int)((f_bits(amax) >> 23) & 0xffu) - 127);
        k = k > 100 ? 100 : (k < -100 ? -100 : k);
        const float sc = bits_f((unsigned)(k + 127) << 23), inv = bits_f((unsigned)(127 - k) << 23);
        if (r < rlimit) { const int e = r < NEXP ? r : r - NEXP; unsigned char* tab8 = r < NEXP ? F.U8 : F.V8; float* rs = r < NEXP ? F.RSU : F.RSV;
            const bool isu = r < NEXP;
            const float sq = amax > 0.f ? 127.0f / amax : 0.f;
#pragma unroll
            for (int j = 0; j < 4; ++j) {
                int w = 0;
                if (isu) { w = pack_i8(v[i][j].x * sq, v[i][j].y * sq, v[i][j].z * sq, v[i][j].w * sq); }
                else { w = __builtin_amdgcn_cvt_pk_fp8_f32(v[i][j].x * sc, v[i][j].y * sc, w, false); w = __builtin_amdgcn_cvt_pk_fp8_f32(v[i][j].z * sc, v[i][j].w * sc, w, true); }
                const int s = 2 * j + (lane >> 5);
                *(GAS unsigned*)(tab8 + (size_t)s * TAB8_SLICE + (size_t)e * 128 + 4 * (lane & 31)) = (unsigned)w;
            }
            if (lane == 0) rs[e] = isu ? amax * (1.0f / 127.0f) : inv; } }
}
__device__ __forceinline__ int crow(int r, int hi) { return (r & 3) + 8 * (r >> 2) + 4 * hi; }
constexpr int VPITCH = 192;
constexpr int KPITCH = 144;
constexpr int ATT_K_OFF = 0, ATT_V_OFF = 32 * KPITCH, ATT_Q_OFF = 32 * KPITCH + 32 * VPITCH, ATT_WAVE_BYTES = 64 * KPITCH + 32 * VPITCH;
struct Tile4 { u32x4 a, b, c, d; };
__device__ __forceinline__ Tile4 tile_load(const bf16* t0, int lane) {
    const bf16* p = t0 + (size_t)(lane >> 3) * DIN + 8 * (lane & 7);
    Tile4 t; t.a = *(const GAS u32x4*)p; t.b = *(const GAS u32x4*)(p + (size_t)8 * DIN); t.c = *(const GAS u32x4*)(p + (size_t)16 * DIN); t.d = *(const GAS u32x4*)(p + (size_t)24 * DIN); return t;
}
__device__ __forceinline__ void tile_store(LAS unsigned char* dst, int pitch, const Tile4& t, int lane) {
    LAS unsigned char* p = dst + (lane >> 3) * pitch + 16 * (lane & 7);
    *(LAS u32x4*)p = t.a; *(LAS u32x4*)(p + 8 * pitch) = t.b; *(LAS u32x4*)(p + 16 * pitch) = t.c; *(LAS u32x4*)(p + 24 * pitch) = t.d;
}
__device__ __forceinline__ bf16x8 kfrag(const LAS unsigned char* kt, int d0, int lane) { const u32x4 w = *(const LAS u32x4*)(kt + (lane & 31) * KPITCH + 32 * d0 + 16 * (lane >> 5)); return __builtin_bit_cast(bf16x8, w); }
__device__ __forceinline__ bf16x8 vfrag(const LAS unsigned char* wl, int dblk, int s, int lane) {
    const int hi = lane >> 5, i = lane & 15, g1 = (lane >> 4) & 1;
    const LAS unsigned char* p = wl + (16 * s + 4 * hi + (i >> 2)) * VPITCH + (32 * dblk + 16 * g1 + 4 * (i & 3)) * 2;
    const v4i16_t lo = __builtin_amdgcn_ds_read_tr16_b64_v4i16((LAS v4i16_t*)p);
    const v4i16_t hh = __builtin_amdgcn_ds_read_tr16_b64_v4i16((LAS v4i16_t*)(p + 8 * VPITCH));
    return (bf16x8){lo[0], lo[1], lo[2], lo[3], hh[0], hh[1], hh[2], hh[3]};
}
__device__ __forceinline__ bf16x8 pack8(const f32x16& a, int s) {
    u32x4 w; w.x = pk2(a[8 * s + 0], a[8 * s + 1]); w.y = pk2(a[8 * s + 2], a[8 * s + 3]); w.z = pk2(a[8 * s + 4], a[8 * s + 5]); w.w = pk2(a[8 * s + 6], a[8 * s + 7]);
    return __builtin_bit_cast(bf16x8, w);
}
__device__ __forceinline__ void head_norm_store(const f32x16& o0, const f32x16& o1, float scale, const float* g, bf16* dstrow, int hi) {
    float ss = 0.f;
#pragma unroll
    for (int r = 0; r < 16; ++r) { const float a = o0[r] * scale, b = o1[r] * scale; ss += a * a + b * b; }
    ss += __shfl_xor(ss, 32);
    const float rs = __builtin_amdgcn_rsqf(ss * (1.f / 64.f) + EPS) * scale;
#pragma unroll
    for (int dblk = 0; dblk < 2; ++dblk)
#pragma unroll
        for (int q4 = 0; q4 < 4; ++q4) { const int d0 = 32 * dblk + 8 * q4 + 4 * hi; const f32x4 gg = *(const GAS f32x4*)(g + d0);
            const f32x16& o = dblk ? o1 : o0;
            u32x2 w; w.x = pk2(o[4 * q4 + 0] * rs * gg.x, o[4 * q4 + 1] * rs * gg.y); w.y = pk2(o[4 * q4 + 2] * rs * gg.z, o[4 * q4 + 3] * rs * gg.w);
            *(GAS u32x2*)(dstrow + d0) = w; }
}

__device__ __forceinline__ void sb_item(Frame& F, int b, int h, int qb, LAS unsigned char* wl) {
    const int lane = F.lane, r32 = lane & 31, hi = lane >> 5;
    const size_t rowbase = (size_t)b * SEQ;
    const bf16* Qp = F.QKV + (rowbase + 32 * qb) * DIN + C_SBQ + h * 64;
    const bf16* Kb = F.QKV + rowbase * DIN + C_SBK + h * 64;
    const bf16* Vb = F.QKV + rowbase * DIN + C_SBV + h * 64;
    bf16x8 qr[4];
    { const Tile4 tq = tile_load(Qp, lane); tile_store(wl + ATT_K_OFF, KPITCH, tq, lane);
#pragma unroll
      for (int d0 = 0; d0 < 4; ++d0) qr[d0] = kfrag(wl + ATT_K_OFF, d0, lane); }
    bf16x8 tri[2];
#pragma unroll
    for (int s = 0; s < 2; ++s)
#pragma unroll
        for (int j = 0; j < 8; ++j) tri[s][j] = (16 * s + 8 * (j >> 2) + 4 * hi + (j & 3) >= r32) ? (short)0x3F80 : (short)0;
    f32x16 o0 = {}, o1 = {}; float C = 0.f;
    Tile4 tk = tile_load(Kb + (size_t)(32 * qb) * DIN, lane), tv = tile_load(Vb + (size_t)(32 * qb) * DIN, lane);
    for (int kt = qb; kt >= 0; --kt) {
        tile_store(wl + ATT_K_OFF, KPITCH, tk, lane); tile_store(wl + ATT_V_OFF, VPITCH, tv, lane);
        { const int kn = kt > 0 ? kt - 1 : 0; tk = tile_load(Kb + (size_t)(32 * kn) * DIN, lane); tv = tile_load(Vb + (size_t)(32 * kn) * DIN, lane); }
        bf16x8 kf[4];
#pragma unroll
        for (int d0 = 0; d0 < 4; ++d0) kf[d0] = kfrag(wl + ATT_K_OFF, d0, lane);
        f32x16 z = {};
#pragma unroll
        for (int d0 = 0; d0 < 4; ++d0) z = __builtin_amdgcn_mfma_f32_32x32x16_bf16(kf[d0], qr[d0], z, 0, 0, 0);
        const int lim = r32 + 32 * (qb - kt);
        f32x16 l, ls;
#pragma unroll
        for (int r = 0; r < 16; ++r) {
            const float zz = z[r] * 0.125f;
            const float e = __builtin_amdgcn_exp2f(-__builtin_fabsf(zz) * LOG2E);
            const float sp = __builtin_fmaxf(zz, 0.f) + LN2 * __builtin_amdgcn_logf(1.0f + e);
            const bool valid = crow(r, hi) < lim;
            l[r] = valid ? -sp : 0.f;
            ls[r] = zz - sp;
        }
        f32x16 lo;
        bf16x8 lh[2], ll[2];
#pragma unroll
        for (int s = 0; s < 2; ++s) {
            u32x4 wh, wlw;
#pragma unroll
            for (int p = 0; p < 4; ++p) { const float a = l[8 * s + 2 * p], c = l[8 * s + 2 * p + 1]; const unsigned w = pk2(a, c); wh[p] = w; lo[8 * s + 2 * p] = a - bf_lo(w); lo[8 * s + 2 * p + 1] = c - bf_hi(w); }
#pragma unroll
            for (int p = 0; p < 4; ++p) wlw[p] = pk2(lo[8 * s + 2 * p], lo[8 * s + 2 * p + 1]);
            lh[s] = __builtin_bit_cast(bf16x8, wh); ll[s] = __builtin_bit_cast(bf16x8, wlw);
        }
        f32x16 Y = {};
        Y = __builtin_amdgcn_mfma_f32_32x32x16_bf16(tri[0], lh[0], Y, 0, 0, 0);
        Y = __builtin_amdgcn_mfma_f32_32x32x16_bf16(tri[1], lh[1], Y, 0, 0, 0);
        Y = __builtin_amdgcn_mfma_f32_32x32x16_bf16(tri[0], ll[0], Y, 0, 0, 0);
        Y = __builtin_amdgcn_mfma_f32_32x32x16_bf16(tri[1], ll[1], Y, 0, 0, 0);
        f32x16 a;
#pragma unroll
        for (int r = 0; r < 16; ++r) {
            const bool valid = crow(r, hi) < lim;
            const float later = C + (Y[r] - l[r]);
            const float av = __builtin_amdgcn_exp2f((ls[r] + later) * LOG2E);
            a[r] = valid ? av : 0.f;
        }
        const float tot = __shfl(Y[0], r32);
        C += tot;
        const bf16x8 a0 = pack8(a, 0), a1 = pack8(a, 1);
        o0 = __builtin_amdgcn_mfma_f32_32x32x16_bf16(vfrag(wl + ATT_V_OFF, 0, 0, lane), a0, o0, 0, 0, 0);
        o0 = __builtin_amdgcn_mfma_f32_32x32x16_bf16(vfrag(wl + ATT_V_OFF, 0, 1, lane), a1, o0, 0, 0, 0);
        o1 = __builtin_amdgcn_mfma_f32_32x32x16_bf16(vfrag(wl + ATT_V_OFF, 1, 0, lane), a0, o1, 0, 0, 0);
        o1 = __builtin_amdgcn_mfma_f32_32x32x16_bf16(vfrag(wl + ATT_V_OFF, 1, 1, lane), a1, o1, 0, 0, 0);
        if (__all(C < SB_EXIT)) break;
    }
    head_norm_store(o0, o1, 1.0f, F.sb_g + h * 64, F.MIX + (rowbase + 32 * qb + r32) * D + h * 64, hi);
}

#define SWA_HEAD(z, qslope, m_, den_, oa, ob) do { \
        float tmax_ = -INFINITY; f32x16 s_; \
        _Pragma("unroll") for (int r = 0; r < 16; ++r) { const int dist = dq - ((r & 3) + 8 * (r >> 2)); const float sv = z[r] * 0.125f - qslope * (float)dist; s_[r] = ((unsigned)dist < 128u) ? sv : -INFINITY; tmax_ = __builtin_fmaxf(tmax_, s_[r]); } \
        tmax_ = __builtin_fmaxf(tmax_, __shfl_xor(tmax_, 32)); \
        const float mn_ = __builtin_fmaxf(m_, tmax_); const float al_ = __builtin_amdgcn_exp2f((m_ - mn_) * LOG2E); m_ = mn_; \
        f32x16 p_; float ps_ = 0.f; \
        _Pragma("unroll") for (int r = 0; r < 16; ++r) { p_[r] = __builtin_amdgcn_exp2f((s_[r] - mn_) * LOG2E); ps_ += p_[r]; } \
        den_ = den_ * al_ + ps_; \
        _Pragma("unroll") for (int r = 0; r < 16; ++r) { oa[r] *= al_; ob[r] *= al_; } \
        const bf16x8 a0_ = pack8(p_, 0), a1_ = pack8(p_, 1); \
        oa = __builtin_amdgcn_mfma_f32_32x32x16_bf16(vf00, a0_, oa, 0, 0, 0); oa = __builtin_amdgcn_mfma_f32_32x32x16_bf16(vf01, a1_, oa, 0, 0, 0); \
        ob = __builtin_amdgcn_mfma_f32_32x32x16_bf16(vf10, a0_, ob, 0, 0, 0); ob = __builtin_amdgcn_mfma_f32_32x32x16_bf16(vf11, a1_, ob, 0, 0, 0); } while (0)
__device__ __forceinline__ void swa_item2(Frame& F, int b, int kv, int hp, int qb, LAS unsigned char* wl) {
    const int lane = F.lane, r32 = lane & 31, hi = lane >> 5, hqA = kv * 4 + 2 * hp, hqB = hqA + 1;
    const size_t rowbase = (size_t)b * SEQ;
    const bf16* QpA = F.QKV + (rowbase + 32 * qb) * DIN + C_SWQ + hqA * 64;
    const bf16* Kb = F.QKV + rowbase * DIN + C_SWK + kv * 64;
    const bf16* Vb = F.QKV + rowbase * DIN + C_SWV + kv * 64;
    const float slopeA = __builtin_amdgcn_exp2f(-(float)(hqA + 1)), slopeB = __builtin_amdgcn_exp2f(-(float)(hqB + 1));
    float mA = F.sinks[hqA], mB = F.sinks[hqB];
    bf16x8 qrA[4];
    { const Tile4 tq = tile_load(QpA, lane); tile_store(wl + ATT_K_OFF, KPITCH, tq, lane);
#pragma unroll
      for (int d0 = 0; d0 < 4; ++d0) qrA[d0] = kfrag(wl + ATT_K_OFF, d0, lane); }
    { const Tile4 tq = tile_load(QpA + 64, lane); tile_store(wl + ATT_Q_OFF, KPITCH, tq, lane); }
    float denA = hi == 0 ? 1.f : 0.f, denB = denA;
    f32x16 oA0 = {}, oA1 = {}, oB0 = {}, oB1 = {};
    const int kt0 = qb - 4 < 0 ? 0 : qb - 4;
    for (int kt = kt0; kt <= qb; ++kt) {
        { const Tile4 tk = tile_load(Kb + (size_t)(32 * kt) * DIN, lane), tv = tile_load(Vb + (size_t)(32 * kt) * DIN, lane);
          tile_store(wl + ATT_K_OFF, KPITCH, tk, lane); tile_store(wl + ATT_V_OFF, VPITCH, tv, lane); }
        const bf16x8 vf00 = vfrag(wl + ATT_V_OFF, 0, 0, lane), vf01 = vfrag(wl + ATT_V_OFF, 0, 1, lane), vf10 = vfrag(wl + ATT_V_OFF, 1, 0, lane), vf11 = vfrag(wl + ATT_V_OFF, 1, 1, lane);
        const int dq = 32 * (qb - kt) + r32 - 4 * hi;
        { f32x16 zA = {};
#pragma unroll
          for (int d0 = 0; d0 < 4; ++d0) zA = __builtin_amdgcn_mfma_f32_32x32x16_bf16(kfrag(wl + ATT_K_OFF, d0, lane), qrA[d0], zA, 0, 0, 0);
          SWA_HEAD(zA, slopeA, mA, denA, oA0, oA1); }
        { f32x16 zB = {};
#pragma unroll
          for (int d0 = 0; d0 < 4; ++d0) zB = __builtin_amdgcn_mfma_f32_32x32x16_bf16(kfrag(wl + ATT_K_OFF, d0, lane), kfrag(wl + ATT_Q_OFF, d0, lane), zB, 0, 0, 0);
          SWA_HEAD(zB, slopeB, mB, denB, oB0, oB1); }
    }
    denA += __shfl_xor(denA, 32); denB += __shfl_xor(denB, 32);
    bf16* dst = F.MIX + (rowbase + 32 * qb + r32) * D + 512 + hqA * 64;
    head_norm_store(oA0, oA1, 1.0f / denA, F.sw_g + hqA * 64, dst, hi);
    head_norm_store(oB0, oB1, 1.0f / denB, F.sw_g + hqB * 64, dst + 64, hi);
}
__device__ __forceinline__ void p2_attention(Frame& F) {
    LAS unsigned char* wl = F.lds + F.wave * 16384;
    static_assert(ATT_WAVE_BYTES <= 16384 && NWAVES * 16384 <= RING_BYTES, "attention LDS");
    const int gw = F.vcu * NWAVES + F.wave, NGW = F.G * NWAVES;
    constexpr int NSB = NB * 8 * 128, NSW = NB * 4 * 128;
    for (int it = gw; it < NSB + NSW; it += NGW) {
        if (it < NSB) { const int qb = it & 127, h = (it >> 7) & 7, b = it >> 10; sb_item(F, b, h, qb, wl); }
        else { const int r = it - NSB; const int qb = r & 127, hp = (r >> 7) & 1, kv = (r >> 8) & 1, b = r >> 9; swa_item2(F, b, kv, hp, qb, wl); }
    }
}

__device__ __forceinline__ int f2ord(unsigned bits) { int x = (int)bits; return x ^ ((x >> 31) & 0x7fffffff); }
template <int N> __device__ __forceinline__ void bitonic_desc(int (&v)[N]) {
#pragma unroll
    for (int k = 2; k <= N; k <<= 1) {
#pragma unroll
        for (int j = k >> 1; j > 0; j >>= 1) {
#pragma unroll
            for (int i = 0; i < N; ++i) {
                const int l = i ^ j;
                if (l > i) { const bool up = ((i & k) == 0); const int a = v[i], b = v[l]; const int mx = a > b ? a : b, mn = a > b ? b : a; v[i] = up ? mx : mn; v[l] = up ? mn : mx; }
            }
        }
    }
}
template <int N> __device__ __forceinline__ void bitonic_merge_desc(int (&v)[N]) {
#pragma unroll
    for (int j = N >> 1; j > 0; j >>= 1) {
#pragma unroll
        for (int i = 0; i < N; ++i) { const int l = i ^ j; if (l > i) { const int a = v[i], b = v[l]; v[i] = a > b ? a : b; v[l] = a > b ? b : a; } }
    }
}
template <int N> __device__ __forceinline__ void bitonic_desc_kv(int (&k)[N], int (&p)[N]) {
#pragma unroll
    for (int kk = 2; kk <= N; kk <<= 1) {
#pragma unroll
        for (int j = kk >> 1; j > 0; j >>= 1) {
#pragma unroll
            for (int i = 0; i < N; ++i) {
                const int l = i ^ j;
                if (l > i) { const bool up = ((i & kk) == 0); const bool sw = up ? (k[i] < k[l]) : (k[i] > k[l]);
                    const int ka = k[i], kb = k[l], pa = p[i], pb = p[l]; k[i] = sw ? kb : ka; k[l] = sw ? ka : kb; p[i] = sw ? pb : pa; p[l] = sw ? pa : pb; }
            }
        }
    }
}
struct Cand { unsigned char i, j; };
struct CandTable { Cand c[64]; int n; };
constexpr CandTable make_cands() { CandTable t{}; int n = 0; for (int i = 0; i < 16; ++i) for (int j = 0; j < 16; ++j) if ((i + 1) * (j + 1) <= 16) { t.c[n].i = (unsigned char)i; t.c[n].j = (unsigned char)j; ++n; } t.n = n; return t; }
constexpr CandTable CANDS = make_cands();
static_assert(CANDS.n == 50, "candidate count");

constexpr int P6_PITCH = 272, P6_KEYS_BYTES = 128 * P6_PITCH, P6_Q_BYTES = 32 * P6_PITCH;
static_assert(2 * P6_KEYS_BYTES + NWAVES * P6_Q_BYTES <= RING_BYTES, "P6 LDS map");
__device__ __forceinline__ void p6_item(Frame& F, int tb, int h, LAS unsigned char* keys_lds, LAS unsigned char* qw) {
    const int lane = F.lane, r32 = lane & 31, hi = lane >> 5;
    const bf16* QP = F.QKV;
    int top0[16], top1[16];
#pragma unroll 1
    for (int half = 0; half < 2; ++half) {
        { const bf16* qsrc = QP + (size_t)(32 * tb + (lane >> 4)) * DQ + h * 256 + half * 128 + 8 * (lane & 15);
          u32x4 t_[8];
#pragma unroll
          for (int i = 0; i < 8; ++i) t_[i] = *(const GAS u32x4*)(qsrc + (size_t)(4 * i) * DQ);
#pragma unroll
          for (int i = 0; i < 8; ++i) *(LAS u32x4*)(qw + (4 * i + (lane >> 4)) * P6_PITCH + 16 * (lane & 15)) = t_[i]; }
        bf16x8 qf[8];
#pragma unroll
        for (int ks = 0; ks < 8; ++ks) { const u32x4 w_ = *(const LAS u32x4*)(qw + r32 * P6_PITCH + 32 * ks + 16 * hi); qf[ks] = __builtin_bit_cast(bf16x8, w_); }
        const LAS unsigned char* kb = keys_lds + half * P6_KEYS_BYTES + r32 * P6_PITCH + 16 * hi;
        int v[64];
#pragma unroll
        for (int nt = 0; nt < 4; ++nt) {
            f32x16 acc = {};
#pragma unroll
            for (int ks = 0; ks < 8; ++ks) { const u32x4 w_ = *(const LAS u32x4*)(kb + (32 * nt) * P6_PITCH + 32 * ks); acc = __builtin_amdgcn_mfma_f32_32x32x16_bf16(__builtin_bit_cast(bf16x8, w_), qf[ks], acc, 0, 0, 0); }
#pragma unroll
            for (int r = 0; r < 16; ++r) { const float av = acc[r]; const unsigned bits = (f_bits(av) & ~0x7Fu) | (unsigned)(32 * nt + crow(r, hi)); v[16 * nt + r] = f2ord(bits); }
        }
        bitonic_desc<64>(v);
        int m[16];
#pragma unroll
        for (int i = 0; i < 16; ++i) { const int o = __shfl_xor(v[15 - i], 32); m[i] = v[i] > o ? v[i] : o; }
        bitonic_merge_desc<16>(m);
#pragma unroll
        for (int i = 0; i < 16; ++i) { if (half == 0) top0[i] = m[i]; else top1[i] = m[i]; }
    }
    float f1[16], f2[16]; int i1[16], i2[16];
#pragma unroll
    for (int i = 0; i < 16; ++i) { const unsigned b1 = (unsigned)f2ord((unsigned)top0[i]), b2 = (unsigned)f2ord((unsigned)top1[i]);
        f1[i] = bits_f(b1 & ~0x7Fu); i1[i] = (int)(b1 & 0x7Fu); f2[i] = bits_f(b2 & ~0x7Fu); i2[i] = (int)(b2 & 0x7Fu); }
    int ck[32], cp[32];
#pragma unroll
    for (int s = 0; s < 32; ++s) {
        if (s < 25) { constexpr int dummy = 0; (void)dummy;
            const int ia = CANDS.c[2 * s].i, ja = CANDS.c[2 * s].j, ib = CANDS.c[2 * s + 1].i, jb = CANDS.c[2 * s + 1].j;
            const float sa = f1[ia] + f2[ja], sb = f1[ib] + f2[jb]; const int pa = (i1[ia] << 7) | i2[ja], pb = (i1[ib] << 7) | i2[jb];
            ck[s] = f2ord(f_bits(hi ? sb : sa)); cp[s] = hi ? pb : pa;
        } else { ck[s] = (int)0x80000000; cp[s] = 0; }
    }
    bitonic_desc_kv<32>(ck, cp);
    int wk[16], wp[16];
#pragma unroll
    for (int i = 0; i < 16; ++i) { const int ok = __shfl_xor(ck[15 - i], 32), op = __shfl_xor(cp[15 - i], 32); const bool t = ck[i] >= ok; wk[i] = t ? ck[i] : ok; wp[i] = t ? cp[i] : op; }
    float vals[16]; float mxv = -INFINITY;
#pragma unroll
    for (int i = 0; i < 16; ++i) { vals[i] = bits_f((unsigned)f2ord((unsigned)wk[i])); mxv = __builtin_fmaxf(mxv, vals[i]); }
    float se = 0.f;
#pragma unroll
    for (int i = 0; i < 16; ++i) { vals[i] = __builtin_amdgcn_exp2f((vals[i] - mxv) * LOG2E); se += vals[i]; }
    const float inv = 1.0f / se;
    const size_t ob = (size_t)(32 * tb + r32) * 128 + h * 16 + hi * 8;
    { u32x4 a; a.x = (unsigned)wp[0] | ((unsigned)wp[1] << 16); a.y = (unsigned)wp[2] | ((unsigned)wp[3] << 16); a.z = (unsigned)wp[4] | ((unsigned)wp[5] << 16); a.w = (unsigned)wp[6] | ((unsigned)wp[7] << 16);
      *(GAS u32x4*)(F.IDX + ob) = a;
      f32x4 ga = {vals[0] * inv, vals[1] * inv, vals[2] * inv, vals[3] * inv}, gb = {vals[4] * inv, vals[5] * inv, vals[6] * inv, vals[7] * inv};
      *(GAS f32x4*)(F.GATE + ob) = ga; *(GAS f32x4*)(F.GATE + ob + 4) = gb; }
}
template <class Sched> __device__ __forceinline__ void p6_topk_own(Frame& F, const Sched& S) {
    LAS unsigned char* keys_lds = F.lds; LAS unsigned char* qw = F.lds + 2 * P6_KEYS_BYTES + F.wave * P6_Q_BYTES;
    pg8::Unit u; int hprev = -1;
    for (int i = 0; S.next(i, u); ++i) {
        const int h = u.pn;
        if (h != hprev) {
            __syncthreads();
#pragma unroll
            for (int half = 0; half < 2; ++half) {
                const bf16* ksrc = F.KEYS + (size_t)(half * 8 + h) * 128 * 128 + (size_t)(F.tid >> 4) * 128 + 8 * (F.tid & 15);
                u32x4 t_[4];
#pragma unroll
                for (int q = 0; q < 4; ++q) t_[q] = *(const GAS u32x4*)(ksrc + (size_t)(32 * q) * 128);
#pragma unroll
                for (int q = 0; q < 4; ++q) *(LAS u32x4*)(keys_lds + half * P6_KEYS_BYTES + ((F.tid >> 4) + 32 * q) * P6_PITCH + 16 * (F.tid & 15)) = t_[q];
            }
            __syncthreads(); hprev = h;
        }
        p6_item(F, 8 * u.pm + F.wave, h, keys_lds, qw);
    }
    { const int gw_ = F.vcu * NWAVES + F.wave, NGW_ = F.G * NWAVES; for (int r = NEXP + gw_; r < 2 * NEXP; r += 4 * NGW_) cvt_rows_fp8<4>(F, r, NGW_, 2 * NEXP, F.lane); }
    __syncthreads();
}

__device__ __forceinline__ float dpp_xor1(float v) { return v + bits_f((unsigned)__builtin_amdgcn_update_dpp(0, (int)f_bits(v), 0xB1, 0xf, 0xf, false)); }
__device__ __forceinline__ float dpp_xor2(float v) { return v + bits_f((unsigned)__builtin_amdgcn_update_dpp(0, (int)f_bits(v), 0x4E, 0xf, 0xf, false)); }
__device__ __forceinline__ float dpp_hmir(float v) { return v + bits_f((unsigned)__builtin_amdgcn_update_dpp(0, (int)f_bits(v), 0x141, 0xf, 0xf, false)); }
__device__ __forceinline__ float dpp_max_xor1(float v) { return __builtin_fmaxf(v, bits_f((unsigned)__builtin_amdgcn_update_dpp(0, (int)f_bits(v), 0xB1, 0xf, 0xf, false))); }
__device__ __forceinline__ float dpp_max_xor2(float v) { return __builtin_fmaxf(v, bits_f((unsigned)__builtin_amdgcn_update_dpp(0, (int)f_bits(v), 0x4E, 0xf, 0xf, false))); }
__device__ __forceinline__ float dpp_max_hmir(float v) { return __builtin_fmaxf(v, bits_f((unsigned)__builtin_amdgcn_update_dpp(0, (int)f_bits(v), 0x141, 0xf, 0xf, false))); }
__device__ __forceinline__ f32x2_t fp8x2(unsigned w, bool hi) { return hi ? __builtin_amdgcn_cvt_pk_f32_fp8((int)w, true) : __builtin_amdgcn_cvt_pk_f32_fp8((int)w, false); }
__device__ __forceinline__ float gelu_tanh(float x) {
    const float y2 = 1.5957691216057308f * (x + 0.044715f * x * x * x);
    return x / (1.0f + __builtin_amdgcn_exp2f(-y2 * LOG2E));
}
__device__ __forceinline__ unsigned vsel16(const u32x4 (&v)[2], int k) { const u32x4 q = v[k >> 3]; const int j = (k >> 1) & 3; const unsigned w = j == 0 ? q.x : j == 1 ? q.y : j == 2 ? q.z : q.w; return (k & 1) ? (w >> 16) : (w & 0xffffu); }
struct TokIn { u32x4 id[2]; u32x4 x0, x1; };
__device__ __forceinline__ int vsel(const u32x4 (&v)[4], int k) { const u32x4 q = v[k >> 2]; const int j = k & 3; return (int)(j == 0 ? q.x : j == 1 ? q.y : j == 2 ? q.z : q.w); }
__device__ __forceinline__ void p7_udots(Frame& F) {
    const int lane = F.lane, g = lane >> 3, c = lane & 7;
    const int s = blockIdx.x & 7, rank = blockIdx.x >> 3, nloc = F.G >> 3;
    const unsigned char* tab = F.U8 + (size_t)s * TAB8_SLICE; const unsigned coff16 = 16u * (unsigned)c;
    bf16* pd = F.PD + (size_t)s * T * 128;
    const int t0 = rank * NWAVES + F.wave, tstride = nloc * NWAVES;
#define P7_IDS(dst, tt) do { const int t_ = (tt) < T ? (tt) : t0; const GAS u32x4* ip_ = (const GAS u32x4*)(F.IDX + (size_t)t_ * 128 + 16 * g); dst.id[0] = ip_[0]; dst.id[1] = ip_[1]; } while (0)
#define P7_X(dst, tt) do { const int t_ = (tt) < T ? (tt) : t0; const bf16* xr_ = F.H + (size_t)t_ * D + 128 * s + 16 * c; dst.x0 = *(const GAS u32x4*)xr_; dst.x1 = *(const GAS u32x4*)(xr_ + 8); } while (0)
#define P7_PCS(pc, in) do { _Pragma("unroll") for (int k = 0; k < 16; ++k) pc[k] = *(const GAS u32x4*)(tab + ((vsel16(in.id, k) << 7) | coff16)); } while (0)
#define P7_MATH(pc, in, tt) do { if ((tt) < T) { \
        float xv[16]; { const unsigned a0 = in.x0.x, a1 = in.x0.y, a2 = in.x0.z, a3 = in.x0.w, b0 = in.x1.x, b1 = in.x1.y, b2 = in.x1.z, b3 = in.x1.w; \
          xv[0] = bf_lo(a0); xv[1] = bf_hi(a0); xv[2] = bf_lo(a1); xv[3] = bf_hi(a1); xv[4] = bf_lo(a2); xv[5] = bf_hi(a2); xv[6] = bf_lo(a3); xv[7] = bf_hi(a3); \
          xv[8] = bf_lo(b0); xv[9] = bf_hi(b0); xv[10] = bf_lo(b1); xv[11] = bf_hi(b1); xv[12] = bf_lo(b2); xv[13] = bf_hi(b2); xv[14] = bf_lo(b3); xv[15] = bf_hi(b3); } \
          \
        float xm = 0.f; _Pragma("unroll") for (int i = 0; i < 16; ++i) xm = __builtin_fmaxf(xm, __builtin_fabsf(xv[i])); \
        xm = dpp_max_hmir(dpp_max_xor2(dpp_max_xor1(xm))); \
        const float sx = xm > 0.f ? 127.0f / xm : 0.f, isx = xm * (1.0f / 127.0f); \
        const int xq0 = pack_i8(xv[0] * sx, xv[1] * sx, xv[2] * sx, xv[3] * sx), xq1 = pack_i8(xv[4] * sx, xv[5] * sx, xv[6] * sx, xv[7] * sx), \
                  xq2 = pack_i8(xv[8] * sx, xv[9] * sx, xv[10] * sx, xv[11] * sx), xq3 = pack_i8(xv[12] * sx, xv[13] * sx, xv[14] * sx, xv[15] * sx); \
        float r0 = 0.f, r1 = 0.f; \
        _Pragma("unroll") for (int k = 0; k < 16; ++k) { \
            const unsigned w0 = pc[k].x, w1 = pc[k].y, w2 = pc[k].z, w3 = pc[k].w; \
            int ia = __builtin_amdgcn_sdot4((int)w0, xq0, 0, false); ia = __builtin_amdgcn_sdot4((int)w1, xq1, ia, false); ia = __builtin_amdgcn_sdot4((int)w2, xq2, ia, false); ia = __builtin_amdgcn_sdot4((int)w3, xq3, ia, false); \
            float p = (float)ia; p = dpp_hmir(dpp_xor2(dpp_xor1(p))); \
            if (k < 8) r0 = (c == k) ? p : r0; else r1 = (c == (k - 8)) ? p : r1; } \
        r0 *= isx; r1 *= isx; \
        pd[(size_t)(tt) * 128 + 16 * g + c] = (bf16)(pk2(r0, r0) & 0xffffu); pd[(size_t)(tt) * 128 + 16 * g + 8 + c] = (bf16)(pk2(r1, r1) & 0xffffu); } } while (0)
    TokIn inA, inB, inC, inN; u32x4 pcA[16], pcB[16], pcC[16];
    P7_IDS(inA, t0); P7_X(inA, t0); P7_PCS(pcA, inA); P7_IDS(inB, t0 + tstride); P7_X(inB, t0 + tstride); P7_PCS(pcB, inB); P7_IDS(inC, t0 + 2 * tstride);
    for (int t = t0; t < T; t += 3 * tstride) {
        P7_X(inC, t + 2 * tstride); P7_PCS(pcC, inC); P7_IDS(inN, t + 3 * tstride); __builtin_amdgcn_sched_barrier(0);
        P7_MATH(pcA, inA, t); __builtin_amdgcn_sched_barrier(0);
        inA.id[0] = inN.id[0]; inA.id[1] = inN.id[1];
        P7_X(inA, t + 3 * tstride); P7_PCS(pcA, inA); P7_IDS(inN, t + 4 * tstride); __builtin_amdgcn_sched_barrier(0);
        P7_MATH(pcB, inB, t + tstride); __builtin_amdgcn_sched_barrier(0);
        inB.id[0] = inN.id[0]; inB.id[1] = inN.id[1];
        P7_X(inB, t + 4 * tstride); P7_PCS(pcB, inB); P7_IDS(inN, t + 5 * tstride); __builtin_amdgcn_sched_barrier(0);
        P7_MATH(pcC, inC, t + 2 * tstride); __builtin_amdgcn_sched_barrier(0);
        inC.id[0] = inN.id[0]; inC.id[1] = inN.id[1];
    }
#undef P7_IDS
#undef P7_X
#undef P7_PCS
#undef P7_MATH
}
__device__ __forceinline__ void p8_combine(Frame& F) {
    const int gtid = F.vcu * NWAVES * 64 + F.tid, gthreads = F.G * NWAVES * 64;
    constexpr int NU = 4;
    for (int i0 = gtid; i0 < T * 128; i0 += NU * gthreads) {
        unsigned short pd[NU][8]; int id[NU]; float gt[NU];
#pragma unroll
        for (int u = 0; u < NU; ++u) { const int i = i0 + u * gthreads < T * 128 ? i0 + u * gthreads : i0;
#pragma unroll
            for (int s = 0; s < 8; ++s) pd[u][s] = __builtin_nontemporal_load(F.PD + (size_t)s * T * 128 + i);
            id[u] = (int)F.IDX[i]; gt[u] = __builtin_nontemporal_load(F.GATE + i); }
        float ru[NU], rv[NU], r2[NU];
#pragma unroll
        for (int u = 0; u < NU; ++u) { const int i = i0 + u * gthreads < T * 128 ? i0 + u * gthreads : i0; ru[u] = F.RSU[id[u]]; rv[u] = F.RSV[id[u]]; r2[u] = F.RS2[i >> 7]; }
#pragma unroll
        for (int u = 0; u < NU; ++u) { const int i = i0 + u * gthreads;
            float d = 0.f;
#pragma unroll
            for (int s = 0; s < 8; ++s) d += bits_f((unsigned)pd[u][s] << 16);
            if (i < T * 128) { const float cv_ = gt[u] * gelu_tanh(d * ru[u] * r2[u]) * rv[u]; F.C[i] = (bf16)(pk2(cv_, cv_) & 0xffffu); } }
    }
}
__device__ __forceinline__ float dpp_ror8(float v) { return v + bits_f((unsigned)__builtin_amdgcn_update_dpp(0, (int)f_bits(v), 0x128, 0xf, 0xf, false)); }
__device__ __forceinline__ float swapadd32(float a, float b) { const auto r = __builtin_amdgcn_permlane32_swap(f_bits(a), f_bits(b), false, false); return bits_f(r[0]) + bits_f(r[1]); }
__device__ __forceinline__ float swapadd16(float a, float b) { const auto r = __builtin_amdgcn_permlane16_swap(f_bits(a), f_bits(b), false, false); return bits_f(r[0]) + bits_f(r[1]); }
struct TokInV { u32x4 id[2]; u32x4 cc[2]; u32x2 xb; };
__device__ __forceinline__ void p9_vacc(Frame& F) {
    const int lane = F.lane, g = lane >> 3, c = lane & 7;
    const int s = blockIdx.x & 7, rank = blockIdx.x >> 3, nloc = F.G >> 3;
    const unsigned char* tab = F.V8 + (size_t)s * TAB8_SLICE; const unsigned coff16 = 16u * (unsigned)c;
    const int t0 = rank * NWAVES + F.wave, tstride = nloc * NWAVES;
    const int coff = 128 * s + 16 * c + 8 * (lane >> 5) + 4 * ((lane >> 4) & 1);
#define P9_IN(dst, tt) do { const int t_ = (tt) < T ? (tt) : t0; const GAS u32x4* ip_ = (const GAS u32x4*)(F.IDX + (size_t)t_ * 128 + 16 * g); dst.id[0] = ip_[0]; dst.id[1] = ip_[1]; \
        const GAS u32x4* cp_ = (const GAS u32x4*)(F.C + (size_t)t_ * 128 + 16 * g); dst.cc[0] = cp_[0]; dst.cc[1] = cp_[1]; \
        dst.xb = *(const GAS u32x2*)(F.H + (size_t)t_ * D + coff); } while (0)
#define P9_PCS(pc, in) do { _Pragma("unroll") for (int k = 0; k < 16; ++k) pc[k] = *(const GAS u32x4*)(tab + ((vsel16(in.id, k) << 7) | coff16)); } while (0)
#define P9_MATH(pc, in, tt) do { if ((tt) < T) { \
        f32x2_t acc[8]; _Pragma("unroll") for (int i = 0; i < 8; ++i) acc[i] = (f32x2_t){0.f, 0.f}; \
        _Pragma("unroll") for (int k = 0; k < 16; ++k) { \
            const unsigned w0 = pc[k].x, w1 = pc[k].y, w2 = pc[k].z, w3 = pc[k].w; const float cf = bits_f(vsel16(in.cc, k) << 16); const f32x2_t c2 = {cf, cf}; \
            acc[0] = __builtin_elementwise_fma(fp8x2(w0, false), c2, acc[0]); acc[1] = __builtin_elementwise_fma(fp8x2(w0, true), c2, acc[1]); \
            acc[2] = __builtin_elementwise_fma(fp8x2(w1, false), c2, acc[2]); acc[3] = __builtin_elementwise_fma(fp8x2(w1, true), c2, acc[3]); \
            acc[4] = __builtin_elementwise_fma(fp8x2(w2, false), c2, acc[4]); acc[5] = __builtin_elementwise_fma(fp8x2(w2, true), c2, acc[5]); \
            acc[6] = __builtin_elementwise_fma(fp8x2(w3, false), c2, acc[6]); acc[7] = __builtin_elementwise_fma(fp8x2(w3, true), c2, acc[7]); } \
          \
        float b_[8]; _Pragma("unroll") for (int i = 0; i < 4; ++i) { b_[2 * i] = swapadd32(acc[i].x, acc[i + 4].x); b_[2 * i + 1] = swapadd32(acc[i].y, acc[i + 4].y); } \
        float d_[4]; _Pragma("unroll") for (int i = 0; i < 4; ++i) d_[i] = dpp_ror8(swapadd16(b_[i], b_[i + 4])); \
        float ss = 0.f; \
        if ((lane & 8) == 0) { bf16* op_ = F.X2 + (size_t)(tt) * D + coff; const unsigned xb0_ = in.xb.x, xb1_ = in.xb.y; const f32x4 y = {bf_lo(xb0_) + d_[0], bf_hi(xb0_) + d_[1], bf_lo(xb1_) + d_[2], bf_hi(xb1_) + d_[3]}; \
            ss = (y.x * y.x + y.y * y.y) + (y.z * y.z + y.w * y.w); u32x2 yw_; yw_.x = pk2(y.x, y.y); yw_.y = pk2(y.z, y.w); *(GAS u32x2*)op_ = yw_; } \
        ss = wave_sum(ss); if (lane == 0) F.SSP[(size_t)s * T + (tt)] = ss; } } while (0)
    TokInV inA, inB; u32x4 pcA[16], pcB[16];
    P9_IN(inA, t0); P9_PCS(pcA, inA); P9_IN(inB, t0 + tstride);
    for (int t = t0; t < T; t += 2 * tstride) {
        P9_PCS(pcB, inB); TokInV inC; P9_IN(inC, t + 2 * tstride); __builtin_amdgcn_sched_barrier(0);
        P9_MATH(pcA, inA, t); __builtin_amdgcn_sched_barrier(0);
        P9_PCS(pcA, inC); inA = inC; TokInV inD; P9_IN(inD, t + 3 * tstride); __builtin_amdgcn_sched_barrier(0);
        P9_MATH(pcB, inB, t + tstride); __builtin_amdgcn_sched_barrier(0);
        inB = inD;
    }
#undef P9_IN
#undef P9_PCS
#undef P9_MATH
}
__device__ __forceinline__ void p10_final(Frame& F) {
    const int gw = F.vcu * NWAVES + F.wave, NGW = F.G * NWAVES, lane = F.lane;
    for (int t = gw; t < T; t += NGW) {
        float ss = 0.f;
#pragma unroll
        for (int s = 0; s < 8; ++s) ss += F.SSP[(size_t)s * T + t];
        const float rs = __builtin_amdgcn_rsqf(ss * (1.f / D) + EPS);
        GAS f32x4* xr = (GAS f32x4*)(F.out + (size_t)t * D) + lane; const GAS f32x4* gr = (const GAS f32x4*)F.gf + lane; const GAS u32x2* br = (const GAS u32x2*)(F.X2 + (size_t)t * D) + lane;
#pragma unroll
        for (int j = 0; j < 4; ++j) { const u32x2 w = __builtin_nontemporal_load(br + 64 * j); const unsigned w0 = w.x, w1 = w.y; const f32x4 gg = gr[64 * j]; __builtin_nontemporal_store((f32x4){bf_lo(w0) * rs * gg.x, bf_hi(w0) * rs * gg.y, bf_lo(w1) * rs * gg.z, bf_hi(w1) * rs * gg.w}, xr + 64 * j); }
    }
}
struct Args { const float* in[14]; float* out; unsigned char* ws; int ph_lo, ph_hi, li, pad; };
__global__ void __launch_bounds__(NWAVES * 64, 2) mk_fwd(Args args) {
    extern __shared__ __attribute__((aligned(16))) unsigned char lds[];
#ifdef PROBE_LO
    unsigned long long pmk_lo = 0, pmk_hi = 0;
    if (PROBE_LO == -1) { asm volatile("s_memrealtime %0\n\ts_waitcnt lgkmcnt(0)" : "=s"(pmk_lo) :: "memory"); }
#endif
    Frame F;
    F.lds = (LAS unsigned char*)lds;
    F.MISC = (volatile LAS unsigned*)(F.lds + MISC_OFF);
    F.tid = threadIdx.x; F.lane = F.tid & 63; F.wave = __builtin_amdgcn_readfirstlane(F.tid >> 6);
    F.G = gridDim.x; { const int bx = blockIdx.x; F.vcu = (F.G % 8 == 0) ? (bx % 8) * (F.G / 8) + bx / 8 : bx; }
    unsigned char* ws = args.ws;
    F.ctl = (gu32*)(ws + WS_CTL);
    F.x = args.in[0]; F.g1 = args.in[1]; F.w_in = args.in[2]; F.sb_g = args.in[3]; F.sw_g = args.in[4]; F.sinks = args.in[5]; F.w_out = args.in[6]; F.g2 = args.in[7];
    F.w_q = args.in[8]; F.keys1 = args.in[9]; F.keys2 = args.in[10]; F.pu = args.in[11]; F.pv = args.in[12]; F.gf = args.in[13]; F.out = args.out;
    F.Wt_in = (bf16*)(ws + WS_WIN); F.Wt_out = (bf16*)(ws + WS_WOUT); F.Wt_q = (bf16*)(ws + WS_WQ); F.KEYS = (bf16*)(ws + WS_KEYS);
    F.H = (bf16*)(ws + WS_H); F.MIX = (bf16*)(ws + WS_MIX); F.QKV = (bf16*)(ws + WS_QKV); F.U8 = ws + WS_U8; F.V8 = ws + WS_V8; F.RSU = (float*)(ws + WS_RSU); F.RSV = (float*)(ws + WS_RSV);
    F.SSQP = (float*)(ws + WS_SSQP); F.RS2 = (float*)(ws + WS_RS2); F.PD = (bf16*)(ws + WS_PD); F.X2 = (bf16*)(ws + WS_X2); F.C = (bf16*)(ws + WS_C); F.SSP = (float*)(ws + WS_SSP);
    F.IDX = (unsigned short*)(ws + WS_IDX); F.GATE = (float*)(ws + WS_GATE);
    for (int u = F.tid; u < (LDS_BYTES - LDSCTL_OFF) / 4; u += NWAVES * 64) ((LAS unsigned*)(F.lds + LDSCTL_OFF))[u] = 0u;
    __syncthreads();
    const int lo = args.ph_lo, hi = args.ph_hi;
    const bool use_bar = (hi - lo) > 1;
    XcdBarrier bar; bar.bar = (unsigned*)(F.ctl + CW_BAR) + args.li * XCD_BAR_WORDS; bar.x = 0; bar.st = nullptr;
    if (use_bar) bar = xcd_barrier_post((unsigned*)(F.ctl + CW_BAR) + args.li * XCD_BAR_WORDS, F.MISC + 8);
#ifndef PHMASK
#define PHMASK 2047
#endif
#define IN(k) (((PHMASK >> (k)) & 1) && lo <= (k) && (k) < hi)
#define SEAM(k) do { if (IN(k) && IN((k) + 1)) xcd_barrier(bar); } while (0)
    const int gw = F.vcu * NWAVES + F.wave, NGW = F.G * NWAVES;
#ifdef PROBE_LO
#define PSTAMP(v) asm volatile("s_memrealtime %0\n\ts_waitcnt lgkmcnt(0)" : "=s"(v) :: "memory")
#define PMARK(k) do { if ((k) == PROBE_LO) { PSTAMP(pmk_lo); } if ((k) == PROBE_HI + 1) { PSTAMP(pmk_hi); } } while (0)
#else
#define PMARK(k) do {} while (0)
#endif

    PMARK(0);
    if (IN(0)) { p0_prologue(F); } SEAM(0);
    PMARK(1);
    if (IN(1)) { pg8::Gemm g{F.H, F.Wt_in, T, DIN, D}; pg8::StaticOrder S; S.init(T, DIN, F.G, (int)blockIdx.x); pg8::EpiBf16 E{F.QKV, DIN};
        pg8::gemm_phase<pg8::EpiBf16, pg8::StaticOrder>(F.lds, g, S, E);
        { const int nfull = (T / 256) * (DIN / 256) % F.G, nb = F.G - nfull;
          if (nb == F.G) { for (int r = (int)blockIdx.x * NWAVES + F.wave; r < NEXP; r += 4 * F.G * NWAVES) cvt_rows_fp8<4>(F, r, F.G * NWAVES, NEXP, F.lane); }
          else if ((int)blockIdx.x >= nfull) { for (int r = ((int)blockIdx.x - nfull) * NWAVES + F.wave; r < NEXP; r += 4 * nb * NWAVES) cvt_rows_fp8<4>(F, r, nb * NWAVES, NEXP, F.lane); } }
        } SEAM(1);
    PMARK(2);
    if (IN(2)) { p2_attention(F); } SEAM(2);
    PMARK(3);
    if (IN(3)) { pg8::Gemm g{F.MIX, F.Wt_out, T, D, D}; pg8::StaticOrder S; S.init(T, D, F.G, (int)blockIdx.x); pg8::EpiResB E{F.x, F.H, D, F.SSQP};
        pg8::gemm_phase<pg8::EpiResB, pg8::StaticOrder>(F.lds, g, S, E); } SEAM(3);
    PMARK(4);
    PMARK(5);
    if (IN(5)) { pg8::Gemm g{F.H, F.Wt_q, T, DQ, D}; pg8::StaticOrder S; S.init(T, DQ, F.G, (int)blockIdx.x); pg8::EpiBf16RS E{F.QKV, DQ, F.SSQP, F.RS2};
        pg8::gemm_phase<pg8::EpiBf16RS, pg8::StaticOrder>(F.lds, g, S, E);
        asm volatile("s_waitcnt vmcnt(0)" ::: "memory"); __syncthreads();
        p6_topk_own(F, S); }
    PMARK(6);
    SEAM(6);
    PMARK(7);
    if (IN(7)) { p7_udots(F); } SEAM(7);
    PMARK(8);
    if (IN(8)) { p8_combine(F); } SEAM(8);
    PMARK(9);
    if (IN(9)) { p9_vacc(F); } SEAM(9);
    PMARK(10);
    if (IN(10)) { p10_final(F); }
#ifdef PROBE_LO
    xcd_barrier(bar);
    PMARK(11);
    if (blockIdx.x == 0 && F.tid == 0) { unsigned long long t0, t1; PSTAMP(t0); const unsigned long long dl = (pmk_hi - pmk_lo) * PROBE_MULT;
        do { __builtin_amdgcn_s_sleep(8); PSTAMP(t1); } while (t1 - t0 < dl); }
#endif
#undef IN
#undef SEAM
}

extern "C" void kernel_launch(void* const* d_in, const int* in_sizes, int n_in, void* d_out, int out_size, void* d_ws, size_t ws_size, hipStream_t stream) {
    static int grid = 0;
    if (grid == 0) {
        if (n_in != 14 || in_sizes[0] != T * D || out_size != T * D || ws_size < WS_END) { fprintf(stderr, "kernel_launch: unexpected shapes (n_in %d, in0 %d, out %d, ws %zu)\n", n_in, n_in > 0 ? in_sizes[0] : -1, out_size, ws_size); grid = -1; return; }
        int dev = 0, cus = 0, per_cu = 0;
        if (hipGetDevice(&dev) != hipSuccess || hipDeviceGetAttribute(&cus, hipDeviceAttributeMultiprocessorCount, dev) != hipSuccess) { grid = -1; return; }
        if (hipFuncSetAttribute((const void*)mk_fwd, hipFuncAttributeMaxDynamicSharedMemorySize, LDS_BYTES) != hipSuccess) { fprintf(stderr, "kernel_launch: hipFuncSetAttribute failed\n"); grid = -1; return; }
        if (hipOccupancyMaxActiveBlocksPerMultiprocessor(&per_cu, (const void*)mk_fwd, NWAVES * 64, LDS_BYTES) != hipSuccess || per_cu < 1)
            fprintf(stderr, "kernel_launch: note: occupancy query reports %d workgroups per CU\n", per_cu);
        (void)hipGetLastError();
        grid = cus;
    }
    if (grid < 0) return;
    if (hipMemsetAsync((char*)d_ws + WS_CTL, 0, CTL_ZERO_BYTES, stream) != hipSuccess) { fprintf(stderr, "kernel_launch: hipMemsetAsync failed\n"); return; }
    Args a{};
    for (int i = 0; i < 14; ++i) a.in[i] = (const float*)d_in[i];
    a.out = (float*)d_out; a.ws = (unsigned char*)d_ws;
#if MK_N_LAUNCHES == 1
    a.ph_lo = 0; a.ph_hi = N_PHASES; a.li = 0;
    hipLaunchKernelGGL(mk_fwd, dim3(grid), dim3(NWAVES * 64), LDS_BYTES, stream, a);
#else
    for (int li = 0; li < N_PHASES; ++li) { a.ph_lo = li; a.ph_hi = li + 1; a.li = 0; hipLaunchKernelGGL(mk_fwd, dim3(grid), dim3(NWAVES * 64), LDS_BYTES, stream, a); }
#endif
    const hipError_t le = hipPeekAtLastError();
    if (le != hipSuccess) fprintf(stderr, "kernel_launch: launch failed: %s\n", hipGetErrorName(le));
}
```

```cpp
#include <hip/hip_runtime.h>
#include <cstdio>
#include <cstdint>

#ifndef MK_N_LAUNCHES
#define MK_N_LAUNCHES 1
#endif

#define LAS __attribute__((address_space(3)))
#define GAS __attribute__((address_space(1)))
typedef unsigned short bf16;
typedef short bf16x8 __attribute__((ext_vector_type(8)));
typedef float f32x4 __attribute__((ext_vector_type(4)));
typedef float f32x16 __attribute__((ext_vector_type(16)));
typedef unsigned u32x4 __attribute__((ext_vector_type(4)));
typedef unsigned u32x2 __attribute__((ext_vector_type(2)));
typedef short v4i16_t __attribute__((ext_vector_type(4)));
typedef float f32x2_t __attribute__((ext_vector_type(2)));
typedef __bf16 bf16x2_t __attribute__((ext_vector_type(2)));
typedef GAS unsigned gu32;

constexpr int T = 16384, SEQ = 4096, NB = 4, D = 1024, DIN = 2304, DQ = 2048;
constexpr int C_SBQ = 0, C_SBK = 512, C_SBV = 1024, C_SWQ = 1536, C_SWK = 2048, C_SWV = 2176;
constexpr int NEXP = 16384;
constexpr float EPS = 1e-6f;
constexpr float LOG2E = 1.4426950408889634f, LN2 = 0.6931471805599453f;
constexpr float SB_EXIT = -40.0f;

namespace pg8 {
constexpr int BM = 256, BK = 64, HALF = 128, HTB = HALF * BK * 2, STAGE_BYTES = 8 * HTB, NXCD = 8, WGM = 8;
__host__ __device__ __forceinline__ int lds_byte(int r, int c) { const int st = (r >> 4) * 2 + (c >> 5), rr = r & 15, cc = c & 31, ob = rr * 64 + cc * 2; return st * 1024 + (ob ^ (((ob >> 9) & 1) << 5)); }
__host__ __device__ __forceinline__ void stage_rc(int b, int& R, int& C) { const int st = b / 1024, sb = b % 1024, swz = sb ^ (((sb >> 9) & 1) << 5); R = (st >> 1) * 16 + swz / 64; C = (st & 1) * 32 + (swz % 64) / 2; }
__host__ __device__ __forceinline__ int perm32(int rho) { const int n = rho >> 4, i = rho & 15; return 8 * (i >> 2) + 4 * n + (i & 3); }
struct Unit { int pm, pn; };
struct Gemm { const bf16* A; const bf16* Bt; int M, N, K; };
struct StaticOrder {
    int nM, nN, nwg, G, c;
    __host__ __device__ void init(int M, int N, int G_, int c_) { nM = M / BM; nN = N / BM; nwg = nM * nN; G = G_; c = c_; }
    __host__ __device__ bool next(int i, Unit& u) const {
        const long L = (long)i * G + c; if (L >= nwg) return false;
        int wgid = (int)L; { const int q = nwg / NXCD, r = nwg % NXCD, xcd = wgid % NXCD, off = wgid / NXCD; wgid = (xcd < r ? xcd * (q + 1) : r * (q + 1) + (xcd - r) * q) + off; }
        const int nig = WGM * nN, gid = wgid / nig, fm = gid * WGM, gsz = (nM - fm) < WGM ? (nM - fm) : WGM;
        u.pm = fm + ((wgid % nig) % gsz); u.pn = (wgid % nig) / gsz; return true;
    }
};
__device__ __forceinline__ unsigned cvt_pk_bf16(float lo, float hi) { f32x2_t v = {lo, hi}; bf16x2_t b = __builtin_convertvector(v, bf16x2_t); return __builtin_bit_cast(unsigned, b); }

struct EpiBf16 {
    static constexpr bool PERM = true;
    bf16* O; int ldc;
    __device__ __forceinline__ void operator()(const f32x4 (&acc)[2][2][4][2], const Unit& u, int wr, int wc, int fr, int fq) const {
        const int row0 = u.pm * BM + wr * 64 + fr; const int col0 = u.pn * BM + wc * 32 + 8 * fq;
        const auto rsrc = __builtin_amdgcn_make_buffer_rsrc((void*)O, 0, 0x7ffffff0, 0x00020000);
#pragma unroll
        for (int ai = 0; ai < 2; ++ai)
#pragma unroll
            for (int m = 0; m < 4; ++m) { const unsigned boff = (unsigned)(((size_t)(row0 + ai * HALF + m * 16) * ldc + col0) * 2);
#pragma unroll
                for (int bj = 0; bj < 2; ++bj) { const f32x4 v0 = acc[ai][bj][m][0], v1 = acc[ai][bj][m][1];
                    u32x4 w; w.x = cvt_pk_bf16(v0[0], v0[1]); w.y = cvt_pk_bf16(v0[2], v0[3]); w.z = cvt_pk_bf16(v1[0], v1[1]); w.w = cvt_pk_bf16(v1[2], v1[3]);
                    __builtin_amdgcn_raw_buffer_store_b128(w, rsrc, boff + bj * HALF * 2, 0, 16); } }
    }
};
struct EpiBf16RS {
    static constexpr bool PERM = true;
    bf16* O; int ldc; const float* ssqp; float* rs2;
    __device__ __forceinline__ void operator()(const f32x4 (&acc)[2][2][4][2], const Unit& u, int wr, int wc, int fr, int fq) const {
        const int row0 = u.pm * BM + wr * 64 + fr; const int col0 = u.pn * BM + wc * 32 + 8 * fq;
#pragma unroll
        for (int ai = 0; ai < 2; ++ai)
#pragma unroll
            for (int m = 0; m < 4; ++m) { const int row = row0 + ai * HALF + m * 16; bf16* rowp = O + (size_t)row * ldc + col0;
                const f32x4* sp = (const f32x4*)(ssqp + (size_t)row * 16); const f32x4 s0 = sp[0], s1 = sp[1], s2 = sp[2], s3 = sp[3];
                const float ss = ((s0[0] + s0[1]) + (s0[2] + s0[3])) + ((s1[0] + s1[1]) + (s1[2] + s1[3])) + ((s2[0] + s2[1]) + (s2[2] + s2[3])) + ((s3[0] + s3[1]) + (s3[2] + s3[3]));
                const float rs = __builtin_amdgcn_rsqf(ss * (1.0f / 1024.0f) + 1e-6f);
                if (u.pn == 0 && wc == 0 && fq == 0) rs2[row] = rs;
#pragma unroll
                for (int bj = 0; bj < 2; ++bj) { const f32x4 v0 = acc[ai][bj][m][0] * rs, v1 = acc[ai][bj][m][1] * rs;
                    u32x4 w; w.x = cvt_pk_bf16(v0[0], v0[1]); w.y = cvt_pk_bf16(v0[2], v0[3]); w.z = cvt_pk_bf16(v1[0], v1[1]); w.w = cvt_pk_bf16(v1[2], v1[3]);
                    *(u32x4*)(rowp + bj * HALF) = w; } }
    }
};
struct EpiResB {
    static constexpr bool PERM = false;
    const float* base; bf16* xb; int ldc; float* ssqp;
    __device__ __forceinline__ void operator()(const f32x4 (&acc)[2][2][4][2], const Unit& u, int wr, int wc, int fr, int fq) const {
        const int col0 = u.pn * BM + wc * 32 + 4 * fq;
#pragma unroll
        for (int ai = 0; ai < 2; ++ai)
#pragma unroll
            for (int m = 0; m < 4; ++m) { const int row = u.pm * BM + ai * HALF + wr * 64 + m * 16 + fr; const size_t off = (size_t)row * ldc + col0; float sq = 0.f;
#pragma unroll
                for (int bj = 0; bj < 2; ++bj)
#pragma unroll
                    for (int n = 0; n < 2; ++n) { const f32x4 bs = __builtin_nontemporal_load((const f32x4*)(base + off + bj * HALF + n * 16)); const f32x4 y = bs + acc[ai][bj][m][n];
                        sq += (y[0] * y[0] + y[1] * y[1]) + (y[2] * y[2] + y[3] * y[3]);
                        u32x2 w; w.x = cvt_pk_bf16(y[0], y[1]); w.y = cvt_pk_bf16(y[2], y[3]); *(u32x2*)(xb + off + bj * HALF + n * 16) = w; }
                sq += __shfl_xor(sq, 16); sq += __shfl_xor(sq, 32);
                if (fq == 0) ssqp[(size_t)row * 16 + u.pn * 4 + wc] = sq; }
    }
};
struct EpiResF32 {
    static constexpr bool PERM = false;
    const float* base; float* out; int ldc;
    __device__ __forceinline__ void operator()(const f32x4 (&acc)[2][2][4][2], const Unit& u, int wr, int wc, int fr, int fq) const {
        const int col0 = u.pn * BM + wc * 32 + 4 * fq;
#pragma unroll
        for (int ai = 0; ai < 2; ++ai)
#pragma unroll
            for (int m = 0; m < 4; ++m) { const size_t off = (size_t)(u.pm * BM + ai * HALF + wr * 64 + m * 16 + fr) * ldc + col0;
#pragma unroll
                for (int bj = 0; bj < 2; ++bj)
#pragma unroll
                    for (int n = 0; n < 2; ++n) { const f32x4 bs = *(const f32x4*)(base + off + bj * HALF + n * 16); *(f32x4*)(out + off + bj * HALF + n * 16) = bs + acc[ai][bj][m][n]; } }
    }
};

template <class Epi, class Sched>
__device__ __forceinline__ void gemm_phase(LAS unsigned char* lds, const Gemm g, const Sched& S, const Epi& E) {
    const int tid = threadIdx.x, wid = __builtin_amdgcn_readfirstlane(tid >> 6), lane = tid & 63, wr = wid >> 2, wc = wid & 3, fr = lane & 15, fq = lane >> 4;
    const int K = g.K, nt = K / BK;
    unsigned voffA[2], voffB[2];
#pragma unroll
    for (int i = 0; i < 2; ++i) { int R, C; stage_rc(tid * 16 + i * 8192, R, C); const int Rb = Epi::PERM ? ((R & ~31) + perm32(R & 31)) : R;
        voffA[i] = (unsigned)(R * K + C) * 2u; voffB[i] = (unsigned)(Rb * K + C) * 2u; }
    const size_t kstep = (size_t)(BK * 2);
    const size_t hstep = (size_t)HALF * K * 2;
    const size_t tstep = 2 * hstep;
    const unsigned ldsw = (unsigned)wid * 1024u;
    const int aoff = lds_byte(wr * 64 + fr, fq * 8), boff = lds_byte(wc * 32 + fr, fq * 8);
#define PG8_SA(b, h) (((b) * 2 + (h)) * HTB)
#define PG8_SB(b, h) ((4 + (b) * 2 + (h)) * HTB)
#define PG8_STAGE(bufoff, gbase, voff) do { _Pragma("unroll") for (int _i = 0; _i < 2; ++_i) \
        __builtin_amdgcn_global_load_lds((const unsigned*)((const char*)(gbase) + (voff)[_i]), (LAS unsigned*)(lds + (bufoff) + ldsw + _i * 8192), 16, 0, 0); } while (0)
#define PG8_LDA(dst, b, h) do { _Pragma("unroll") for (int m = 0; m < 4; ++m) _Pragma("unroll") for (int k = 0; k < 2; ++k) dst[m][k] = *(const LAS bf16x8*)(lds + PG8_SA(b, h) + aoff + m * 2048 + k * 1024); } while (0)
#define PG8_LDB(dst, b, h) do { _Pragma("unroll") for (int n = 0; n < 2; ++n) _Pragma("unroll") for (int k = 0; k < 2; ++k) dst[n][k] = *(const LAS bf16x8*)(lds + PG8_SB(b, h) + boff + n * 2048 + k * 1024); } while (0)
#define PG8_MMA(ai, bj, At, Bt) do { __builtin_amdgcn_s_setprio(1); _Pragma("unroll") for (int m = 0; m < 4; ++m) _Pragma("unroll") for (int n = 0; n < 2; ++n) _Pragma("unroll") for (int k = 0; k < 2; ++k) \
        acc[ai][bj][m][n] = __builtin_amdgcn_mfma_f32_16x16x32_bf16(Bt[n][k], At[m][k], acc[ai][bj][m][n], 0, 0, 0); __builtin_amdgcn_s_setprio(0); } while (0)
#define PG8_WAIT_V(n) asm volatile("s_waitcnt vmcnt(" #n ")" ::: "memory")
#define PG8_WAIT_L(n) asm volatile("s_waitcnt lgkmcnt(" #n ")" ::: "memory")
#define PG8_BAR __builtin_amdgcn_s_barrier()
#define PG8_SCHED __builtin_amdgcn_sched_barrier(0)
    Unit cur, nxt; int ui = 0;
    if (!S.next(0, cur)) return;
    f32x4 acc[2][2][4][2];
#pragma unroll
    for (int a = 0; a < 2; ++a)
#pragma unroll
        for (int b = 0; b < 2; ++b)
#pragma unroll
            for (int m = 0; m < 4; ++m)
#pragma unroll
                for (int n = 0; n < 2; ++n) acc[a][b][m][n] = (f32x4){0.f, 0.f, 0.f, 0.f};
    bf16x8 At[4][2], B0[2][2], B1[2][2];
    const char* cA = (const char*)g.A + (size_t)cur.pm * tstep; const char* cB = (const char*)g.Bt + (size_t)cur.pn * tstep;
    PG8_STAGE(PG8_SB(0, 0), cB, voffB); PG8_STAGE(PG8_SB(0, 1), cB + hstep, voffB); PG8_STAGE(PG8_SA(0, 0), cA, voffA); PG8_STAGE(PG8_SA(0, 1), cA + hstep, voffA);
    if (wr == 1) PG8_BAR;
    PG8_WAIT_V(2); PG8_BAR;
    PG8_STAGE(PG8_SB(1, 0), cB + kstep, voffB); PG8_STAGE(PG8_SA(1, 0), cA + kstep, voffA); PG8_STAGE(PG8_SB(1, 1), cB + hstep + kstep, voffB);
    PG8_WAIT_V(6); PG8_BAR;
    for (;;) {
        const bool has_next = S.next(ui + 1, nxt);
        const char* nA = has_next ? (const char*)g.A + (size_t)nxt.pm * tstep : cA; const char* nB = has_next ? (const char*)g.Bt + (size_t)nxt.pn * tstep : cB;
        for (int t = 0; t < nt; t += 2) {
            const bool last = (t == nt - 2);
            const char* a1 = cA + (size_t)(t + 1) * kstep;
            const char* a2 = last ? nA : cA + (size_t)(t + 2) * kstep; const char* b2 = last ? nB : cB + (size_t)(t + 2) * kstep;
            const char* a3 = a2 + kstep; const char* b3 = b2 + kstep;
            PG8_LDB(B0, 0, 0); PG8_LDB(B1, 0, 1); PG8_SCHED; PG8_LDA(At, 0, 0); PG8_STAGE(PG8_SA(1, 1), a1 + hstep, voffA);
            PG8_WAIT_V(8); PG8_WAIT_L(0); PG8_BAR; PG8_MMA(0, 0, At, B0); PG8_MMA(0, 1, At, B1); PG8_BAR; PG8_SCHED;
            PG8_LDA(At, 0, 1); PG8_STAGE(PG8_SB(0, 0), b2, voffB); PG8_STAGE(PG8_SB(0, 1), b2 + hstep, voffB); PG8_STAGE(PG8_SA(0, 0), a2, voffA);
            PG8_WAIT_V(8); PG8_WAIT_L(0); PG8_BAR; PG8_MMA(1, 0, At, B0); PG8_MMA(1, 1, At, B1); PG8_BAR; PG8_SCHED;
            PG8_LDB(B0, 1, 0); PG8_LDB(B1, 1, 1); PG8_SCHED; PG8_LDA(At, 1, 0); PG8_STAGE(PG8_SA(0, 1), a2 + hstep, voffA);
            PG8_WAIT_V(8); PG8_WAIT_L(0); PG8_BAR; PG8_MMA(0, 0, At, B0); PG8_MMA(0, 1, At, B1); PG8_BAR; PG8_SCHED;
            PG8_LDA(At, 1, 1); PG8_STAGE(PG8_SB(1, 0), b3, voffB); PG8_STAGE(PG8_SB(1, 1), b3 + hstep, voffB); PG8_STAGE(PG8_SA(1, 0), a3, voffA);
            PG8_WAIT_V(8); PG8_WAIT_L(0); PG8_BAR; PG8_MMA(1, 0, At, B0); PG8_MMA(1, 1, At, B1); PG8_BAR; PG8_SCHED;
        }
        if (wr == 0) PG8_BAR;
        E(acc, cur, wr, wc, fr, fq);
        if (!has_next) break;
#pragma unroll
        for (int a = 0; a < 2; ++a)
#pragma unroll
            for (int b = 0; b < 2; ++b)
#pragma unroll
                for (int m = 0; m < 4; ++m)
#pragma unroll
                    for (int n = 0; n < 2; ++n) acc[a][b][m][n] = (f32x4){0.f, 0.f, 0.f, 0.f};
        cur = nxt; cA = nA; cB = nB; ++ui;
        if (wr == 1) PG8_BAR;
    }
    PG8_WAIT_V(0);
    PG8_BAR;
#undef PG8_SA
#undef PG8_SB
#undef PG8_STAGE
#undef PG8_LDA
#undef PG8_LDB
#undef PG8_MMA
#undef PG8_WAIT_V
#undef PG8_WAIT_L
#undef PG8_BAR
#undef PG8_SCHED
}
}

constexpr int NWAVES = 8;
constexpr int N_PHASES = 11;
constexpr size_t MiB = 1u << 20;
constexpr size_t WS_CTL = 0, CTL_ZERO_BYTES = 32 * 1024;
constexpr size_t WS_WIN = 1 * MiB;
constexpr size_t WS_WOUT = 6 * MiB;
constexpr size_t WS_WQ = 8 * MiB;
constexpr size_t WS_KEYS = 12 * MiB;
constexpr size_t WS_RSU = 12 * MiB + 512 * 1024, WS_RSV = 12 * MiB + 768 * 1024;
constexpr size_t WS_RS2 = 12 * MiB + 896 * 1024;
constexpr size_t WS_IDX = 13 * MiB;
constexpr size_t WS_GATE = 21 * MiB;
constexpr size_t WS_SSQP = WS_GATE;
constexpr size_t WS_H = 29 * MiB;
constexpr size_t WS_MIX = 61 * MiB;
constexpr size_t WS_C = WS_MIX, WS_SSP = WS_MIX + 8 * MiB;
constexpr size_t WS_X2 = 165 * MiB - 32 * MiB;
constexpr size_t WS_QKV = 93 * MiB;
constexpr size_t WS_PD = WS_QKV;
constexpr size_t WS_U8 = 165 * MiB;
constexpr size_t WS_V8 = 181 * MiB;
constexpr size_t WS_END = 197 * MiB;
constexpr size_t TAB8_SLICE = (size_t)NEXP * 128;
constexpr int CW_BAR = 4096;
static_assert((CW_BAR + 3456) * 4 <= 32 * 1024, "barrier words inside the per-call memset");
constexpr int RING_BYTES = 147456;
constexpr int LDSCTL_OFF = RING_BYTES, MISC_OFF = LDSCTL_OFF + 320;
constexpr int LDS_BYTES = 155648;

#define RLX_AGENT __ATOMIC_RELAXED, __HIP_MEMORY_SCOPE_AGENT
#define LDS_WAIT() asm volatile("s_waitcnt lgkmcnt(0)" ::: "memory")
__device__ __forceinline__ unsigned f2bf(float f) { unsigned u = __builtin_bit_cast(unsigned, f); return (u + 0x7fffu + ((u >> 16) & 1u)) >> 16; }
__device__ __forceinline__ unsigned pk2(float lo, float hi) { return pg8::cvt_pk_bf16(lo, hi); }
__device__ __forceinline__ unsigned f_bits(float f) { return __builtin_bit_cast(unsigned, f); }
__device__ __forceinline__ float bits_f(unsigned u) { return __builtin_bit_cast(float, u); }
__device__ __forceinline__ float bf_lo(unsigned w) { return __builtin_bit_cast(float, w << 16); }
__device__ __forceinline__ float bf_hi(unsigned w) { return __builtin_bit_cast(float, w & 0xffff0000u); }

#define XB_TMO      128
#define XB_XCNT(j)  (256  + 64 * (j))
#define XB_XSUB(j)  (1280 + 64 * (j))
#define XB_XGEN(j)  (2304 + 64 * (j))
#define XB_TOP      3328
#define XB_TOPGEN   3392
#define XCD_BAR_WORDS 3456
#define XB_SPIN_CAP (1u << 18)
__device__ __forceinline__ unsigned xb_ld(unsigned* p)              { return __hip_atomic_load(p, __ATOMIC_RELAXED, __HIP_MEMORY_SCOPE_AGENT); }
__device__ __forceinline__ unsigned xb_add(unsigned* p, unsigned v) { return __hip_atomic_fetch_add(p, v, __ATOMIC_RELAXED, __HIP_MEMORY_SCOPE_AGENT); }
__device__ __forceinline__ unsigned xb_xcc_id() { return (unsigned)__builtin_amdgcn_s_getreg((3 << 11) | 20) & 0xFu; }
#define XB_SPIN(cond, bar) do { unsigned _sp = 0; while (cond) { __builtin_amdgcn_s_sleep(1); \
    if ((++_sp & 255u) == 0u) { if (xb_ld(&(bar)[XB_TMO])) break; if (_sp > XB_SPIN_CAP) { atomicAdd(&(bar)[XB_TMO], 1u); break; } } } } while (0)
struct XcdBarrier { unsigned* bar; unsigned x; volatile LAS unsigned* st; };
__device__ __forceinline__ XcdBarrier xcd_barrier_post(unsigned* bar, volatile LAS unsigned* st) {
    XcdBarrier b; b.bar = bar; b.x = xb_xcc_id(); b.st = st;
    if (threadIdx.x == 0) (void)xb_add(&bar[XB_XCNT(b.x)], 1u);
    return b;
}
__device__ __forceinline__ void xcd_barrier_complete(unsigned* bar, unsigned x, unsigned& nloc, unsigned& nx) {
    const unsigned G = gridDim.x * gridDim.y * gridDim.z;
    unsigned sum, cnt, mine, sp = 0u;
    for (;;) {
        sum = 0u; cnt = 0u; mine = 0u;
#pragma unroll
        for (unsigned j = 0; j < 16; ++j) { const unsigned c = xb_ld(&bar[XB_XCNT(j)]); sum += c; cnt += (c > 0u) ? 1u : 0u; mine = (j == x) ? c : mine; }
        if (sum == G) break;
        __builtin_amdgcn_s_sleep(1);
        if ((++sp & 255u) == 0u) { if (xb_ld(&bar[XB_TMO])) break; if (sp > XB_SPIN_CAP) { atomicAdd(&bar[XB_TMO], 1u); break; } }
    }
    nloc = mine > 0u ? mine : 1u; nx = cnt > 0u ? cnt : 1u;
}
__device__ __forceinline__ void xcd_barrier(const XcdBarrier& b) {
    asm volatile("s_waitcnt vmcnt(0)" ::: "memory");
    __syncthreads();
    if (threadIdx.x == 0) {
        unsigned* bar = b.bar;
        __builtin_amdgcn_s_waitcnt(0);
        unsigned nloc = b.st[0], nx = b.st[1];
        if (nloc == 0u) { xcd_barrier_complete(bar, b.x, nloc, nx); b.st[0] = nloc; b.st[1] = nx; }
        const unsigned old = xb_add(&bar[XB_XSUB(b.x)], 1u);
        const unsigned gen = old / nloc;
        if (old + 1u == (gen + 1u) * nloc) {
            __builtin_amdgcn_fence(__ATOMIC_RELEASE, "agent");
            asm volatile("s_waitcnt vmcnt(0)" ::: "memory");
            const unsigned og = xb_add(&bar[XB_TOP], 1u);
            const unsigned tg = og / nx;
            if (og + 1u == (tg + 1u) * nx) xb_add(&bar[XB_TOPGEN], 1u);
            else XB_SPIN(xb_ld(&bar[XB_TOPGEN]) == tg, bar);
            __builtin_amdgcn_fence(__ATOMIC_ACQUIRE, "agent");
            xb_add(&bar[XB_XGEN(b.x)], 1u);
            asm volatile("s_waitcnt vmcnt(0)" ::: "memory");
        } else {
            XB_SPIN(xb_ld(&bar[XB_XGEN(b.x)]) == gen, bar);
            __builtin_amdgcn_fence(__ATOMIC_ACQUIRE, "agent");
            asm volatile("s_waitcnt vmcnt(0)" ::: "memory");
        }
    }
    __syncthreads();
}

struct Frame {
    LAS unsigned char* lds;
    volatile LAS unsigned* MISC;
    gu32* ctl;
    int tid, lane, wave;
    int vcu, G;
    const float *x, *g1, *w_in, *sb_g, *sw_g, *sinks, *w_out, *g2, *w_q, *keys1, *keys2, *pu, *pv, *gf;
    float* out;
    bf16 *Wt_in, *Wt_out, *Wt_q, *KEYS, *H, *MIX, *QKV;
    unsigned char *U8, *V8, *C8; float *RSU, *RSV, *SSP, *SSQP, *RS2, *CS; bf16 *PD, *X2;
    unsigned short* IDX; float* GATE;
};

__device__ __forceinline__ float wave_sum(float v) {
#pragma unroll
    for (int o = 1; o < 64; o <<= 1) v += __shfl_xor(v, o);
    return v;
}

__device__ __forceinline__ void p0_transpose_item(const float* W, int K, int N, bf16* WT, LAS float* scr, int item, int lane, const float* gk = nullptr) {
    const int nblk = N / 32, kb = item / nblk, nb = item % nblk, k0 = 64 * kb, n0 = 32 * nb;
#pragma unroll 8
    for (int i = 0; i < 32; ++i) { const int kk = 2 * i + (lane >> 5); const float gq = gk ? gk[k0 + kk] : 1.0f; scr[kk * 33 + (lane & 31)] = __builtin_nontemporal_load(W + (size_t)(k0 + kk) * N + n0 + (lane & 31)) * gq; }
    LDS_WAIT(); asm volatile("" ::: "memory");
    const int c = lane & 7;
#pragma unroll
    for (int j = 0; j < 4; ++j) { const int n = (lane >> 3) + 8 * j; const LAS float* s = scr + (8 * c) * 33 + n;
        u32x4 o; o.x = pk2(s[0 * 33], s[1 * 33]); o.y = pk2(s[2 * 33], s[3 * 33]); o.z = pk2(s[4 * 33], s[5 * 33]); o.w = pk2(s[6 * 33], s[7 * 33]);
        *(GAS u32x4*)(WT + (size_t)(n0 + n) * K + k0 + 8 * c) = o; }
    LDS_WAIT(); asm volatile("" ::: "memory");
}
template <int NR> __device__ __forceinline__ void rms_rows_to_bf16(const float* xbase, const float* g, bf16* obase, int m0, int mstride, int lane) {
    f32x4 v[NR][4];
#pragma unroll
    for (int i = 0; i < NR; ++i) { const int m = m0 + i * mstride; const GAS f32x4* xr = (const GAS f32x4*)(xbase + (size_t)(m < T ? m : m0) * D) + lane;
#pragma unroll
        for (int j = 0; j < 4; ++j) v[i][j] = __builtin_nontemporal_load(xr + 64 * j); }
    const GAS f32x4* gr = (const GAS f32x4*)g + lane;
    f32x4 gg[4];
#pragma unroll
    for (int j = 0; j < 4; ++j) gg[j] = gr[64 * j];
#pragma unroll
    for (int i = 0; i < NR; ++i) { const int m = m0 + i * mstride;
        float s = 0.f;
#pragma unroll
        for (int j = 0; j < 4; ++j) s += (v[i][j].x * v[i][j].x + v[i][j].y * v[i][j].y) + (v[i][j].z * v[i][j].z + v[i][j].w * v[i][j].w);
        const float rs = __builtin_amdgcn_rsqf(wave_sum(s) * (1.f / D) + EPS);
        if (m < T) { GAS u32x2* o8 = (GAS u32x2*)(obase + (size_t)m * D) + lane;
#pragma unroll
            for (int j = 0; j < 4; ++j) { u32x2 w; w.x = pk2(v[i][j].x * rs * gg[j].x, v[i][j].y * rs * gg[j].y); w.y = pk2(v[i][j].z * rs * gg[j].z, v[i][j].w * rs * gg[j].w); o8[64 * j] = w; } } }
}
__device__ __forceinline__ void cvt_array_bf16(const float* src, bf16* dst, size_t n8, int gtid, int gthreads) {
    for (size_t i = gtid; i < n8; i += gthreads) {
        const f32x4 a = __builtin_nontemporal_load((const GAS f32x4*)(src + i * 8)), b = __builtin_nontemporal_load((const GAS f32x4*)(src + i * 8 + 4));
        u32x4 o; o.x = pk2(a.x, a.y); o.y = pk2(a.z, a.w); o.z = pk2(b.x, b.y); o.w = pk2(b.z, b.w);
        *(GAS u32x4*)(dst + i * 8) = o;
    }
}
__device__ __forceinline__ void p0_prologue(Frame& F) {
    LAS float* scr = (LAS float*)(F.lds + F.wave * 16384);
    const int gw = F.vcu * NWAVES + F.wave, NGW = F.G * NWAVES;
    constexpr int I_IN = (D / 64) * (DIN / 32), I_OUT = (D / 64) * (D / 32), I_Q = (D / 64) * (DQ / 32);
    constexpr int NITEMS = I_IN + I_OUT + I_Q;
    for (int it = gw; it < NITEMS; it += NGW) {
        int r = it;
        if (r < I_IN) { p0_transpose_item(F.w_in, D, DIN, F.Wt_in, scr, r, F.lane); continue; } r -= I_IN;
        if (r < I_OUT) { p0_transpose_item(F.w_out, D, D, F.Wt_out, scr, r, F.lane); continue; } r -= I_OUT;
        p0_transpose_item(F.w_q, D, DQ, F.Wt_q, scr, r, F.lane, F.g2);
    }
    for (int m = gw; m < T; m += 4 * NGW) rms_rows_to_bf16<4>(F.x, F.g1, F.H, m, NGW, F.lane);
    const int gtid = F.vcu * NWAVES * 64 + F.tid, gthreads = F.G * NWAVES * 64;
    cvt_array_bf16(F.keys1, F.KEYS, (size_t)8 * 128 * 128 / 8, gtid, gthreads);
    cvt_array_bf16(F.keys2, F.KEYS + 8 * 128 * 128, (size_t)8 * 128 * 128 / 8, gtid, gthreads);
}

__device__ __forceinline__ int pack_i8(float a, float b, float c, float d) {
    const int qa = (int)__builtin_rintf(a), qb = (int)__builtin_rintf(b), qc = (int)__builtin_rintf(c), qd = (int)__builtin_rintf(d);
    return (qa & 0xff) | ((qb & 0xff) << 8) | ((qc & 0xff) << 16) | (qd << 24);
}
__device__ __forceinline__ float wave_max(float v) {
#pragma unroll
    for (int o = 1; o < 64; o <<= 1) v = __builtin_fmaxf(v, __shfl_xor(v, o));
    return v;
}
template <int NR> __device__ __forceinline__ void cvt_rows_fp8(Frame& F, int r0, int rstride, int rlimit, int lane) {
    f32x4 v[NR][4];
#pragma unroll
    for (int i = 0; i < NR; ++i) { int r = r0 + i * rstride; r = r < rlimit ? r : r0; const float* src = r < NEXP ? F.pu + (size_t)r * D : F.pv + (size_t)(r - NEXP) * D;
        const GAS f32x4* xr = (const GAS f32x4*)src + lane;
#pragma unroll
        for (int j = 0; j < 4; ++j) v[i][j] = __builtin_nontemporal_load(xr + 64 * j); }
    f32x4 g2v[4];
#pragma unroll
    for (int j = 0; j < 4; ++j) g2v[j] = ((const GAS f32x4*)F.g2)[lane + 64 * j];
#pragma unroll
    for (int i = 0; i < NR; ++i) { const int r = r0 + i * rstride;
        if (r < NEXP) {
#pragma unroll
            for (int j = 0; j < 4; ++j) v[i][j] = v[i][j] * g2v[j]; }
        float amax = 0.f;
#pragma unroll
        for (int j = 0; j < 4; ++j) amax = __builtin_fmaxf(amax, __builtin_fmaxf(__builtin_fmaxf(__builtin_fabsf(v[i][j].x), __builtin_fabsf(v[i][j].y)), __builtin_fmaxf(__builtin_fabsf(v[i][j].z), __builtin_fabsf(v[i][j].w))));
        amax = wave_max(amax);
        int k = 6 - ((int)((f_bits(amax) >> 23) & 0xffu) - 127);
        k = k > 100 ? 100 : (k < -100 ? -100 : k);
        const float sc = bits_f((unsigned)(k + 127) << 23), inv = bits_f((unsigned)(127 - k) << 23);
        if (r < rlimit) { const int e = r < NEXP ? r : r - NEXP; unsigned char* tab8 = r < NEXP ? F.U8 : F.V8; float* rs = r < NEXP ? F.RSU : F.RSV;
            const float sq = amax > 0.f ? 127.0f / amax : 0.f;
#pragma unroll
            for (int j = 0; j < 4; ++j) {
                const int w = pack_i8(v[i][j].x * sq, v[i][j].y * sq, v[i][j].z * sq, v[i][j].w * sq);
                const int s = 2 * j + (lane >> 5);
                *(GAS unsigned*)(tab8 + (size_t)s * TAB8_SLICE + (size_t)e * 128 + 4 * (lane & 31)) = (unsigned)w;
            }
            if (lane == 0) rs[e] = amax * (1.0f / 127.0f); } }
}
__device__ __forceinline__ int crow(int r, int hi) { return (r & 3) + 8 * (r >> 2) + 4 * hi; }
constexpr int VPITCH = 192;
constexpr int KPITCH = 144;
constexpr int ATT_K_OFF = 0, ATT_V_OFF = 32 * KPITCH, ATT_Q_OFF = 32 * KPITCH + 32 * VPITCH, ATT_WAVE_BYTES = 64 * KPITCH + 32 * VPITCH;
struct Tile4 { u32x4 a, b, c, d; };
__device__ __forceinline__ Tile4 tile_load(const bf16* t0, int lane) {
    const bf16* p = t0 + (size_t)(lane >> 3) * DIN + 8 * (lane & 7);
    Tile4 t; t.a = *(const GAS u32x4*)p; t.b = *(const GAS u32x4*)(p + (size_t)8 * DIN); t.c = *(const GAS u32x4*)(p + (size_t)16 * DIN); t.d = *(const GAS u32x4*)(p + (size_t)24 * DIN); return t;
}
__device__ __forceinline__ void tile_store(LAS unsigned char* dst, int pitch, const Tile4& t, int lane) {
    LAS unsigned char* p = dst + (lane >> 3) * pitch + 16 * (lane & 7);
    *(LAS u32x4*)p = t.a; *(LAS u32x4*)(p + 8 * pitch) = t.b; *(LAS u32x4*)(p + 16 * pitch) = t.c; *(LAS u32x4*)(p + 24 * pitch) = t.d;
}
__device__ __forceinline__ bf16x8 kfrag(const LAS unsigned char* kt, int d0, int lane) { const u32x4 w = *(const LAS u32x4*)(kt + (lane & 31) * KPITCH + 32 * d0 + 16 * (lane >> 5)); return __builtin_bit_cast(bf16x8, w); }
__device__ __forceinline__ bf16x8 vfrag(const LAS unsigned char* wl, int dblk, int s, int lane) {
    const int hi = lane >> 5, i = lane & 15, g1 = (lane >> 4) & 1;
    const LAS unsigned char* p = wl + (16 * s + 4 * hi + (i >> 2)) * VPITCH + (32 * dblk + 16 * g1 + 4 * (i & 3)) * 2;
    const v4i16_t lo = __builtin_amdgcn_ds_read_tr16_b64_v4i16((LAS v4i16_t*)p);
    const v4i16_t hh = __builtin_amdgcn_ds_read_tr16_b64_v4i16((LAS v4i16_t*)(p + 8 * VPITCH));
    return (bf16x8){lo[0], lo[1], lo[2], lo[3], hh[0], hh[1], hh[2], hh[3]};
}
__device__ __forceinline__ bf16x8 pack8(const f32x16& a, int s) {
    u32x4 w; w.x = pk2(a[8 * s + 0], a[8 * s + 1]); w.y = pk2(a[8 * s + 2], a[8 * s + 3]); w.z = pk2(a[8 * s + 4], a[8 * s + 5]); w.w = pk2(a[8 * s + 6], a[8 * s + 7]);
    return __builtin_bit_cast(bf16x8, w);
}
__device__ __forceinline__ void head_norm_store(const f32x16& o0, const f32x16& o1, float scale, const float* g, bf16* dstrow, int hi) {
    float ss = 0.f;
#pragma unroll
    for (int r = 0; r < 16; ++r) { const float a = o0[r] * scale, b = o1[r] * scale; ss += a * a + b * b; }
    ss += __shfl_xor(ss, 32);
    const float rs = __builtin_amdgcn_rsqf(ss * (1.f / 64.f) + EPS) * scale;
#pragma unroll
    for (int dblk = 0; dblk < 2; ++dblk)
#pragma unroll
        for (int q4 = 0; q4 < 4; ++q4) { const int d0 = 32 * dblk + 8 * q4 + 4 * hi; const f32x4 gg = *(const GAS f32x4*)(g + d0);
            const f32x16& o = dblk ? o1 : o0;
            u32x2 w; w.x = pk2(o[4 * q4 + 0] * rs * gg.x, o[4 * q4 + 1] * rs * gg.y); w.y = pk2(o[4 * q4 + 2] * rs * gg.z, o[4 * q4 + 3] * rs * gg.w);
            *(GAS u32x2*)(dstrow + d0) = w; }
}

__device__ __forceinline__ void sb_item(Frame& F, int b, int h, int qb, LAS unsigned char* wl) {
    const int lane = F.lane, r32 = lane & 31, hi = lane >> 5;
    const size_t rowbase = (size_t)b * SEQ;
    const bf16* Qp = F.QKV + (rowbase + 32 * qb) * DIN + C_SBQ + h * 64;
    const bf16* Kb = F.QKV + rowbase * DIN + C_SBK + h * 64;
    const bf16* Vb = F.QKV + rowbase * DIN + C_SBV + h * 64;
    bf16x8 qr[4];
    { const Tile4 tq = tile_load(Qp, lane); tile_store(wl + ATT_K_OFF, KPITCH, tq, lane);
#pragma unroll
      for (int d0 = 0; d0 < 4; ++d0) qr[d0] = kfrag(wl + ATT_K_OFF, d0, lane); }
    bf16x8 tri[2];
#pragma unroll
    for (int s = 0; s < 2; ++s)
#pragma unroll
        for (int j = 0; j < 8; ++j) tri[s][j] = (16 * s + 8 * (j >> 2) + 4 * hi + (j & 3) >= r32) ? (short)0x3F80 : (short)0;
    f32x16 o0 = {}, o1 = {}; float C = 0.f;
    Tile4 tk = tile_load(Kb + (size_t)(32 * qb) * DIN, lane), tv = tile_load(Vb + (size_t)(32 * qb) * DIN, lane);
    for (int kt = qb; kt >= 0; --kt) {
        tile_store(wl + ATT_K_OFF, KPITCH, tk, lane); tile_store(wl + ATT_V_OFF, VPITCH, tv, lane);
        { const int kn = kt > 0 ? kt - 1 : 0; tk = tile_load(Kb + (size_t)(32 * kn) * DIN, lane); tv = tile_load(Vb + (size_t)(32 * kn) * DIN, lane); }
        bf16x8 kf[4];
#pragma unroll
        for (int d0 = 0; d0 < 4; ++d0) kf[d0] = kfrag(wl + ATT_K_OFF, d0, lane);
        f32x16 z = {};
#pragma unroll
        for (int d0 = 0; d0 < 4; ++d0) z = __builtin_amdgcn_mfma_f32_32x32x16_bf16(kf[d0], qr[d0], z, 0, 0, 0);
        const int lim = r32 + 32 * (qb - kt);
        f32x16 l, ls;
#pragma unroll
        for (int r = 0; r < 16; ++r) {
            const float zz = z[r] * 0.125f;
            const float e = __builtin_amdgcn_exp2f(-__builtin_fabsf(zz) * LOG2E);
            const float sp = __builtin_fmaxf(zz, 0.f) + LN2 * __builtin_amdgcn_logf(1.0f + e);
            const bool valid = crow(r, hi) < lim;
            l[r] = valid ? -sp : 0.f;
            ls[r] = zz - sp;
        }
        f32x16 lo;
        bf16x8 lh[2], ll[2];
#pragma unroll
        for (int s = 0; s < 2; ++s) {
            u32x4 wh, wlw;
#pragma unroll
            for (int p = 0; p < 4; ++p) { const float a = l[8 * s + 2 * p], c = l[8 * s + 2 * p + 1]; const unsigned w = pk2(a, c); wh[p] = w; lo[8 * s + 2 * p] = a - bf_lo(w); lo[8 * s + 2 * p + 1] = c - bf_hi(w); }
#pragma unroll
            for (int p = 0; p < 4; ++p) wlw[p] = pk2(lo[8 * s + 2 * p], lo[8 * s + 2 * p + 1]);
            lh[s] = __builtin_bit_cast(bf16x8, wh); ll[s] = __builtin_bit_cast(bf16x8, wlw);
        }
        f32x16 Y = {};
        Y = __builtin_amdgcn_mfma_f32_32x32x16_bf16(tri[0], lh[0], Y, 0, 0, 0);
        Y = __builtin_amdgcn_mfma_f32_32x32x16_bf16(tri[1], lh[1], Y, 0, 0, 0);
        Y = __builtin_amdgcn_mfma_f32_32x32x16_bf16(tri[0], ll[0], Y, 0, 0, 0);
        Y = __builtin_amdgcn_mfma_f32_32x32x16_bf16(tri[1], ll[1], Y, 0, 0, 0);
        f32x16 a;
#pragma unroll
        for (int r = 0; r < 16; ++r) {
            const bool valid = crow(r, hi) < lim;
            const float later = C + (Y[r] - l[r]);
            const float av = __builtin_amdgcn_exp2f((ls[r] + later) * LOG2E);
            a[r] = valid ? av : 0.f;
        }
        const float tot = __shfl(Y[0], r32);
        C += tot;
        const bf16x8 a0 = pack8(a, 0), a1 = pack8(a, 1);
        o0 = __builtin_amdgcn_mfma_f32_32x32x16_bf16(vfrag(wl + ATT_V_OFF, 0, 0, lane), a0, o0, 0, 0, 0);
        o0 = __builtin_amdgcn_mfma_f32_32x32x16_bf16(vfrag(wl + ATT_V_OFF, 0, 1, lane), a1, o0, 0, 0, 0);
        o1 = __builtin_amdgcn_mfma_f32_32x32x16_bf16(vfrag(wl + ATT_V_OFF, 1, 0, lane), a0, o1, 0, 0, 0);
        o1 = __builtin_amdgcn_mfma_f32_32x32x16_bf16(vfrag(wl + ATT_V_OFF, 1, 1, lane), a1, o1, 0, 0, 0);
        if (__all(C < SB_EXIT)) break;
    }
    head_norm_store(o0, o1, 1.0f, F.sb_g + h * 64, F.MIX + (rowbase + 32 * qb + r32) * D + h * 64, hi);
}

#define SWA_HEAD(z, qslope, m_, den_, oa, ob) do { \
        float tmax_ = -INFINITY; f32x16 s_; \
        _Pragma("unroll") for (int r = 0; r < 16; ++r) { const int dist = dq - ((r & 3) + 8 * (r >> 2)); const float sv = z[r] * 0.125f - qslope * (float)dist; s_[r] = ((unsigned)dist < 128u) ? sv : -INFINITY; tmax_ = __builtin_fmaxf(tmax_, s_[r]); } \
        tmax_ = __builtin_fmaxf(tmax_, __shfl_xor(tmax_, 32)); \
        const float mn_ = __builtin_fmaxf(m_, tmax_); const float al_ = __builtin_amdgcn_exp2f((m_ - mn_) * LOG2E); m_ = mn_; \
        f32x16 p_; float ps_ = 0.f; \
        _Pragma("unroll") for (int r = 0; r < 16; ++r) { p_[r] = __builtin_amdgcn_exp2f((s_[r] - mn_) * LOG2E); ps_ += p_[r]; } \
        den_ = den_ * al_ + ps_; \
        _Pragma("unroll") for (int r = 0; r < 16; ++r) { oa[r] *= al_; ob[r] *= al_; } \
        const bf16x8 a0_ = pack8(p_, 0), a1_ = pack8(p_, 1); \
        oa = __builtin_amdgcn_mfma_f32_32x32x16_bf16(vf00, a0_, oa, 0, 0, 0); oa = __builtin_amdgcn_mfma_f32_32x32x16_bf16(vf01, a1_, oa, 0, 0, 0); \
        ob = __builtin_amdgcn_mfma_f32_32x32x16_bf16(vf10, a0_, ob, 0, 0, 0); ob = __builtin_amdgcn_mfma_f32_32x32x16_bf16(vf11, a1_, ob, 0, 0, 0); } while (0)
__device__ __forceinline__ void swa_item2(Frame& F, int b, int kv, int hp, int qb, LAS unsigned char* wl) {
    const int lane = F.lane, r32 = lane & 31, hi = lane >> 5, hqA = kv * 4 + 2 * hp, hqB = hqA + 1;
    const size_t rowbase = (size_t)b * SEQ;
    const bf16* QpA = F.QKV + (rowbase + 32 * qb) * DIN + C_SWQ + hqA * 64;
    const bf16* Kb = F.QKV + rowbase * DIN + C_SWK + kv * 64;
    const bf16* Vb = F.QKV + rowbase * DIN + C_SWV + kv * 64;
    const float slopeA = __builtin_amdgcn_exp2f(-(float)(hqA + 1)), slopeB = __builtin_amdgcn_exp2f(-(float)(hqB + 1));
    float mA = F.sinks[hqA], mB = F.sinks[hqB];
    bf16x8 qrA[4];
    { const Tile4 tq = tile_load(QpA, lane); tile_store(wl + ATT_K_OFF, KPITCH, tq, lane);
#pragma unroll
      for (int d0 = 0; d0 < 4; ++d0) qrA[d0] = kfrag(wl + ATT_K_OFF, d0, lane); }
    { const Tile4 tq = tile_load(QpA + 64, lane); tile_store(wl + ATT_Q_OFF, KPITCH, tq, lane); }
    float denA = hi == 0 ? 1.f : 0.f, denB = denA;
    f32x16 oA0 = {}, oA1 = {}, oB0 = {}, oB1 = {};
    const int kt0 = qb - 4 < 0 ? 0 : qb - 4;
    for (int kt = kt0; kt <= qb; ++kt) {
        { const Tile4 tk = tile_load(Kb + (size_t)(32 * kt) * DIN, lane), tv = tile_load(Vb + (size_t)(32 * kt) * DIN, lane);
          tile_store(wl + ATT_K_OFF, KPITCH, tk, lane); tile_store(wl + ATT_V_OFF, VPITCH, tv, lane); }
        const bf16x8 vf00 = vfrag(wl + ATT_V_OFF, 0, 0, lane), vf01 = vfrag(wl + ATT_V_OFF, 0, 1, lane), vf10 = vfrag(wl + ATT_V_OFF, 1, 0, lane), vf11 = vfrag(wl + ATT_V_OFF, 1, 1, lane);
        const int dq = 32 * (qb - kt) + r32 - 4 * hi;
        { f32x16 zA = {};
#pragma unroll
          for (int d0 = 0; d0 < 4; ++d0) zA = __builtin_amdgcn_mfma_f32_32x32x16_bf16(kfrag(wl + ATT_K_OFF, d0, lane), qrA[d0], zA, 0, 0, 0);
          SWA_HEAD(zA, slopeA, mA, denA, oA0, oA1); }
        { f32x16 zB = {};
#pragma unroll
          for (int d0 = 0; d0 < 4; ++d0) zB = __builtin_amdgcn_mfma_f32_32x32x16_bf16(kfrag(wl + ATT_K_OFF, d0, lane), kfrag(wl + ATT_Q_OFF, d0, lane), zB, 0, 0, 0);
          SWA_HEAD(zB, slopeB, mB, denB, oB0, oB1); }
    }
    denA += __shfl_xor(denA, 32); denB += __shfl_xor(denB, 32);
    bf16* dst = F.MIX + (rowbase + 32 * qb + r32) * D + 512 + hqA * 64;
    head_norm_store(oA0, oA1, 1.0f / denA, F.sw_g + hqA * 64, dst, hi);
    head_norm_store(oB0, oB1, 1.0f / denB, F.sw_g + hqB * 64, dst + 64, hi);
}
__device__ __forceinline__ void p2_attention(Frame& F) {
    LAS unsigned char* wl = F.lds + F.wave * 16384;
    static_assert(ATT_WAVE_BYTES <= 16384 && NWAVES * 16384 <= RING_BYTES, "attention LDS");
    const int gw = F.vcu * NWAVES + F.wave, NGW = F.G * NWAVES;
    constexpr int NSB = NB * 8 * 128, NSW = NB * 4 * 128;
    for (int it = gw; it < NSB + NSW; it += NGW) {
        if (it < NSB) { const int qb = it & 127, h = (it >> 7) & 7, b = it >> 10; sb_item(F, b, h, qb, wl); }
        else { const int r = it - NSB; const int qb = r & 127, hp = (r >> 7) & 1, kv = (r >> 8) & 1, b = r >> 9; swa_item2(F, b, kv, hp, qb, wl); }
    }
}

__device__ __forceinline__ int f2ord(unsigned bits) { int x = (int)bits; return x ^ ((x >> 31) & 0x7fffffff); }
template <int N> __device__ __forceinline__ void bitonic_desc(int (&v)[N]) {
#pragma unroll
    for (int k = 2; k <= N; k <<= 1) {
#pragma unroll
        for (int j = k >> 1; j > 0; j >>= 1) {
#pragma unroll
            for (int i = 0; i < N; ++i) {
                const int l = i ^ j;
                if (l > i) { const bool up = ((i & k) == 0); const int a = v[i], b = v[l]; const int mx = a > b ? a : b, mn = a > b ? b : a; v[i] = up ? mx : mn; v[l] = up ? mn : mx; }
            }
        }
    }
}
template <int N> __device__ __forceinline__ void bitonic_merge_desc(int (&v)[N]) {
#pragma unroll
    for (int j = N >> 1; j > 0; j >>= 1) {
#pragma unroll
        for (int i = 0; i < N; ++i) { const int l = i ^ j; if (l > i) { const int a = v[i], b = v[l]; v[i] = a > b ? a : b; v[l] = a > b ? b : a; } }
    }
}
template <int N> __device__ __forceinline__ void bitonic_desc_kv(int (&k)[N], int (&p)[N]) {
#pragma unroll
    for (int kk = 2; kk <= N; kk <<= 1) {
#pragma unroll
        for (int j = kk >> 1; j > 0; j >>= 1) {
#pragma unroll
            for (int i = 0; i < N; ++i) {
                const int l = i ^ j;
                if (l > i) { const bool up = ((i & kk) == 0); const bool sw = up ? (k[i] < k[l]) : (k[i] > k[l]);
                    const int ka = k[i], kb = k[l], pa = p[i], pb = p[l]; k[i] = sw ? kb : ka; k[l] = sw ? ka : kb; p[i] = sw ? pb : pa; p[l] = sw ? pa : pb; }
            }
        }
    }
}
struct Cand { unsigned char i, j; };
struct CandTable { Cand c[64]; int n; };
constexpr CandTable make_cands() { CandTable t{}; int n = 0; for (int i = 0; i < 16; ++i) for (int j = 0; j < 16; ++j) if ((i + 1) * (j + 1) <= 16) { t.c[n].i = (unsigned char)i; t.c[n].j = (unsigned char)j; ++n; } t.n = n; return t; }
constexpr CandTable CANDS = make_cands();
static_assert(CANDS.n == 50, "candidate count");

constexpr int P6_PITCH = 272, P6_KEYS_BYTES = 128 * P6_PITCH, P6_Q_BYTES = 32 * P6_PITCH;
static_assert(2 * P6_KEYS_BYTES + NWAVES * P6_Q_BYTES <= RING_BYTES, "P6 LDS map");
__device__ __forceinline__ void p6_item(Frame& F, int tb, int h, LAS unsigned char* keys_lds, LAS unsigned char* qw) {
    const int lane = F.lane, r32 = lane & 31, hi = lane >> 5;
    const bf16* QP = F.QKV;
    int top0[16], top1[16];
#pragma unroll 1
    for (int half = 0; half < 2; ++half) {
        { const bf16* qsrc = QP + (size_t)(32 * tb + (lane >> 4)) * DQ + h * 256 + half * 128 + 8 * (lane & 15);
          u32x4 t_[8];
#pragma unroll
          for (int i = 0; i < 8; ++i) t_[i] = *(const GAS u32x4*)(qsrc + (size_t)(4 * i) * DQ);
#pragma unroll
          for (int i = 0; i < 8; ++i) *(LAS u32x4*)(qw + (4 * i + (lane >> 4)) * P6_PITCH + 16 * (lane & 15)) = t_[i]; }
        bf16x8 qf[8];
#pragma unroll
        for (int ks = 0; ks < 8; ++ks) { const u32x4 w_ = *(const LAS u32x4*)(qw + r32 * P6_PITCH + 32 * ks + 16 * hi); qf[ks] = __builtin_bit_cast(bf16x8, w_); }
        const LAS unsigned char* kb = keys_lds + half * P6_KEYS_BYTES + r32 * P6_PITCH + 16 * hi;
        int v[64];
#pragma unroll
        for (int nt = 0; nt < 4; ++nt) {
            f32x16 acc = {};
#pragma unroll
            for (int ks = 0; ks < 8; ++ks) { const u32x4 w_ = *(const LAS u32x4*)(kb + (32 * nt) * P6_PITCH + 32 * ks); acc = __builtin_amdgcn_mfma_f32_32x32x16_bf16(__builtin_bit_cast(bf16x8, w_), qf[ks], acc, 0, 0, 0); }
#pragma unroll
            for (int r = 0; r < 16; ++r) { const float av = acc[r]; const unsigned bits = (f_bits(av) & ~0x7Fu) | (unsigned)(32 * nt + crow(r, hi)); v[16 * nt + r] = f2ord(bits); }
        }
        bitonic_desc<64>(v);
        int m[16];
#pragma unroll
        for (int i = 0; i < 16; ++i) { const int o = __shfl_xor(v[15 - i], 32); m[i] = v[i] > o ? v[i] : o; }
        bitonic_merge_desc<16>(m);
#pragma unroll
        for (int i = 0; i < 16; ++i) { if (half == 0) top0[i] = m[i]; else top1[i] = m[i]; }
    }
    float f1[16], f2[16]; int i1[16], i2[16];
#pragma unroll
    for (int i = 0; i < 16; ++i) { const unsigned b1 = (unsigned)f2ord((unsigned)top0[i]), b2 = (unsigned)f2ord((unsigned)top1[i]);
        f1[i] = bits_f(b1 & ~0x7Fu); i1[i] = (int)(b1 & 0x7Fu); f2[i] = bits_f(b2 & ~0x7Fu); i2[i] = (int)(b2 & 0x7Fu); }
    int ck[32], cp[32];
#pragma unroll
    for (int s = 0; s < 32; ++s) {
        if (s < 25) { constexpr int dummy = 0; (void)dummy;
            const int ia = CANDS.c[2 * s].i, ja = CANDS.c[2 * s].j, ib = CANDS.c[2 * s + 1].i, jb = CANDS.c[2 * s + 1].j;
            const float sa = f1[ia] + f2[ja], sb = f1[ib] + f2[jb]; const int pa = (i1[ia] << 7) | i2[ja], pb = (i1[ib] << 7) | i2[jb];
            ck[s] = f2ord(f_bits(hi ? sb : sa)); cp[s] = hi ? pb : pa;
        } else { ck[s] = (int)0x80000000; cp[s] = 0; }
    }
    bitonic_desc_kv<32>(ck, cp);
    int wk[16], wp[16];
#pragma unroll
    for (int i = 0; i < 16; ++i) { const int ok = __shfl_xor(ck[15 - i], 32), op = __shfl_xor(cp[15 - i], 32); const bool t = ck[i] >= ok; wk[i] = t ? ck[i] : ok; wp[i] = t ? cp[i] : op; }
    float vals[16]; float mxv = -INFINITY;
#pragma unroll
    for (int i = 0; i < 16; ++i) { vals[i] = bits_f((unsigned)f2ord((unsigned)wk[i])); mxv = __builtin_fmaxf(mxv, vals[i]); }
    float se = 0.f;
#pragma unroll
    for (int i = 0; i < 16; ++i) { vals[i] = __builtin_amdgcn_exp2f((vals[i] - mxv) * LOG2E); se += vals[i]; }
    const float inv = 1.0f / se;
    const size_t ob = (size_t)(32 * tb + r32) * 128 + h * 16 + hi * 8;
    { u32x4 a; a.x = (unsigned)wp[0] | ((unsigned)wp[1] << 16); a.y = (unsigned)wp[2] | ((unsigned)wp[3] << 16); a.z = (unsigned)wp[4] | ((unsigned)wp[5] << 16); a.w = (unsigned)wp[6] | ((unsigned)wp[7] << 16);
      *(GAS u32x4*)(F.IDX + ob) = a;
      f32x4 ga = {vals[0] * inv, vals[1] * inv, vals[2] * inv, vals[3] * inv}, gb = {vals[4] * inv, vals[5] * inv, vals[6] * inv, vals[7] * inv};
      *(GAS f32x4*)(F.GATE + ob) = ga; *(GAS f32x4*)(F.GATE + ob + 4) = gb; }
}
template <class Sched> __device__ __forceinline__ void p6_topk_own(Frame& F, const Sched& S) {
    LAS unsigned char* keys_lds = F.lds; LAS unsigned char* qw = F.lds + 2 * P6_KEYS_BYTES + F.wave * P6_Q_BYTES;
    pg8::Unit u; int hprev = -1;
    for (int i = 0; S.next(i, u); ++i) {
        const int h = u.pn;
        if (h != hprev) {
            __syncthreads();
#pragma unroll
            for (int half = 0; half < 2; ++half) {
                const bf16* ksrc = F.KEYS + (size_t)(half * 8 + h) * 128 * 128 + (size_t)(F.tid >> 4) * 128 + 8 * (F.tid & 15);
                u32x4 t_[4];
#pragma unroll
                for (int q = 0; q < 4; ++q) t_[q] = *(const GAS u32x4*)(ksrc + (size_t)(32 * q) * 128);
#pragma unroll
                for (int q = 0; q < 4; ++q) *(LAS u32x4*)(keys_lds + half * P6_KEYS_BYTES + ((F.tid >> 4) + 32 * q) * P6_PITCH + 16 * (F.tid & 15)) = t_[q];
            }
            __syncthreads(); hprev = h;
        }
        p6_item(F, 8 * u.pm + F.wave, h, keys_lds, qw);
    }
    { const int gw_ = F.vcu * NWAVES + F.wave, NGW_ = F.G * NWAVES; for (int r = NEXP + gw_; r < 2 * NEXP; r += 4 * NGW_) cvt_rows_fp8<4>(F, r, NGW_, 2 * NEXP, F.lane); }
    __syncthreads();
}

__device__ __forceinline__ float dpp_xor1(float v) { return v + bits_f((unsigned)__builtin_amdgcn_update_dpp(0, (int)f_bits(v), 0xB1, 0xf, 0xf, false)); }
__device__ __forceinline__ float dpp_xor2(float v) { return v + bits_f((unsigned)__builtin_amdgcn_update_dpp(0, (int)f_bits(v), 0x4E, 0xf, 0xf, false)); }
__device__ __forceinline__ float dpp_hmir(float v) { return v + bits_f((unsigned)__builtin_amdgcn_update_dpp(0, (int)f_bits(v), 0x141, 0xf, 0xf, false)); }
__device__ __forceinline__ float dpp_max_xor1(float v) { return __builtin_fmaxf(v, bits_f((unsigned)__builtin_amdgcn_update_dpp(0, (int)f_bits(v), 0xB1, 0xf, 0xf, false))); }
__device__ __forceinline__ float dpp_max_xor2(float v) { return __builtin_fmaxf(v, bits_f((unsigned)__builtin_amdgcn_update_dpp(0, (int)f_bits(v), 0x4E, 0xf, 0xf, false))); }
__device__ __forceinline__ float dpp_max_hmir(float v) { return __builtin_fmaxf(v, bits_f((unsigned)__builtin_amdgcn_update_dpp(0, (int)f_bits(v), 0x141, 0xf, 0xf, false))); }
__device__ __forceinline__ f32x2_t fp8x2(unsigned w, bool hi) { return hi ? __builtin_amdgcn_cvt_pk_f32_fp8((int)w, true) : __builtin_amdgcn_cvt_pk_f32_fp8((int)w, false); }
__device__ __forceinline__ float gelu_tanh(float x) {
    const float y2 = 1.5957691216057308f * (x + 0.044715f * x * x * x);
    return x / (1.0f + __builtin_amdgcn_exp2f(-y2 * LOG2E));
}
__device__ __forceinline__ unsigned vsel16(const u32x4 (&v)[2], int k) { const u32x4 q = v[k >> 3]; const int j = (k >> 1) & 3; const unsigned w = j == 0 ? q.x : j == 1 ? q.y : j == 2 ? q.z : q.w; return (k & 1) ? (w >> 16) : (w & 0xffffu); }
struct TokIn { u32x4 id[2]; u32x4 x0, x1; };
__device__ __forceinline__ int vsel(const u32x4 (&v)[4], int k) { const u32x4 q = v[k >> 2]; const int j = k & 3; return (int)(j == 0 ? q.x : j == 1 ? q.y : j == 2 ? q.z : q.w); }
__device__ __forceinline__ void p7_udots(Frame& F) {
    const int lane = F.lane, g = lane >> 3, c = lane & 7;
    const int s = blockIdx.x & 7, rank = blockIdx.x >> 3, nloc = F.G >> 3;
    const unsigned char* tab = F.U8 + (size_t)s * TAB8_SLICE; const unsigned coff16 = 16u * (unsigned)c;
    bf16* pd = F.PD + (size_t)s * T * 128;
    const int t0 = rank * NWAVES + F.wave, tstride = nloc * NWAVES;
#define P7_IDS(dst, tt) do { const int t_ = (tt) < T ? (tt) : t0; const GAS u32x4* ip_ = (const GAS u32x4*)(F.IDX + (size_t)t_ * 128 + 16 * g); dst.id[0] = ip_[0]; dst.id[1] = ip_[1]; } while (0)
#define P7_X(dst, tt) do { const int t_ = (tt) < T ? (tt) : t0; const bf16* xr_ = F.H + (size_t)t_ * D + 128 * s + 16 * c; dst.x0 = *(const GAS u32x4*)xr_; dst.x1 = *(const GAS u32x4*)(xr_ + 8); } while (0)
#define P7_PCS(pc, in) do { _Pragma("unroll") for (int k = 0; k < 16; ++k) pc[k] = *(const GAS u32x4*)(tab + ((vsel16(in.id, k) << 7) | coff16)); } while (0)
#define P7_MATH(pc, in, tt) do { if ((tt) < T) { \
        float xv[16]; { const unsigned a0 = in.x0.x, a1 = in.x0.y, a2 = in.x0.z, a3 = in.x0.w, b0 = in.x1.x, b1 = in.x1.y, b2 = in.x1.z, b3 = in.x1.w; \
          xv[0] = bf_lo(a0); xv[1] = bf_hi(a0); xv[2] = bf_lo(a1); xv[3] = bf_hi(a1); xv[4] = bf_lo(a2); xv[5] = bf_hi(a2); xv[6] = bf_lo(a3); xv[7] = bf_hi(a3); \
          xv[8] = bf_lo(b0); xv[9] = bf_hi(b0); xv[10] = bf_lo(b1); xv[11] = bf_hi(b1); xv[12] = bf_lo(b2); xv[13] = bf_hi(b2); xv[14] = bf_lo(b3); xv[15] = bf_hi(b3); } \
          \
        float xm = 0.f; _Pragma("unroll") for (int i = 0; i < 16; ++i) xm = __builtin_fmaxf(xm, __builtin_fabsf(xv[i])); \
        xm = dpp_max_hmir(dpp_max_xor2(dpp_max_xor1(xm))); \
        const float sx = xm > 0.f ? 127.0f / xm : 0.f, isx = xm * (1.0f / 127.0f); \
        const int xq0 = pack_i8(xv[0] * sx, xv[1] * sx, xv[2] * sx, xv[3] * sx), xq1 = pack_i8(xv[4] * sx, xv[5] * sx, xv[6] * sx, xv[7] * sx), \
                  xq2 = pack_i8(xv[8] * sx, xv[9] * sx, xv[10] * sx, xv[11] * sx), xq3 = pack_i8(xv[12] * sx, xv[13] * sx, xv[14] * sx, xv[15] * sx); \
        float r0 = 0.f, r1 = 0.f; \
        _Pragma("unroll") for (int k = 0; k < 16; ++k) { \
            const unsigned w0 = pc[k].x, w1 = pc[k].y, w2 = pc[k].z, w3 = pc[k].w; \
            int ia = __builtin_amdgcn_sdot4((int)w0, xq0, 0, false); ia = __builtin_amdgcn_sdot4((int)w1, xq1, ia, false); ia = __builtin_amdgcn_sdot4((int)w2, xq2, ia, false); ia = __builtin_amdgcn_sdot4((int)w3, xq3, ia, false); \
            float p = (float)ia; p = dpp_hmir(dpp_xor2(dpp_xor1(p))); \
            if (k < 8) r0 = (c == k) ? p : r0; else r1 = (c == (k - 8)) ? p : r1; } \
        r0 *= isx; r1 *= isx; \
        pd[(size_t)(tt) * 128 + 16 * g + c] = (bf16)(pk2(r0, r0) & 0xffffu); pd[(size_t)(tt) * 128 + 16 * g + 8 + c] = (bf16)(pk2(r1, r1) & 0xffffu); } } while (0)
    TokIn inA, inB, inC, inN; u32x4 pcA[16], pcB[16], pcC[16];
    P7_IDS(inA, t0); P7_X(inA, t0); P7_PCS(pcA, inA); P7_IDS(inB, t0 + tstride); P7_X(inB, t0 + tstride); P7_PCS(pcB, inB); P7_IDS(inC, t0 + 2 * tstride);
    for (int t = t0; t < T; t += 3 * tstride) {
        P7_X(inC, t + 2 * tstride); P7_PCS(pcC, inC); P7_IDS(inN, t + 3 * tstride); __builtin_amdgcn_sched_barrier(0);
        P7_MATH(pcA, inA, t); __builtin_amdgcn_sched_barrier(0);
        inA.id[0] = inN.id[0]; inA.id[1] = inN.id[1];
        P7_X(inA, t + 3 * tstride); P7_PCS(pcA, inA); P7_IDS(inN, t + 4 * tstride); __builtin_amdgcn_sched_barrier(0);
        P7_MATH(pcB, inB, t + tstride); __builtin_amdgcn_sched_barrier(0);
        inB.id[0] = inN.id[0]; inB.id[1] = inN.id[1];
        P7_X(inB, t + 4 * tstride); P7_PCS(pcB, inB); P7_IDS(inN, t + 5 * tstride); __builtin_amdgcn_sched_barrier(0);
        P7_MATH(pcC, inC, t + 2 * tstride); __builtin_amdgcn_sched_barrier(0);
        inC.id[0] = inN.id[0]; inC.id[1] = inN.id[1];
    }
#undef P7_IDS
#undef P7_X
#undef P7_PCS
#undef P7_MATH
}
__device__ __forceinline__ void p8_combine(Frame& F) {
    const int gw = F.vcu * NWAVES + F.wave, NGW = F.G * NWAVES, lane = F.lane;
    constexpr int NU = 4;
    for (int t0 = gw; t0 < T; t0 += NU * NGW) {
        unsigned pdw[NU][8], idw[NU]; f32x2_t gt[NU];
#pragma unroll
        for (int u = 0; u < NU; ++u) { const int t = t0 + u * NGW < T ? t0 + u * NGW : t0; const size_t o = (size_t)t * 128 + 2 * lane;
#pragma unroll
            for (int s = 0; s < 8; ++s) pdw[u][s] = __builtin_nontemporal_load((const GAS unsigned*)(F.PD + (size_t)s * T * 128 + o));
            idw[u] = *(const GAS unsigned*)(F.IDX + o); gt[u] = __builtin_nontemporal_load((const GAS f32x2_t*)(F.GATE + o)); }
        float ru0[NU], ru1[NU], rv0[NU], rv1[NU], r2[NU];
#pragma unroll
        for (int u = 0; u < NU; ++u) { const int t = t0 + u * NGW < T ? t0 + u * NGW : t0; const int i0 = (int)(idw[u] & 0xffffu), i1 = (int)(idw[u] >> 16);
            ru0[u] = F.RSU[i0]; ru1[u] = F.RSU[i1]; rv0[u] = F.RSV[i0]; rv1[u] = F.RSV[i1]; r2[u] = F.RS2[t]; }
#pragma unroll
        for (int u = 0; u < NU; ++u) { const int t = t0 + u * NGW;
            float d0 = 0.f, d1 = 0.f;
#pragma unroll
            for (int s = 0; s < 8; ++s) { const unsigned w = pdw[u][s]; d0 += bf_lo(w); d1 += bf_hi(w); }
            const float c0 = gt[u].x * gelu_tanh(d0 * ru0[u] * r2[u]) * rv0[u], c1 = gt[u].y * gelu_tanh(d1 * ru1[u] * r2[u]) * rv1[u];
            const float m = wave_max(__builtin_fmaxf(__builtin_fabsf(c0), __builtin_fabsf(c1)));
            const float sq = m > 0.f ? 127.0f / m : 0.f;
            const int q0 = (int)__builtin_rintf(c0 * sq), q1 = (int)__builtin_rintf(c1 * sq);
            if (t < T) { *(GAS unsigned short*)(F.C8 + (size_t)t * 128 + 2 * lane) = (unsigned short)((q0 & 0xff) | ((q1 & 0xff) << 8)); if (lane == 0) F.CS[t] = m * (1.0f / 127.0f); } }
    }
}
typedef int v2i_t __attribute__((ext_vector_type(2)));
typedef int v4i_t __attribute__((ext_vector_type(4)));
constexpr int P9_PITCH = 144, P9_WAVE_BYTES = 128 * P9_PITCH, P9_OSC_OFF = LDSCTL_OFF + 512;
static_assert(NWAVES * P9_WAVE_BYTES <= RING_BYTES && P9_OSC_OFF + NWAVES * 512 <= LDS_BYTES, "P9 LDS map");
struct TokInV { u32x4 id[2]; u32x4 a0, a1; u32x2 xb; float cs; };
__device__ __forceinline__ void p9_vacc(Frame& F) {
    const int lane = F.lane, g = lane >> 3, c = lane & 7, m16 = lane & 15, q = lane >> 4;
    const int s = blockIdx.x & 7, rank = blockIdx.x >> 3, nloc = F.G >> 3;
    const unsigned char* tab = F.V8 + (size_t)s * TAB8_SLICE; const unsigned coff16 = 16u * (unsigned)c;
    const int t0 = rank * NWAVES + F.wave, tstride = nloc * NWAVES;
    LAS unsigned char* wl = F.lds + F.wave * P9_WAVE_BYTES;
    LAS float* osc = (LAS float*)(F.lds + P9_OSC_OFF + F.wave * 512);
    LAS unsigned char* wst = wl + (16 * g) * P9_PITCH + 16 * c;
    const LAS unsigned char* wrd = wl + (16 * q + (m16 >> 1)) * P9_PITCH + 8 * (m16 & 1);
    const int coff = 128 * s + 4 * (lane & 31);
#define P9_IN(dst, tt) do { const int t_ = (tt) < T ? (tt) : t0; const GAS u32x4* ip_ = (const GAS u32x4*)(F.IDX + (size_t)t_ * 128 + 16 * g); dst.id[0] = ip_[0]; dst.id[1] = ip_[1]; \
        const GAS u32x4* cp_ = (const GAS u32x4*)(F.C8 + (size_t)t_ * 128 + 16 * q); const u32x4 z_ = {0u, 0u, 0u, 0u}; dst.a0 = cp_[0]; dst.a1 = cp_[4]; if (m16 != 0) { dst.a0 = z_; dst.a1 = z_; } \
        dst.xb = *(const GAS u32x2*)(F.H + (size_t)t_ * D + coff); dst.cs = F.CS[t_]; } while (0)
#define P9_PCS(pc, in) do { _Pragma("unroll") for (int k = 0; k < 16; ++k) pc[k] = *(const GAS u32x4*)(tab + ((vsel16(in.id, k) << 7) | coff16)); } while (0)
#define P9_MATH(pc, in, tt) do { if ((tt) < T) { \
        _Pragma("unroll") for (int k = 0; k < 16; ++k) *(LAS u32x4*)(wst + k * P9_PITCH) = pc[k]; \
        v4i_t acc[8]; _Pragma("unroll") for (int nb = 0; nb < 8; ++nb) acc[nb] = (v4i_t){0, 0, 0, 0}; \
        _Pragma("unroll") for (int s2 = 0; s2 < 2; ++s2) { const v4i_t av = __builtin_bit_cast(v4i_t, s2 ? in.a1 : in.a0); \
            _Pragma("unroll") for (int nb = 0; nb < 8; ++nb) { \
                const v2i_t lo = __builtin_amdgcn_ds_read_tr8_b64_v2i32((LAS v2i_t*)(wrd + (64 * s2) * P9_PITCH + 16 * nb)); \
                const v2i_t hi = __builtin_amdgcn_ds_read_tr8_b64_v2i32((LAS v2i_t*)(wrd + (64 * s2 + 8) * P9_PITCH + 16 * nb)); \
                const v4i_t bv = {lo.x, lo.y, hi.x, hi.y}; \
                acc[nb] = __builtin_amdgcn_mfma_i32_16x16x64_i8(av, bv, acc[nb], 0, 0, 0); } } \
          \
        if (lane < 16) { _Pragma("unroll") for (int nb = 0; nb < 8; ++nb) osc[16 * nb + lane] = (float)acc[nb][0] * in.cs; } \
        asm volatile("" ::: "memory"); \
        float ss = 0.f; \
        if (lane < 32) { const f32x4 d_ = *(const LAS f32x4*)(osc + 4 * lane); bf16* op_ = F.X2 + (size_t)(tt) * D + coff; const unsigned xb0_ = in.xb.x, xb1_ = in.xb.y; \
            const f32x4 y = {bf_lo(xb0_) + d_[0], bf_hi(xb0_) + d_[1], bf_lo(xb1_) + d_[2], bf_hi(xb1_) + d_[3]}; \
            ss = (y.x * y.x + y.y * y.y) + (y.z * y.z + y.w * y.w); u32x2 yw_; yw_.x = pk2(y.x, y.y); yw_.y = pk2(y.z, y.w); *(GAS u32x2*)op_ = yw_; } \
        ss = wave_sum(ss); if (lane == 0) F.SSP[(size_t)s * T + (tt)] = ss; } } while (0)
    TokInV inA, inB; u32x4 pcA[16], pcB[16];
    P9_IN(inA, t0); P9_PCS(pcA, inA); P9_IN(inB, t0 + tstride);
    for (int t = t0; t < T; t += 2 * tstride) {
        P9_PCS(pcB, inB); TokInV inC; P9_IN(inC, t + 2 * tstride); __builtin_amdgcn_sched_barrier(0);
        P9_MATH(pcA, inA, t); __builtin_amdgcn_sched_barrier(0);
        P9_PCS(pcA, inC); inA = inC; TokInV inD; P9_IN(inD, t + 3 * tstride); __builtin_amdgcn_sched_barrier(0);
        P9_MATH(pcB, inB, t + tstride); __builtin_amdgcn_sched_barrier(0);
        inB = inD;
    }
#undef P9_IN
#undef P9_PCS
#undef P9_MATH
}
__device__ __forceinline__ void p10_final(Frame& F) {
    const int gw = F.vcu * NWAVES + F.wave, NGW = F.G * NWAVES, lane = F.lane;
    for (int t = gw; t < T; t += NGW) {
        float ss = 0.f;
#pragma unroll
        for (int s = 0; s < 8; ++s) ss += F.SSP[(size_t)s * T + t];
        const float rs = __builtin_amdgcn_rsqf(ss * (1.f / D) + EPS);
        GAS f32x4* xr = (GAS f32x4*)(F.out + (size_t)t * D) + lane; const GAS f32x4* gr = (const GAS f32x4*)F.gf + lane; const GAS u32x2* br = (const GAS u32x2*)(F.X2 + (size_t)t * D) + lane;
#pragma unroll
        for (int j = 0; j < 4; ++j) { const u32x2 w = __builtin_nontemporal_load(br + 64 * j); const unsigned w0 = w.x, w1 = w.y; const f32x4 gg = gr[64 * j]; __builtin_nontemporal_store((f32x4){bf_lo(w0) * rs * gg.x, bf_hi(w0) * rs * gg.y, bf_lo(w1) * rs * gg.z, bf_hi(w1) * rs * gg.w}, xr + 64 * j); }
    }
}
struct Args { const float* in[14]; float* out; unsigned char* ws; int ph_lo, ph_hi, li, pad; };
__global__ void __launch_bounds__(NWAVES * 64, 2) mk_fwd(Args args) {
    extern __shared__ __attribute__((aligned(16))) unsigned char lds[];
#ifdef PROBE_LO
    unsigned long long pmk_lo = 0, pmk_hi = 0;
    if (PROBE_LO == -1) { asm volatile("s_memrealtime %0\n\ts_waitcnt lgkmcnt(0)" : "=s"(pmk_lo) :: "memory"); }
#endif
    Frame F;
    F.lds = (LAS unsigned char*)lds;
    F.MISC = (volatile LAS unsigned*)(F.lds + MISC_OFF);
    F.tid = threadIdx.x; F.lane = F.tid & 63; F.wave = __builtin_amdgcn_readfirstlane(F.tid >> 6);
    F.G = gridDim.x; { const int bx = blockIdx.x; F.vcu = (F.G % 8 == 0) ? (bx % 8) * (F.G / 8) + bx / 8 : bx; }
    unsigned char* ws = args.ws;
    F.ctl = (gu32*)(ws + WS_CTL);
    F.x = args.in[0]; F.g1 = args.in[1]; F.w_in = args.in[2]; F.sb_g = args.in[3]; F.sw_g = args.in[4]; F.sinks = args.in[5]; F.w_out = args.in[6]; F.g2 = args.in[7];
    F.w_q = args.in[8]; F.keys1 = args.in[9]; F.keys2 = args.in[10]; F.pu = args.in[11]; F.pv = args.in[12]; F.gf = args.in[13]; F.out = args.out;
    F.Wt_in = (bf16*)(ws + WS_WIN); F.Wt_out = (bf16*)(ws + WS_WOUT); F.Wt_q = (bf16*)(ws + WS_WQ); F.KEYS = (bf16*)(ws + WS_KEYS);
    F.H = (bf16*)(ws + WS_H); F.MIX = (bf16*)(ws + WS_MIX); F.QKV = (bf16*)(ws + WS_QKV); F.U8 = ws + WS_U8; F.V8 = ws + WS_V8; F.RSU = (float*)(ws + WS_RSU); F.RSV = (float*)(ws + WS_RSV);
    F.SSQP = (float*)(ws + WS_SSQP); F.RS2 = (float*)(ws + WS_RS2); F.PD = (bf16*)(ws + WS_PD); F.X2 = (bf16*)(ws + WS_X2); F.C8 = ws + WS_C; F.CS = (float*)(ws + WS_C + 6 * MiB); F.SSP = (float*)(ws + WS_SSP);
    F.IDX = (unsigned short*)(ws + WS_IDX); F.GATE = (float*)(ws + WS_GATE);
    for (int u = F.tid; u < (LDS_BYTES - LDSCTL_OFF) / 4; u += NWAVES * 64) ((LAS unsigned*)(F.lds + LDSCTL_OFF))[u] = 0u;
    __syncthreads();
    const int lo = args.ph_lo, hi = args.ph_hi;
    const bool use_bar = (hi - lo) > 1;
    XcdBarrier bar; bar.bar = (unsigned*)(F.ctl + CW_BAR) + args.li * XCD_BAR_WORDS; bar.x = 0; bar.st = nullptr;
    if (use_bar) bar = xcd_barrier_post((unsigned*)(F.ctl + CW_BAR) + args.li * XCD_BAR_WORDS, F.MISC + 8);
#ifndef PHMASK
#define PHMASK 2047
#endif
#define IN(k) (((PHMASK >> (k)) & 1) && lo <= (k) && (k) < hi)
#define SEAM(k) do { if (IN(k) && IN((k) + 1)) xcd_barrier(bar); } while (0)
    const int gw = F.vcu * NWAVES + F.wave, NGW = F.G * NWAVES;
#ifdef PROBE_LO
#define PSTAMP(v) asm volatile("s_memrealtime %0\n\ts_waitcnt lgkmcnt(0)" : "=s"(v) :: "memory")
#define PMARK(k) do { if ((k) == PROBE_LO) { PSTAMP(pmk_lo); } if ((k) == PROBE_HI + 1) { PSTAMP(pmk_hi); } } while (0)
#else
#define PMARK(k) do {} while (0)
#endif

    PMARK(0);
    if (IN(0)) { p0_prologue(F); } SEAM(0);
    PMARK(1);
    if (IN(1)) { pg8::Gemm g{F.H, F.Wt_in, T, DIN, D}; pg8::StaticOrder S; S.init(T, DIN, F.G, (int)blockIdx.x); pg8::EpiBf16 E{F.QKV, DIN};
        pg8::gemm_phase<pg8::EpiBf16, pg8::StaticOrder>(F.lds, g, S, E);
        { const int nfull = (T / 256) * (DIN / 256) % F.G, nb = F.G - nfull;
          if (nb == F.G) { for (int r = (int)blockIdx.x * NWAVES + F.wave; r < NEXP; r += 4 * F.G * NWAVES) cvt_rows_fp8<4>(F, r, F.G * NWAVES, NEXP, F.lane); }
          else if ((int)blockIdx.x >= nfull) { for (int r = ((int)blockIdx.x - nfull) * NWAVES + F.wave; r < NEXP; r += 4 * nb * NWAVES) cvt_rows_fp8<4>(F, r, nb * NWAVES, NEXP, F.lane); } }
        } SEAM(1);
    PMARK(2);
    if (IN(2)) { p2_attention(F); } SEAM(2);
    PMARK(3);
    if (IN(3)) { pg8::Gemm g{F.MIX, F.Wt_out, T, D, D}; pg8::StaticOrder S; S.init(T, D, F.G, (int)blockIdx.x); pg8::EpiResB E{F.x, F.H, D, F.SSQP};
        pg8::gemm_phase<pg8::EpiResB, pg8::StaticOrder>(F.lds, g, S, E); } SEAM(3);
    PMARK(4);
    PMARK(5);
    if (IN(5)) { pg8::Gemm g{F.H, F.Wt_q, T, DQ, D}; pg8::StaticOrder S; S.init(T, DQ, F.G, (int)blockIdx.x); pg8::EpiBf16RS E{F.QKV, DQ, F.SSQP, F.RS2};
        pg8::gemm_phase<pg8::EpiBf16RS, pg8::StaticOrder>(F.lds, g, S, E);
        asm volatile("s_waitcnt vmcnt(0)" ::: "memory"); __syncthreads();
        p6_topk_own(F, S); }
    PMARK(6);
    SEAM(6);
    PMARK(7);
    if (IN(7)) { p7_udots(F); } SEAM(7);
    PMARK(8);
    if (IN(8)) { p8_combine(F); } SEAM(8);
    PMARK(9);
    if (IN(9)) { p9_vacc(F); } SEAM(9);
    PMARK(10);
    if (IN(10)) { p10_final(F); }
#ifdef PROBE_LO
    xcd_barrier(bar);
    PMARK(11);
    if (blockIdx.x == 0 && F.tid == 0) { unsigned long long t0, t1; PSTAMP(t0); const unsigned long long dl = (pmk_hi - pmk_lo) * PROBE_MULT;
        do { __builtin_amdgcn_s_sleep(8); PSTAMP(t1); } while (t1 - t0 < dl); }
#endif
#undef IN
#undef SEAM
}

extern "C" void kernel_launch(void* const* d_in, const int* in_sizes, int n_in, void* d_out, int out_size, void* d_ws, size_t ws_size, hipStream_t stream) {
    static int grid = 0;
    if (grid == 0) {
        if (n_in != 14 || in_sizes[0] != T * D || out_size != T * D || ws_size < WS_END) { fprintf(stderr, "kernel_launch: unexpected shapes (n_in %d, in0 %d, out %d, ws %zu)\n", n_in, n_in > 0 ? in_sizes[0] : -1, out_size, ws_size); grid = -1; return; }
        int dev = 0, cus = 0, per_cu = 0;
        if (hipGetDevice(&dev) != hipSuccess || hipDeviceGetAttribute(&cus, hipDeviceAttributeMultiprocessorCount, dev) != hipSuccess) { grid = -1; return; }
        if (hipFuncSetAttribute((const void*)mk_fwd, hipFuncAttributeMaxDynamicSharedMemorySize, LDS_BYTES) != hipSuccess) { fprintf(stderr, "kernel_launch: hipFuncSetAttribute failed\n"); grid = -1; return; }
        if (hipOccupancyMaxActiveBlocksPerMultiprocessor(&per_cu, (const void*)mk_fwd, NWAVES * 64, LDS_BYTES) != hipSuccess || per_cu < 1)
            fprintf(stderr, "kernel_launch: note: occupancy query reports %d workgroups per CU\n", per_cu);
        (void)hipGetLastError();
        grid = cus;
    }
    if (grid < 0) return;
    if (hipMemsetAsync((char*)d_ws + WS_CTL, 0, CTL_ZERO_BYTES, stream) != hipSuccess) { fprintf(stderr, "kernel_launch: hipMemsetAsync failed\n"); return; }
    Args a{};
    for (int i = 0; i < 14; ++i) a.in[i] = (const float*)d_in[i];
    a.out = (float*)d_out; a.ws = (unsigned char*)d_ws;
#if MK_N_LAUNCHES == 1
    a.ph_lo = 0; a.ph_hi = N_PHASES; a.li = 0;
    hipLaunchKernelGGL(mk_fwd, dim3(grid), dim3(NWAVES * 64), LDS_BYTES, stream, a);
#else
    for (int li = 0; li < N_PHASES; ++li) { a.ph_lo = li; a.ph_hi = li + 1; a.li = 0; hipLaunchKernelGGL(mk_fwd, dim3(grid), dim3(NWAVES * 64), LDS_BYTES, stream, a); }
#endif
    const hipError_t le = hipPeekAtLastError();
    if (le != hipSuccess) fprintf(stderr, "kernel_launch: launch failed: %s\n", hipGetErrorName(le));
}
```

```cpp
#include <hip/hip_runtime.h>
#include <cstdio>
#include <cstdint>

#ifndef MK_N_LAUNCHES
#define MK_N_LAUNCHES 1
#endif

#define LAS __attribute__((address_space(3)))
#define GAS __attribute__((address_space(1)))
typedef unsigned short bf16;
typedef short bf16x8 __attribute__((ext_vector_type(8)));
typedef float f32x4 __attribute__((ext_vector_type(4)));
typedef float f32x16 __attribute__((ext_vector_type(16)));
typedef unsigned u32x4 __attribute__((ext_vector_type(4)));
typedef unsigned u32x2 __attribute__((ext_vector_type(2)));
typedef short v4i16_t __attribute__((ext_vector_type(4)));
typedef float f32x2_t __attribute__((ext_vector_type(2)));
typedef __bf16 bf16x2_t __attribute__((ext_vector_type(2)));
typedef GAS unsigned gu32;

constexpr int T = 16384, SEQ = 4096, NB = 4, D = 1024, DIN = 2304, DQ = 2048;
constexpr int C_SBQ = 0, C_SBK = 512, C_SBV = 1024, C_SWQ = 1536, C_SWK = 2048, C_SWV = 2176;
constexpr int NEXP = 16384;
constexpr float EPS = 1e-6f;
constexpr float LOG2E = 1.4426950408889634f, LN2 = 0.6931471805599453f;
constexpr float SB_EXIT = -40.0f;

namespace pg8 {
constexpr int BM = 256, BK = 64, HALF = 128, HTB = HALF * BK * 2, STAGE_BYTES = 8 * HTB, NXCD = 8, WGM = 8;
__host__ __device__ __forceinline__ int lds_byte(int r, int c) { const int st = (r >> 4) * 2 + (c >> 5), rr = r & 15, cc = c & 31, ob = rr * 64 + cc * 2; return st * 1024 + (ob ^ (((ob >> 9) & 1) << 5)); }
__host__ __device__ __forceinline__ void stage_rc(int b, int& R, int& C) { const int st = b / 1024, sb = b % 1024, swz = sb ^ (((sb >> 9) & 1) << 5); R = (st >> 1) * 16 + swz / 64; C = (st & 1) * 32 + (swz % 64) / 2; }
__host__ __device__ __forceinline__ int perm32(int rho) { const int n = rho >> 4, i = rho & 15; return 8 * (i >> 2) + 4 * n + (i & 3); }
struct Unit { int pm, pn; };
struct Gemm { const bf16* A; const bf16* Bt; int M, N, K; };
struct StaticOrder {
    int nM, nN, nwg, G, c;
    __host__ __device__ void init(int M, int N, int G_, int c_) { nM = M / BM; nN = N / BM; nwg = nM * nN; G = G_; c = c_; }
    __host__ __device__ bool next(int i, Unit& u) const {
        const long L = (long)i * G + c; if (L >= nwg) return false;
        int wgid = (int)L; { const int q = nwg / NXCD, r = nwg % NXCD, xcd = wgid % NXCD, off = wgid / NXCD; wgid = (xcd < r ? xcd * (q + 1) : r * (q + 1) + (xcd - r) * q) + off; }
        const int nig = WGM * nN, gid = wgid / nig, fm = gid * WGM, gsz = (nM - fm) < WGM ? (nM - fm) : WGM;
        u.pm = fm + ((wgid % nig) % gsz); u.pn = (wgid % nig) / gsz; return true;
    }
};
__device__ __forceinline__ unsigned cvt_pk_bf16(float lo, float hi) { f32x2_t v = {lo, hi}; bf16x2_t b = __builtin_convertvector(v, bf16x2_t); return __builtin_bit_cast(unsigned, b); }

struct EpiBf16 {
    static constexpr bool PERM = true;
    bf16* O; int ldc;
    __device__ __forceinline__ void operator()(const f32x4 (&acc)[2][2][4][2], const Unit& u, int wr, int wc, int fr, int fq) const {
        const int row0 = u.pm * BM + wr * 64 + fr; const int col0 = u.pn * BM + wc * 32 + 8 * fq;
        const auto rsrc = __builtin_amdgcn_make_buffer_rsrc((void*)O, 0, 0x7ffffff0, 0x00020000);
#pragma unroll
        for (int ai = 0; ai < 2; ++ai)
#pragma unroll
            for (int m = 0; m < 4; ++m) { const unsigned boff = (unsigned)(((size_t)(row0 + ai * HALF + m * 16) * ldc + col0) * 2);
#pragma unroll
                for (int bj = 0; bj < 2; ++bj) { const f32x4 v0 = acc[ai][bj][m][0], v1 = acc[ai][bj][m][1];
                    u32x4 w; w.x = cvt_pk_bf16(v0[0], v0[1]); w.y = cvt_pk_bf16(v0[2], v0[3]); w.z = cvt_pk_bf16(v1[0], v1[1]); w.w = cvt_pk_bf16(v1[2], v1[3]);
                    __builtin_amdgcn_raw_buffer_store_b128(w, rsrc, boff + bj * HALF * 2, 0, 16); } }
    }
};
struct EpiBf16RS {
    static constexpr bool PERM = true;
    bf16* O; int ldc; const float* ssqp; float* rs2;
    __device__ __forceinline__ void operator()(const f32x4 (&acc)[2][2][4][2], const Unit& u, int wr, int wc, int fr, int fq) const {
        const int row0 = u.pm * BM + wr * 64 + fr; const int col0 = u.pn * BM + wc * 32 + 8 * fq;
#pragma unroll
        for (int ai = 0; ai < 2; ++ai)
#pragma unroll
            for (int m = 0; m < 4; ++m) { const int row = row0 + ai * HALF + m * 16; bf16* rowp = O + (size_t)row * ldc + col0;
                const f32x4* sp = (const f32x4*)(ssqp + (size_t)row * 16); const f32x4 s0 = sp[0], s1 = sp[1], s2 = sp[2], s3 = sp[3];
                const float ss = ((s0[0] + s0[1]) + (s0[2] + s0[3])) + ((s1[0] + s1[1]) + (s1[2] + s1[3])) + ((s2[0] + s2[1]) + (s2[2] + s2[3])) + ((s3[0] + s3[1]) + (s3[2] + s3[3]));
                const float rs = __builtin_amdgcn_rsqf(ss * (1.0f / 1024.0f) + 1e-6f);
                if (u.pn == 0 && wc == 0 && fq == 0) rs2[row] = rs;
#pragma unroll
                for (int bj = 0; bj < 2; ++bj) { const f32x4 v0 = acc[ai][bj][m][0] * rs, v1 = acc[ai][bj][m][1] * rs;
                    u32x4 w; w.x = cvt_pk_bf16(v0[0], v0[1]); w.y = cvt_pk_bf16(v0[2], v0[3]); w.z = cvt_pk_bf16(v1[0], v1[1]); w.w = cvt_pk_bf16(v1[2], v1[3]);
                    *(u32x4*)(rowp + bj * HALF) = w; } }
    }
};
struct EpiResB {
    static constexpr bool PERM = false;
    const float* base; bf16* xb; int ldc; float* ssqp;
    __device__ __forceinline__ void operator()(const f32x4 (&acc)[2][2][4][2], const Unit& u, int wr, int wc, int fr, int fq) const {
        const int col0 = u.pn * BM + wc * 32 + 4 * fq;
#pragma unroll
        for (int ai = 0; ai < 2; ++ai)
#pragma unroll
            for (int m = 0; m < 4; ++m) { const int row = u.pm * BM + ai * HALF + wr * 64 + m * 16 + fr; const size_t off = (size_t)row * ldc + col0; float sq = 0.f;
#pragma unroll
                for (int bj = 0; bj < 2; ++bj)
#pragma unroll
                    for (int n = 0; n < 2; ++n) { const f32x4 bs = __builtin_nontemporal_load((const f32x4*)(base + off + bj * HALF + n * 16)); const f32x4 y = bs + acc[ai][bj][m][n];
                        sq += (y[0] * y[0] + y[1] * y[1]) + (y[2] * y[2] + y[3] * y[3]);
                        u32x2 w; w.x = cvt_pk_bf16(y[0], y[1]); w.y = cvt_pk_bf16(y[2], y[3]); *(u32x2*)(xb + off + bj * HALF + n * 16) = w; }
                sq += __shfl_xor(sq, 16); sq += __shfl_xor(sq, 32);
                if (fq == 0) ssqp[(size_t)row * 16 + u.pn * 4 + wc] = sq; }
    }
};
struct EpiResF32 {
    static constexpr bool PERM = false;
    const float* base; float* out; int ldc;
    __device__ __forceinline__ void operator()(const f32x4 (&acc)[2][2][4][2], const Unit& u, int wr, int wc, int fr, int fq) const {
        const int col0 = u.pn * BM + wc * 32 + 4 * fq;
#pragma unroll
        for (int ai = 0; ai < 2; ++ai)
#pragma unroll
            for (int m = 0; m < 4; ++m) { const size_t off = (size_t)(u.pm * BM + ai * HALF + wr * 64 + m * 16 + fr) * ldc + col0;
#pragma unroll
                for (int bj = 0; bj < 2; ++bj)
#pragma unroll
                    for (int n = 0; n < 2; ++n) { const f32x4 bs = *(const f32x4*)(base + off + bj * HALF + n * 16); *(f32x4*)(out + off + bj * HALF + n * 16) = bs + acc[ai][bj][m][n]; } }
    }
};

template <class Epi, class Sched>
__device__ __forceinline__ void gemm_phase(LAS unsigned char* lds, const Gemm g, const Sched& S, const Epi& E) {
    const int tid = threadIdx.x, wid = __builtin_amdgcn_readfirstlane(tid >> 6), lane = tid & 63, wr = wid >> 2, wc = wid & 3, fr = lane & 15, fq = lane >> 4;
    const int K = g.K, nt = K / BK;
    unsigned voffA[2], voffB[2];
#pragma unroll
    for (int i = 0; i < 2; ++i) { int R, C; stage_rc(tid * 16 + i * 8192, R, C); const int Rb = Epi::PERM ? ((R & ~31) + perm32(R & 31)) : R;
        voffA[i] = (unsigned)(R * K + C) * 2u; voffB[i] = (unsigned)(Rb * K + C) * 2u; }
    const size_t kstep = (size_t)(BK * 2);
    const size_t hstep = (size_t)HALF * K * 2;
    const size_t tstep = 2 * hstep;
    const unsigned ldsw = (unsigned)wid * 1024u;
    const int aoff = lds_byte(wr * 64 + fr, fq * 8), boff = lds_byte(wc * 32 + fr, fq * 8);
#define PG8_SA(b, h) (((b) * 2 + (h)) * HTB)
#define PG8_SB(b, h) ((4 + (b) * 2 + (h)) * HTB)
#define PG8_STAGE(bufoff, gbase, voff) do { _Pragma("unroll") for (int _i = 0; _i < 2; ++_i) \
        __builtin_amdgcn_global_load_lds((const unsigned*)((const char*)(gbase) + (voff)[_i]), (LAS unsigned*)(lds + (bufoff) + ldsw + _i * 8192), 16, 0, 0); } while (0)
#define PG8_LDA(dst, b, h) do { _Pragma("unroll") for (int m = 0; m < 4; ++m) _Pragma("unroll") for (int k = 0; k < 2; ++k) dst[m][k] = *(const LAS bf16x8*)(lds + PG8_SA(b, h) + aoff + m * 2048 + k * 1024); } while (0)
#define PG8_LDB(dst, b, h) do { _Pragma("unroll") for (int n = 0; n < 2; ++n) _Pragma("unroll") for (int k = 0; k < 2; ++k) dst[n][k] = *(const LAS bf16x8*)(lds + PG8_SB(b, h) + boff + n * 2048 + k * 1024); } while (0)
#define PG8_MMA(ai, bj, At, Bt) do { __builtin_amdgcn_s_setprio(1); _Pragma("unroll") for (int m = 0; m < 4; ++m) _Pragma("unroll") for (int n = 0; n < 2; ++n) _Pragma("unroll") for (int k = 0; k < 2; ++k) \
        acc[ai][bj][m][n] = __builtin_amdgcn_mfma_f32_16x16x32_bf16(Bt[n][k], At[m][k], acc[ai][bj][m][n], 0, 0, 0); __builtin_amdgcn_s_setprio(0); } while (0)
#define PG8_WAIT_V(n) asm volatile("s_waitcnt vmcnt(" #n ")" ::: "memory")
#define PG8_WAIT_L(n) asm volatile("s_waitcnt lgkmcnt(" #n ")" ::: "memory")
#define PG8_BAR __builtin_amdgcn_s_barrier()
#define PG8_SCHED __builtin_amdgcn_sched_barrier(0)
    Unit cur, nxt; int ui = 0;
    if (!S.next(0, cur)) return;
    f32x4 acc[2][2][4][2];
#pragma unroll
    for (int a = 0; a < 2; ++a)
#pragma unroll
        for (int b = 0; b < 2; ++b)
#pragma unroll
            for (int m = 0; m < 4; ++m)
#pragma unroll
                for (int n = 0; n < 2; ++n) acc[a][b][m][n] = (f32x4){0.f, 0.f, 0.f, 0.f};
    bf16x8 At[4][2], B0[2][2], B1[2][2];
    const char* cA = (const char*)g.A + (size_t)cur.pm * tstep; const char* cB = (const char*)g.Bt + (size_t)cur.pn * tstep;
    PG8_STAGE(PG8_SB(0, 0), cB, voffB); PG8_STAGE(PG8_SB(0, 1), cB + hstep, voffB); PG8_STAGE(PG8_SA(0, 0), cA, voffA); PG8_STAGE(PG8_SA(0, 1), cA + hstep, voffA);
    if (wr == 1) PG8_BAR;
    PG8_WAIT_V(2); PG8_BAR;
    PG8_STAGE(PG8_SB(1, 0), cB + kstep, voffB); PG8_STAGE(PG8_SA(1, 0), cA + kstep, voffA); PG8_STAGE(PG8_SB(1, 1), cB + hstep + kstep, voffB);
    PG8_WAIT_V(6); PG8_BAR;
    for (;;) {
        const bool has_next = S.next(ui + 1, nxt);
        const char* nA = has_next ? (const char*)g.A + (size_t)nxt.pm * tstep : cA; const char* nB = has_next ? (const char*)g.Bt + (size_t)nxt.pn * tstep : cB;
        for (int t = 0; t < nt; t += 2) {
            const bool last = (t == nt - 2);
            const char* a1 = cA + (size_t)(t + 1) * kstep;
            const char* a2 = last ? nA : cA + (size_t)(t + 2) * kstep; const char* b2 = last ? nB : cB + (size_t)(t + 2) * kstep;
            const char* a3 = a2 + kstep; const char* b3 = b2 + kstep;
            PG8_LDB(B0, 0, 0); PG8_LDB(B1, 0, 1); PG8_SCHED; PG8_LDA(At, 0, 0); PG8_STAGE(PG8_SA(1, 1), a1 + hstep, voffA);
            PG8_WAIT_V(8); PG8_WAIT_L(0); PG8_BAR; PG8_MMA(0, 0, At, B0); PG8_MMA(0, 1, At, B1); PG8_BAR; PG8_SCHED;
            PG8_LDA(At, 0, 1); PG8_STAGE(PG8_SB(0, 0), b2, voffB); PG8_STAGE(PG8_SB(0, 1), b2 + hstep, voffB); PG8_STAGE(PG8_SA(0, 0), a2, voffA);
            PG8_WAIT_V(8); PG8_WAIT_L(0); PG8_BAR; PG8_MMA(1, 0, At, B0); PG8_MMA(1, 1, At, B1); PG8_BAR; PG8_SCHED;
            PG8_LDB(B0, 1, 0); PG8_LDB(B1, 1, 1); PG8_SCHED; PG8_LDA(At, 1, 0); PG8_STAGE(PG8_SA(0, 1), a2 + hstep, voffA);
            PG8_WAIT_V(8); PG8_WAIT_L(0); PG8_BAR; PG8_MMA(0, 0, At, B0); PG8_MMA(0, 1, At, B1); PG8_BAR; PG8_SCHED;
            PG8_LDA(At, 1, 1); PG8_STAGE(PG8_SB(1, 0), b3, voffB); PG8_STAGE(PG8_SB(1, 1), b3 + hstep, voffB); PG8_STAGE(PG8_SA(1, 0), a3, voffA);
            PG8_WAIT_V(8); PG8_WAIT_L(0); PG8_BAR; PG8_MMA(1, 0, At, B0); PG8_MMA(1, 1, At, B1); PG8_BAR; PG8_SCHED;
        }
        if (wr == 0) PG8_BAR;
        E(acc, cur, wr, wc, fr, fq);
        if (!has_next) break;
#pragma unroll
        for (int a = 0; a < 2; ++a)
#pragma unroll
            for (int b = 0; b < 2; ++b)
#pragma unroll
                for (int m = 0; m < 4; ++m)
#pragma unroll
                    for (int n = 0; n < 2; ++n) acc[a][b][m][n] = (f32x4){0.f, 0.f, 0.f, 0.f};
        cur = nxt; cA = nA; cB = nB; ++ui;
        if (wr == 1) PG8_BAR;
    }
    PG8_WAIT_V(0);
    PG8_BAR;
#undef PG8_SA
#undef PG8_SB
#undef PG8_STAGE
#undef PG8_LDA
#undef PG8_LDB
#undef PG8_MMA
#undef PG8_WAIT_V
#undef PG8_WAIT_L
#undef PG8_BAR
#undef PG8_SCHED
}
}

constexpr int NWAVES = 8;
constexpr int N_PHASES = 11;
constexpr size_t MiB = 1u << 20;
constexpr size_t WS_CTL = 0, CTL_ZERO_BYTES = 32 * 1024;
constexpr size_t WS_WIN = 1 * MiB;
constexpr size_t WS_WOUT = 6 * MiB;
constexpr size_t WS_WQ = 8 * MiB;
constexpr size_t WS_KEYS = 12 * MiB;
constexpr size_t WS_RSU = 12 * MiB + 512 * 1024, WS_RSV = 12 * MiB + 768 * 1024;
constexpr size_t WS_RS2 = 12 * MiB + 896 * 1024;
constexpr size_t WS_IDX = 13 * MiB;
constexpr size_t WS_GATE = 21 * MiB;
constexpr size_t WS_SSQP = WS_GATE;
constexpr size_t WS_H = 29 * MiB;
constexpr size_t WS_MIX = 61 * MiB;
constexpr size_t WS_C = WS_MIX, WS_SSP = WS_MIX + 8 * MiB;
constexpr size_t WS_X2 = 165 * MiB - 32 * MiB;
constexpr size_t WS_QKV = 93 * MiB;
constexpr size_t WS_PD = WS_QKV;
constexpr size_t WS_U8 = 165 * MiB;
constexpr size_t WS_V8 = 181 * MiB;
constexpr size_t WS_END = 197 * MiB;
constexpr size_t TAB8_SLICE = (size_t)NEXP * 128;
constexpr int CW_BAR = 4096;
static_assert((CW_BAR + 3456) * 4 <= 32 * 1024, "barrier words inside the per-call memset");
constexpr int RING_BYTES = 147456;
constexpr int LDSCTL_OFF = RING_BYTES, MISC_OFF = LDSCTL_OFF + 320;
constexpr int LDS_BYTES = 155648;

#define RLX_AGENT __ATOMIC_RELAXED, __HIP_MEMORY_SCOPE_AGENT
#define LDS_WAIT() asm volatile("s_waitcnt lgkmcnt(0)" ::: "memory")
__device__ __forceinline__ unsigned f2bf(float f) { unsigned u = __builtin_bit_cast(unsigned, f); return (u + 0x7fffu + ((u >> 16) & 1u)) >> 16; }
__device__ __forceinline__ unsigned pk2(float lo, float hi) { return pg8::cvt_pk_bf16(lo, hi); }
__device__ __forceinline__ unsigned f_bits(float f) { return __builtin_bit_cast(unsigned, f); }
__device__ __forceinline__ float bits_f(unsigned u) { return __builtin_bit_cast(float, u); }
__device__ __forceinline__ float bf_lo(unsigned w) { return __builtin_bit_cast(float, w << 16); }
__device__ __forceinline__ float bf_hi(unsigned w) { return __builtin_bit_cast(float, w & 0xffff0000u); }

#define XB_TMO      128
#define XB_XCNT(j)  (256  + 64 * (j))
#define XB_XSUB(j)  (1280 + 64 * (j))
#define XB_XGEN(j)  (2304 + 64 * (j))
#define XB_TOP      3328
#define XB_TOPGEN   3392
#define XCD_BAR_WORDS 3456
#define XB_SPIN_CAP (1u << 18)
__device__ __forceinline__ unsigned xb_ld(unsigned* p)              { return __hip_atomic_load(p, __ATOMIC_RELAXED, __HIP_MEMORY_SCOPE_AGENT); }
__device__ __forceinline__ unsigned xb_add(unsigned* p, unsigned v) { return __hip_atomic_fetch_add(p, v, __ATOMIC_RELAXED, __HIP_MEMORY_SCOPE_AGENT); }
__device__ __forceinline__ unsigned xb_xcc_id() { return (unsigned)__builtin_amdgcn_s_getreg((3 << 11) | 20) & 0xFu; }
#define XB_SPIN(cond, bar) do { unsigned _sp = 0; while (cond) { __builtin_amdgcn_s_sleep(1); \
    if ((++_sp & 255u) == 0u) { if (xb_ld(&(bar)[XB_TMO])) break; if (_sp > XB_SPIN_CAP) { atomicAdd(&(bar)[XB_TMO], 1u); break; } } } } while (0)
struct XcdBarrier { unsigned* bar; unsigned x; volatile LAS unsigned* st; };
__device__ __forceinline__ XcdBarrier xcd_barrier_post(unsigned* bar, volatile LAS unsigned* st) {
    XcdBarrier b; b.bar = bar; b.x = xb_xcc_id(); b.st = st;
    if (threadIdx.x == 0) (void)xb_add(&bar[XB_XCNT(b.x)], 1u);
    return b;
}
__device__ __forceinline__ void xcd_barrier_complete(unsigned* bar, unsigned x, unsigned& nloc, unsigned& nx) {
    const unsigned G = gridDim.x * gridDim.y * gridDim.z;
    unsigned sum, cnt, mine, sp = 0u;
    for (;;) {
        sum = 0u; cnt = 0u; mine = 0u;
#pragma unroll
        for (unsigned j = 0; j < 16; ++j) { const unsigned c = xb_ld(&bar[XB_XCNT(j)]); sum += c; cnt += (c > 0u) ? 1u : 0u; mine = (j == x) ? c : mine; }
        if (sum == G) break;
        __builtin_amdgcn_s_sleep(1);
        if ((++sp & 255u) == 0u) { if (xb_ld(&bar[XB_TMO])) break; if (sp > XB_SPIN_CAP) { atomicAdd(&bar[XB_TMO], 1u); break; } }
    }
    nloc = mine > 0u ? mine : 1u; nx = cnt > 0u ? cnt : 1u;
}
__device__ __forceinline__ void xcd_barrier(const XcdBarrier& b) {
    asm volatile("s_waitcnt vmcnt(0)" ::: "memory");
    __syncthreads();
    if (threadIdx.x == 0) {
        unsigned* bar = b.bar;
        __builtin_amdgcn_s_waitcnt(0);
        unsigned nloc = b.st[0], nx = b.st[1];
        if (nloc == 0u) { xcd_barrier_complete(bar, b.x, nloc, nx); b.st[0] = nloc; b.st[1] = nx; }
        const unsigned old = xb_add(&bar[XB_XSUB(b.x)], 1u);
        const unsigned gen = old / nloc;
        if (old + 1u == (gen + 1u) * nloc) {
            __builtin_amdgcn_fence(__ATOMIC_RELEASE, "agent");
            asm volatile("s_waitcnt vmcnt(0)" ::: "memory");
            const unsigned og = xb_add(&bar[XB_TOP], 1u);
            const unsigned tg = og / nx;
            if (og + 1u == (tg + 1u) * nx) xb_add(&bar[XB_TOPGEN], 1u);
            else XB_SPIN(xb_ld(&bar[XB_TOPGEN]) == tg, bar);
            __builtin_amdgcn_fence(__ATOMIC_ACQUIRE, "agent");
            xb_add(&bar[XB_XGEN(b.x)], 1u);
            asm volatile("s_waitcnt vmcnt(0)" ::: "memory");
        } else {
            XB_SPIN(xb_ld(&bar[XB_XGEN(b.x)]) == gen, bar);
            __builtin_amdgcn_fence(__ATOMIC_ACQUIRE, "agent");
            asm volatile("s_waitcnt vmcnt(0)" ::: "memory");
        }
    }
    __syncthreads();
}

struct Frame {
    LAS unsigned char* lds;
    volatile LAS unsigned* MISC;
    gu32* ctl;
    int tid, lane, wave;
    int vcu, G;
    const float *x, *g1, *w_in, *sb_g, *sw_g, *sinks, *w_out, *g2, *w_q, *keys1, *keys2, *pu, *pv, *gf;
    float* out;
    bf16 *Wt_in, *Wt_out, *Wt_q, *KEYS, *H, *MIX, *QKV;
    unsigned char *U8, *V8, *C8; float *RSU, *RSV, *SSP, *SSQP, *RS2, *CS; bf16 *PD, *X2;
    unsigned short* IDX; float* GATE;
};

__device__ __forceinline__ float wave_sum(float v) {
#pragma unroll
    for (int o = 1; o < 64; o <<= 1) v += __shfl_xor(v, o);
    return v;
}

__device__ __forceinline__ void p0_transpose_item(const float* W, int K, int N, bf16* WT, LAS float* scr, int item, int lane, const float* gk = nullptr) {
    const int nblk = N / 32, kb = item / nblk, nb = item % nblk, k0 = 64 * kb, n0 = 32 * nb;
#pragma unroll 8
    for (int i = 0; i < 32; ++i) { const int kk = 2 * i + (lane >> 5); const float gq = gk ? gk[k0 + kk] : 1.0f; scr[kk * 33 + (lane & 31)] = __builtin_nontemporal_load(W + (size_t)(k0 + kk) * N + n0 + (lane & 31)) * gq; }
    LDS_WAIT(); asm volatile("" ::: "memory");
    const int c = lane & 7;
#pragma unroll
    for (int j = 0; j < 4; ++j) { const int n = (lane >> 3) + 8 * j; const LAS float* s = scr + (8 * c) * 33 + n;
        u32x4 o; o.x = pk2(s[0 * 33], s[1 * 33]); o.y = pk2(s[2 * 33], s[3 * 33]); o.z = pk2(s[4 * 33], s[5 * 33]); o.w = pk2(s[6 * 33], s[7 * 33]);
        *(GAS u32x4*)(WT + (size_t)(n0 + n) * K + k0 + 8 * c) = o; }
    LDS_WAIT(); asm volatile("" ::: "memory");
}
template <int NR> __device__ __forceinline__ void rms_rows_to_bf16(const float* xbase, const float* g, bf16* obase, int m0, int mstride, int lane) {
    f32x4 v[NR][4];
#pragma unroll
    for (int i = 0; i < NR; ++i) { const int m = m0 + i * mstride; const GAS f32x4* xr = (const GAS f32x4*)(xbase + (size_t)(m < T ? m : m0) * D) + lane;
#pragma unroll
        for (int j = 0; j < 4; ++j) v[i][j] = __builtin_nontemporal_load(xr + 64 * j); }
    const GAS f32x4* gr = (const GAS f32x4*)g + lane;
    f32x4 gg[4];
#pragma unroll
    for (int j = 0; j < 4; ++j) gg[j] = gr[64 * j];
#pragma unroll
    for (int i = 0; i < NR; ++i) { const int m = m0 + i * mstride;
        float s = 0.f;
#pragma unroll
        for (int j = 0; j < 4; ++j) s += (v[i][j].x * v[i][j].x + v[i][j].y * v[i][j].y) + (v[i][j].z * v[i][j].z + v[i][j].w * v[i][j].w);
        const float rs = __builtin_amdgcn_rsqf(wave_sum(s) * (1.f / D) + EPS);
        if (m < T) { GAS u32x2* o8 = (GAS u32x2*)(obase + (size_t)m * D) + lane;
#pragma unroll
            for (int j = 0; j < 4; ++j) { u32x2 w; w.x = pk2(v[i][j].x * rs * gg[j].x, v[i][j].y * rs * gg[j].y); w.y = pk2(v[i][j].z * rs * gg[j].z, v[i][j].w * rs * gg[j].w); o8[64 * j] = w; } } }
}
__device__ __forceinline__ void cvt_array_bf16(const float* src, bf16* dst, size_t n8, int gtid, int gthreads) {
    for (size_t i = gtid; i < n8; i += gthreads) {
        const f32x4 a = __builtin_nontemporal_load((const GAS f32x4*)(src + i * 8)), b = __builtin_nontemporal_load((const GAS f32x4*)(src + i * 8 + 4));
        u32x4 o; o.x = pk2(a.x, a.y); o.y = pk2(a.z, a.w); o.z = pk2(b.x, b.y); o.w = pk2(b.z, b.w);
        *(GAS u32x4*)(dst + i * 8) = o;
    }
}
__device__ __forceinline__ void p0_prologue(Frame& F) {
    LAS float* scr = (LAS float*)(F.lds + F.wave * 16384);
    const int gw = F.vcu * NWAVES + F.wave, NGW = F.G * NWAVES;
    constexpr int I_IN = (D / 64) * (DIN / 32), I_OUT = (D / 64) * (D / 32), I_Q = (D / 64) * (DQ / 32);
    constexpr int NITEMS = I_IN + I_OUT + I_Q;
    for (int it = gw; it < NITEMS; it += NGW) {
        int r = it;
        if (r < I_IN) { p0_transpose_item(F.w_in, D, DIN, F.Wt_in, scr, r, F.lane); continue; } r -= I_IN;
        if (r < I_OUT) { p0_transpose_item(F.w_out, D, D, F.Wt_out, scr, r, F.lane); continue; } r -= I_OUT;
        p0_transpose_item(F.w_q, D, DQ, F.Wt_q, scr, r, F.lane, F.g2);
    }
    for (int m = gw; m < T; m += 4 * NGW) rms_rows_to_bf16<4>(F.x, F.g1, F.H, m, NGW, F.lane);
    const int gtid = F.vcu * NWAVES * 64 + F.tid, gthreads = F.G * NWAVES * 64;
    cvt_array_bf16(F.keys1, F.KEYS, (size_t)8 * 128 * 128 / 8, gtid, gthreads);
    cvt_array_bf16(F.keys2, F.KEYS + 8 * 128 * 128, (size_t)8 * 128 * 128 / 8, gtid, gthreads);
}

__device__ __forceinline__ int pack_i8(float a, float b, float c, float d) {
    const int qa = (int)__builtin_rintf(a), qb = (int)__builtin_rintf(b), qc = (int)__builtin_rintf(c), qd = (int)__builtin_rintf(d);
    return (qa & 0xff) | ((qb & 0xff) << 8) | ((qc & 0xff) << 16) | (qd << 24);
}
__device__ __forceinline__ float wave_max(float v) {
#pragma unroll
    for (int o = 1; o < 64; o <<= 1) v = __builtin_fmaxf(v, __shfl_xor(v, o));
    return v;
}
template <int NR> __device__ __forceinline__ void cvt_rows_fp8(Frame& F, int r0, int rstride, int rlimit, int lane) {
    f32x4 v[NR][4];
#pragma unroll
    for (int i = 0; i < NR; ++i) { int r = r0 + i * rstride; r = r < rlimit ? r : r0; const float* src = r < NEXP ? F.pu + (size_t)r * D : F.pv + (size_t)(r - NEXP) * D;
        const GAS f32x4* xr = (const GAS f32x4*)src + lane;
#pragma unroll
        for (int j = 0; j < 4; ++j) v[i][j] = __builtin_nontemporal_load(xr + 64 * j); }
    f32x4 g2v[4];
#pragma unroll
    for (int j = 0; j < 4; ++j) g2v[j] = ((const GAS f32x4*)F.g2)[lane + 64 * j];
#pragma unroll
    for (int i = 0; i < NR; ++i) { const int r = r0 + i * rstride;
        if (r < NEXP) {
#pragma unroll
            for (int j = 0; j < 4; ++j) v[i][j] = v[i][j] * g2v[j]; }
        float amax = 0.f;
#pragma unroll
        for (int j = 0; j < 4; ++j) amax = __builtin_fmaxf(amax, __builtin_fmaxf(__builtin_fmaxf(__builtin_fabsf(v[i][j].x), __builtin_fabsf(v[i][j].y)), __builtin_fmaxf(__builtin_fabsf(v[i][j].z), __builtin_fabsf(v[i][j].w))));
        amax = wave_max(amax);
        int k = 6 - ((int)((f_bits(amax) >> 23) & 0xffu) - 127);
        k = k > 100 ? 100 : (k < -100 ? -100 : k);
        const float sc = bits_f((unsigned)(k + 127) << 23), inv = bits_f((unsigned)(127 - k) << 23);
        if (r < rlimit) { const int e = r < NEXP ? r : r - NEXP; unsigned char* tab8 = r < NEXP ? F.U8 : F.V8; float* rs = r < NEXP ? F.RSU : F.RSV;
            const float sq = amax > 0.f ? 127.0f / amax : 0.f;
#pragma unroll
            for (int j = 0; j < 4; ++j) {
                const int w = pack_i8(v[i][j].x * sq, v[i][j].y * sq, v[i][j].z * sq, v[i][j].w * sq);
                const int s = 2 * j + (lane >> 5);
                *(GAS unsigned*)(tab8 + (size_t)s * TAB8_SLICE + (size_t)e * 128 + 4 * (lane & 31)) = (unsigned)w;
            }
            if (lane == 0) rs[e] = amax * (1.0f / 127.0f); } }
}
__device__ __forceinline__ int crow(int r, int hi) { return (r & 3) + 8 * (r >> 2) + 4 * hi; }
constexpr int VPITCH = 192;
constexpr int KPITCH = 144;
constexpr int ATT_K_OFF = 0, ATT_V_OFF = 32 * KPITCH, ATT_Q_OFF = 32 * KPITCH + 32 * VPITCH, ATT_WAVE_BYTES = 64 * KPITCH + 32 * VPITCH;
struct Tile4 { u32x4 a, b, c, d; };
__device__ __forceinline__ Tile4 tile_load(const bf16* t0, int lane) {
    const bf16* p = t0 + (size_t)(lane >> 3) * DIN + 8 * (lane & 7);
    Tile4 t; t.a = *(const GAS u32x4*)p; t.b = *(const GAS u32x4*)(p + (size_t)8 * DIN); t.c = *(const GAS u32x4*)(p + (size_t)16 * DIN); t.d = *(const GAS u32x4*)(p + (size_t)24 * DIN); return t;
}
__device__ __forceinline__ void tile_store(LAS unsigned char* dst, int pitch, const Tile4& t, int lane) {
    LAS unsigned char* p = dst + (lane >> 3) * pitch + 16 * (lane & 7);
    *(LAS u32x4*)p = t.a; *(LAS u32x4*)(p + 8 * pitch) = t.b; *(LAS u32x4*)(p + 16 * pitch) = t.c; *(LAS u32x4*)(p + 24 * pitch) = t.d;
}
__device__ __forceinline__ bf16x8 kfrag(const LAS unsigned char* kt, int d0, int lane) { const u32x4 w = *(const LAS u32x4*)(kt + (lane & 31) * KPITCH + 32 * d0 + 16 * (lane >> 5)); return __builtin_bit_cast(bf16x8, w); }
__device__ __forceinline__ bf16x8 vfrag(const LAS unsigned char* wl, int dblk, int s, int lane) {
    const int hi = lane >> 5, i = lane & 15, g1 = (lane >> 4) & 1;
    const LAS unsigned char* p = wl + (16 * s + 4 * hi + (i >> 2)) * VPITCH + (32 * dblk + 16 * g1 + 4 * (i & 3)) * 2;
    const v4i16_t lo = __builtin_amdgcn_ds_read_tr16_b64_v4i16((LAS v4i16_t*)p);
    const v4i16_t hh = __builtin_amdgcn_ds_read_tr16_b64_v4i16((LAS v4i16_t*)(p + 8 * VPITCH));
    return (bf16x8){lo[0], lo[1], lo[2], lo[3], hh[0], hh[1], hh[2], hh[3]};
}
__device__ __forceinline__ bf16x8 pack8(const f32x16& a, int s) {
    u32x4 w; w.x = pk2(a[8 * s + 0], a[8 * s + 1]); w.y = pk2(a[8 * s + 2], a[8 * s + 3]); w.z = pk2(a[8 * s + 4], a[8 * s + 5]); w.w = pk2(a[8 * s + 6], a[8 * s + 7]);
    return __builtin_bit_cast(bf16x8, w);
}
__device__ __forceinline__ void head_norm_store(const f32x16& o0, const f32x16& o1, float scale, const float* g, bf16* dstrow, int hi) {
    float ss = 0.f;
#pragma unroll
    for (int r = 0; r < 16; ++r) { const float a = o0[r] * scale, b = o1[r] * scale; ss += a * a + b * b; }
    ss += __shfl_xor(ss, 32);
    const float rs = __builtin_amdgcn_rsqf(ss * (1.f / 64.f) + EPS) * scale;
#pragma unroll
    for (int dblk = 0; dblk < 2; ++dblk)
#pragma unroll
        for (int q4 = 0; q4 < 4; ++q4) { const int d0 = 32 * dblk + 8 * q4 + 4 * hi; const f32x4 gg = *(const GAS f32x4*)(g + d0);
            const f32x16& o = dblk ? o1 : o0;
            u32x2 w; w.x = pk2(o[4 * q4 + 0] * rs * gg.x, o[4 * q4 + 1] * rs * gg.y); w.y = pk2(o[4 * q4 + 2] * rs * gg.z, o[4 * q4 + 3] * rs * gg.w);
            *(GAS u32x2*)(dstrow + d0) = w; }
}

__device__ __forceinline__ void sb_item(Frame& F, int b, int h, int qb, LAS unsigned char* wl) {
    const int lane = F.lane, r32 = lane & 31, hi = lane >> 5;
    const size_t rowbase = (size_t)b * SEQ;
    const bf16* Qp = F.QKV + (rowbase + 32 * qb) * DIN + C_SBQ + h * 64;
    const bf16* Kb = F.QKV + rowbase * DIN + C_SBK + h * 64;
    const bf16* Vb = F.QKV + rowbase * DIN + C_SBV + h * 64;
    bf16x8 qr[4];
    { const Tile4 tq = tile_load(Qp, lane); tile_store(wl + ATT_K_OFF, KPITCH, tq, lane);
#pragma unroll
      for (int d0 = 0; d0 < 4; ++d0) qr[d0] = kfrag(wl + ATT_K_OFF, d0, lane); }
    bf16x8 tri[2];
#pragma unroll
    for (int s = 0; s < 2; ++s)
#pragma unroll
        for (int j = 0; j < 8; ++j) tri[s][j] = (16 * s + 8 * (j >> 2) + 4 * hi + (j & 3) >= r32) ? (short)0x3F80 : (short)0;
    f32x16 o0 = {}, o1 = {}; float C = 0.f;
    Tile4 tk = tile_load(Kb + (size_t)(32 * qb) * DIN, lane), tv = tile_load(Vb + (size_t)(32 * qb) * DIN, lane);
    for (int kt = qb; kt >= 0; --kt) {
        tile_store(wl + ATT_K_OFF, KPITCH, tk, lane); tile_store(wl + ATT_V_OFF, VPITCH, tv, lane);
        { const int kn = kt > 0 ? kt - 1 : 0; tk = tile_load(Kb + (size_t)(32 * kn) * DIN, lane); tv = tile_load(Vb + (size_t)(32 * kn) * DIN, lane); }
        bf16x8 kf[4];
#pragma unroll
        for (int d0 = 0; d0 < 4; ++d0) kf[d0] = kfrag(wl + ATT_K_OFF, d0, lane);
        f32x16 z = {};
#pragma unroll
        for (int d0 = 0; d0 < 4; ++d0) z = __builtin_amdgcn_mfma_f32_32x32x16_bf16(kf[d0], qr[d0], z, 0, 0, 0);
        const int lim = r32 + 32 * (qb - kt);
        f32x16 l, ls;
#pragma unroll
        for (int r = 0; r < 16; ++r) {
            const float zz = z[r] * 0.125f;
            const float e = __builtin_amdgcn_exp2f(-__builtin_fabsf(zz) * LOG2E);
            const float sp = __builtin_fmaxf(zz, 0.f) + LN2 * __builtin_amdgcn_logf(1.0f + e);
            const bool valid = crow(r, hi) < lim;
            l[r] = valid ? -sp : 0.f;
            ls[r] = zz - sp;
        }
        f32x16 lo;
        bf16x8 lh[2], ll[2];
#pragma unroll
        for (int s = 0; s < 2; ++s) {
            u32x4 wh, wlw;
#pragma unroll
            for (int p = 0; p < 4; ++p) { const float a = l[8 * s + 2 * p], c = l[8 * s + 2 * p + 1]; const unsigned w = pk2(a, c); wh[p] = w; lo[8 * s + 2 * p] = a - bf_lo(w); lo[8 * s + 2 * p + 1] = c - bf_hi(w); }
#pragma unroll
            for (int p = 0; p < 4; ++p) wlw[p] = pk2(lo[8 * s + 2 * p], lo[8 * s + 2 * p + 1]);
            lh[s] = __builtin_bit_cast(bf16x8, wh); ll[s] = __builtin_bit_cast(bf16x8, wlw);
        }
        f32x16 Y = {};
        Y = __builtin_amdgcn_mfma_f32_32x32x16_bf16(tri[0], lh[0], Y, 0, 0, 0);
        Y = __builtin_amdgcn_mfma_f32_32x32x16_bf16(tri[1], lh[1], Y, 0, 0, 0);
        Y = __builtin_amdgcn_mfma_f32_32x32x16_bf16(tri[0], ll[0], Y, 0, 0, 0);
        Y = __builtin_amdgcn_mfma_f32_32x32x16_bf16(tri[1], ll[1], Y, 0, 0, 0);
        f32x16 a;
#pragma unroll
        for (int r = 0; r < 16; ++r) {
            const bool valid = crow(r, hi) < lim;
            const float later = C + (Y[r] - l[r]);
            const float av = __builtin_amdgcn_exp2f((ls[r] + later) * LOG2E);
            a[r] = valid ? av : 0.f;
        }
        const float tot = __shfl(Y[0], r32);
        C += tot;
        const bf16x8 a0 = pack8(a, 0), a1 = pack8(a, 1);
        o0 = __builtin_amdgcn_mfma_f32_32x32x16_bf16(vfrag(wl + ATT_V_OFF, 0, 0, lane), a0, o0, 0, 0, 0);
        o0 = __builtin_amdgcn_mfma_f32_32x32x16_bf16(vfrag(wl + ATT_V_OFF, 0, 1, lane), a1, o0, 0, 0, 0);
        o1 = __builtin_amdgcn_mfma_f32_32x32x16_bf16(vfrag(wl + ATT_V_OFF, 1, 0, lane), a0, o1, 0, 0, 0);
        o1 = __builtin_amdgcn_mfma_f32_32x32x16_bf16(vfrag(wl + ATT_V_OFF, 1, 1, lane), a1, o1, 0, 0, 0);
        if (__all(C < SB_EXIT)) break;
    }
    head_norm_store(o0, o1, 1.0f, F.sb_g + h * 64, F.MIX + (rowbase + 32 * qb + r32) * D + h * 64, hi);
}

#define SWA_HEAD(z, qslope, m_, den_, oa, ob) do { \
        float tmax_ = -INFINITY; f32x16 s_; \
        _Pragma("unroll") for (int r = 0; r < 16; ++r) { const int dist = dq - ((r & 3) + 8 * (r >> 2)); const float sv = z[r] * 0.125f - qslope * (float)dist; s_[r] = ((unsigned)dist < 128u) ? sv : -INFINITY; tmax_ = __builtin_fmaxf(tmax_, s_[r]); } \
        tmax_ = __builtin_fmaxf(tmax_, __shfl_xor(tmax_, 32)); \
        const float mn_ = __builtin_fmaxf(m_, tmax_); const float al_ = __builtin_amdgcn_exp2f((m_ - mn_) * LOG2E); m_ = mn_; \
        f32x16 p_; float ps_ = 0.f; \
        _Pragma("unroll") for (int r = 0; r < 16; ++r) { p_[r] = __builtin_amdgcn_exp2f((s_[r] - mn_) * LOG2E); ps_ += p_[r]; } \
        den_ = den_ * al_ + ps_; \
        _Pragma("unroll") for (int r = 0; r < 16; ++r) { oa[r] *= al_; ob[r] *= al_; } \
        const bf16x8 a0_ = pack8(p_, 0), a1_ = pack8(p_, 1); \
        oa = __builtin_amdgcn_mfma_f32_32x32x16_bf16(vf00, a0_, oa, 0, 0, 0); oa = __builtin_amdgcn_mfma_f32_32x32x16_bf16(vf01, a1_, oa, 0, 0, 0); \
        ob = __builtin_amdgcn_mfma_f32_32x32x16_bf16(vf10, a0_, ob, 0, 0, 0); ob = __builtin_amdgcn_mfma_f32_32x32x16_bf16(vf11, a1_, ob, 0, 0, 0); } while (0)
__device__ __forceinline__ void swa_item2(Frame& F, int b, int kv, int hp, int qb, LAS unsigned char* wl) {
    const int lane = F.lane, r32 = lane & 31, hi = lane >> 5, hqA = kv * 4 + 2 * hp, hqB = hqA + 1;
    const size_t rowbase = (size_t)b * SEQ;
    const bf16* QpA = F.QKV + (rowbase + 32 * qb) * DIN + C_SWQ + hqA * 64;
    const bf16* Kb = F.QKV + rowbase * DIN + C_SWK + kv * 64;
    const bf16* Vb = F.QKV + rowbase * DIN + C_SWV + kv * 64;
    const float slopeA = __builtin_amdgcn_exp2f(-(float)(hqA + 1)), slopeB = __builtin_amdgcn_exp2f(-(float)(hqB + 1));
    float mA = F.sinks[hqA], mB = F.sinks[hqB];
    bf16x8 qrA[4];
    { const Tile4 tq = tile_load(QpA, lane); tile_store(wl + ATT_K_OFF, KPITCH, tq, lane);
#pragma unroll
      for (int d0 = 0; d0 < 4; ++d0) qrA[d0] = kfrag(wl + ATT_K_OFF, d0, lane); }
    { const Tile4 tq = tile_load(QpA + 64, lane); tile_store(wl + ATT_Q_OFF, KPITCH, tq, lane); }
    float denA = hi == 0 ? 1.f : 0.f, denB = denA;
    f32x16 oA0 = {}, oA1 = {}, oB0 = {}, oB1 = {};
    const int kt0 = qb - 4 < 0 ? 0 : qb - 4;
    for (int kt = kt0; kt <= qb; ++kt) {
        { const Tile4 tk = tile_load(Kb + (size_t)(32 * kt) * DIN, lane), tv = tile_load(Vb + (size_t)(32 * kt) * DIN, lane);
          tile_store(wl + ATT_K_OFF, KPITCH, tk, lane); tile_store(wl + ATT_V_OFF, VPITCH, tv, lane); }
        const bf16x8 vf00 = vfrag(wl + ATT_V_OFF, 0, 0, lane), vf01 = vfrag(wl + ATT_V_OFF, 0, 1, lane), vf10 = vfrag(wl + ATT_V_OFF, 1, 0, lane), vf11 = vfrag(wl + ATT_V_OFF, 1, 1, lane);
        const int dq = 32 * (qb - kt) + r32 - 4 * hi;
        { f32x16 zA = {};
#pragma unroll
          for (int d0 = 0; d0 < 4; ++d0) zA = __builtin_amdgcn_mfma_f32_32x32x16_bf16(kfrag(wl + ATT_K_OFF, d0, lane), qrA[d0], zA, 0, 0, 0);
          SWA_HEAD(zA, slopeA, mA, denA, oA0, oA1); }
        { f32x16 zB = {};
#pragma unroll
          for (int d0 = 0; d0 < 4; ++d0) zB = __builtin_amdgcn_mfma_f32_32x32x16_bf16(kfrag(wl + ATT_K_OFF, d0, lane), kfrag(wl + ATT_Q_OFF, d0, lane), zB, 0, 0, 0);
          SWA_HEAD(zB, slopeB, mB, denB, oB0, oB1); }
    }
    denA += __shfl_xor(denA, 32); denB += __shfl_xor(denB, 32);
    bf16* dst = F.MIX + (rowbase + 32 * qb + r32) * D + 512 + hqA * 64;
    head_norm_store(oA0, oA1, 1.0f / denA, F.sw_g + hqA * 64, dst, hi);
    head_norm_store(oB0, oB1, 1.0f / denB, F.sw_g + hqB * 64, dst + 64, hi);
}
__device__ __forceinline__ void p2_attention(Frame& F) {
    LAS unsigned char* wl = F.lds + F.wave * 16384;
    static_assert(ATT_WAVE_BYTES <= 16384 && NWAVES * 16384 <= RING_BYTES, "attention LDS");
    const int gw = F.vcu * NWAVES + F.wave, NGW = F.G * NWAVES;
    constexpr int NSB = NB * 8 * 128, NSW = NB * 4 * 128;
    for (int it = gw; it < NSB + NSW; it += NGW) {
        if (it < NSB) { const int qb = it & 127, h = (it >> 7) & 7, b = it >> 10; sb_item(F, b, h, qb, wl); }
        else { const int r = it - NSB; const int qb = r & 127, hp = (r >> 7) & 1, kv = (r >> 8) & 1, b = r >> 9; swa_item2(F, b, kv, hp, qb, wl); }
    }
}

__device__ __forceinline__ int f2ord(unsigned bits) { int x = (int)bits; return x ^ ((x >> 31) & 0x7fffffff); }
template <int N> __device__ __forceinline__ void bitonic_desc(int (&v)[N]) {
#pragma unroll
    for (int k = 2; k <= N; k <<= 1) {
#pragma unroll
        for (int j = k >> 1; j > 0; j >>= 1) {
#pragma unroll
            for (int i = 0; i < N; ++i) {
                const int l = i ^ j;
                if (l > i) { const bool up = ((i & k) == 0); const int a = v[i], b = v[l]; const int mx = a > b ? a : b, mn = a > b ? b : a; v[i] = up ? mx : mn; v[l] = up ? mn : mx; }
            }
        }
    }
}
template <int N> __device__ __forceinline__ void bitonic_merge_desc(int (&v)[N]) {
#pragma unroll
    for (int j = N >> 1; j > 0; j >>= 1) {
#pragma unroll
        for (int i = 0; i < N; ++i) { const int l = i ^ j; if (l > i) { const int a = v[i], b = v[l]; v[i] = a > b ? a : b; v[l] = a > b ? b : a; } }
    }
}
template <int N> __device__ __forceinline__ void bitonic_desc_kv(int (&k)[N], int (&p)[N]) {
#pragma unroll
    for (int kk = 2; kk <= N; kk <<= 1) {
#pragma unroll
        for (int j = kk >> 1; j > 0; j >>= 1) {
#pragma unroll
            for (int i = 0; i < N; ++i) {
                const int l = i ^ j;
                if (l > i) { const bool up = ((i & kk) == 0); const bool sw = up ? (k[i] < k[l]) : (k[i] > k[l]);
                    const int ka = k[i], kb = k[l], pa = p[i], pb = p[l]; k[i] = sw ? kb : ka; k[l] = sw ? ka : kb; p[i] = sw ? pb : pa; p[l] = sw ? pa : pb; }
            }
        }
    }
}
struct Cand { unsigned char i, j; };
struct CandTable { Cand c[64]; int n; };
constexpr CandTable make_cands() { CandTable t{}; int n = 0; for (int i = 0; i < 16; ++i) for (int j = 0; j < 16; ++j) if ((i + 1) * (j + 1) <= 16) { t.c[n].i = (unsigned char)i; t.c[n].j = (unsigned char)j; ++n; } t.n = n; return t; }
constexpr CandTable CANDS = make_cands();
static_assert(CANDS.n == 50, "candidate count");

constexpr int P6_PITCH = 272, P6_KEYS_BYTES = 128 * P6_PITCH, P6_Q_BYTES = 32 * P6_PITCH;
static_assert(2 * P6_KEYS_BYTES + NWAVES * P6_Q_BYTES <= RING_BYTES, "P6 LDS map");
__device__ __forceinline__ void p6_item(Frame& F, int tb, int h, LAS unsigned char* keys_lds, LAS unsigned char* qw) {
    const int lane = F.lane, r32 = lane & 31, hi = lane >> 5;
    const bf16* QP = F.QKV;
    int top0[16], top1[16];
#pragma unroll 1
    for (int half = 0; half < 2; ++half) {
        { const bf16* qsrc = QP + (size_t)(32 * tb + (lane >> 4)) * DQ + h * 256 + half * 128 + 8 * (lane & 15);
          u32x4 t_[8];
#pragma unroll
          for (int i = 0; i < 8; ++i) t_[i] = *(const GAS u32x4*)(qsrc + (size_t)(4 * i) * DQ);
#pragma unroll
          for (int i = 0; i < 8; ++i) *(LAS u32x4*)(qw + (4 * i + (lane >> 4)) * P6_PITCH + 16 * (lane & 15)) = t_[i]; }
        bf16x8 qf[8];
#pragma unroll
        for (int ks = 0; ks < 8; ++ks) { const u32x4 w_ = *(const LAS u32x4*)(qw + r32 * P6_PITCH + 32 * ks + 16 * hi); qf[ks] = __builtin_bit_cast(bf16x8, w_); }
        const LAS unsigned char* kb = keys_lds + half * P6_KEYS_BYTES + r32 * P6_PITCH + 16 * hi;
        int v[64];
#pragma unroll
        for (int nt = 0; nt < 4; ++nt) {
            f32x16 acc = {};
#pragma unroll
            for (int ks = 0; ks < 8; ++ks) { const u32x4 w_ = *(const LAS u32x4*)(kb + (32 * nt) * P6_PITCH + 32 * ks); acc = __builtin_amdgcn_mfma_f32_32x32x16_bf16(__builtin_bit_cast(bf16x8, w_), qf[ks], acc, 0, 0, 0); }
#pragma unroll
            for (int r = 0; r < 16; ++r) { const float av = acc[r]; const unsigned bits = (f_bits(av) & ~0x7Fu) | (unsigned)(32 * nt + crow(r, hi)); v[16 * nt + r] = f2ord(bits); }
        }
        bitonic_desc<64>(v);
        int m[16];
#pragma unroll
        for (int i = 0; i < 16; ++i) { const int o = __shfl_xor(v[15 - i], 32); m[i] = v[i] > o ? v[i] : o; }
        bitonic_merge_desc<16>(m);
#pragma unroll
        for (int i = 0; i < 16; ++i) { if (half == 0) top0[i] = m[i]; else top1[i] = m[i]; }
    }
    float f1[16], f2[16]; int i1[16], i2[16];
#pragma unroll
    for (int i = 0; i < 16; ++i) { const unsigned b1 = (unsigned)f2ord((unsigned)top0[i]), b2 = (unsigned)f2ord((unsigned)top1[i]);
        f1[i] = bits_f(b1 & ~0x7Fu); i1[i] = (int)(b1 & 0x7Fu); f2[i] = bits_f(b2 & ~0x7Fu); i2[i] = (int)(b2 & 0x7Fu); }
    int ck[32], cp[32];
#pragma unroll
    for (int s = 0; s < 32; ++s) {
        if (s < 25) { constexpr int dummy = 0; (void)dummy;
            const int ia = CANDS.c[2 * s].i, ja = CANDS.c[2 * s].j, ib = CANDS.c[2 * s + 1].i, jb = CANDS.c[2 * s + 1].j;
            const float sa = f1[ia] + f2[ja], sb = f1[ib] + f2[jb]; const int pa = (i1[ia] << 7) | i2[ja], pb = (i1[ib] << 7) | i2[jb];
            ck[s] = f2ord(f_bits(hi ? sb : sa)); cp[s] = hi ? pb : pa;
        } else { ck[s] = (int)0x80000000; cp[s] = 0; }
    }
    bitonic_desc_kv<32>(ck, cp);
    int wk[16], wp[16];
#pragma unroll
    for (int i = 0; i < 16; ++i) { const int ok = __shfl_xor(ck[15 - i], 32), op = __shfl_xor(cp[15 - i], 32); const bool t = ck[i] >= ok; wk[i] = t ? ck[i] : ok; wp[i] = t ? cp[i] : op; }
    float vals[16]; float mxv = -INFINITY;
#pragma unroll
    for (int i = 0; i < 16; ++i) { vals[i] = bits_f((unsigned)f2ord((unsigned)wk[i])); mxv = __builtin_fmaxf(mxv, vals[i]); }
    float se = 0.f;
#pragma unroll
    for (int i = 0; i < 16; ++i) { vals[i] = __builtin_amdgcn_exp2f((vals[i] - mxv) * LOG2E); se += vals[i]; }
    const float inv = 1.0f / se;
    const size_t ob = (size_t)(32 * tb + r32) * 128 + h * 16 + hi * 8;
    { u32x4 a; a.x = (unsigned)wp[0] | ((unsigned)wp[1] << 16); a.y = (unsigned)wp[2] | ((unsigned)wp[3] << 16); a.z = (unsigned)wp[4] | ((unsigned)wp[5] << 16); a.w = (unsigned)wp[6] | ((unsigned)wp[7] << 16);
      *(GAS u32x4*)(F.IDX + ob) = a;
      f32x4 ga = {vals[0] * inv, vals[1] * inv, vals[2] * inv, vals[3] * inv}, gb = {vals[4] * inv, vals[5] * inv, vals[6] * inv, vals[7] * inv};
      *(GAS f32x4*)(F.GATE + ob) = ga; *(GAS f32x4*)(F.GATE + ob + 4) = gb; }
}
template <class Sched> __device__ __forceinline__ void p6_topk_own(Frame& F, const Sched& S) {
    LAS unsigned char* keys_lds = F.lds; LAS unsigned char* qw = F.lds + 2 * P6_KEYS_BYTES + F.wave * P6_Q_BYTES;
    pg8::Unit u; int hprev = -1;
    for (int i = 0; S.next(i, u); ++i) {
        const int h = u.pn;
        if (h != hprev) {
            __syncthreads();
#pragma unroll
            for (int half = 0; half < 2; ++half) {
                const bf16* ksrc = F.KEYS + (size_t)(half * 8 + h) * 128 * 128 + (size_t)(F.tid >> 4) * 128 + 8 * (F.tid & 15);
                u32x4 t_[4];
#pragma unroll
                for (int q = 0; q < 4; ++q) t_[q] = *(const GAS u32x4*)(ksrc + (size_t)(32 * q) * 128);
#pragma unroll
                for (int q = 0; q < 4; ++q) *(LAS u32x4*)(keys_lds + half * P6_KEYS_BYTES + ((F.tid >> 4) + 32 * q) * P6_PITCH + 16 * (F.tid & 15)) = t_[q];
            }
            __syncthreads(); hprev = h;
        }
        p6_item(F, 8 * u.pm + F.wave, h, keys_lds, qw);
    }
    { const int gw_ = F.vcu * NWAVES + F.wave, NGW_ = F.G * NWAVES; for (int r = NEXP + gw_; r < 2 * NEXP; r += 4 * NGW_) cvt_rows_fp8<4>(F, r, NGW_, 2 * NEXP, F.lane); }
    __syncthreads();
}

__device__ __forceinline__ float dpp_xor1(float v) { return v + bits_f((unsigned)__builtin_amdgcn_update_dpp(0, (int)f_bits(v), 0xB1, 0xf, 0xf, false)); }
__device__ __forceinline__ float dpp_xor2(float v) { return v + bits_f((unsigned)__builtin_amdgcn_update_dpp(0, (int)f_bits(v), 0x4E, 0xf, 0xf, false)); }
__device__ __forceinline__ float dpp_hmir(float v) { return v + bits_f((unsigned)__builtin_amdgcn_update_dpp(0, (int)f_bits(v), 0x141, 0xf, 0xf, false)); }
__device__ __forceinline__ float dpp_max_xor1(float v) { return __builtin_fmaxf(v, bits_f((unsigned)__builtin_amdgcn_update_dpp(0, (int)f_bits(v), 0xB1, 0xf, 0xf, false))); }
__device__ __forceinline__ float dpp_max_xor2(float v) { return __builtin_fmaxf(v, bits_f((unsigned)__builtin_amdgcn_update_dpp(0, (int)f_bits(v), 0x4E, 0xf, 0xf, false))); }
__device__ __forceinline__ float dpp_max_hmir(float v) { return __builtin_fmaxf(v, bits_f((unsigned)__builtin_amdgcn_update_dpp(0, (int)f_bits(v), 0x141, 0xf, 0xf, false))); }
__device__ __forceinline__ f32x2_t fp8x2(unsigned w, bool hi) { return hi ? __builtin_amdgcn_cvt_pk_f32_fp8((int)w, true) : __builtin_amdgcn_cvt_pk_f32_fp8((int)w, false); }
__device__ __forceinline__ float gelu_tanh(float x) {
    const float y2 = 1.5957691216057308f * (x + 0.044715f * x * x * x);
    return x / (1.0f + __builtin_amdgcn_exp2f(-y2 * LOG2E));
}
__device__ __forceinline__ unsigned vsel16(const u32x4 (&v)[2], int k) { const u32x4 q = v[k >> 3]; const int j = (k >> 1) & 3; const unsigned w = j == 0 ? q.x : j == 1 ? q.y : j == 2 ? q.z : q.w; return (k & 1) ? (w >> 16) : (w & 0xffffu); }
struct TokIn { u32x4 id[2]; u32x4 x0, x1; };
__device__ __forceinline__ int vsel(const u32x4 (&v)[4], int k) { const u32x4 q = v[k >> 2]; const int j = k & 3; return (int)(j == 0 ? q.x : j == 1 ? q.y : j == 2 ? q.z : q.w); }
__device__ __forceinline__ void p7_udots(Frame& F) {
    const int lane = F.lane, g = lane >> 3, c = lane & 7;
    const int s = blockIdx.x & 7, rank = blockIdx.x >> 3, nloc = F.G >> 3;
    const unsigned char* tab = F.U8 + (size_t)s * TAB8_SLICE; const unsigned coff16 = 16u * (unsigned)c;
    bf16* pd = F.PD + (size_t)s * T * 128;
    const int t0 = rank * NWAVES + F.wave, tstride = nloc * NWAVES;
#define P7_IDS(dst, tt) do { const int t_ = (tt) < T ? (tt) : t0; const GAS u32x4* ip_ = (const GAS u32x4*)(F.IDX + (size_t)t_ * 128 + 16 * g); dst.id[0] = ip_[0]; dst.id[1] = ip_[1]; } while (0)
#define P7_X(dst, tt) do { const int t_ = (tt) < T ? (tt) : t0; const bf16* xr_ = F.H + (size_t)t_ * D + 128 * s + 16 * c; dst.x0 = *(const GAS u32x4*)xr_; dst.x1 = *(const GAS u32x4*)(xr_ + 8); } while (0)
#define P7_PCS(pc, in) do { _Pragma("unroll") for (int k = 0; k < 16; ++k) pc[k] = *(const GAS u32x4*)(tab + ((vsel16(in.id, k) << 7) | coff16)); } while (0)
#define P7_MATH(pc, in, tt) do { if ((tt) < T) { \
        float xv[16]; { const unsigned a0 = in.x0.x, a1 = in.x0.y, a2 = in.x0.z, a3 = in.x0.w, b0 = in.x1.x, b1 = in.x1.y, b2 = in.x1.z, b3 = in.x1.w; \
          xv[0] = bf_lo(a0); xv[1] = bf_hi(a0); xv[2] = bf_lo(a1); xv[3] = bf_hi(a1); xv[4] = bf_lo(a2); xv[5] = bf_hi(a2); xv[6] = bf_lo(a3); xv[7] = bf_hi(a3); \
          xv[8] = bf_lo(b0); xv[9] = bf_hi(b0); xv[10] = bf_lo(b1); xv[11] = bf_hi(b1); xv[12] = bf_lo(b2); xv[13] = bf_hi(b2); xv[14] = bf_lo(b3); xv[15] = bf_hi(b3); } \
          \
        float xm = 0.f; _Pragma("unroll") for (int i = 0; i < 16; ++i) xm = __builtin_fmaxf(xm, __builtin_fabsf(xv[i])); \
        xm = dpp_max_hmir(dpp_max_xor2(dpp_max_xor1(xm))); \
        const float sx = xm > 0.f ? 127.0f / xm : 0.f, isx = xm * (1.0f / 127.0f); \
        const int xq0 = pack_i8(xv[0] * sx, xv[1] * sx, xv[2] * sx, xv[3] * sx), xq1 = pack_i8(xv[4] * sx, xv[5] * sx, xv[6] * sx, xv[7] * sx), \
                  xq2 = pack_i8(xv[8] * sx, xv[9] * sx, xv[10] * sx, xv[11] * sx), xq3 = pack_i8(xv[12] * sx, xv[13] * sx, xv[14] * sx, xv[15] * sx); \
        float r0 = 0.f, r1 = 0.f; \
        _Pragma("unroll") for (int k = 0; k < 16; ++k) { \
            const unsigned w0 = pc[k].x, w1 = pc[k].y, w2 = pc[k].z, w3 = pc[k].w; \
            int ia = __builtin_amdgcn_sdot4((int)w0, xq0, 0, false); ia = __builtin_amdgcn_sdot4((int)w1, xq1, ia, false); ia = __builtin_amdgcn_sdot4((int)w2, xq2, ia, false); ia = __builtin_amdgcn_sdot4((int)w3, xq3, ia, false); \
            float p = (float)ia; p = dpp_hmir(dpp_xor2(dpp_xor1(p))); \
            if (k < 8) r0 = (c == k) ? p : r0; else r1 = (c == (k - 8)) ? p : r1; } \
        r0 *= isx; r1 *= isx; \
        pd[(size_t)(tt) * 128 + 16 * g + c] = (bf16)(pk2(r0, r0) & 0xffffu); pd[(size_t)(tt) * 128 + 16 * g + 8 + c] = (bf16)(pk2(r1, r1) & 0xffffu); } } while (0)
    TokIn inA, inB, inC, inN; u32x4 pcA[16], pcB[16], pcC[16];
    P7_IDS(inA, t0); P7_X(inA, t0); P7_PCS(pcA, inA); P7_IDS(inB, t0 + tstride); P7_X(inB, t0 + tstride); P7_PCS(pcB, inB); P7_IDS(inC, t0 + 2 * tstride);
    for (int t = t0; t < T; t += 3 * tstride) {
        P7_X(inC, t + 2 * tstride); P7_PCS(pcC, inC); P7_IDS(inN, t + 3 * tstride); __builtin_amdgcn_sched_barrier(0);
        P7_MATH(pcA, inA, t); __builtin_amdgcn_sched_barrier(0);
        inA.id[0] = inN.id[0]; inA.id[1] = inN.id[1];
        P7_X(inA, t + 3 * tstride); P7_PCS(pcA, inA); P7_IDS(inN, t + 4 * tstride); __builtin_amdgcn_sched_barrier(0);
        P7_MATH(pcB, inB, t + tstride); __builtin_amdgcn_sched_barrier(0);
        inB.id[0] = inN.id[0]; inB.id[1] = inN.id[1];
        P7_X(inB, t + 4 * tstride); P7_PCS(pcB, inB); P7_IDS(inN, t + 5 * tstride); __builtin_amdgcn_sched_barrier(0);
        P7_MATH(pcC, inC, t + 2 * tstride); __builtin_amdgcn_sched_barrier(0);
        inC.id[0] = inN.id[0]; inC.id[1] = inN.id[1];
    }
#undef P7_IDS
#undef P7_X
#undef P7_PCS
#undef P7_MATH
}
__device__ __forceinline__ void p8_combine(Frame& F) {
    const int gw = F.vcu * NWAVES + F.wave, NGW = F.G * NWAVES, lane = F.lane;
    constexpr int NU = 4;
    for (int t0 = gw; t0 < T; t0 += NU * NGW) {
        unsigned pdw[NU][8], idw[NU]; f32x2_t gt[NU];
#pragma unroll
        for (int u = 0; u < NU; ++u) { const int t = t0 + u * NGW < T ? t0 + u * NGW : t0; const size_t o = (size_t)t * 128 + 2 * lane;
#pragma unroll
            for (int s = 0; s < 8; ++s) pdw[u][s] = __builtin_nontemporal_load((const GAS unsigned*)(F.PD + (size_t)s * T * 128 + o));
            idw[u] = *(const GAS unsigned*)(F.IDX + o); gt[u] = __builtin_nontemporal_load((const GAS f32x2_t*)(F.GATE + o)); }
        float ru0[NU], ru1[NU], rv0[NU], rv1[NU], r2[NU];
#pragma unroll
        for (int u = 0; u < NU; ++u) { const int t = t0 + u * NGW < T ? t0 + u * NGW : t0; const int i0 = (int)(idw[u] & 0xffffu), i1 = (int)(idw[u] >> 16);
            ru0[u] = F.RSU[i0]; ru1[u] = F.RSU[i1]; rv0[u] = F.RSV[i0]; rv1[u] = F.RSV[i1]; r2[u] = F.RS2[t]; }
#pragma unroll
        for (int u = 0; u < NU; ++u) { const int t = t0 + u * NGW;
            float d0 = 0.f, d1 = 0.f;
#pragma unroll
            for (int s = 0; s < 8; ++s) { const unsigned w = pdw[u][s]; d0 += bf_lo(w); d1 += bf_hi(w); }
            const float c0 = gt[u].x * gelu_tanh(d0 * ru0[u] * r2[u]) * rv0[u], c1 = gt[u].y * gelu_tanh(d1 * ru1[u] * r2[u]) * rv1[u];
            const float m = wave_max(__builtin_fmaxf(__builtin_fabsf(c0), __builtin_fabsf(c1)));
            const float sq = m > 0.f ? 127.0f / m : 0.f;
            const int q0 = (int)__builtin_rintf(c0 * sq), q1 = (int)__builtin_rintf(c1 * sq);
            if (t < T) { *(GAS unsigned short*)(F.C8 + (size_t)t * 128 + 2 * lane) = (unsigned short)((q0 & 0xff) | ((q1 & 0xff) << 8)); if (lane == 0) F.CS[t] = m * (1.0f / 127.0f); } }
    }
}
typedef int v2i_t __attribute__((ext_vector_type(2)));
typedef int v4i_t __attribute__((ext_vector_type(4)));
constexpr int P9_PITCH = 144, P9_WAVE_BYTES = 128 * P9_PITCH, P9_OSC_OFF = LDSCTL_OFF + 512;
static_assert(NWAVES * P9_WAVE_BYTES <= RING_BYTES && P9_OSC_OFF + NWAVES * 512 <= LDS_BYTES, "P9 LDS map");
struct TokInV { u32x4 id[2]; u32x4 a0, a1; u32x2 xb; float cs; };
__device__ __forceinline__ void p9_vacc(Frame& F) {
    const int lane = F.lane, g = lane >> 3, c = lane & 7, m16 = lane & 15, q = lane >> 4;
    const int s = blockIdx.x & 7, rank = blockIdx.x >> 3, nloc = F.G >> 3;
    const unsigned char* tab = F.V8 + (size_t)s * TAB8_SLICE; const unsigned coff16 = 16u * (unsigned)c;
    const int t0 = rank * NWAVES + F.wave, tstride = nloc * NWAVES;
    LAS unsigned char* wl = F.lds + F.wave * P9_WAVE_BYTES;
    LAS float* osc = (LAS float*)(F.lds + P9_OSC_OFF + F.wave * 512);
    LAS unsigned char* wst = wl + (16 * g) * P9_PITCH + 16 * c;
    const LAS unsigned char* wrd = wl + (16 * q + (m16 >> 1)) * P9_PITCH + 8 * (m16 & 1);
    const int coff = 128 * s + 4 * (lane & 31);
#define P9_IN(dst, tt) do { const int t_ = (tt) < T ? (tt) : t0; const GAS u32x4* ip_ = (const GAS u32x4*)(F.IDX + (size_t)t_ * 128 + 16 * g); dst.id[0] = ip_[0]; dst.id[1] = ip_[1]; \
        const GAS u32x4* cp_ = (const GAS u32x4*)(F.C8 + (size_t)t_ * 128 + 16 * q); const u32x4 z_ = {0u, 0u, 0u, 0u}; dst.a0 = cp_[0]; dst.a1 = cp_[4]; if (m16 != 0) { dst.a0 = z_; dst.a1 = z_; } \
        dst.xb = *(const GAS u32x2*)(F.H + (size_t)t_ * D + coff); dst.cs = F.CS[t_]; } while (0)
#define P9_PCS(pc, in) do { _Pragma("unroll") for (int k = 0; k < 16; ++k) pc[k] = *(const GAS u32x4*)(tab + ((vsel16(in.id, k) << 7) | coff16)); } while (0)
#define P9_STAGE(pc) do { _Pragma("unroll") for (int k = 0; k < 16; ++k) *(LAS u32x4*)(wst + k * P9_PITCH) = pc[k]; } while (0)
#define P9_MATH(in, tt) do { if ((tt) < T) { \
        v4i_t acc[8]; _Pragma("unroll") for (int nb = 0; nb < 8; ++nb) acc[nb] = (v4i_t){0, 0, 0, 0}; \
        _Pragma("unroll") for (int s2 = 0; s2 < 2; ++s2) { const v4i_t av = __builtin_bit_cast(v4i_t, s2 ? in.a1 : in.a0); \
            _Pragma("unroll") for (int nb = 0; nb < 8; ++nb) { \
                const v2i_t lo = __builtin_amdgcn_ds_read_tr8_b64_v2i32((LAS v2i_t*)(wrd + (64 * s2) * P9_PITCH + 16 * nb)); \
                const v2i_t hi = __builtin_amdgcn_ds_read_tr8_b64_v2i32((LAS v2i_t*)(wrd + (64 * s2 + 8) * P9_PITCH + 16 * nb)); \
                const v4i_t bv = {lo.x, lo.y, hi.x, hi.y}; \
                acc[nb] = __builtin_amdgcn_mfma_i32_16x16x64_i8(av, bv, acc[nb], 0, 0, 0); } } \
          \
        if (lane < 16) { _Pragma("unroll") for (int nb = 0; nb < 8; ++nb) osc[16 * nb + lane] = (float)acc[nb][0] * in.cs; } \
        asm volatile("" ::: "memory"); \
        float ss = 0.f; \
        if (lane < 32) { const f32x4 d_ = *(const LAS f32x4*)(osc + 4 * lane); bf16* op_ = F.X2 + (size_t)(tt) * D + coff; const unsigned xb0_ = in.xb.x, xb1_ = in.xb.y; \
            const f32x4 y = {bf_lo(xb0_) + d_[0], bf_hi(xb0_) + d_[1], bf_lo(xb1_) + d_[2], bf_hi(xb1_) + d_[3]}; \
            ss = (y.x * y.x + y.y * y.y) + (y.z * y.z + y.w * y.w); u32x2 yw_; yw_.x = pk2(y.x, y.y); yw_.y = pk2(y.z, y.w); *(GAS u32x2*)op_ = yw_; } \
        ss = wave_sum(ss); if (lane == 0) F.SSP[(size_t)s * T + (tt)] = ss; } } while (0)
    TokInV inA, inB, inC; u32x4 pcA[16], pcB[16];
    P9_IN(inA, t0); P9_PCS(pcA, inA); P9_IN(inB, t0 + tstride); P9_PCS(pcB, inB); P9_IN(inC, t0 + 2 * tstride);
    for (int t = t0; t < T; t += 2 * tstride) {
        TokInV inD, inE;
        P9_STAGE(pcA); P9_PCS(pcA, inC); P9_IN(inD, t + 3 * tstride); __builtin_amdgcn_sched_barrier(0);
        P9_MATH(inA, t); __builtin_amdgcn_sched_barrier(0);
        P9_STAGE(pcB); P9_PCS(pcB, inD); P9_IN(inE, t + 4 * tstride); __builtin_amdgcn_sched_barrier(0);
        P9_MATH(inB, t + tstride); __builtin_amdgcn_sched_barrier(0);
        inA = inC; inB = inD; inC = inE;
    }
#undef P9_IN
#undef P9_PCS
#undef P9_STAGE
#undef P9_MATH
}
__device__ __forceinline__ void p10_final(Frame& F) {
    const int gw = F.vcu * NWAVES + F.wave, NGW = F.G * NWAVES, lane = F.lane;
    for (int t = gw; t < T; t += NGW) {
        float ss = 0.f;
#pragma unroll
        for (int s = 0; s < 8; ++s) ss += F.SSP[(size_t)s * T + t];
        const float rs = __builtin_amdgcn_rsqf(ss * (1.f / D) + EPS);
        GAS f32x4* xr = (GAS f32x4*)(F.out + (size_t)t * D) + lane; const GAS f32x4* gr = (const GAS f32x4*)F.gf + lane; const GAS u32x2* br = (const GAS u32x2*)(F.X2 + (size_t)t * D) + lane;
#pragma unroll
        for (int j = 0; j < 4; ++j) { const u32x2 w = __builtin_nontemporal_load(br + 64 * j); const unsigned w0 = w.x, w1 = w.y; const f32x4 gg = gr[64 * j]; __builtin_nontemporal_store((f32x4){bf_lo(w0) * rs * gg.x, bf_hi(w0) * rs * gg.y, bf_lo(w1) * rs * gg.z, bf_hi(w1) * rs * gg.w}, xr + 64 * j); }
    }
}
struct Args { const float* in[14]; float* out; unsigned char* ws; int ph_lo, ph_hi, li, pad; };
__global__ void __launch_bounds__(NWAVES * 64, 2) mk_fwd(Args args) {
    extern __shared__ __attribute__((aligned(16))) unsigned char lds[];
#ifdef PROBE_LO
    unsigned long long pmk_lo = 0, pmk_hi = 0;
    if (PROBE_LO == -1) { asm volatile("s_memrealtime %0\n\ts_waitcnt lgkmcnt(0)" : "=s"(pmk_lo) :: "memory"); }
#endif
    Frame F;
    F.lds = (LAS unsigned char*)lds;
    F.MISC = (volatile LAS unsigned*)(F.lds + MISC_OFF);
    F.tid = threadIdx.x; F.lane = F.tid & 63; F.wave = __builtin_amdgcn_readfirstlane(F.tid >> 6);
    F.G = gridDim.x; { const int bx = blockIdx.x; F.vcu = (F.G % 8 == 0) ? (bx % 8) * (F.G / 8) + bx / 8 : bx; }
    unsigned char* ws = args.ws;
    F.ctl = (gu32*)(ws + WS_CTL);
    F.x = args.in[0]; F.g1 = args.in[1]; F.w_in = args.in[2]; F.sb_g = args.in[3]; F.sw_g = args.in[4]; F.sinks = args.in[5]; F.w_out = args.in[6]; F.g2 = args.in[7];
    F.w_q = args.in[8]; F.keys1 = args.in[9]; F.keys2 = args.in[10]; F.pu = args.in[11]; F.pv = args.in[12]; F.gf = args.in[13]; F.out = args.out;
    F.Wt_in = (bf16*)(ws + WS_WIN); F.Wt_out = (bf16*)(ws + WS_WOUT); F.Wt_q = (bf16*)(ws + WS_WQ); F.KEYS = (bf16*)(ws + WS_KEYS);
    F.H = (bf16*)(ws + WS_H); F.MIX = (bf16*)(ws + WS_MIX); F.QKV = (bf16*)(ws + WS_QKV); F.U8 = ws + WS_U8; F.V8 = ws + WS_V8; F.RSU = (float*)(ws + WS_RSU); F.RSV = (float*)(ws + WS_RSV);
    F.SSQP = (float*)(ws + WS_SSQP); F.RS2 = (float*)(ws + WS_RS2); F.PD = (bf16*)(ws + WS_PD); F.X2 = (bf16*)(ws + WS_X2); F.C8 = ws + WS_C; F.CS = (float*)(ws + WS_C + 6 * MiB); F.SSP = (float*)(ws + WS_SSP);
    F.IDX = (unsigned short*)(ws + WS_IDX); F.GATE = (float*)(ws + WS_GATE);
    for (int u = F.tid; u < (LDS_BYTES - LDSCTL_OFF) / 4; u += NWAVES * 64) ((LAS unsigned*)(F.lds + LDSCTL_OFF))[u] = 0u;
    __syncthreads();
    const int lo = args.ph_lo, hi = args.ph_hi;
    const bool use_bar = (hi - lo) > 1;
    XcdBarrier bar; bar.bar = (unsigned*)(F.ctl + CW_BAR) + args.li * XCD_BAR_WORDS; bar.x = 0; bar.st = nullptr;
    if (use_bar) bar = xcd_barrier_post((unsigned*)(F.ctl + CW_BAR) + args.li * XCD_BAR_WORDS, F.MISC + 8);
#ifndef PHMASK
#define PHMASK 2047
#endif
#define IN(k) (((PHMASK >> (k)) & 1) && lo <= (k) && (k) < hi)
#define SEAM(k) do { if (IN(k) && IN((k) + 1)) xcd_barrier(bar); } while (0)
    const int gw = F.vcu * NWAVES + F.wave, NGW = F.G * NWAVES;
#ifdef PROBE_LO
#define PSTAMP(v) asm volatile("s_memrealtime %0\n\ts_waitcnt lgkmcnt(0)" : "=s"(v) :: "memory")
#define PMARK(k) do { if ((k) == PROBE_LO) { PSTAMP(pmk_lo); } if ((k) == PROBE_HI + 1) { PSTAMP(pmk_hi); } } while (0)
#else
#define PMARK(k) do {} while (0)
#endif

    PMARK(0);
    if (IN(0)) { p0_prologue(F); } SEAM(0);
    PMARK(1);
    if (IN(1)) { pg8::Gemm g{F.H, F.Wt_in, T, DIN, D}; pg8::StaticOrder S; S.init(T, DIN, F.G, (int)blockIdx.x); pg8::EpiBf16 E{F.QKV, DIN};
        pg8::gemm_phase<pg8::EpiBf16, pg8::StaticOrder>(F.lds, g, S, E);
        { const int nfull = (T / 256) * (DIN / 256) % F.G, nb = F.G - nfull;
          if (nb == F.G) { for (int r = (int)blockIdx.x * NWAVES + F.wave; r < NEXP; r += 4 * F.G * NWAVES) cvt_rows_fp8<4>(F, r, F.G * NWAVES, NEXP, F.lane); }
          else if ((int)blockIdx.x >= nfull) { for (int r = ((int)blockIdx.x - nfull) * NWAVES + F.wave; r < NEXP; r += 4 * nb * NWAVES) cvt_rows_fp8<4>(F, r, nb * NWAVES, NEXP, F.lane); } }
        } SEAM(1);
    PMARK(2);
    if (IN(2)) { p2_attention(F); } SEAM(2);
    PMARK(3);
    if (IN(3)) { pg8::Gemm g{F.MIX, F.Wt_out, T, D, D}; pg8::StaticOrder S; S.init(T, D, F.G, (int)blockIdx.x); pg8::EpiResB E{F.x, F.H, D, F.SSQP};
        pg8::gemm_phase<pg8::EpiResB, pg8::StaticOrder>(F.lds, g, S, E); } SEAM(3);
    PMARK(4);
    PMARK(5);
    if (IN(5)) { pg8::Gemm g{F.H, F.Wt_q, T, DQ, D}; pg8::StaticOrder S; S.init(T, DQ, F.G, (int)blockIdx.x); pg8::EpiBf16RS E{F.QKV, DQ, F.SSQP, F.RS2};
        pg8::gemm_phase<pg8::EpiBf16RS, pg8::StaticOrder>(F.lds, g, S, E);
        asm volatile("s_waitcnt vmcnt(0)" ::: "memory"); __syncthreads();
        p6_topk_own(F, S); }
    PMARK(6);
    SEAM(6);
    PMARK(7);
    if (IN(7)) { p7_udots(F); } SEAM(7);
    PMARK(8);
    if (IN(8)) { p8_combine(F); } SEAM(8);
    PMARK(9);
    if (IN(9)) { p9_vacc(F); } SEAM(9);
    PMARK(10);
    if (IN(10)) { p10_final(F); }
#ifdef PROBE_LO
    xcd_barrier(bar);
    PMARK(11);
    if (blockIdx.x == 0 && F.tid == 0) { unsigned long long t0, t1; PSTAMP(t0); const unsigned long long dl = (pmk_hi - pmk_lo) * PROBE_MULT;
        do { __builtin_amdgcn_s_sleep(8); PSTAMP(t1); } while (t1 - t0 < dl); }
#endif
#undef IN
#undef SEAM
}

extern "C" void kernel_launch(void* const* d_in, const int* in_sizes, int n_in, void* d_out, int out_size, void* d_ws, size_t ws_size, hipStream_t stream) {
    static int grid = 0;
    if (grid == 0) {
        if (n_in != 14 || in_sizes[0] != T * D || out_size != T * D || ws_size < WS_END) { fprintf(stderr, "kernel_launch: unexpected shapes (n_in %d, in0 %d, out %d, ws %zu)\n", n_in, n_in > 0 ? in_sizes[0] : -1, out_size, ws_size); grid = -1; return; }
        int dev = 0, cus = 0, per_cu = 0;
        if (hipGetDevice(&dev) != hipSuccess || hipDeviceGetAttribute(&cus, hipDeviceAttributeMultiprocessorCount, dev) != hipSuccess) { grid = -1; return; }
        if (hipFuncSetAttribute((const void*)mk_fwd, hipFuncAttributeMaxDynamicSharedMemorySize, LDS_BYTES) != hipSuccess) { fprintf(stderr, "kernel_launch: hipFuncSetAttribute failed\n"); grid = -1; return; }
        if (hipOccupancyMaxActiveBlocksPerMultiprocessor(&per_cu, (const void*)mk_fwd, NWAVES * 64, LDS_BYTES) != hipSuccess || per_cu < 1)
            fprintf(stderr, "kernel_launch: note: occupancy query reports %d workgroups per CU\n", per_cu);
        (void)hipGetLastError();
        grid = cus;
    }
    if (grid < 0) return;
    if (hipMemsetAsync((char*)d_ws + WS_CTL, 0, CTL_ZERO_BYTES, stream) != hipSuccess) { fprintf(stderr, "kernel_launch: hipMemsetAsync failed\n"); return; }
    Args a{};
    for (int i = 0; i < 14; ++i) a.in[i] = (const float*)d_in[i];
    a.out = (float*)d_out; a.ws = (unsigned char*)d_ws;
#if MK_N_LAUNCHES == 1
    a.ph_lo = 0; a.ph_hi = N_PHASES; a.li = 0;
    hipLaunchKernelGGL(mk_fwd, dim3(grid), dim3(NWAVES * 64), LDS_BYTES, stream, a);
#else
    for (int li = 0; li < N_PHASES; ++li) { a.ph_lo = li; a.ph_hi = li + 1; a.li = 0; hipLaunchKernelGGL(mk_fwd, dim3(grid), dim3(NWAVES * 64), LDS_BYTES, stream, a); }
#endif
    const hipError_t le = hipPeekAtLastError();
    if (le != hipSuccess) fprintf(stderr, "kernel_launch: launch failed: %s\n", hipGetErrorName(le));
}
```

```cpp
#include <hip/hip_runtime.h>
#include <cstdio>
#include <cstdint>

#ifndef MK_N_LAUNCHES
#define MK_N_LAUNCHES 1
#endif

#define LAS __attribute__((address_space(3)))
#define GAS __attribute__((address_space(1)))
typedef unsigned short bf16;
typedef short bf16x8 __attribute__((ext_vector_type(8)));
typedef float f32x4 __attribute__((ext_vector_type(4)));
typedef float f32x16 __attribute__((ext_vector_type(16)));
typedef unsigned u32x4 __attribute__((ext_vector_type(4)));
typedef unsigned u32x2 __attribute__((ext_vector_type(2)));
typedef short v4i16_t __attribute__((ext_vector_type(4)));
typedef float f32x2_t __attribute__((ext_vector_type(2)));
typedef __bf16 bf16x2_t __attribute__((ext_vector_type(2)));
typedef GAS unsigned gu32;

constexpr int T = 16384, SEQ = 4096, NB = 4, D = 1024, DIN = 2304, DQ = 2048;
constexpr int C_SBQ = 0, C_SBK = 512, C_SBV = 1024, C_SWQ = 1536, C_SWK = 2048, C_SWV = 2176;
constexpr int NEXP = 16384;
constexpr float EPS = 1e-6f;
constexpr float LOG2E = 1.4426950408889634f, LN2 = 0.6931471805599453f;
constexpr float SB_EXIT = -40.0f;

namespace pg8 {
constexpr int BM = 256, BK = 64, HALF = 128, HTB = HALF * BK * 2, STAGE_BYTES = 8 * HTB, NXCD = 8, WGM = 8;
__host__ __device__ __forceinline__ int lds_byte(int r, int c) { const int st = (r >> 4) * 2 + (c >> 5), rr = r & 15, cc = c & 31, ob = rr * 64 + cc * 2; return st * 1024 + (ob ^ (((ob >> 9) & 1) << 5)); }
__host__ __device__ __forceinline__ void stage_rc(int b, int& R, int& C) { const int st = b / 1024, sb = b % 1024, swz = sb ^ (((sb >> 9) & 1) << 5); R = (st >> 1) * 16 + swz / 64; C = (st & 1) * 32 + (swz % 64) / 2; }
__host__ __device__ __forceinline__ int perm32(int rho) { const int n = rho >> 4, i = rho & 15; return 8 * (i >> 2) + 4 * n + (i & 3); }
struct Unit { int pm, pn; };
struct Gemm { const bf16* A; const bf16* Bt; int M, N, K; };
struct StaticOrder {
    int nM, nN, nwg, G, c;
    __host__ __device__ void init(int M, int N, int G_, int c_) { nM = M / BM; nN = N / BM; nwg = nM * nN; G = G_; c = c_; }
    __host__ __device__ bool next(int i, Unit& u) const {
        const long L = (long)i * G + c; if (L >= nwg) return false;
        int wgid = (int)L; { const int q = nwg / NXCD, r = nwg % NXCD, xcd = wgid % NXCD, off = wgid / NXCD; wgid = (xcd < r ? xcd * (q + 1) : r * (q + 1) + (xcd - r) * q) + off; }
        const int nig = WGM * nN, gid = wgid / nig, fm = gid * WGM, gsz = (nM - fm) < WGM ? (nM - fm) : WGM;
        u.pm = fm + ((wgid % nig) % gsz); u.pn = (wgid % nig) / gsz; return true;
    }
};
__device__ __forceinline__ unsigned cvt_pk_bf16(float lo, float hi) { f32x2_t v = {lo, hi}; bf16x2_t b = __builtin_convertvector(v, bf16x2_t); return __builtin_bit_cast(unsigned, b); }

struct EpiBf16 {
    static constexpr bool PERM = true;
    bf16* O; int ldc;
    __device__ __forceinline__ void operator()(const f32x4 (&acc)[2][2][4][2], const Unit& u, int wr, int wc, int fr, int fq) const {
        const int row0 = u.pm * BM + wr * 64 + fr; const int col0 = u.pn * BM + wc * 32 + 8 * fq;
        const auto rsrc = __builtin_amdgcn_make_buffer_rsrc((void*)O, 0, 0x7ffffff0, 0x00020000);
#pragma unroll
        for (int ai = 0; ai < 2; ++ai)
#pragma unroll
            for (int m = 0; m < 4; ++m) { const unsigned boff = (unsigned)(((size_t)(row0 + ai * HALF + m * 16) * ldc + col0) * 2);
#pragma unroll
                for (int bj = 0; bj < 2; ++bj) { const f32x4 v0 = acc[ai][bj][m][0], v1 = acc[ai][bj][m][1];
                    u32x4 w; w.x = cvt_pk_bf16(v0[0], v0[1]); w.y = cvt_pk_bf16(v0[2], v0[3]); w.z = cvt_pk_bf16(v1[0], v1[1]); w.w = cvt_pk_bf16(v1[2], v1[3]);
                    __builtin_amdgcn_raw_buffer_store_b128(w, rsrc, boff + bj * HALF * 2, 0, 16); } }
    }
};
struct EpiBf16RS {
    static constexpr bool PERM = true;
    bf16* O; int ldc; const float* ssqp; float* rs2;
    __device__ __forceinline__ void operator()(const f32x4 (&acc)[2][2][4][2], const Unit& u, int wr, int wc, int fr, int fq) const {
        const int row0 = u.pm * BM + wr * 64 + fr; const int col0 = u.pn * BM + wc * 32 + 8 * fq;
#pragma unroll
        for (int ai = 0; ai < 2; ++ai)
#pragma unroll
            for (int m = 0; m < 4; ++m) { const int row = row0 + ai * HALF + m * 16; bf16* rowp = O + (size_t)row * ldc + col0;
                const f32x4* sp = (const f32x4*)(ssqp + (size_t)row * 16); const f32x4 s0 = sp[0], s1 = sp[1], s2 = sp[2], s3 = sp[3];
                const float ss = ((s0[0] + s0[1]) + (s0[2] + s0[3])) + ((s1[0] + s1[1]) + (s1[2] + s1[3])) + ((s2[0] + s2[1]) + (s2[2] + s2[3])) + ((s3[0] + s3[1]) + (s3[2] + s3[3]));
                const float rs = __builtin_amdgcn_rsqf(ss * (1.0f / 1024.0f) + 1e-6f);
                if (u.pn == 0 && wc == 0 && fq == 0) rs2[row] = rs;
#pragma unroll
                for (int bj = 0; bj < 2; ++bj) { const f32x4 v0 = acc[ai][bj][m][0] * rs, v1 = acc[ai][bj][m][1] * rs;
                    u32x4 w; w.x = cvt_pk_bf16(v0[0], v0[1]); w.y = cvt_pk_bf16(v0[2], v0[3]); w.z = cvt_pk_bf16(v1[0], v1[1]); w.w = cvt_pk_bf16(v1[2], v1[3]);
                    *(u32x4*)(rowp + bj * HALF) = w; } }
    }
};
struct EpiResB {
    static constexpr bool PERM = false;
    const float* base; bf16* xb; int ldc; float* ssqp;
    __device__ __forceinline__ void operator()(const f32x4 (&acc)[2][2][4][2], const Unit& u, int wr, int wc, int fr, int fq) const {
        const int col0 = u.pn * BM + wc * 32 + 4 * fq;
#pragma unroll
        for (int ai = 0; ai < 2; ++ai)
#pragma unroll
            for (int m = 0; m < 4; ++m) { const int row = u.pm * BM + ai * HALF + wr * 64 + m * 16 + fr; const size_t off = (size_t)row * ldc + col0; float sq = 0.f;
#pragma unroll
                for (int bj = 0; bj < 2; ++bj)
#pragma unroll
                    for (int n = 0; n < 2; ++n) { const f32x4 bs = __builtin_nontemporal_load((const f32x4*)(base + off + bj * HALF + n * 16)); const f32x4 y = bs + acc[ai][bj][m][n];
                        sq += (y[0] * y[0] + y[1] * y[1]) + (y[2] * y[2] + y[3] * y[3]);
                        u32x2 w; w.x = cvt_pk_bf16(y[0], y[1]); w.y = cvt_pk_bf16(y[2], y[3]); *(u32x2*)(xb + off + bj * HALF + n * 16) = w; }
                { const auto r16_ = __builtin_amdgcn_permlane16_swap(__builtin_bit_cast(unsigned, sq), __builtin_bit_cast(unsigned, sq), false, false); sq += __builtin_bit_cast(float, (threadIdx.x & 16) ? r16_[0] : r16_[1]); }
                { const auto r32_ = __builtin_amdgcn_permlane32_swap(__builtin_bit_cast(unsigned, sq), __builtin_bit_cast(unsigned, sq), false, false); sq += __builtin_bit_cast(float, (threadIdx.x & 32) ? r32_[0] : r32_[1]); }
                if (fq == 0) ssqp[(size_t)row * 16 + u.pn * 4 + wc] = sq; }
    }
};
struct EpiResF32 {
    static constexpr bool PERM = false;
    const float* base; float* out; int ldc;
    __device__ __forceinline__ void operator()(const f32x4 (&acc)[2][2][4][2], const Unit& u, int wr, int wc, int fr, int fq) const {
        const int col0 = u.pn * BM + wc * 32 + 4 * fq;
#pragma unroll
        for (int ai = 0; ai < 2; ++ai)
#pragma unroll
            for (int m = 0; m < 4; ++m) { const size_t off = (size_t)(u.pm * BM + ai * HALF + wr * 64 + m * 16 + fr) * ldc + col0;
#pragma unroll
                for (int bj = 0; bj < 2; ++bj)
#pragma unroll
                    for (int n = 0; n < 2; ++n) { const f32x4 bs = *(const f32x4*)(base + off + bj * HALF + n * 16); *(f32x4*)(out + off + bj * HALF + n * 16) = bs + acc[ai][bj][m][n]; } }
    }
};

template <class Epi, class Sched>
__device__ __forceinline__ void gemm_phase(LAS unsigned char* lds, const Gemm g, const Sched& S, const Epi& E) {
    const int tid = threadIdx.x, wid = __builtin_amdgcn_readfirstlane(tid >> 6), lane = tid & 63, wr = wid >> 2, wc = wid & 3, fr = lane & 15, fq = lane >> 4;
    const int K = g.K, nt = K / BK;
    unsigned voffA[2], voffB[2];
#pragma unroll
    for (int i = 0; i < 2; ++i) { int R, C; stage_rc(tid * 16 + i * 8192, R, C); const int Rb = Epi::PERM ? ((R & ~31) + perm32(R & 31)) : R;
        voffA[i] = (unsigned)(R * K + C) * 2u; voffB[i] = (unsigned)(Rb * K + C) * 2u; }
    const size_t kstep = (size_t)(BK * 2);
    const size_t hstep = (size_t)HALF * K * 2;
    const size_t tstep = 2 * hstep;
    const unsigned ldsw = (unsigned)wid * 1024u;
    const int aoff = lds_byte(wr * 64 + fr, fq * 8), boff = lds_byte(wc * 32 + fr, fq * 8);
#define PG8_SA(b, h) (((b) * 2 + (h)) * HTB)
#define PG8_SB(b, h) ((4 + (b) * 2 + (h)) * HTB)
#define PG8_STAGE(bufoff, gbase, voff) do { _Pragma("unroll") for (int _i = 0; _i < 2; ++_i) \
        __builtin_amdgcn_global_load_lds((const unsigned*)((const char*)(gbase) + (voff)[_i]), (LAS unsigned*)(lds + (bufoff) + ldsw + _i * 8192), 16, 0, 0); } while (0)
#define PG8_LDA(dst, b, h) do { _Pragma("unroll") for (int m = 0; m < 4; ++m) _Pragma("unroll") for (int k = 0; k < 2; ++k) dst[m][k] = *(const LAS bf16x8*)(lds + PG8_SA(b, h) + aoff + m * 2048 + k * 1024); } while (0)
#define PG8_LDB(dst, b, h) do { _Pragma("unroll") for (int n = 0; n < 2; ++n) _Pragma("unroll") for (int k = 0; k < 2; ++k) dst[n][k] = *(const LAS bf16x8*)(lds + PG8_SB(b, h) + boff + n * 2048 + k * 1024); } while (0)
#define PG8_MMA(ai, bj, At, Bt) do { __builtin_amdgcn_s_setprio(1); _Pragma("unroll") for (int m = 0; m < 4; ++m) _Pragma("unroll") for (int n = 0; n < 2; ++n) _Pragma("unroll") for (int k = 0; k < 2; ++k) \
        acc[ai][bj][m][n] = __builtin_amdgcn_mfma_f32_16x16x32_bf16(Bt[n][k], At[m][k], acc[ai][bj][m][n], 0, 0, 0); __builtin_amdgcn_s_setprio(0); } while (0)
#define PG8_WAIT_V(n) asm volatile("s_waitcnt vmcnt(" #n ")" ::: "memory")
#define PG8_WAIT_L(n) asm volatile("s_waitcnt lgkmcnt(" #n ")" ::: "memory")
#define PG8_BAR __builtin_amdgcn_s_barrier()
#define PG8_SCHED __builtin_amdgcn_sched_barrier(0)
    Unit cur, nxt; int ui = 0;
    if (!S.next(0, cur)) return;
    f32x4 acc[2][2][4][2];
#pragma unroll
    for (int a = 0; a < 2; ++a)
#pragma unroll
        for (int b = 0; b < 2; ++b)
#pragma unroll
            for (int m = 0; m < 4; ++m)
#pragma unroll
                for (int n = 0; n < 2; ++n) acc[a][b][m][n] = (f32x4){0.f, 0.f, 0.f, 0.f};
    bf16x8 At[4][2], B0[2][2], B1[2][2];
    const char* cA = (const char*)g.A + (size_t)cur.pm * tstep; const char* cB = (const char*)g.Bt + (size_t)cur.pn * tstep;
    PG8_STAGE(PG8_SB(0, 0), cB, voffB); PG8_STAGE(PG8_SB(0, 1), cB + hstep, voffB); PG8_STAGE(PG8_SA(0, 0), cA, voffA); PG8_STAGE(PG8_SA(0, 1), cA + hstep, voffA);
    if (wr == 1) PG8_BAR;
    PG8_WAIT_V(2); PG8_BAR;
    PG8_STAGE(PG8_SB(1, 0), cB + kstep, voffB); PG8_STAGE(PG8_SA(1, 0), cA + kstep, voffA); PG8_STAGE(PG8_SB(1, 1), cB + hstep + kstep, voffB);
    PG8_WAIT_V(6); PG8_BAR;
    for (;;) {
        const bool has_next = S.next(ui + 1, nxt);
        const char* nA = has_next ? (const char*)g.A + (size_t)nxt.pm * tstep : cA; const char* nB = has_next ? (const char*)g.Bt + (size_t)nxt.pn * tstep : cB;
        for (int t = 0; t < nt; t += 2) {
            const bool last = (t == nt - 2);
            const char* a1 = cA + (size_t)(t + 1) * kstep;
            const char* a2 = last ? nA : cA + (size_t)(t + 2) * kstep; const char* b2 = last ? nB : cB + (size_t)(t + 2) * kstep;
            const char* a3 = a2 + kstep; const char* b3 = b2 + kstep;
            PG8_LDB(B0, 0, 0); PG8_LDB(B1, 0, 1); PG8_SCHED; PG8_LDA(At, 0, 0); PG8_STAGE(PG8_SA(1, 1), a1 + hstep, voffA);
            PG8_WAIT_V(8); PG8_WAIT_L(0); PG8_BAR; PG8_MMA(0, 0, At, B0); PG8_MMA(0, 1, At, B1); PG8_BAR; PG8_SCHED;
            PG8_LDA(At, 0, 1); PG8_STAGE(PG8_SB(0, 0), b2, voffB); PG8_STAGE(PG8_SB(0, 1), b2 + hstep, voffB); PG8_STAGE(PG8_SA(0, 0), a2, voffA);
            PG8_WAIT_V(8); PG8_WAIT_L(0); PG8_BAR; PG8_MMA(1, 0, At, B0); PG8_MMA(1, 1, At, B1); PG8_BAR; PG8_SCHED;
            PG8_LDB(B0, 1, 0); PG8_LDB(B1, 1, 1); PG8_SCHED; PG8_LDA(At, 1, 0); PG8_STAGE(PG8_SA(0, 1), a2 + hstep, voffA);
            PG8_WAIT_V(8); PG8_WAIT_L(0); PG8_BAR; PG8_MMA(0, 0, At, B0); PG8_MMA(0, 1, At, B1); PG8_BAR; PG8_SCHED;
            PG8_LDA(At, 1, 1); PG8_STAGE(PG8_SB(1, 0), b3, voffB); PG8_STAGE(PG8_SB(1, 1), b3 + hstep, voffB); PG8_STAGE(PG8_SA(1, 0), a3, voffA);
            PG8_WAIT_V(8); PG8_WAIT_L(0); PG8_BAR; PG8_MMA(1, 0, At, B0); PG8_MMA(1, 1, At, B1); PG8_BAR; PG8_SCHED;
        }
        if (wr == 0) PG8_BAR;
        E(acc, cur, wr, wc, fr, fq);
        if (!has_next) break;
#pragma unroll
        for (int a = 0; a < 2; ++a)
#pragma unroll
            for (int b = 0; b < 2; ++b)
#pragma unroll
                for (int m = 0; m < 4; ++m)
#pragma unroll
                    for (int n = 0; n < 2; ++n) acc[a][b][m][n] = (f32x4){0.f, 0.f, 0.f, 0.f};
        cur = nxt; cA = nA; cB = nB; ++ui;
        if (wr == 1) PG8_BAR;
    }
    PG8_WAIT_V(0);
    PG8_BAR;
#undef PG8_SA
#undef PG8_SB
#undef PG8_STAGE
#undef PG8_LDA
#undef PG8_LDB
#undef PG8_MMA
#undef PG8_WAIT_V
#undef PG8_WAIT_L
#undef PG8_BAR
#undef PG8_SCHED
}
}

constexpr int NWAVES = 8;
constexpr int N_PHASES = 11;
constexpr size_t MiB = 1u << 20;
constexpr size_t WS_CTL = 0, CTL_ZERO_BYTES = 32 * 1024;
constexpr size_t WS_WIN = 1 * MiB;
constexpr size_t WS_WOUT = 6 * MiB;
constexpr size_t WS_WQ = 8 * MiB;
constexpr size_t WS_KEYS = 12 * MiB;
constexpr size_t WS_RSU = 12 * MiB + 512 * 1024, WS_RSV = 12 * MiB + 768 * 1024;
constexpr size_t WS_RS2 = 12 * MiB + 896 * 1024;
constexpr size_t WS_IDX = 13 * MiB;
constexpr size_t WS_GATE = 21 * MiB;
constexpr size_t WS_SSQP = WS_GATE;
constexpr size_t WS_H = 29 * MiB;
constexpr size_t WS_MIX = 61 * MiB;
constexpr size_t WS_C = WS_MIX, WS_SSP = WS_MIX + 8 * MiB;
constexpr size_t WS_X2 = 165 * MiB - 32 * MiB;
constexpr size_t WS_QKV = 93 * MiB;
constexpr size_t WS_PD = WS_QKV;
constexpr size_t WS_U8 = 165 * MiB;
constexpr size_t WS_V8 = 181 * MiB;
constexpr size_t WS_END = 197 * MiB;
constexpr size_t TAB8_SLICE = (size_t)NEXP * 128;
constexpr int CW_BAR = 4096;
static_assert((CW_BAR + 3456) * 4 <= 32 * 1024, "barrier words inside the per-call memset");
constexpr int RING_BYTES = 147456;
constexpr int LDSCTL_OFF = RING_BYTES, MISC_OFF = LDSCTL_OFF + 320;
constexpr int LDS_BYTES = 155648;

#define RLX_AGENT __ATOMIC_RELAXED, __HIP_MEMORY_SCOPE_AGENT
#define LDS_WAIT() asm volatile("s_waitcnt lgkmcnt(0)" ::: "memory")
__device__ __forceinline__ unsigned f2bf(float f) { unsigned u = __builtin_bit_cast(unsigned, f); return (u + 0x7fffu + ((u >> 16) & 1u)) >> 16; }
__device__ __forceinline__ unsigned pk2(float lo, float hi) { return pg8::cvt_pk_bf16(lo, hi); }
__device__ __forceinline__ unsigned f_bits(float f) { return __builtin_bit_cast(unsigned, f); }
__device__ __forceinline__ float bits_f(unsigned u) { return __builtin_bit_cast(float, u); }
__device__ __forceinline__ float bf_lo(unsigned w) { return __builtin_bit_cast(float, w << 16); }
__device__ __forceinline__ float bf_hi(unsigned w) { return __builtin_bit_cast(float, w & 0xffff0000u); }

#define XB_TMO      128
#define XB_XCNT(j)  (256  + 64 * (j))
#define XB_XSUB(j)  (1280 + 64 * (j))
#define XB_XGEN(j)  (2304 + 64 * (j))
#define XB_TOP      3328
#define XB_TOPGEN   3392
#define XCD_BAR_WORDS 3456
#define XB_SPIN_CAP (1u << 18)
__device__ __forceinline__ unsigned xb_ld(unsigned* p)              { return __hip_atomic_load(p, __ATOMIC_RELAXED, __HIP_MEMORY_SCOPE_AGENT); }
__device__ __forceinline__ unsigned xb_add(unsigned* p, unsigned v) { return __hip_atomic_fetch_add(p, v, __ATOMIC_RELAXED, __HIP_MEMORY_SCOPE_AGENT); }
__device__ __forceinline__ unsigned xb_xcc_id() { return (unsigned)__builtin_amdgcn_s_getreg((3 << 11) | 20) & 0xFu; }
#define XB_SPIN(cond, bar) do { unsigned _sp = 0; while (cond) { __builtin_amdgcn_s_sleep(1); \
    if ((++_sp & 255u) == 0u) { if (xb_ld(&(bar)[XB_TMO])) break; if (_sp > XB_SPIN_CAP) { atomicAdd(&(bar)[XB_TMO], 1u); break; } } } } while (0)
struct XcdBarrier { unsigned* bar; unsigned x; volatile LAS unsigned* st; };
__device__ __forceinline__ XcdBarrier xcd_barrier_post(unsigned* bar, volatile LAS unsigned* st) {
    XcdBarrier b; b.bar = bar; b.x = xb_xcc_id(); b.st = st;
    if (threadIdx.x == 0) (void)xb_add(&bar[XB_XCNT(b.x)], 1u);
    return b;
}
__device__ __forceinline__ void xcd_barrier_complete(unsigned* bar, unsigned x, unsigned& nloc, unsigned& nx) {
    const unsigned G = gridDim.x * gridDim.y * gridDim.z;
    unsigned sum, cnt, mine, sp = 0u;
    for (;;) {
        sum = 0u; cnt = 0u; mine = 0u;
#pragma unroll
        for (unsigned j = 0; j < 16; ++j) { const unsigned c = xb_ld(&bar[XB_XCNT(j)]); sum += c; cnt += (c > 0u) ? 1u : 0u; mine = (j == x) ? c : mine; }
        if (sum == G) break;
        __builtin_amdgcn_s_sleep(1);
        if ((++sp & 255u) == 0u) { if (xb_ld(&bar[XB_TMO])) break; if (sp > XB_SPIN_CAP) { atomicAdd(&bar[XB_TMO], 1u); break; } }
    }
    nloc = mine > 0u ? mine : 1u; nx = cnt > 0u ? cnt : 1u;
}
__device__ __forceinline__ void xcd_barrier(const XcdBarrier& b) {
    asm volatile("s_waitcnt vmcnt(0)" ::: "memory");
    __syncthreads();
    if (threadIdx.x == 0) {
        unsigned* bar = b.bar;
        __builtin_amdgcn_s_waitcnt(0);
        unsigned nloc = b.st[0], nx = b.st[1];
        if (nloc == 0u) { xcd_barrier_complete(bar, b.x, nloc, nx); b.st[0] = nloc; b.st[1] = nx; }
        const unsigned old = xb_add(&bar[XB_XSUB(b.x)], 1u);
        const unsigned gen = old / nloc;
        if (old + 1u == (gen + 1u) * nloc) {
            __builtin_amdgcn_fence(__ATOMIC_RELEASE, "agent");
            asm volatile("s_waitcnt vmcnt(0)" ::: "memory");
            const unsigned og = xb_add(&bar[XB_TOP], 1u);
            const unsigned tg = og / nx;
            if (og + 1u == (tg + 1u) * nx) xb_add(&bar[XB_TOPGEN], 1u);
            else XB_SPIN(xb_ld(&bar[XB_TOPGEN]) == tg, bar);
            __builtin_amdgcn_fence(__ATOMIC_ACQUIRE, "agent");
            xb_add(&bar[XB_XGEN(b.x)], 1u);
            asm volatile("s_waitcnt vmcnt(0)" ::: "memory");
        } else {
            XB_SPIN(xb_ld(&bar[XB_XGEN(b.x)]) == gen, bar);
            __builtin_amdgcn_fence(__ATOMIC_ACQUIRE, "agent");
            asm volatile("s_waitcnt vmcnt(0)" ::: "memory");
        }
    }
    __syncthreads();
}

struct Frame {
    LAS unsigned char* lds;
    volatile LAS unsigned* MISC;
    gu32* ctl;
    int tid, lane, wave;
    int vcu, G;
    const float *x, *g1, *w_in, *sb_g, *sw_g, *sinks, *w_out, *g2, *w_q, *keys1, *keys2, *pu, *pv, *gf;
    float* out;
    bf16 *Wt_in, *Wt_out, *Wt_q, *KEYS, *H, *MIX, *QKV;
    unsigned char *U8, *V8, *C8; float *RSU, *RSV, *SSP, *SSQP, *RS2, *CS; bf16 *PD, *X2;
    unsigned short* IDX; float* GATE;
};

__device__ __forceinline__ unsigned partner32(unsigned x) { const auto r = __builtin_amdgcn_permlane32_swap(x, x, false, false); return (threadIdx.x & 32) ? r[0] : r[1]; }
__device__ __forceinline__ unsigned partner16(unsigned x) { const auto r = __builtin_amdgcn_permlane16_swap(x, x, false, false); return (threadIdx.x & 16) ? r[0] : r[1]; }
#define DPPF(v, ctl) bits_f((unsigned)__builtin_amdgcn_update_dpp(0, (int)f_bits(v), (ctl), 0xf, 0xf, false))
__device__ __forceinline__ float wave_sum(float v) {
    v += DPPF(v, 0xB1); v += DPPF(v, 0x4E); v += DPPF(v, 0x141); v += DPPF(v, 0x140);
    v += bits_f(partner16(f_bits(v))); v += bits_f(partner32(f_bits(v)));
    return v;
}

__device__ __forceinline__ void p0_transpose_item(const float* W, int K, int N, bf16* WT, LAS float* scr, int item, int lane, const float* gk = nullptr) {
    const int nblk = N / 32, kb = item / nblk, nb = item % nblk, k0 = 64 * kb, n0 = 32 * nb;
#pragma unroll 8
    for (int i = 0; i < 32; ++i) { const int kk = 2 * i + (lane >> 5); const float gq = gk ? gk[k0 + kk] : 1.0f; scr[kk * 33 + (lane & 31)] = __builtin_nontemporal_load(W + (size_t)(k0 + kk) * N + n0 + (lane & 31)) * gq; }
    LDS_WAIT(); asm volatile("" ::: "memory");
    const int c = lane & 7;
#pragma unroll
    for (int j = 0; j < 4; ++j) { const int n = (lane >> 3) + 8 * j; const LAS float* s = scr + (8 * c) * 33 + n;
        u32x4 o; o.x = pk2(s[0 * 33], s[1 * 33]); o.y = pk2(s[2 * 33], s[3 * 33]); o.z = pk2(s[4 * 33], s[5 * 33]); o.w = pk2(s[6 * 33], s[7 * 33]);
        *(GAS u32x4*)(WT + (size_t)(n0 + n) * K + k0 + 8 * c) = o; }
    LDS_WAIT(); asm volatile("" ::: "memory");
}
template <int NR> __device__ __forceinline__ void rms_rows_to_bf16(const float* xbase, const float* g, bf16* obase, int m0, int mstride, int lane) {
    f32x4 v[NR][4];
#pragma unroll
    for (int i = 0; i < NR; ++i) { const int m = m0 + i * mstride; const GAS f32x4* xr = (const GAS f32x4*)(xbase + (size_t)(m < T ? m : m0) * D) + lane;
#pragma unroll
        for (int j = 0; j < 4; ++j) v[i][j] = __builtin_nontemporal_load(xr + 64 * j); }
    const GAS f32x4* gr = (const GAS f32x4*)g + lane;
    f32x4 gg[4];
#pragma unroll
    for (int j = 0; j < 4; ++j) gg[j] = gr[64 * j];
#pragma unroll
    for (int i = 0; i < NR; ++i) { const int m = m0 + i * mstride;
        float s = 0.f;
#pragma unroll
        for (int j = 0; j < 4; ++j) s += (v[i][j].x * v[i][j].x + v[i][j].y * v[i][j].y) + (v[i][j].z * v[i][j].z + v[i][j].w * v[i][j].w);
        const float rs = __builtin_amdgcn_rsqf(wave_sum(s) * (1.f / D) + EPS);
        if (m < T) { GAS u32x2* o8 = (GAS u32x2*)(obase + (size_t)m * D) + lane;
#pragma unroll
            for (int j = 0; j < 4; ++j) { u32x2 w; w.x = pk2(v[i][j].x * rs * gg[j].x, v[i][j].y * rs * gg[j].y); w.y = pk2(v[i][j].z * rs * gg[j].z, v[i][j].w * rs * gg[j].w); o8[64 * j] = w; } } }
}
__device__ __forceinline__ void cvt_array_bf16(const float* src, bf16* dst, size_t n8, int gtid, int gthreads) {
    for (size_t i = gtid; i < n8; i += gthreads) {
        const f32x4 a = __builtin_nontemporal_load((const GAS f32x4*)(src + i * 8)), b = __builtin_nontemporal_load((const GAS f32x4*)(src + i * 8 + 4));
        u32x4 o; o.x = pk2(a.x, a.y); o.y = pk2(a.z, a.w); o.z = pk2(b.x, b.y); o.w = pk2(b.z, b.w);
        *(GAS u32x4*)(dst + i * 8) = o;
    }
}
__device__ __forceinline__ void p0_prologue(Frame& F) {
    LAS float* scr = (LAS float*)(F.lds + F.wave * 16384);
    const int gw = F.vcu * NWAVES + F.wave, NGW = F.G * NWAVES;
    constexpr int I_IN = (D / 64) * (DIN / 32), I_OUT = (D / 64) * (D / 32), I_Q = (D / 64) * (DQ / 32);
    constexpr int NITEMS = I_IN + I_OUT + I_Q;
    for (int it = gw; it < NITEMS; it += NGW) {
        int r = it;
        if (r < I_IN) { p0_transpose_item(F.w_in, D, DIN, F.Wt_in, scr, r, F.lane); continue; } r -= I_IN;
        if (r < I_OUT) { p0_transpose_item(F.w_out, D, D, F.Wt_out, scr, r, F.lane); continue; } r -= I_OUT;
        p0_transpose_item(F.w_q, D, DQ, F.Wt_q, scr, r, F.lane, F.g2);
    }
    for (int m = gw; m < T; m += 4 * NGW) rms_rows_to_bf16<4>(F.x, F.g1, F.H, m, NGW, F.lane);
    const int gtid = F.vcu * NWAVES * 64 + F.tid, gthreads = F.G * NWAVES * 64;
    cvt_array_bf16(F.keys1, F.KEYS, (size_t)8 * 128 * 128 / 8, gtid, gthreads);
    cvt_array_bf16(F.keys2, F.KEYS + 8 * 128 * 128, (size_t)8 * 128 * 128 / 8, gtid, gthreads);
}

__device__ __forceinline__ int pack_i8(float a, float b, float c, float d) {
    const int qa = (int)__builtin_rintf(a), qb = (int)__builtin_rintf(b), qc = (int)__builtin_rintf(c), qd = (int)__builtin_rintf(d);
    return (qa & 0xff) | ((qb & 0xff) << 8) | ((qc & 0xff) << 16) | (qd << 24);
}
__device__ __forceinline__ float wave_max(float v) {
    v = __builtin_fmaxf(v, DPPF(v, 0xB1)); v = __builtin_fmaxf(v, DPPF(v, 0x4E)); v = __builtin_fmaxf(v, DPPF(v, 0x141)); v = __builtin_fmaxf(v, DPPF(v, 0x140));
    v = __builtin_fmaxf(v, bits_f(partner16(f_bits(v)))); v = __builtin_fmaxf(v, bits_f(partner32(f_bits(v))));
    return v;
}
template <int NR> __device__ __forceinline__ void cvt_rows_fp8(Frame& F, int r0, int rstride, int rlimit, int lane) {
    f32x4 v[NR][4];
#pragma unroll
    for (int i = 0; i < NR; ++i) { int r = r0 + i * rstride; r = r < rlimit ? r : r0; const float* src = r < NEXP ? F.pu + (size_t)r * D : F.pv + (size_t)(r - NEXP) * D;
        const GAS f32x4* xr = (const GAS f32x4*)src + lane;
#pragma unroll
        for (int j = 0; j < 4; ++j) v[i][j] = __builtin_nontemporal_load(xr + 64 * j); }
    f32x4 g2v[4];
#pragma unroll
    for (int j = 0; j < 4; ++j) g2v[j] = ((const GAS f32x4*)F.g2)[lane + 64 * j];
#pragma unroll
    for (int i = 0; i < NR; ++i) { const int r = r0 + i * rstride;
        if (r < NEXP) {
#pragma unroll
            for (int j = 0; j < 4; ++j) v[i][j] = v[i][j] * g2v[j]; }
        float amax = 0.f;
#pragma unroll
        for (int j = 0; j < 4; ++j) amax = __builtin_fmaxf(amax, __builtin_fmaxf(__builtin_fmaxf(__builtin_fabsf(v[i][j].x), __builtin_fabsf(v[i][j].y)), __builtin_fmaxf(__builtin_fabsf(v[i][j].z), __builtin_fabsf(v[i][j].w))));
        amax = wave_max(amax);
        int k = 6 - ((int)((f_bits(amax) >> 23) & 0xffu) - 127);
        k = k > 100 ? 100 : (k < -100 ? -100 : k);
        const float sc = bits_f((unsigned)(k + 127) << 23), inv = bits_f((unsigned)(127 - k) << 23);
        if (r < rlimit) { const int e = r < NEXP ? r : r - NEXP; unsigned char* tab8 = r < NEXP ? F.U8 : F.V8; float* rs = r < NEXP ? F.RSU : F.RSV;
            const float sq = amax > 0.f ? 127.0f / amax : 0.f;
#pragma unroll
            for (int j = 0; j < 4; ++j) {
                const int w = pack_i8(v[i][j].x * sq, v[i][j].y * sq, v[i][j].z * sq, v[i][j].w * sq);
                const int s = 2 * j + (lane >> 5);
                *(GAS unsigned*)(tab8 + (size_t)s * TAB8_SLICE + (size_t)e * 128 + 4 * (lane & 31)) = (unsigned)w;
            }
            if (lane == 0) rs[e] = amax * (1.0f / 127.0f); } }
}
__device__ __forceinline__ int crow(int r, int hi) { return (r & 3) + 8 * (r >> 2) + 4 * hi; }
constexpr int VPITCH = 192;
constexpr int KPITCH = 144;
constexpr int ATT_K_OFF = 0, ATT_V_OFF = 32 * KPITCH, ATT_Q_OFF = 32 * KPITCH + 32 * VPITCH, ATT_WAVE_BYTES = 64 * KPITCH + 32 * VPITCH;
struct Tile4 { u32x4 a, b, c, d; };
__device__ __forceinline__ Tile4 tile_load(const bf16* t0, int lane) {
    const bf16* p = t0 + (size_t)(lane >> 3) * DIN + 8 * (lane & 7);
    Tile4 t; t.a = *(const GAS u32x4*)p; t.b = *(const GAS u32x4*)(p + (size_t)8 * DIN); t.c = *(const GAS u32x4*)(p + (size_t)16 * DIN); t.d = *(const GAS u32x4*)(p + (size_t)24 * DIN); return t;
}
__device__ __forceinline__ void tile_store(LAS unsigned char* dst, int pitch, const Tile4& t, int lane) {
    LAS unsigned char* p = dst + (lane >> 3) * pitch + 16 * (lane & 7);
    *(LAS u32x4*)p = t.a; *(LAS u32x4*)(p + 8 * pitch) = t.b; *(LAS u32x4*)(p + 16 * pitch) = t.c; *(LAS u32x4*)(p + 24 * pitch) = t.d;
}
__device__ __forceinline__ bf16x8 kfrag(const LAS unsigned char* kt, int d0, int lane) { const u32x4 w = *(const LAS u32x4*)(kt + (lane & 31) * KPITCH + 32 * d0 + 16 * (lane >> 5)); return __builtin_bit_cast(bf16x8, w); }
__device__ __forceinline__ bf16x8 vfrag(const LAS unsigned char* wl, int dblk, int s, int lane) {
    const int hi = lane >> 5, i = lane & 15, g1 = (lane >> 4) & 1;
    const LAS unsigned char* p = wl + (16 * s + 4 * hi + (i >> 2)) * VPITCH + (32 * dblk + 16 * g1 + 4 * (i & 3)) * 2;
    const v4i16_t lo = __builtin_amdgcn_ds_read_tr16_b64_v4i16((LAS v4i16_t*)p);
    const v4i16_t hh = __builtin_amdgcn_ds_read_tr16_b64_v4i16((LAS v4i16_t*)(p + 8 * VPITCH));
    return (bf16x8){lo[0], lo[1], lo[2], lo[3], hh[0], hh[1], hh[2], hh[3]};
}
__device__ __forceinline__ bf16x8 pack8(const f32x16& a, int s) {
    u32x4 w; w.x = pk2(a[8 * s + 0], a[8 * s + 1]); w.y = pk2(a[8 * s + 2], a[8 * s + 3]); w.z = pk2(a[8 * s + 4], a[8 * s + 5]); w.w = pk2(a[8 * s + 6], a[8 * s + 7]);
    return __builtin_bit_cast(bf16x8, w);
}
__device__ __forceinline__ void head_norm_store(const f32x16& o0, const f32x16& o1, float scale, const float* g, bf16* dstrow, int hi) {
    float ss = 0.f;
#pragma unroll
    for (int r = 0; r < 16; ++r) { const float a = o0[r] * scale, b = o1[r] * scale; ss += a * a + b * b; }
    ss += bits_f(partner32(f_bits(ss)));
    const float rs = __builtin_amdgcn_rsqf(ss * (1.f / 64.f) + EPS) * scale;
#pragma unroll
    for (int dblk = 0; dblk < 2; ++dblk)
#pragma unroll
        for (int q4 = 0; q4 < 4; ++q4) { const int d0 = 32 * dblk + 8 * q4 + 4 * hi; const f32x4 gg = *(const GAS f32x4*)(g + d0);
            const f32x16& o = dblk ? o1 : o0;
            u32x2 w; w.x = pk2(o[4 * q4 + 0] * rs * gg.x, o[4 * q4 + 1] * rs * gg.y); w.y = pk2(o[4 * q4 + 2] * rs * gg.z, o[4 * q4 + 3] * rs * gg.w);
            *(GAS u32x2*)(dstrow + d0) = w; }
}

__device__ __forceinline__ void sb_item(Frame& F, int b, int h, int qb, LAS unsigned char* wl) {
    const int lane = F.lane, r32 = lane & 31, hi = lane >> 5;
    const size_t rowbase = (size_t)b * SEQ;
    const bf16* Qp = F.QKV + (rowbase + 32 * qb) * DIN + C_SBQ + h * 64;
    const bf16* Kb = F.QKV + rowbase * DIN + C_SBK + h * 64;
    const bf16* Vb = F.QKV + rowbase * DIN + C_SBV + h * 64;
    bf16x8 qr[4];
    { const Tile4 tq = tile_load(Qp, lane); tile_store(wl + ATT_K_OFF, KPITCH, tq, lane);
#pragma unroll
      for (int d0 = 0; d0 < 4; ++d0) qr[d0] = kfrag(wl + ATT_K_OFF, d0, lane); }
    bf16x8 tri[2];
#pragma unroll
    for (int s = 0; s < 2; ++s)
#pragma unroll
        for (int j = 0; j < 8; ++j) tri[s][j] = (16 * s + 8 * (j >> 2) + 4 * hi + (j & 3) >= r32) ? (short)0x3F80 : (short)0;
    f32x16 o0 = {}, o1 = {}; float C = 0.f;
    Tile4 tk = tile_load(Kb + (size_t)(32 * qb) * DIN, lane), tv = tile_load(Vb + (size_t)(32 * qb) * DIN, lane);
    for (int kt = qb; kt >= 0; --kt) {
        tile_store(wl + ATT_K_OFF, KPITCH, tk, lane); tile_store(wl + ATT_V_OFF, VPITCH, tv, lane);
        { const int kn = kt > 0 ? kt - 1 : 0; tk = tile_load(Kb + (size_t)(32 * kn) * DIN, lane); tv = tile_load(Vb + (size_t)(32 * kn) * DIN, lane); }
        bf16x8 kf[4];
#pragma unroll
        for (int d0 = 0; d0 < 4; ++d0) kf[d0] = kfrag(wl + ATT_K_OFF, d0, lane);
        f32x16 z = {};
#pragma unroll
        for (int d0 = 0; d0 < 4; ++d0) z = __builtin_amdgcn_mfma_f32_32x32x16_bf16(kf[d0], qr[d0], z, 0, 0, 0);
        const int lim = r32 + 32 * (qb - kt);
        f32x16 l, ls;
#pragma unroll
        for (int r = 0; r < 16; ++r) {
            const float zz = z[r] * 0.125f;
            const float e = __builtin_amdgcn_exp2f(-__builtin_fabsf(zz) * LOG2E);
            const float sp = __builtin_fmaxf(zz, 0.f) + LN2 * __builtin_amdgcn_logf(1.0f + e);
            const bool valid = crow(r, hi) < lim;
            l[r] = valid ? -sp : 0.f;
            ls[r] = zz - sp;
        }
        f32x16 lo;
        bf16x8 lh[2], ll[2];
#pragma unroll
        for (int s = 0; s < 2; ++s) {
            u32x4 wh, wlw;
#pragma unroll
            for (int p = 0; p < 4; ++p) { const float a = l[8 * s + 2 * p], c = l[8 * s + 2 * p + 1]; const unsigned w = pk2(a, c); wh[p] = w; lo[8 * s + 2 * p] = a - bf_lo(w); lo[8 * s + 2 * p + 1] = c - bf_hi(w); }
#pragma unroll
            for (int p = 0; p < 4; ++p) wlw[p] = pk2(lo[8 * s + 2 * p], lo[8 * s + 2 * p + 1]);
            lh[s] = __builtin_bit_cast(bf16x8, wh); ll[s] = __builtin_bit_cast(bf16x8, wlw);
        }
        f32x16 Y = {};
        Y = __builtin_amdgcn_mfma_f32_32x32x16_bf16(tri[0], lh[0], Y, 0, 0, 0);
        Y = __builtin_amdgcn_mfma_f32_32x32x16_bf16(tri[1], lh[1], Y, 0, 0, 0);
        Y = __builtin_amdgcn_mfma_f32_32x32x16_bf16(tri[0], ll[0], Y, 0, 0, 0);
        Y = __builtin_amdgcn_mfma_f32_32x32x16_bf16(tri[1], ll[1], Y, 0, 0, 0);
        f32x16 a;
#pragma unroll
        for (int r = 0; r < 16; ++r) {
            const bool valid = crow(r, hi) < lim;
            const float later = C + (Y[r] - l[r]);
            const float av = __builtin_amdgcn_exp2f((ls[r] + later) * LOG2E);
            a[r] = valid ? av : 0.f;
        }
        float tot; { const float y0_ = Y[0]; const auto r_ = __builtin_amdgcn_permlane32_swap(f_bits(y0_), f_bits(y0_), false, false); tot = hi ? bits_f(r_[0]) : y0_; }
        C += tot;
        const bf16x8 a0 = pack8(a, 0), a1 = pack8(a, 1);
        o0 = __builtin_amdgcn_mfma_f32_32x32x16_bf16(vfrag(wl + ATT_V_OFF, 0, 0, lane), a0, o0, 0, 0, 0);
        o0 = __builtin_amdgcn_mfma_f32_32x32x16_bf16(vfrag(wl + ATT_V_OFF, 0, 1, lane), a1, o0, 0, 0, 0);
        o1 = __builtin_amdgcn_mfma_f32_32x32x16_bf16(vfrag(wl + ATT_V_OFF, 1, 0, lane), a0, o1, 0, 0, 0);
        o1 = __builtin_amdgcn_mfma_f32_32x32x16_bf16(vfrag(wl + ATT_V_OFF, 1, 1, lane), a1, o1, 0, 0, 0);
        if (__all(C < SB_EXIT)) break;
    }
    head_norm_store(o0, o1, 1.0f, F.sb_g + h * 64, F.MIX + (rowbase + 32 * qb + r32) * D + h * 64, hi);
}

#define SWA_HEAD(z, qslope, m_, den_, oa, ob) do { \
        float tmax_ = -INFINITY; f32x16 s_; \
        _Pragma("unroll") for (int r = 0; r < 16; ++r) { const int dist = dq - ((r & 3) + 8 * (r >> 2)); const float sv = z[r] * 0.125f - qslope * (float)dist; s_[r] = ((unsigned)dist < 128u) ? sv : -INFINITY; tmax_ = __builtin_fmaxf(tmax_, s_[r]); } \
        tmax_ = __builtin_fmaxf(tmax_, bits_f(partner32(f_bits(tmax_)))); \
        const float mn_ = __builtin_fmaxf(m_, tmax_); const float al_ = __builtin_amdgcn_exp2f((m_ - mn_) * LOG2E); m_ = mn_; \
        f32x16 p_; float ps_ = 0.f; \
        _Pragma("unroll") for (int r = 0; r < 16; ++r) { p_[r] = __builtin_amdgcn_exp2f((s_[r] - mn_) * LOG2E); ps_ += p_[r]; } \
        den_ = den_ * al_ + ps_; \
        _Pragma("unroll") for (int r = 0; r < 16; ++r) { oa[r] *= al_; ob[r] *= al_; } \
        const bf16x8 a0_ = pack8(p_, 0), a1_ = pack8(p_, 1); \
        oa = __builtin_amdgcn_mfma_f32_32x32x16_bf16(vf00, a0_, oa, 0, 0, 0); oa = __builtin_amdgcn_mfma_f32_32x32x16_bf16(vf01, a1_, oa, 0, 0, 0); \
        ob = __builtin_amdgcn_mfma_f32_32x32x16_bf16(vf10, a0_, ob, 0, 0, 0); ob = __builtin_amdgcn_mfma_f32_32x32x16_bf16(vf11, a1_, ob, 0, 0, 0); } while (0)
__device__ __forceinline__ void swa_item2(Frame& F, int b, int kv, int hp, int qb, LAS unsigned char* wl) {
    const int lane = F.lane, r32 = lane & 31, hi = lane >> 5, hqA = kv * 4 + 2 * hp, hqB = hqA + 1;
    const size_t rowbase = (size_t)b * SEQ;
    const bf16* QpA = F.QKV + (rowbase + 32 * qb) * DIN + C_SWQ + hqA * 64;
    const bf16* Kb = F.QKV + rowbase * DIN + C_SWK + kv * 64;
    const bf16* Vb = F.QKV + rowbase * DIN + C_SWV + kv * 64;
    const float slopeA = __builtin_amdgcn_exp2f(-(float)(hqA + 1)), slopeB = __builtin_amdgcn_exp2f(-(float)(hqB + 1));
    float mA = F.sinks[hqA], mB = F.sinks[hqB];
    bf16x8 qrA[4];
    { const Tile4 tq = tile_load(QpA, lane); tile_store(wl + ATT_K_OFF, KPITCH, tq, lane);
#pragma unroll
      for (int d0 = 0; d0 < 4; ++d0) qrA[d0] = kfrag(wl + ATT_K_OFF, d0, lane); }
    { const Tile4 tq = tile_load(QpA + 64, lane); tile_store(wl + ATT_Q_OFF, KPITCH, tq, lane); }
    float denA = hi == 0 ? 1.f : 0.f, denB = denA;
    f32x16 oA0 = {}, oA1 = {}, oB0 = {}, oB1 = {};
    const int kt0 = qb - 4 < 0 ? 0 : qb - 4;
    for (int kt = kt0; kt <= qb; ++kt) {
        { const Tile4 tk = tile_load(Kb + (size_t)(32 * kt) * DIN, lane), tv = tile_load(Vb + (size_t)(32 * kt) * DIN, lane);
          tile_store(wl + ATT_K_OFF, KPITCH, tk, lane); tile_store(wl + ATT_V_OFF, VPITCH, tv, lane); }
        const bf16x8 vf00 = vfrag(wl + ATT_V_OFF, 0, 0, lane), vf01 = vfrag(wl + ATT_V_OFF, 0, 1, lane), vf10 = vfrag(wl + ATT_V_OFF, 1, 0, lane), vf11 = vfrag(wl + ATT_V_OFF, 1, 1, lane);
        const int dq = 32 * (qb - kt) + r32 - 4 * hi;
        { f32x16 zA = {};
#pragma unroll
          for (int d0 = 0; d0 < 4; ++d0) zA = __builtin_amdgcn_mfma_f32_32x32x16_bf16(kfrag(wl + ATT_K_OFF, d0, lane), qrA[d0], zA, 0, 0, 0);
          SWA_HEAD(zA, slopeA, mA, denA, oA0, oA1); }
        { f32x16 zB = {};
#pragma unroll
          for (int d0 = 0; d0 < 4; ++d0) zB = __builtin_amdgcn_mfma_f32_32x32x16_bf16(kfrag(wl + ATT_K_OFF, d0, lane), kfrag(wl + ATT_Q_OFF, d0, lane), zB, 0, 0, 0);
          SWA_HEAD(zB, slopeB, mB, denB, oB0, oB1); }
    }
    denA += bits_f(partner32(f_bits(denA))); denB += bits_f(partner32(f_bits(denB)));
    bf16* dst = F.MIX + (rowbase + 32 * qb + r32) * D + 512 + hqA * 64;
    head_norm_store(oA0, oA1, 1.0f / denA, F.sw_g + hqA * 64, dst, hi);
    head_norm_store(oB0, oB1, 1.0f / denB, F.sw_g + hqB * 64, dst + 64, hi);
}
__device__ __forceinline__ void p2_attention(Frame& F) {
    LAS unsigned char* wl = F.lds + F.wave * 16384;
    static_assert(ATT_WAVE_BYTES <= 16384 && NWAVES * 16384 <= RING_BYTES, "attention LDS");
    const int gw = F.vcu * NWAVES + F.wave, NGW = F.G * NWAVES;
    constexpr int NSB = NB * 8 * 128, NSW = NB * 4 * 128;
    for (int it = gw; it < NSB + NSW; it += NGW) {
        if (it < NSB) { const int qb = it & 127, h = (it >> 7) & 7, b = it >> 10; sb_item(F, b, h, qb, wl); }
        else { const int r = it - NSB; const int qb = r & 127, hp = (r >> 7) & 1, kv = (r >> 8) & 1, b = r >> 9; swa_item2(F, b, kv, hp, qb, wl); }
    }
}

__device__ __forceinline__ int f2ord(unsigned bits) { int x = (int)bits; return x ^ ((x >> 31) & 0x7fffffff); }
template <int N> __device__ __forceinline__ void bitonic_desc(int (&v)[N]) {
#pragma unroll
    for (int k = 2; k <= N; k <<= 1) {
#pragma unroll
        for (int j = k >> 1; j > 0; j >>= 1) {
#pragma unroll
            for (int i = 0; i < N; ++i) {
                const int l = i ^ j;
                if (l > i) { const bool up = ((i & k) == 0); const int a = v[i], b = v[l]; const int mx = a > b ? a : b, mn = a > b ? b : a; v[i] = up ? mx : mn; v[l] = up ? mn : mx; }
            }
        }
    }
}
template <int N> __device__ __forceinline__ void bitonic_merge_desc(int (&v)[N]) {
#pragma unroll
    for (int j = N >> 1; j > 0; j >>= 1) {
#pragma unroll
        for (int i = 0; i < N; ++i) { const int l = i ^ j; if (l > i) { const int a = v[i], b = v[l]; v[i] = a > b ? a : b; v[l] = a > b ? b : a; } }
    }
}
template <int N> __device__ __forceinline__ void bitonic_desc_kv(int (&k)[N], int (&p)[N]) {
#pragma unroll
    for (int kk = 2; kk <= N; kk <<= 1) {
#pragma unroll
        for (int j = kk >> 1; j > 0; j >>= 1) {
#pragma unroll
            for (int i = 0; i < N; ++i) {
                const int l = i ^ j;
                if (l > i) { const bool up = ((i & kk) == 0); const bool sw = up ? (k[i] < k[l]) : (k[i] > k[l]);
                    const int ka = k[i], kb = k[l], pa = p[i], pb = p[l]; k[i] = sw ? kb : ka; k[l] = sw ? ka : kb; p[i] = sw ? pb : pa; p[l] = sw ? pa : pb; }
            }
        }
    }
}
struct Cand { unsigned char i, j; };
struct CandTable { Cand c[64]; int n; };
constexpr CandTable make_cands() { CandTable t{}; int n = 0; for (int i = 0; i < 16; ++i) for (int j = 0; j < 16; ++j) if ((i + 1) * (j + 1) <= 16) { t.c[n].i = (unsigned char)i; t.c[n].j = (unsigned char)j; ++n; } t.n = n; return t; }
constexpr CandTable CANDS = make_cands();
static_assert(CANDS.n == 50, "candidate count");

constexpr int P6_PITCH = 272, P6_KEYS_BYTES = 128 * P6_PITCH, P6_Q_BYTES = 32 * P6_PITCH;
static_assert(2 * P6_KEYS_BYTES + NWAVES * P6_Q_BYTES <= RING_BYTES, "P6 LDS map");
__device__ __forceinline__ void p6_item(Frame& F, int tb, int h, LAS unsigned char* keys_lds, LAS unsigned char* qw) {
    const int lane = F.lane, r32 = lane & 31, hi = lane >> 5;
    const bf16* QP = F.QKV;
    int top0[16], top1[16];
#pragma unroll 1
    for (int half = 0; half < 2; ++half) {
        { const bf16* qsrc = QP + (size_t)(32 * tb + (lane >> 4)) * DQ + h * 256 + half * 128 + 8 * (lane & 15);
          u32x4 t_[8];
#pragma unroll
          for (int i = 0; i < 8; ++i) t_[i] = *(const GAS u32x4*)(qsrc + (size_t)(4 * i) * DQ);
#pragma unroll
          for (int i = 0; i < 8; ++i) *(LAS u32x4*)(qw + (4 * i + (lane >> 4)) * P6_PITCH + 16 * (lane & 15)) = t_[i]; }
        bf16x8 qf[8];
#pragma unroll
        for (int ks = 0; ks < 8; ++ks) { const u32x4 w_ = *(const LAS u32x4*)(qw + r32 * P6_PITCH + 32 * ks + 16 * hi); qf[ks] = __builtin_bit_cast(bf16x8, w_); }
        const LAS unsigned char* kb = keys_lds + half * P6_KEYS_BYTES + r32 * P6_PITCH + 16 * hi;
        int v[64];
#pragma unroll
        for (int nt = 0; nt < 4; ++nt) {
            f32x16 acc = {};
#pragma unroll
            for (int ks = 0; ks < 8; ++ks) { const u32x4 w_ = *(const LAS u32x4*)(kb + (32 * nt) * P6_PITCH + 32 * ks); acc = __builtin_amdgcn_mfma_f32_32x32x16_bf16(__builtin_bit_cast(bf16x8, w_), qf[ks], acc, 0, 0, 0); }
#pragma unroll
            for (int r = 0; r < 16; ++r) { const float av = acc[r]; const unsigned bits = (f_bits(av) & ~0x7Fu) | (unsigned)(32 * nt + crow(r, hi)); v[16 * nt + r] = f2ord(bits); }
        }
        bitonic_desc<64>(v);
        int m[16];
#pragma unroll
        for (int i = 0; i < 16; ++i) { const int o = (int)partner32((unsigned)v[15 - i]); m[i] = v[i] > o ? v[i] : o; }
        bitonic_merge_desc<16>(m);
#pragma unroll
        for (int i = 0; i < 16; ++i) { if (half == 0) top0[i] = m[i]; else top1[i] = m[i]; }
    }
    float f1[16], f2[16]; int i1[16], i2[16];
#pragma unroll
    for (int i = 0; i < 16; ++i) { const unsigned b1 = (unsigned)f2ord((unsigned)top0[i]), b2 = (unsigned)f2ord((unsigned)top1[i]);
        f1[i] = bits_f(b1 & ~0x7Fu); i1[i] = (int)(b1 & 0x7Fu); f2[i] = bits_f(b2 & ~0x7Fu); i2[i] = (int)(b2 & 0x7Fu); }
    int ck[32], cp[32];
#pragma unroll
    for (int s = 0; s < 32; ++s) {
        if (s < 25) { constexpr int dummy = 0; (void)dummy;
            const int ia = CANDS.c[2 * s].i, ja = CANDS.c[2 * s].j, ib = CANDS.c[2 * s + 1].i, jb = CANDS.c[2 * s + 1].j;
            const float sa = f1[ia] + f2[ja], sb = f1[ib] + f2[jb]; const int pa = (i1[ia] << 7) | i2[ja], pb = (i1[ib] << 7) | i2[jb];
            ck[s] = f2ord(f_bits(hi ? sb : sa)); cp[s] = hi ? pb : pa;
        } else { ck[s] = (int)0x80000000; cp[s] = 0; }
    }
    bitonic_desc_kv<32>(ck, cp);
    int wk[16], wp[16];
#pragma unroll
    for (int i = 0; i < 16; ++i) { const int ok = (int)partner32((unsigned)ck[15 - i]), op = (int)partner32((unsigned)cp[15 - i]); const bool t = ck[i] >= ok; wk[i] = t ? ck[i] : ok; wp[i] = t ? cp[i] : op; }
    float vals[16]; float mxv = -INFINITY;
#pragma unroll
    for (int i = 0; i < 16; ++i) { vals[i] = bits_f((unsigned)f2ord((unsigned)wk[i])); mxv = __builtin_fmaxf(mxv, vals[i]); }
    float se = 0.f;
#pragma unroll
    for (int i = 0; i < 16; ++i) { vals[i] = __builtin_amdgcn_exp2f((vals[i] - mxv) * LOG2E); se += vals[i]; }
    const float inv = 1.0f / se;
    const size_t ob = (size_t)(32 * tb + r32) * 128 + h * 16 + hi * 8;
    { u32x4 a; a.x = (unsigned)wp[0] | ((unsigned)wp[1] << 16); a.y = (unsigned)wp[2] | ((unsigned)wp[3] << 16); a.z = (unsigned)wp[4] | ((unsigned)wp[5] << 16); a.w = (unsigned)wp[6] | ((unsigned)wp[7] << 16);
      *(GAS u32x4*)(F.IDX + ob) = a;
      f32x4 ga = {vals[0] * inv, vals[1] * inv, vals[2] * inv, vals[3] * inv}, gb = {vals[4] * inv, vals[5] * inv, vals[6] * inv, vals[7] * inv};
      *(GAS f32x4*)(F.GATE + ob) = ga; *(GAS f32x4*)(F.GATE + ob + 4) = gb; }
}
template <class Sched> __device__ __forceinline__ void p6_topk_own(Frame& F, const Sched& S) {
    LAS unsigned char* keys_lds = F.lds; LAS unsigned char* qw = F.lds + 2 * P6_KEYS_BYTES + F.wave * P6_Q_BYTES;
    pg8::Unit u; int hprev = -1;
    for (int i = 0; S.next(i, u); ++i) {
        const int h = u.pn;
        if (h != hprev) {
            __syncthreads();
#pragma unroll
            for (int half = 0; half < 2; ++half) {
                const bf16* ksrc = F.KEYS + (size_t)(half * 8 + h) * 128 * 128 + (size_t)(F.tid >> 4) * 128 + 8 * (F.tid & 15);
                u32x4 t_[4];
#pragma unroll
                for (int q = 0; q < 4; ++q) t_[q] = *(const GAS u32x4*)(ksrc + (size_t)(32 * q) * 128);
#pragma unroll
                for (int q = 0; q < 4; ++q) *(LAS u32x4*)(keys_lds + half * P6_KEYS_BYTES + ((F.tid >> 4) + 32 * q) * P6_PITCH + 16 * (F.tid & 15)) = t_[q];
            }
            __syncthreads(); hprev = h;
        }
        p6_item(F, 8 * u.pm + F.wave, h, keys_lds, qw);
    }
    { const int gw_ = F.vcu * NWAVES + F.wave, NGW_ = F.G * NWAVES; for (int r = NEXP + gw_; r < 2 * NEXP; r += 4 * NGW_) cvt_rows_fp8<4>(F, r, NGW_, 2 * NEXP, F.lane); }
    __syncthreads();
}

__device__ __forceinline__ float dpp_xor1(float v) { return v + bits_f((unsigned)__builtin_amdgcn_update_dpp(0, (int)f_bits(v), 0xB1, 0xf, 0xf, false)); }
__device__ __forceinline__ float dpp_xor2(float v) { return v + bits_f((unsigned)__builtin_amdgcn_update_dpp(0, (int)f_bits(v), 0x4E, 0xf, 0xf, false)); }
__device__ __forceinline__ float dpp_hmir(float v) { return v + bits_f((unsigned)__builtin_amdgcn_update_dpp(0, (int)f_bits(v), 0x141, 0xf, 0xf, false)); }
__device__ __forceinline__ float dpp_max_xor1(float v) { return __builtin_fmaxf(v, bits_f((unsigned)__builtin_amdgcn_update_dpp(0, (int)f_bits(v), 0xB1, 0xf, 0xf, false))); }
__device__ __forceinline__ float dpp_max_xor2(float v) { return __builtin_fmaxf(v, bits_f((unsigned)__builtin_amdgcn_update_dpp(0, (int)f_bits(v), 0x4E, 0xf, 0xf, false))); }
__device__ __forceinline__ float dpp_max_hmir(float v) { return __builtin_fmaxf(v, bits_f((unsigned)__builtin_amdgcn_update_dpp(0, (int)f_bits(v), 0x141, 0xf, 0xf, false))); }
__device__ __forceinline__ float dpp_rmir(float v) { return v + bits_f((unsigned)__builtin_amdgcn_update_dpp(0, (int)f_bits(v), 0x140, 0xf, 0xf, false)); }
__device__ __forceinline__ f32x2_t fp8x2(unsigned w, bool hi) { return hi ? __builtin_amdgcn_cvt_pk_f32_fp8((int)w, true) : __builtin_amdgcn_cvt_pk_f32_fp8((int)w, false); }
__device__ __forceinline__ float gelu_tanh(float x) {
    const float y2 = 1.5957691216057308f * (x + 0.044715f * x * x * x);
    return x / (1.0f + __builtin_amdgcn_exp2f(-y2 * LOG2E));
}
__device__ __forceinline__ unsigned vsel16(const u32x4 (&v)[2], int k) { const u32x4 q = v[k >> 3]; const int j = (k >> 1) & 3; const unsigned w = j == 0 ? q.x : j == 1 ? q.y : j == 2 ? q.z : q.w; return (k & 1) ? (w >> 16) : (w & 0xffffu); }
struct TokIn { u32x4 id[2]; u32x4 x0, x1; };
__device__ __forceinline__ int vsel(const u32x4 (&v)[4], int k) { const u32x4 q = v[k >> 2]; const int j = k & 3; return (int)(j == 0 ? q.x : j == 1 ? q.y : j == 2 ? q.z : q.w); }
__device__ __forceinline__ void p7_udots(Frame& F) {
    const int lane = F.lane, g = lane >> 3, c = lane & 7;
    const int s = blockIdx.x & 7, rank = blockIdx.x >> 3, nloc = F.G >> 3;
    const unsigned char* tab = F.U8 + (size_t)s * TAB8_SLICE; const unsigned coff16 = 16u * (unsigned)c;
    bf16* pd = F.PD + (size_t)s * T * 128;
    const int t0 = rank * NWAVES + F.wave, tstride = nloc * NWAVES;
#define P7_IDS(dst, tt) do { const int t_ = (tt) < T ? (tt) : t0; const GAS u32x4* ip_ = (const GAS u32x4*)(F.IDX + (size_t)t_ * 128 + 16 * g); dst.id[0] = ip_[0]; dst.id[1] = ip_[1]; } while (0)
#define P7_X(dst, tt) do { const int t_ = (tt) < T ? (tt) : t0; const bf16* xr_ = F.H + (size_t)t_ * D + 128 * s + 16 * c; dst.x0 = *(const GAS u32x4*)xr_; dst.x1 = *(const GAS u32x4*)(xr_ + 8); } while (0)
#define P7_PCS(pc, in) do { _Pragma("unroll") for (int k = 0; k < 16; ++k) pc[k] = *(const GAS u32x4*)(tab + ((vsel16(in.id, k) << 7) | coff16)); } while (0)
#define P7_MATH(pc, in, tt) do { if ((tt) < T) { \
        float xv[16]; { const unsigned a0 = in.x0.x, a1 = in.x0.y, a2 = in.x0.z, a3 = in.x0.w, b0 = in.x1.x, b1 = in.x1.y, b2 = in.x1.z, b3 = in.x1.w; \
          xv[0] = bf_lo(a0); xv[1] = bf_hi(a0); xv[2] = bf_lo(a1); xv[3] = bf_hi(a1); xv[4] = bf_lo(a2); xv[5] = bf_hi(a2); xv[6] = bf_lo(a3); xv[7] = bf_hi(a3); \
          xv[8] = bf_lo(b0); xv[9] = bf_hi(b0); xv[10] = bf_lo(b1); xv[11] = bf_hi(b1); xv[12] = bf_lo(b2); xv[13] = bf_hi(b2); xv[14] = bf_lo(b3); xv[15] = bf_hi(b3); } \
          \
        float xm = 0.f; _Pragma("unroll") for (int i = 0; i < 16; ++i) xm = __builtin_fmaxf(xm, __builtin_fabsf(xv[i])); \
        xm = dpp_max_hmir(dpp_max_xor2(dpp_max_xor1(xm))); \
        const float sx = xm > 0.f ? 127.0f / xm : 0.f, isx = xm * (1.0f / 127.0f); \
        const int xq0 = pack_i8(xv[0] * sx, xv[1] * sx, xv[2] * sx, xv[3] * sx), xq1 = pack_i8(xv[4] * sx, xv[5] * sx, xv[6] * sx, xv[7] * sx), \
                  xq2 = pack_i8(xv[8] * sx, xv[9] * sx, xv[10] * sx, xv[11] * sx), xq3 = pack_i8(xv[12] * sx, xv[13] * sx, xv[14] * sx, xv[15] * sx); \
        float r0 = 0.f, r1 = 0.f; \
        _Pragma("unroll") for (int k = 0; k < 16; ++k) { \
            const unsigned w0 = pc[k].x, w1 = pc[k].y, w2 = pc[k].z, w3 = pc[k].w; \
            int ia = __builtin_amdgcn_sdot4((int)w0, xq0, 0, false); ia = __builtin_amdgcn_sdot4((int)w1, xq1, ia, false); ia = __builtin_amdgcn_sdot4((int)w2, xq2, ia, false); ia = __builtin_amdgcn_sdot4((int)w3, xq3, ia, false); \
            float p = (float)ia; p = dpp_hmir(dpp_xor2(dpp_xor1(p))); \
            if (k < 8) r0 = (c == k) ? p : r0; else r1 = (c == (k - 8)) ? p : r1; } \
        r0 *= isx; r1 *= isx; \
        pd[(size_t)(tt) * 128 + 16 * g + c] = (bf16)(pk2(r0, r0) & 0xffffu); pd[(size_t)(tt) * 128 + 16 * g + 8 + c] = (bf16)(pk2(r1, r1) & 0xffffu); } } while (0)
    TokIn inA, inB, inC, inN; u32x4 pcA[16], pcB[16], pcC[16];
    P7_IDS(inA, t0); P7_X(inA, t0); P7_PCS(pcA, inA); P7_IDS(inB, t0 + tstride); P7_X(inB, t0 + tstride); P7_PCS(pcB, inB); P7_IDS(inC, t0 + 2 * tstride);
    for (int t = t0; t < T; t += 3 * tstride) {
        P7_X(inC, t + 2 * tstride); P7_PCS(pcC, inC); P7_IDS(inN, t + 3 * tstride); __builtin_amdgcn_sched_barrier(0);
        P7_MATH(pcA, inA, t); __builtin_amdgcn_sched_barrier(0);
        inA.id[0] = inN.id[0]; inA.id[1] = inN.id[1];
        P7_X(inA, t + 3 * tstride); P7_PCS(pcA, inA); P7_IDS(inN, t + 4 * tstride); __builtin_amdgcn_sched_barrier(0);
        P7_MATH(pcB, inB, t + tstride); __builtin_amdgcn_sched_barrier(0);
        inB.id[0] = inN.id[0]; inB.id[1] = inN.id[1];
        P7_X(inB, t + 4 * tstride); P7_PCS(pcB, inB); P7_IDS(inN, t + 5 * tstride); __builtin_amdgcn_sched_barrier(0);
        P7_MATH(pcC, inC, t + 2 * tstride); __builtin_amdgcn_sched_barrier(0);
        inC.id[0] = inN.id[0]; inC.id[1] = inN.id[1];
    }
#undef P7_IDS
#undef P7_X
#undef P7_PCS
#undef P7_MATH
}
__device__ __forceinline__ void p8_combine(Frame& F) {
    const int gw = F.vcu * NWAVES + F.wave, NGW = F.G * NWAVES, lane = F.lane;
    constexpr int NU = 4;
    for (int t0 = gw; t0 < T; t0 += NU * NGW) {
        unsigned pdw[NU][8], idw[NU]; f32x2_t gt[NU];
#pragma unroll
        for (int u = 0; u < NU; ++u) { const int t = t0 + u * NGW < T ? t0 + u * NGW : t0; const size_t o = (size_t)t * 128 + 2 * lane;
#pragma unroll
            for (int s = 0; s < 8; ++s) pdw[u][s] = __builtin_nontemporal_load((const GAS unsigned*)(F.PD + (size_t)s * T * 128 + o));
            idw[u] = *(const GAS unsigned*)(F.IDX + o); gt[u] = __builtin_nontemporal_load((const GAS f32x2_t*)(F.GATE + o)); }
        float ru0[NU], ru1[NU], rv0[NU], rv1[NU], r2[NU];
#pragma unroll
        for (int u = 0; u < NU; ++u) { const int t = t0 + u * NGW < T ? t0 + u * NGW : t0; const int i0 = (int)(idw[u] & 0xffffu), i1 = (int)(idw[u] >> 16);
            ru0[u] = F.RSU[i0]; ru1[u] = F.RSU[i1]; rv0[u] = F.RSV[i0]; rv1[u] = F.RSV[i1]; r2[u] = F.RS2[t]; }
#pragma unroll
        for (int u = 0; u < NU; ++u) { const int t = t0 + u * NGW;
            float d0 = 0.f, d1 = 0.f;
#pragma unroll
            for (int s = 0; s < 8; ++s) { const unsigned w = pdw[u][s]; d0 += bf_lo(w); d1 += bf_hi(w); }
            const float c0 = gt[u].x * gelu_tanh(d0 * ru0[u] * r2[u]) * rv0[u], c1 = gt[u].y * gelu_tanh(d1 * ru1[u] * r2[u]) * rv1[u];
            const float m = wave_max(__builtin_fmaxf(__builtin_fabsf(c0), __builtin_fabsf(c1)));
            const float sq = m > 0.f ? 127.0f / m : 0.f;
            const int q0 = (int)__builtin_rintf(c0 * sq), q1 = (int)__builtin_rintf(c1 * sq);
            if (t < T) { *(GAS unsigned short*)(F.C8 + (size_t)t * 128 + 2 * lane) = (unsigned short)((q0 & 0xff) | ((q1 & 0xff) << 8)); if (lane == 0) F.CS[t] = m * (1.0f / 127.0f); } }
    }
}
typedef int v2i_t __attribute__((ext_vector_type(2)));
typedef int v4i_t __attribute__((ext_vector_type(4)));
constexpr int P9_PITCH = 144, P9_WAVE_BYTES = 128 * P9_PITCH, P9_OSC_OFF = LDSCTL_OFF + 512;
static_assert(NWAVES * P9_WAVE_BYTES <= RING_BYTES && P9_OSC_OFF + NWAVES * 512 <= LDS_BYTES, "P9 LDS map");
struct TokInV { u32x4 id[2]; u32x4 a0, a1; u32x2 xb; float cs; };
__device__ __forceinline__ void p9_vacc(Frame& F) {
    const int lane = F.lane, g = lane >> 3, c = lane & 7, m16 = lane & 15, q = lane >> 4;
    const int s = blockIdx.x & 7, rank = blockIdx.x >> 3, nloc = F.G >> 3;
    const unsigned char* tab = F.V8 + (size_t)s * TAB8_SLICE; const unsigned coff16 = 16u * (unsigned)c;
    const int t0 = rank * NWAVES + F.wave, tstride = nloc * NWAVES;
    LAS unsigned char* wl = F.lds + F.wave * P9_WAVE_BYTES;
    LAS float* osc = (LAS float*)(F.lds + P9_OSC_OFF + F.wave * 512);
    LAS unsigned char* wst = wl + (16 * g) * P9_PITCH + 16 * c;
    const LAS unsigned char* wrd = wl + (16 * q + (m16 >> 1)) * P9_PITCH + 8 * (m16 & 1);
    const int coff = 128 * s + 4 * (lane & 31);
#define P9_IN(dst, tt) do { const int t_ = (tt) < T ? (tt) : t0; const GAS u32x4* ip_ = (const GAS u32x4*)(F.IDX + (size_t)t_ * 128 + 16 * g); dst.id[0] = ip_[0]; dst.id[1] = ip_[1]; \
        const GAS u32x4* cp_ = (const GAS u32x4*)(F.C8 + (size_t)t_ * 128 + 16 * q); const u32x4 z_ = {0u, 0u, 0u, 0u}; dst.a0 = cp_[0]; dst.a1 = cp_[4]; if (m16 != 0) { dst.a0 = z_; dst.a1 = z_; } \
        dst.xb = *(const GAS u32x2*)(F.H + (size_t)t_ * D + coff); dst.cs = F.CS[t_]; } while (0)
#define P9_PCS(pc, in) do { _Pragma("unroll") for (int k = 0; k < 16; ++k) pc[k] = *(const GAS u32x4*)(tab + ((vsel16(in.id, k) << 7) | coff16)); } while (0)
#define P9_STAGE(pc) do { _Pragma("unroll") for (int k = 0; k < 16; ++k) *(LAS u32x4*)(wst + k * P9_PITCH) = pc[k]; } while (0)
#define P9_MATH(in, tt) do { if ((tt) < T) { \
        v4i_t acc[8]; _Pragma("unroll") for (int nb = 0; nb < 8; ++nb) acc[nb] = (v4i_t){0, 0, 0, 0}; \
        _Pragma("unroll") for (int s2 = 0; s2 < 2; ++s2) { const v4i_t av = __builtin_bit_cast(v4i_t, s2 ? in.a1 : in.a0); \
            _Pragma("unroll") for (int nb = 0; nb < 8; ++nb) { \
                const v2i_t lo = __builtin_amdgcn_ds_read_tr8_b64_v2i32((LAS v2i_t*)(wrd + (64 * s2) * P9_PITCH + 16 * nb)); \
                const v2i_t hi = __builtin_amdgcn_ds_read_tr8_b64_v2i32((LAS v2i_t*)(wrd + (64 * s2 + 8) * P9_PITCH + 16 * nb)); \
                const v4i_t bv = {lo.x, lo.y, hi.x, hi.y}; \
                acc[nb] = __builtin_amdgcn_mfma_i32_16x16x64_i8(av, bv, acc[nb], 0, 0, 0); } } \
          \
        if (lane < 16) { _Pragma("unroll") for (int nb = 0; nb < 8; ++nb) osc[16 * nb + lane] = (float)acc[nb][0] * in.cs; } \
        asm volatile("" ::: "memory"); \
        float ss = 0.f; \
        if (lane < 32) { const f32x4 d_ = *(const LAS f32x4*)(osc + 4 * lane); bf16* op_ = F.X2 + (size_t)(tt) * D + coff; const unsigned xb0_ = in.xb.x, xb1_ = in.xb.y; \
            const f32x4 y = {bf_lo(xb0_) + d_[0], bf_hi(xb0_) + d_[1], bf_lo(xb1_) + d_[2], bf_hi(xb1_) + d_[3]}; \
            ss = (y.x * y.x + y.y * y.y) + (y.z * y.z + y.w * y.w); u32x2 yw_; yw_.x = pk2(y.x, y.y); yw_.y = pk2(y.z, y.w); *(GAS u32x2*)op_ = yw_; } \
        ss = dpp_rmir(dpp_hmir(dpp_xor2(dpp_xor1(ss)))); if ((lane & 47) == 0) F.SSP[((size_t)s * T + (tt)) * 2 + (lane >> 4)] = ss; } } while (0)
    TokInV inA, inB, inC; u32x4 pcA[16], pcB[16];
    P9_IN(inA, t0); P9_PCS(pcA, inA); P9_IN(inB, t0 + tstride); P9_PCS(pcB, inB); P9_IN(inC, t0 + 2 * tstride);
    for (int t = t0; t < T; t += 2 * tstride) {
        TokInV inD, inE;
        P9_STAGE(pcA); P9_PCS(pcA, inC); P9_IN(inD, t + 3 * tstride); __builtin_amdgcn_sched_barrier(0);
        P9_MATH(inA, t); __builtin_amdgcn_sched_barrier(0);
        P9_STAGE(pcB); P9_PCS(pcB, inD); P9_IN(inE, t + 4 * tstride); __builtin_amdgcn_sched_barrier(0);
        P9_MATH(inB, t + tstride); __builtin_amdgcn_sched_barrier(0);
        inA = inC; inB = inD; inC = inE;
    }
#undef P9_IN
#undef P9_PCS
#undef P9_STAGE
#undef P9_MATH
}
__device__ __forceinline__ void p10_final(Frame& F) {
    const int gw = F.vcu * NWAVES + F.wave, NGW = F.G * NWAVES, lane = F.lane;
    for (int t = gw; t < T; t += NGW) {
        float ss = 0.f;
#pragma unroll
        for (int s = 0; s < 8; ++s) ss += F.SSP[((size_t)s * T + t) * 2] + F.SSP[((size_t)s * T + t) * 2 + 1];
        const float rs = __builtin_amdgcn_rsqf(ss * (1.f / D) + EPS);
        GAS f32x4* xr = (GAS f32x4*)(F.out + (size_t)t * D) + lane; const GAS f32x4* gr = (const GAS f32x4*)F.gf + lane; const GAS u32x2* br = (const GAS u32x2*)(F.X2 + (size_t)t * D) + lane;
#pragma unroll
        for (int j = 0; j < 4; ++j) { const u32x2 w = __builtin_nontemporal_load(br + 64 * j); const unsigned w0 = w.x, w1 = w.y; const f32x4 gg = gr[64 * j]; __builtin_nontemporal_store((f32x4){bf_lo(w0) * rs * gg.x, bf_hi(w0) * rs * gg.y, bf_lo(w1) * rs * gg.z, bf_hi(w1) * rs * gg.w}, xr + 64 * j); }
    }
}
struct Args { const float* in[14]; float* out; unsigned char* ws; int ph_lo, ph_hi, li, pad; };
__global__ void __launch_bounds__(NWAVES * 64, 2) mk_fwd(Args args) {
    extern __shared__ __attribute__((aligned(16))) unsigned char lds[];
#ifdef PROBE_LO
    unsigned long long pmk_lo = 0, pmk_hi = 0;
    if (PROBE_LO == -1) { asm volatile("s_memrealtime %0\n\ts_waitcnt lgkmcnt(0)" : "=s"(pmk_lo) :: "memory"); }
#endif
    Frame F;
    F.lds = (LAS unsigned char*)lds;
    F.MISC = (volatile LAS unsigned*)(F.lds + MISC_OFF);
    F.tid = threadIdx.x; F.lane = F.tid & 63; F.wave = __builtin_amdgcn_readfirstlane(F.tid >> 6);
    F.G = gridDim.x; { const int bx = blockIdx.x; F.vcu = (F.G % 8 == 0) ? (bx % 8) * (F.G / 8) + bx / 8 : bx; }
    unsigned char* ws = args.ws;
    F.ctl = (gu32*)(ws + WS_CTL);
    F.x = args.in[0]; F.g1 = args.in[1]; F.w_in = args.in[2]; F.sb_g = args.in[3]; F.sw_g = args.in[4]; F.sinks = args.in[5]; F.w_out = args.in[6]; F.g2 = args.in[7];
    F.w_q = args.in[8]; F.keys1 = args.in[9]; F.keys2 = args.in[10]; F.pu = args.in[11]; F.pv = args.in[12]; F.gf = args.in[13]; F.out = args.out;
    F.Wt_in = (bf16*)(ws + WS_WIN); F.Wt_out = (bf16*)(ws + WS_WOUT); F.Wt_q = (bf16*)(ws + WS_WQ); F.KEYS = (bf16*)(ws + WS_KEYS);
    F.H = (bf16*)(ws + WS_H); F.MIX = (bf16*)(ws + WS_MIX); F.QKV = (bf16*)(ws + WS_QKV); F.U8 = ws + WS_U8; F.V8 = ws + WS_V8; F.RSU = (float*)(ws + WS_RSU); F.RSV = (float*)(ws + WS_RSV);
    F.SSQP = (float*)(ws + WS_SSQP); F.RS2 = (float*)(ws + WS_RS2); F.PD = (bf16*)(ws + WS_PD); F.X2 = (bf16*)(ws + WS_X2); F.C8 = ws + WS_C; F.CS = (float*)(ws + WS_C + 6 * MiB); F.SSP = (float*)(ws + WS_SSP);
    F.IDX = (unsigned short*)(ws + WS_IDX); F.GATE = (float*)(ws + WS_GATE);
    for (int u = F.tid; u < (LDS_BYTES - LDSCTL_OFF) / 4; u += NWAVES * 64) ((LAS unsigned*)(F.lds + LDSCTL_OFF))[u] = 0u;
    __syncthreads();
    const int lo = args.ph_lo, hi = args.ph_hi;
    const bool use_bar = (hi - lo) > 1;
    XcdBarrier bar; bar.bar = (unsigned*)(F.ctl + CW_BAR) + args.li * XCD_BAR_WORDS; bar.x = 0; bar.st = nullptr;
    if (use_bar) bar = xcd_barrier_post((unsigned*)(F.ctl + CW_BAR) + args.li * XCD_BAR_WORDS, F.MISC + 8);
#ifndef PHMASK
#define PHMASK 2047
#endif
#define IN(k) (((PHMASK >> (k)) & 1) && lo <= (k) && (k) < hi)
#define SEAM(k) do { if (IN(k) && IN((k) + 1)) xcd_barrier(bar); } while (0)
    const int gw = F.vcu * NWAVES + F.wave, NGW = F.G * NWAVES;
#ifdef PROBE_LO
#define PSTAMP(v) asm volatile("s_memrealtime %0\n\ts_waitcnt lgkmcnt(0)" : "=s"(v) :: "memory")
#define PMARK(k) do { if ((k) == PROBE_LO) { PSTAMP(pmk_lo); } if ((k) == PROBE_HI + 1) { PSTAMP(pmk_hi); } } while (0)
#else
#define PMARK(k) do {} while (0)
#endif

    PMARK(0);
    if (IN(0)) { p0_prologue(F); } SEAM(0);
    PMARK(1);
    if (IN(1)) { pg8::Gemm g{F.H, F.Wt_in, T, DIN, D}; pg8::StaticOrder S; S.init(T, DIN, F.G, (int)blockIdx.x); pg8::EpiBf16 E{F.QKV, DIN};
        pg8::gemm_phase<pg8::EpiBf16, pg8::StaticOrder>(F.lds, g, S, E);
        { const int nfull = (T / 256) * (DIN / 256) % F.G, nb = F.G - nfull;
          if (nb == F.G) { for (int r = (int)blockIdx.x * NWAVES + F.wave; r < NEXP; r += 4 * F.G * NWAVES) cvt_rows_fp8<4>(F, r, F.G * NWAVES, NEXP, F.lane); }
          else if ((int)blockIdx.x >= nfull) { for (int r = ((int)blockIdx.x - nfull) * NWAVES + F.wave; r < NEXP; r += 4 * nb * NWAVES) cvt_rows_fp8<4>(F, r, nb * NWAVES, NEXP, F.lane); } }
        } SEAM(1);
    PMARK(2);
    if (IN(2)) { p2_attention(F); } SEAM(2);
    PMARK(3);
    if (IN(3)) { pg8::Gemm g{F.MIX, F.Wt_out, T, D, D}; pg8::StaticOrder S; S.init(T, D, F.G, (int)blockIdx.x); pg8::EpiResB E{F.x, F.H, D, F.SSQP};
        pg8::gemm_phase<pg8::EpiResB, pg8::StaticOrder>(F.lds, g, S, E); } SEAM(3);
    PMARK(4);
    PMARK(5);
    if (IN(5)) { pg8::Gemm g{F.H, F.Wt_q, T, DQ, D}; pg8::StaticOrder S; S.init(T, DQ, F.G, (int)blockIdx.x); pg8::EpiBf16RS E{F.QKV, DQ, F.SSQP, F.RS2};
        pg8::gemm_phase<pg8::EpiBf16RS, pg8::StaticOrder>(F.lds, g, S, E);
        asm volatile("s_waitcnt vmcnt(0)" ::: "memory"); __syncthreads();
        p6_topk_own(F, S); }
    PMARK(6);
    SEAM(6);
    PMARK(7);
    if (IN(7)) { p7_udots(F); } SEAM(7);
    PMARK(8);
    if (IN(8)) { p8_combine(F); } SEAM(8);
    PMARK(9);
    if (IN(9)) { p9_vacc(F); } SEAM(9);
    PMARK(10);
    if (IN(10)) { p10_final(F); }
#ifdef PROBE_LO
    xcd_barrier(bar);
    PMARK(11);
    if (blockIdx.x == 0 && F.tid == 0) { unsigned long long t0, t1; PSTAMP(t0); const unsigned long long dl = (pmk_hi - pmk_lo) * PROBE_MULT;
        do { __builtin_amdgcn_s_sleep(8); PSTAMP(t1); } while (t1 - t0 < dl); }
#endif
#undef IN
#undef SEAM
}

extern "C" void kernel_launch(void* const* d_in, const int* in_sizes, int n_in, void* d_out, int out_size, void* d_ws, size_t ws_size, hipStream_t stream) {
    static int grid = 0;
    if (grid == 0) {
        if (n_in != 14 || in_sizes[0] != T * D || out_size != T * D || ws_size < WS_END) { fprintf(stderr, "kernel_launch: unexpected shapes (n_in %d, in0 %d, out %d, ws %zu)\n", n_in, n_in > 0 ? in_sizes[0] : -1, out_size, ws_size); grid = -1; return; }
        int dev = 0, cus = 0, per_cu = 0;
        if (hipGetDevice(&dev) != hipSuccess || hipDeviceGetAttribute(&cus, hipDeviceAttributeMultiprocessorCount, dev) != hipSuccess) { grid = -1; return; }
        if (hipFuncSetAttribute((const void*)mk_fwd, hipFuncAttributeMaxDynamicSharedMemorySize, LDS_BYTES) != hipSuccess) { fprintf(stderr, "kernel_launch: hipFuncSetAttribute failed\n"); grid = -1; return; }
        if (hipOccupancyMaxActiveBlocksPerMultiprocessor(&per_cu, (const void*)mk_fwd, NWAVES * 64, LDS_BYTES) != hipSuccess || per_cu < 1)
            fprintf(stderr, "kernel_launch: note: occupancy query reports %d workgroups per CU\n", per_cu);
        (void)hipGetLastError();
        grid = cus;
    }
    if (grid < 0) return;
    if (hipMemsetAsync((char*)d_ws + WS_CTL, 0, CTL_ZERO_BYTES, stream) != hipSuccess) { fprintf(stderr, "kernel_launch: hipMemsetAsync failed\n"); return; }
    Args a{};
    for (int i = 0; i < 14; ++i) a.in[i] = (const float*)d_in[i];
    a.out = (float*)d_out; a.ws = (unsigned char*)d_ws;
#if MK_N_LAUNCHES == 1
    a.ph_lo = 0; a.ph_hi = N_PHASES; a.li = 0;
    hipLaunchKernelGGL(mk_fwd, dim3(grid), dim3(NWAVES * 64), LDS_BYTES, stream, a);
#else
    for (int li = 0; li < N_PHASES; ++li) { a.ph_lo = li; a.ph_hi = li + 1; a.li = 0; hipLaunchKernelGGL(mk_fwd, dim3(grid), dim3(NWAVES * 64), LDS_BYTES, stream, a); }
#endif
    const hipError_t le = hipPeekAtLastError();
    if (le != hipSuccess) fprintf(stderr, "kernel_launch: launch failed: %s\n", hipGetErrorName(le));
}
```

```cpp
#include <hip/hip_runtime.h>
#include <cstdio>
#include <cstdint>

#ifndef MK_N_LAUNCHES
#define MK_N_LAUNCHES 1
#endif

#define LAS __attribute__((address_space(3)))
#define GAS __attribute__((address_space(1)))
typedef unsigned short bf16;
typedef short bf16x8 __attribute__((ext_vector_type(8)));
typedef float f32x4 __attribute__((ext_vector_type(4)));
typedef float f32x16 __attribute__((ext_vector_type(16)));
typedef unsigned u32x4 __attribute__((ext_vector_type(4)));
typedef unsigned u32x2 __attribute__((ext_vector_type(2)));
typedef short v4i16_t __attribute__((ext_vector_type(4)));
typedef float f32x2_t __attribute__((ext_vector_type(2)));
typedef __bf16 bf16x2_t __attribute__((ext_vector_type(2)));
typedef GAS unsigned gu32;

constexpr int T = 16384, SEQ = 4096, NB = 4, D = 1024, DIN = 2304, DQ = 2048;
constexpr int C_SBQ = 0, C_SBK = 512, C_SBV = 1024, C_SWQ = 1536, C_SWK = 2048, C_SWV = 2176;
constexpr int NEXP = 16384;
constexpr float EPS = 1e-6f;
constexpr float LOG2E = 1.4426950408889634f, LN2 = 0.6931471805599453f;
constexpr float SB_EXIT = -40.0f;

namespace pg8 {
constexpr int BM = 256, BK = 64, HALF = 128, HTB = HALF * BK * 2, STAGE_BYTES = 8 * HTB, NXCD = 8, WGM = 8;
__host__ __device__ __forceinline__ int lds_byte(int r, int c) { const int st = (r >> 4) * 2 + (c >> 5), rr = r & 15, cc = c & 31, ob = rr * 64 + cc * 2; return st * 1024 + (ob ^ (((ob >> 9) & 1) << 5)); }
__host__ __device__ __forceinline__ void stage_rc(int b, int& R, int& C) { const int st = b / 1024, sb = b % 1024, swz = sb ^ (((sb >> 9) & 1) << 5); R = (st >> 1) * 16 + swz / 64; C = (st & 1) * 32 + (swz % 64) / 2; }
__host__ __device__ __forceinline__ int perm32(int rho) { const int n = rho >> 4, i = rho & 15; return 8 * (i >> 2) + 4 * n + (i & 3); }
struct Unit { int pm, pn; };
struct Gemm { const bf16* A; const bf16* Bt; int M, N, K; };
struct StaticOrder {
    int nM, nN, nwg, G, c;
    __host__ __device__ void init(int M, int N, int G_, int c_) { nM = M / BM; nN = N / BM; nwg = nM * nN; G = G_; c = c_; }
    __host__ __device__ bool next(int i, Unit& u) const {
        const long L = (long)i * G + c; if (L >= nwg) return false;
        int wgid = (int)L; { const int q = nwg / NXCD, r = nwg % NXCD, xcd = wgid % NXCD, off = wgid / NXCD; wgid = (xcd < r ? xcd * (q + 1) : r * (q + 1) + (xcd - r) * q) + off; }
        const int nig = WGM * nN, gid = wgid / nig, fm = gid * WGM, gsz = (nM - fm) < WGM ? (nM - fm) : WGM;
        u.pm = fm + ((wgid % nig) % gsz); u.pn = (wgid % nig) / gsz; return true;
    }
};
__device__ __forceinline__ unsigned cvt_pk_bf16(float lo, float hi) { f32x2_t v = {lo, hi}; bf16x2_t b = __builtin_convertvector(v, bf16x2_t); return __builtin_bit_cast(unsigned, b); }

struct EpiBf16 {
    static constexpr bool PERM = true;
    bf16* O; int ldc;
    __device__ __forceinline__ void operator()(const f32x4 (&acc)[2][2][4][2], const Unit& u, int wr, int wc, int fr, int fq) const {
        const int row0 = u.pm * BM + wr * 64 + fr; const int col0 = u.pn * BM + wc * 32 + 8 * fq;
        const auto rsrc = __builtin_amdgcn_make_buffer_rsrc((void*)O, 0, 0x7ffffff0, 0x00020000);
#pragma unroll
        for (int ai = 0; ai < 2; ++ai)
#pragma unroll
            for (int m = 0; m < 4; ++m) { const unsigned boff = (unsigned)(((size_t)(row0 + ai * HALF + m * 16) * ldc + col0) * 2);
#pragma unroll
                for (int bj = 0; bj < 2; ++bj) { const f32x4 v0 = acc[ai][bj][m][0], v1 = acc[ai][bj][m][1];
                    u32x4 w; w.x = cvt_pk_bf16(v0[0], v0[1]); w.y = cvt_pk_bf16(v0[2], v0[3]); w.z = cvt_pk_bf16(v1[0], v1[1]); w.w = cvt_pk_bf16(v1[2], v1[3]);
                    __builtin_amdgcn_raw_buffer_store_b128(w, rsrc, boff + bj * HALF * 2, 0, 16); } }
    }
};
struct EpiBf16RS {
    static constexpr bool PERM = true;
    bf16* O; int ldc; const float* ssqp; float* rs2;
    __device__ __forceinline__ void operator()(const f32x4 (&acc)[2][2][4][2], const Unit& u, int wr, int wc, int fr, int fq) const {
        const int row0 = u.pm * BM + wr * 64 + fr; const int col0 = u.pn * BM + wc * 32 + 8 * fq;
#pragma unroll
        for (int ai = 0; ai < 2; ++ai)
#pragma unroll
            for (int m = 0; m < 4; ++m) { const int row = row0 + ai * HALF + m * 16; bf16* rowp = O + (size_t)row * ldc + col0;
                const f32x4* sp = (const f32x4*)(ssqp + (size_t)row * 16); const f32x4 s0 = sp[0], s1 = sp[1], s2 = sp[2], s3 = sp[3];
                const float ss = ((s0[0] + s0[1]) + (s0[2] + s0[3])) + ((s1[0] + s1[1]) + (s1[2] + s1[3])) + ((s2[0] + s2[1]) + (s2[2] + s2[3])) + ((s3[0] + s3[1]) + (s3[2] + s3[3]));
                const float rs = __builtin_amdgcn_rsqf(ss * (1.0f / 1024.0f) + 1e-6f);
                if (u.pn == 0 && wc == 0 && fq == 0) rs2[row] = rs;
#pragma unroll
                for (int bj = 0; bj < 2; ++bj) { const f32x4 v0 = acc[ai][bj][m][0] * rs, v1 = acc[ai][bj][m][1] * rs;
                    u32x4 w; w.x = cvt_pk_bf16(v0[0], v0[1]); w.y = cvt_pk_bf16(v0[2], v0[3]); w.z = cvt_pk_bf16(v1[0], v1[1]); w.w = cvt_pk_bf16(v1[2], v1[3]);
                    *(u32x4*)(rowp + bj * HALF) = w; } }
    }
};
struct EpiResB {
    static constexpr bool PERM = false;
    const float* g1; const float* irs1; bf16* xb; int ldc; float* ssqp;
    __device__ __forceinline__ void operator()(const f32x4 (&acc)[2][2][4][2], const Unit& u, int wr, int wc, int fr, int fq) const {
        const int col0 = u.pn * BM + wc * 32 + 4 * fq;
        f32x4 ig[2][2];
#pragma unroll
        for (int bj = 0; bj < 2; ++bj)
#pragma unroll
            for (int n = 0; n < 2; ++n) { const f32x4 gv = *(const f32x4*)(g1 + col0 + bj * HALF + n * 16); ig[bj][n] = (f32x4){__builtin_amdgcn_rcpf(gv[0]), __builtin_amdgcn_rcpf(gv[1]), __builtin_amdgcn_rcpf(gv[2]), __builtin_amdgcn_rcpf(gv[3])}; }
#pragma unroll
        for (int ai = 0; ai < 2; ++ai)
#pragma unroll
            for (int m = 0; m < 4; ++m) { const int row = u.pm * BM + ai * HALF + wr * 64 + m * 16 + fr; const size_t off = (size_t)row * ldc + col0; float sq = 0.f; const float ir = irs1[row];
#pragma unroll
                for (int bj = 0; bj < 2; ++bj)
#pragma unroll
                    for (int n = 0; n < 2; ++n) { const u32x2 hw = *(const u32x2*)(xb + off + bj * HALF + n * 16); const unsigned h0 = hw.x, h1 = hw.y;
                        const f32x4 bs = {__builtin_bit_cast(float, h0 << 16) * ir * ig[bj][n][0], __builtin_bit_cast(float, h0 & 0xffff0000u) * ir * ig[bj][n][1], __builtin_bit_cast(float, h1 << 16) * ir * ig[bj][n][2], __builtin_bit_cast(float, h1 & 0xffff0000u) * ir * ig[bj][n][3]};
                        const f32x4 y = bs + acc[ai][bj][m][n];
                        sq += (y[0] * y[0] + y[1] * y[1]) + (y[2] * y[2] + y[3] * y[3]);
                        u32x2 w; w.x = cvt_pk_bf16(y[0], y[1]); w.y = cvt_pk_bf16(y[2], y[3]); *(u32x2*)(xb + off + bj * HALF + n * 16) = w; }
                { const auto r16_ = __builtin_amdgcn_permlane16_swap(__builtin_bit_cast(unsigned, sq), __builtin_bit_cast(unsigned, sq), false, false); sq += __builtin_bit_cast(float, (threadIdx.x & 16) ? r16_[0] : r16_[1]); }
                { const auto r32_ = __builtin_amdgcn_permlane32_swap(__builtin_bit_cast(unsigned, sq), __builtin_bit_cast(unsigned, sq), false, false); sq += __builtin_bit_cast(float, (threadIdx.x & 32) ? r32_[0] : r32_[1]); }
                if (fq == 0) ssqp[(size_t)row * 16 + u.pn * 4 + wc] = sq; }
    }
};
struct EpiResF32 {
    static constexpr bool PERM = false;
    const float* base; float* out; int ldc;
    __device__ __forceinline__ void operator()(const f32x4 (&acc)[2][2][4][2], const Unit& u, int wr, int wc, int fr, int fq) const {
        const int col0 = u.pn * BM + wc * 32 + 4 * fq;
#pragma unroll
        for (int ai = 0; ai < 2; ++ai)
#pragma unroll
            for (int m = 0; m < 4; ++m) { const size_t off = (size_t)(u.pm * BM + ai * HALF + wr * 64 + m * 16 + fr) * ldc + col0;
#pragma unroll
                for (int bj = 0; bj < 2; ++bj)
#pragma unroll
                    for (int n = 0; n < 2; ++n) { const f32x4 bs = *(const f32x4*)(base + off + bj * HALF + n * 16); *(f32x4*)(out + off + bj * HALF + n * 16) = bs + acc[ai][bj][m][n]; } }
    }
};

template <class Epi, class Sched>
__device__ __forceinline__ void gemm_phase(LAS unsigned char* lds, const Gemm g, const Sched& S, const Epi& E) {
    const int tid = threadIdx.x, wid = __builtin_amdgcn_readfirstlane(tid >> 6), lane = tid & 63, wr = wid >> 2, wc = wid & 3, fr = lane & 15, fq = lane >> 4;
    const int K = g.K, nt = K / BK;
    unsigned voffA[2], voffB[2];
#pragma unroll
    for (int i = 0; i < 2; ++i) { int R, C; stage_rc(tid * 16 + i * 8192, R, C); const int Rb = Epi::PERM ? ((R & ~31) + perm32(R & 31)) : R;
        voffA[i] = (unsigned)(R * K + C) * 2u; voffB[i] = (unsigned)(Rb * K + C) * 2u; }
    const size_t kstep = (size_t)(BK * 2);
    const size_t hstep = (size_t)HALF * K * 2;
    const size_t tstep = 2 * hstep;
    const unsigned ldsw = (unsigned)wid * 1024u;
    const int aoff = lds_byte(wr * 64 + fr, fq * 8), boff = lds_byte(wc * 32 + fr, fq * 8);
#define PG8_SA(b, h) (((b) * 2 + (h)) * HTB)
#define PG8_SB(b, h) ((4 + (b) * 2 + (h)) * HTB)
#define PG8_STAGE(bufoff, gbase, voff) do { _Pragma("unroll") for (int _i = 0; _i < 2; ++_i) \
        __builtin_amdgcn_global_load_lds((const unsigned*)((const char*)(gbase) + (voff)[_i]), (LAS unsigned*)(lds + (bufoff) + ldsw + _i * 8192), 16, 0, 0); } while (0)
#define PG8_LDA(dst, b, h) do { _Pragma("unroll") for (int m = 0; m < 4; ++m) _Pragma("unroll") for (int k = 0; k < 2; ++k) dst[m][k] = *(const LAS bf16x8*)(lds + PG8_SA(b, h) + aoff + m * 2048 + k * 1024); } while (0)
#define PG8_LDB(dst, b, h) do { _Pragma("unroll") for (int n = 0; n < 2; ++n) _Pragma("unroll") for (int k = 0; k < 2; ++k) dst[n][k] = *(const LAS bf16x8*)(lds + PG8_SB(b, h) + boff + n * 2048 + k * 1024); } while (0)
#define PG8_MMA(ai, bj, At, Bt) do { __builtin_amdgcn_s_setprio(1); _Pragma("unroll") for (int m = 0; m < 4; ++m) _Pragma("unroll") for (int n = 0; n < 2; ++n) _Pragma("unroll") for (int k = 0; k < 2; ++k) \
        acc[ai][bj][m][n] = __builtin_amdgcn_mfma_f32_16x16x32_bf16(Bt[n][k], At[m][k], acc[ai][bj][m][n], 0, 0, 0); __builtin_amdgcn_s_setprio(0); } while (0)
#define PG8_WAIT_V(n) asm volatile("s_waitcnt vmcnt(" #n ")" ::: "memory")
#define PG8_WAIT_L(n) asm volatile("s_waitcnt lgkmcnt(" #n ")" ::: "memory")
#define PG8_BAR __builtin_amdgcn_s_barrier()
#define PG8_SCHED __builtin_amdgcn_sched_barrier(0)
    Unit cur, nxt; int ui = 0;
    if (!S.next(0, cur)) return;
    f32x4 acc[2][2][4][2];
#pragma unroll
    for (int a = 0; a < 2; ++a)
#pragma unroll
        for (int b = 0; b < 2; ++b)
#pragma unroll
            for (int m = 0; m < 4; ++m)
#pragma unroll
                for (int n = 0; n < 2; ++n) acc[a][b][m][n] = (f32x4){0.f, 0.f, 0.f, 0.f};
    bf16x8 At[4][2], B0[2][2], B1[2][2];
    const char* cA = (const char*)g.A + (size_t)cur.pm * tstep; const char* cB = (const char*)g.Bt + (size_t)cur.pn * tstep;
    PG8_STAGE(PG8_SB(0, 0), cB, voffB); PG8_STAGE(PG8_SB(0, 1), cB + hstep, voffB); PG8_STAGE(PG8_SA(0, 0), cA, voffA); PG8_STAGE(PG8_SA(0, 1), cA + hstep, voffA);
    if (wr == 1) PG8_BAR;
    PG8_WAIT_V(2); PG8_BAR;
    PG8_STAGE(PG8_SB(1, 0), cB + kstep, voffB); PG8_STAGE(PG8_SA(1, 0), cA + kstep, voffA); PG8_STAGE(PG8_SB(1, 1), cB + hstep + kstep, voffB);
    PG8_WAIT_V(6); PG8_BAR;
    for (;;) {
        const bool has_next = S.next(ui + 1, nxt);
        const char* nA = has_next ? (const char*)g.A + (size_t)nxt.pm * tstep : cA; const char* nB = has_next ? (const char*)g.Bt + (size_t)nxt.pn * tstep : cB;
        for (int t = 0; t < nt; t += 2) {
            const bool last = (t == nt - 2);
            const char* a1 = cA + (size_t)(t + 1) * kstep;
            const char* a2 = last ? nA : cA + (size_t)(t + 2) * kstep; const char* b2 = last ? nB : cB + (size_t)(t + 2) * kstep;
            const char* a3 = a2 + kstep; const char* b3 = b2 + kstep;
            PG8_LDB(B0, 0, 0); PG8_LDB(B1, 0, 1); PG8_SCHED; PG8_LDA(At, 0, 0); PG8_STAGE(PG8_SA(1, 1), a1 + hstep, voffA);
            PG8_WAIT_V(8); PG8_WAIT_L(0); PG8_BAR; PG8_MMA(0, 0, At, B0); PG8_MMA(0, 1, At, B1); PG8_BAR; PG8_SCHED;
            PG8_LDA(At, 0, 1); PG8_STAGE(PG8_SB(0, 0), b2, voffB); PG8_STAGE(PG8_SB(0, 1), b2 + hstep, voffB); PG8_STAGE(PG8_SA(0, 0), a2, voffA);
            PG8_WAIT_V(8); PG8_WAIT_L(0); PG8_BAR; PG8_MMA(1, 0, At, B0); PG8_MMA(1, 1, At, B1); PG8_BAR; PG8_SCHED;
            PG8_LDB(B0, 1, 0); PG8_LDB(B1, 1, 1); PG8_SCHED; PG8_LDA(At, 1, 0); PG8_STAGE(PG8_SA(0, 1), a2 + hstep, voffA);
            PG8_WAIT_V(8); PG8_WAIT_L(0); PG8_BAR; PG8_MMA(0, 0, At, B0); PG8_MMA(0, 1, At, B1); PG8_BAR; PG8_SCHED;
            PG8_LDA(At, 1, 1); PG8_STAGE(PG8_SB(1, 0), b3, voffB); PG8_STAGE(PG8_SB(1, 1), b3 + hstep, voffB); PG8_STAGE(PG8_SA(1, 0), a3, voffA);
            PG8_WAIT_V(8); PG8_WAIT_L(0); PG8_BAR; PG8_MMA(1, 0, At, B0); PG8_MMA(1, 1, At, B1); PG8_BAR; PG8_SCHED;
        }
        if (wr == 0) PG8_BAR;
        E(acc, cur, wr, wc, fr, fq);
        if (!has_next) break;
#pragma unroll
        for (int a = 0; a < 2; ++a)
#pragma unroll
            for (int b = 0; b < 2; ++b)
#pragma unroll
                for (int m = 0; m < 4; ++m)
#pragma unroll
                    for (int n = 0; n < 2; ++n) acc[a][b][m][n] = (f32x4){0.f, 0.f, 0.f, 0.f};
        cur = nxt; cA = nA; cB = nB; ++ui;
        if (wr == 1) PG8_BAR;
    }
    PG8_WAIT_V(0);
    PG8_BAR;
#undef PG8_SA
#undef PG8_SB
#undef PG8_STAGE
#undef PG8_LDA
#undef PG8_LDB
#undef PG8_MMA
#undef PG8_WAIT_V
#undef PG8_WAIT_L
#undef PG8_BAR
#undef PG8_SCHED
}
}

constexpr int NWAVES = 8;
constexpr int N_PHASES = 11;
constexpr size_t MiB = 1u << 20;
constexpr size_t WS_CTL = 0, CTL_ZERO_BYTES = 32 * 1024;
constexpr size_t WS_WIN = 1 * MiB;
constexpr size_t WS_WOUT = 6 * MiB;
constexpr size_t WS_WQ = 8 * MiB;
constexpr size_t WS_KEYS = 12 * MiB;
constexpr size_t WS_RSU = 12 * MiB + 512 * 1024, WS_RSV = 12 * MiB + 768 * 1024;
constexpr size_t WS_RS2 = 12 * MiB + 896 * 1024;
constexpr size_t WS_IRS1 = 12 * MiB + 960 * 1024;
constexpr size_t WS_IDX = 13 * MiB;
constexpr size_t WS_GATE = 21 * MiB;
constexpr size_t WS_SSQP = WS_GATE;
constexpr size_t WS_H = 29 * MiB;
constexpr size_t WS_MIX = 61 * MiB;
constexpr size_t WS_C = WS_MIX, WS_SSP = WS_MIX + 8 * MiB;
constexpr size_t WS_X2 = 165 * MiB - 32 * MiB;
constexpr size_t WS_QKV = 93 * MiB;
constexpr size_t WS_PD = WS_QKV;
constexpr size_t WS_U8 = 165 * MiB;
constexpr size_t WS_V8 = 181 * MiB;
constexpr size_t WS_END = 197 * MiB;
constexpr size_t TAB8_SLICE = (size_t)NEXP * 128;
constexpr int CW_BAR = 4096;
static_assert((CW_BAR + 3456) * 4 <= 32 * 1024, "barrier words inside the per-call memset");
constexpr int RING_BYTES = 147456;
constexpr int LDSCTL_OFF = RING_BYTES, MISC_OFF = LDSCTL_OFF + 320;
constexpr int LDS_BYTES = 155648;

#define RLX_AGENT __ATOMIC_RELAXED, __HIP_MEMORY_SCOPE_AGENT
#define LDS_WAIT() asm volatile("s_waitcnt lgkmcnt(0)" ::: "memory")
__device__ __forceinline__ unsigned f2bf(float f) { unsigned u = __builtin_bit_cast(unsigned, f); return (u + 0x7fffu + ((u >> 16) & 1u)) >> 16; }
__device__ __forceinline__ unsigned pk2(float lo, float hi) { return pg8::cvt_pk_bf16(lo, hi); }
__device__ __forceinline__ unsigned f_bits(float f) { return __builtin_bit_cast(unsigned, f); }
__device__ __forceinline__ float bits_f(unsigned u) { return __builtin_bit_cast(float, u); }
__device__ __forceinline__ float bf_lo(unsigned w) { return __builtin_bit_cast(float, w << 16); }
__device__ __forceinline__ float bf_hi(unsigned w) { return __builtin_bit_cast(float, w & 0xffff0000u); }

#define XB_TMO      128
#define XB_XCNT(j)  (256  + 64 * (j))
#define XB_XSUB(j)  (1280 + 64 * (j))
#define XB_XGEN(j)  (2304 + 64 * (j))
#define XB_TOP      3328
#define XB_TOPGEN   3392
#define XCD_BAR_WORDS 3456
#define XB_SPIN_CAP (1u << 18)
__device__ __forceinline__ unsigned xb_ld(unsigned* p)              { return __hip_atomic_load(p, __ATOMIC_RELAXED, __HIP_MEMORY_SCOPE_AGENT); }
__device__ __forceinline__ unsigned xb_add(unsigned* p, unsigned v) { return __hip_atomic_fetch_add(p, v, __ATOMIC_RELAXED, __HIP_MEMORY_SCOPE_AGENT); }
__device__ __forceinline__ unsigned xb_xcc_id() { return (unsigned)__builtin_amdgcn_s_getreg((3 << 11) | 20) & 0xFu; }
#define XB_SPIN(cond, bar) do { unsigned _sp = 0; while (cond) { __builtin_amdgcn_s_sleep(1); \
    if ((++_sp & 255u) == 0u) { if (xb_ld(&(bar)[XB_TMO])) break; if (_sp > XB_SPIN_CAP) { atomicAdd(&(bar)[XB_TMO], 1u); break; } } } } while (0)
struct XcdBarrier { unsigned* bar; unsigned x; volatile LAS unsigned* st; };
__device__ __forceinline__ XcdBarrier xcd_barrier_post(unsigned* bar, volatile LAS unsigned* st) {
    XcdBarrier b; b.bar = bar; b.x = xb_xcc_id(); b.st = st;
    if (threadIdx.x == 0) (void)xb_add(&bar[XB_XCNT(b.x)], 1u);
    return b;
}
__device__ __forceinline__ void xcd_barrier_complete(unsigned* bar, unsigned x, unsigned& nloc, unsigned& nx) {
    const unsigned G = gridDim.x * gridDim.y * gridDim.z;
    unsigned sum, cnt, mine, sp = 0u;
    for (;;) {
        sum = 0u; cnt = 0u; mine = 0u;
#pragma unroll
        for (unsigned j = 0; j < 16; ++j) { const unsigned c = xb_ld(&bar[XB_XCNT(j)]); sum += c; cnt += (c > 0u) ? 1u : 0u; mine = (j == x) ? c : mine; }
        if (sum == G) break;
        __builtin_amdgcn_s_sleep(1);
        if ((++sp & 255u) == 0u) { if (xb_ld(&bar[XB_TMO])) break; if (sp > XB_SPIN_CAP) { atomicAdd(&bar[XB_TMO], 1u); break; } }
    }
    nloc = mine > 0u ? mine : 1u; nx = cnt > 0u ? cnt : 1u;
}
__device__ __forceinline__ void xcd_barrier(const XcdBarrier& b) {
    asm volatile("s_waitcnt vmcnt(0)" ::: "memory");
    __syncthreads();
    if (threadIdx.x == 0) {
        unsigned* bar = b.bar;
        __builtin_amdgcn_s_waitcnt(0);
        unsigned nloc = b.st[0], nx = b.st[1];
        if (nloc == 0u) { xcd_barrier_complete(bar, b.x, nloc, nx); b.st[0] = nloc; b.st[1] = nx; }
        const unsigned old = xb_add(&bar[XB_XSUB(b.x)], 1u);
        const unsigned gen = old / nloc;
        if (old + 1u == (gen + 1u) * nloc) {
            __builtin_amdgcn_fence(__ATOMIC_RELEASE, "agent");
            asm volatile("s_waitcnt vmcnt(0)" ::: "memory");
            const unsigned og = xb_add(&bar[XB_TOP], 1u);
            const unsigned tg = og / nx;
            if (og + 1u == (tg + 1u) * nx) xb_add(&bar[XB_TOPGEN], 1u);
            else XB_SPIN(xb_ld(&bar[XB_TOPGEN]) == tg, bar);
            __builtin_amdgcn_fence(__ATOMIC_ACQUIRE, "agent");
            xb_add(&bar[XB_XGEN(b.x)], 1u);
            asm volatile("s_waitcnt vmcnt(0)" ::: "memory");
        } else {
            XB_SPIN(xb_ld(&bar[XB_XGEN(b.x)]) == gen, bar);
            __builtin_amdgcn_fence(__ATOMIC_ACQUIRE, "agent");
            asm volatile("s_waitcnt vmcnt(0)" ::: "memory");
        }
    }
    __syncthreads();
}

struct Frame {
    LAS unsigned char* lds;
    volatile LAS unsigned* MISC;
    gu32* ctl;
    int tid, lane, wave;
    int vcu, G;
    const float *x, *g1, *w_in, *sb_g, *sw_g, *sinks, *w_out, *g2, *w_q, *keys1, *keys2, *pu, *pv, *gf;
    float* out;
    bf16 *Wt_in, *Wt_out, *Wt_q, *KEYS, *H, *MIX, *QKV;
    unsigned char *U8, *V8, *C8; float *RSU, *RSV, *SSP, *SSQP, *RS2, *CS, *IRS1; bf16 *PD, *X2;
    unsigned short* IDX; float* GATE;
};

__device__ __forceinline__ unsigned partner32(unsigned x) { const auto r = __builtin_amdgcn_permlane32_swap(x, x, false, false); return (threadIdx.x & 32) ? r[0] : r[1]; }
__device__ __forceinline__ unsigned partner16(unsigned x) { const auto r = __builtin_amdgcn_permlane16_swap(x, x, false, false); return (threadIdx.x & 16) ? r[0] : r[1]; }
#define DPPF(v, ctl) bits_f((unsigned)__builtin_amdgcn_update_dpp(0, (int)f_bits(v), (ctl), 0xf, 0xf, false))
__device__ __forceinline__ float wave_sum(float v) {
    v += DPPF(v, 0xB1); v += DPPF(v, 0x4E); v += DPPF(v, 0x141); v += DPPF(v, 0x140);
    v += bits_f(partner16(f_bits(v))); v += bits_f(partner32(f_bits(v)));
    return v;
}

__device__ __forceinline__ void p0_transpose_item(const float* W, int K, int N, bf16* WT, LAS float* scr, int item, int lane, const float* gk = nullptr) {
    const int nblk = N / 32, kb = item / nblk, nb = item % nblk, k0 = 64 * kb, n0 = 32 * nb;
#pragma unroll 8
    for (int i = 0; i < 32; ++i) { const int kk = 2 * i + (lane >> 5); const float gq = gk ? gk[k0 + kk] : 1.0f; scr[kk * 33 + (lane & 31)] = __builtin_nontemporal_load(W + (size_t)(k0 + kk) * N + n0 + (lane & 31)) * gq; }
    LDS_WAIT(); asm volatile("" ::: "memory");
    const int c = lane & 7;
#pragma unroll
    for (int j = 0; j < 4; ++j) { const int n = (lane >> 3) + 8 * j; const LAS float* s = scr + (8 * c) * 33 + n;
        u32x4 o; o.x = pk2(s[0 * 33], s[1 * 33]); o.y = pk2(s[2 * 33], s[3 * 33]); o.z = pk2(s[4 * 33], s[5 * 33]); o.w = pk2(s[6 * 33], s[7 * 33]);
        *(GAS u32x4*)(WT + (size_t)(n0 + n) * K + k0 + 8 * c) = o; }
    LDS_WAIT(); asm volatile("" ::: "memory");
}
template <int NR> __device__ __forceinline__ void rms_rows_to_bf16(const float* xbase, const float* g, bf16* obase, float* irs, int m0, int mstride, int lane) {
    f32x4 v[NR][4];
#pragma unroll
    for (int i = 0; i < NR; ++i) { const int m = m0 + i * mstride; const GAS f32x4* xr = (const GAS f32x4*)(xbase + (size_t)(m < T ? m : m0) * D) + lane;
#pragma unroll
        for (int j = 0; j < 4; ++j) v[i][j] = __builtin_nontemporal_load(xr + 64 * j); }
    const GAS f32x4* gr = (const GAS f32x4*)g + lane;
    f32x4 gg[4];
#pragma unroll
    for (int j = 0; j < 4; ++j) gg[j] = gr[64 * j];
#pragma unroll
    for (int i = 0; i < NR; ++i) { const int m = m0 + i * mstride;
        float s = 0.f;
#pragma unroll
        for (int j = 0; j < 4; ++j) s += (v[i][j].x * v[i][j].x + v[i][j].y * v[i][j].y) + (v[i][j].z * v[i][j].z + v[i][j].w * v[i][j].w);
        const float ms_ = wave_sum(s) * (1.f / D) + EPS; const float rs = __builtin_amdgcn_rsqf(ms_);
        if (m < T) { if (lane == 0) irs[m] = __builtin_sqrtf(ms_); GAS u32x2* o8 = (GAS u32x2*)(obase + (size_t)m * D) + lane;
#pragma unroll
            for (int j = 0; j < 4; ++j) { u32x2 w; w.x = pk2(v[i][j].x * rs * gg[j].x, v[i][j].y * rs * gg[j].y); w.y = pk2(v[i][j].z * rs * gg[j].z, v[i][j].w * rs * gg[j].w); o8[64 * j] = w; } } }
}
__device__ __forceinline__ void cvt_array_bf16(const float* src, bf16* dst, size_t n8, int gtid, int gthreads) {
    for (size_t i = gtid; i < n8; i += gthreads) {
        const f32x4 a = __builtin_nontemporal_load((const GAS f32x4*)(src + i * 8)), b = __builtin_nontemporal_load((const GAS f32x4*)(src + i * 8 + 4));
        u32x4 o; o.x = pk2(a.x, a.y); o.y = pk2(a.z, a.w); o.z = pk2(b.x, b.y); o.w = pk2(b.z, b.w);
        *(GAS u32x4*)(dst + i * 8) = o;
    }
}
__device__ __forceinline__ void p0_prologue(Frame& F) {
    LAS float* scr = (LAS float*)(F.lds + F.wave * 16384);
    const int gw = F.vcu * NWAVES + F.wave, NGW = F.G * NWAVES;
    constexpr int I_IN = (D / 64) * (DIN / 32), I_OUT = (D / 64) * (D / 32), I_Q = (D / 64) * (DQ / 32);
    constexpr int NITEMS = I_IN + I_OUT + I_Q;
    for (int it = gw; it < NITEMS; it += NGW) {
        int r = it;
        if (r < I_IN) { p0_transpose_item(F.w_in, D, DIN, F.Wt_in, scr, r, F.lane); continue; } r -= I_IN;
        if (r < I_OUT) { p0_transpose_item(F.w_out, D, D, F.Wt_out, scr, r, F.lane); continue; } r -= I_OUT;
        p0_transpose_item(F.w_q, D, DQ, F.Wt_q, scr, r, F.lane, F.g2);
    }
    for (int m = gw; m < T; m += 4 * NGW) rms_rows_to_bf16<4>(F.x, F.g1, F.H, F.IRS1, m, NGW, F.lane);
    const int gtid = F.vcu * NWAVES * 64 + F.tid, gthreads = F.G * NWAVES * 64;
    cvt_array_bf16(F.keys1, F.KEYS, (size_t)8 * 128 * 128 / 8, gtid, gthreads);
    cvt_array_bf16(F.keys2, F.KEYS + 8 * 128 * 128, (size_t)8 * 128 * 128 / 8, gtid, gthreads);
}

__device__ __forceinline__ int pack_i8(float a, float b, float c, float d) {
    const int qa = (int)__builtin_rintf(a), qb = (int)__builtin_rintf(b), qc = (int)__builtin_rintf(c), qd = (int)__builtin_rintf(d);
    return (qa & 0xff) | ((qb & 0xff) << 8) | ((qc & 0xff) << 16) | (qd << 24);
}
__device__ __forceinline__ float wave_max(float v) {
    v = __builtin_fmaxf(v, DPPF(v, 0xB1)); v = __builtin_fmaxf(v, DPPF(v, 0x4E)); v = __builtin_fmaxf(v, DPPF(v, 0x141)); v = __builtin_fmaxf(v, DPPF(v, 0x140));
    v = __builtin_fmaxf(v, bits_f(partner16(f_bits(v)))); v = __builtin_fmaxf(v, bits_f(partner32(f_bits(v))));
    return v;
}
template <int NR> __device__ __forceinline__ void cvt_rows_fp8(Frame& F, int r0, int rstride, int rlimit, int lane) {
    f32x4 v[NR][4];
#pragma unroll
    for (int i = 0; i < NR; ++i) { int r = r0 + i * rstride; r = r < rlimit ? r : r0; const float* src = r < NEXP ? F.pu + (size_t)r * D : F.pv + (size_t)(r - NEXP) * D;
        const GAS f32x4* xr = (const GAS f32x4*)src + lane;
#pragma unroll
        for (int j = 0; j < 4; ++j) v[i][j] = __builtin_nontemporal_load(xr + 64 * j); }
    f32x4 g2v[4];
#pragma unroll
    for (int j = 0; j < 4; ++j) g2v[j] = ((const GAS f32x4*)F.g2)[lane + 64 * j];
#pragma unroll
    for (int i = 0; i < NR; ++i) { const int r = r0 + i * rstride;
        if (r < NEXP) {
#pragma unroll
            for (int j = 0; j < 4; ++j) v[i][j] = v[i][j] * g2v[j]; }
        float amax = 0.f;
#pragma unroll
        for (int j = 0; j < 4; ++j) amax = __builtin_fmaxf(amax, __builtin_fmaxf(__builtin_fmaxf(__builtin_fabsf(v[i][j].x), __builtin_fabsf(v[i][j].y)), __builtin_fmaxf(__builtin_fabsf(v[i][j].z), __builtin_fabsf(v[i][j].w))));
        amax = wave_max(amax);
        int k = 6 - ((int)((f_bits(amax) >> 23) & 0xffu) - 127);
        k = k > 100 ? 100 : (k < -100 ? -100 : k);
        const float sc = bits_f((unsigned)(k + 127) << 23), inv = bits_f((unsigned)(127 - k) << 23);
        if (r < rlimit) { const int e = r < NEXP ? r : r - NEXP; unsigned char* tab8 = r < NEXP ? F.U8 : F.V8; float* rs = r < NEXP ? F.RSU : F.RSV;
            const float sq = amax > 0.f ? 127.0f / amax : 0.f;
#pragma unroll
            for (int j = 0; j < 4; ++j) {
                const int w = pack_i8(v[i][j].x * sq, v[i][j].y * sq, v[i][j].z * sq, v[i][j].w * sq);
                const int s = 2 * j + (lane >> 5);
                *(GAS unsigned*)(tab8 + (size_t)s * TAB8_SLICE + (size_t)e * 128 + 4 * (lane & 31)) = (unsigned)w;
            }
            if (lane == 0) rs[e] = amax * (1.0f / 127.0f); } }
}
__device__ __forceinline__ int crow(int r, int hi) { return (r & 3) + 8 * (r >> 2) + 4 * hi; }
constexpr int VPITCH = 192;
constexpr int KPITCH = 144;
constexpr int ATT_K_OFF = 0, ATT_V_OFF = 32 * KPITCH, ATT_Q_OFF = 32 * KPITCH + 32 * VPITCH, ATT_WAVE_BYTES = 64 * KPITCH + 32 * VPITCH;
struct Tile4 { u32x4 a, b, c, d; };
__device__ __forceinline__ Tile4 tile_load(const bf16* t0, int lane) {
    const bf16* p = t0 + (size_t)(lane >> 3) * DIN + 8 * (lane & 7);
    Tile4 t; t.a = *(const GAS u32x4*)p; t.b = *(const GAS u32x4*)(p + (size_t)8 * DIN); t.c = *(const GAS u32x4*)(p + (size_t)16 * DIN); t.d = *(const GAS u32x4*)(p + (size_t)24 * DIN); return t;
}
__device__ __forceinline__ void tile_store(LAS unsigned char* dst, int pitch, const Tile4& t, int lane) {
    LAS unsigned char* p = dst + (lane >> 3) * pitch + 16 * (lane & 7);
    *(LAS u32x4*)p = t.a; *(LAS u32x4*)(p + 8 * pitch) = t.b; *(LAS u32x4*)(p + 16 * pitch) = t.c; *(LAS u32x4*)(p + 24 * pitch) = t.d;
}
__device__ __forceinline__ bf16x8 kfrag(const LAS unsigned char* kt, int d0, int lane) { const u32x4 w = *(const LAS u32x4*)(kt + (lane & 31) * KPITCH + 32 * d0 + 16 * (lane >> 5)); return __builtin_bit_cast(bf16x8, w); }
__device__ __forceinline__ bf16x8 vfrag(const LAS unsigned char* wl, int dblk, int s, int lane) {
    const int hi = lane >> 5, i = lane & 15, g1 = (lane >> 4) & 1;
    const LAS unsigned char* p = wl + (16 * s + 4 * hi + (i >> 2)) * VPITCH + (32 * dblk + 16 * g1 + 4 * (i & 3)) * 2;
    const v4i16_t lo = __builtin_amdgcn_ds_read_tr16_b64_v4i16((LAS v4i16_t*)p);
    const v4i16_t hh = __builtin_amdgcn_ds_read_tr16_b64_v4i16((LAS v4i16_t*)(p + 8 * VPITCH));
    return (bf16x8){lo[0], lo[1], lo[2], lo[3], hh[0], hh[1], hh[2], hh[3]};
}
__device__ __forceinline__ bf16x8 pack8(const f32x16& a, int s) {
    u32x4 w; w.x = pk2(a[8 * s + 0], a[8 * s + 1]); w.y = pk2(a[8 * s + 2], a[8 * s + 3]); w.z = pk2(a[8 * s + 4], a[8 * s + 5]); w.w = pk2(a[8 * s + 6], a[8 * s + 7]);
    return __builtin_bit_cast(bf16x8, w);
}
__device__ __forceinline__ void head_norm_store(const f32x16& o0, const f32x16& o1, float scale, const float* g, bf16* dstrow, int hi) {
    float ss = 0.f;
#pragma unroll
    for (int r = 0; r < 16; ++r) { const float a = o0[r] * scale, b = o1[r] * scale; ss += a * a + b * b; }
    ss += bits_f(partner32(f_bits(ss)));
    const float rs = __builtin_amdgcn_rsqf(ss * (1.f / 64.f) + EPS) * scale;
#pragma unroll
    for (int dblk = 0; dblk < 2; ++dblk)
#pragma unroll
        for (int q4 = 0; q4 < 4; ++q4) { const int d0 = 32 * dblk + 8 * q4 + 4 * hi; const f32x4 gg = *(const GAS f32x4*)(g + d0);
            const f32x16& o = dblk ? o1 : o0;
            u32x2 w; w.x = pk2(o[4 * q4 + 0] * rs * gg.x, o[4 * q4 + 1] * rs * gg.y); w.y = pk2(o[4 * q4 + 2] * rs * gg.z, o[4 * q4 + 3] * rs * gg.w);
            *(GAS u32x2*)(dstrow + d0) = w; }
}

__device__ __forceinline__ void sb_item(Frame& F, int b, int h, int qb, LAS unsigned char* wl) {
    const int lane = F.lane, r32 = lane & 31, hi = lane >> 5;
    const size_t rowbase = (size_t)b * SEQ;
    const bf16* Qp = F.QKV + (rowbase + 32 * qb) * DIN + C_SBQ + h * 64;
    const bf16* Kb = F.QKV + rowbase * DIN + C_SBK + h * 64;
    const bf16* Vb = F.QKV + rowbase * DIN + C_SBV + h * 64;
    bf16x8 qr[4];
    { const Tile4 tq = tile_load(Qp, lane); tile_store(wl + ATT_K_OFF, KPITCH, tq, lane);
#pragma unroll
      for (int d0 = 0; d0 < 4; ++d0) qr[d0] = kfrag(wl + ATT_K_OFF, d0, lane); }
    bf16x8 tri[2];
#pragma unroll
    for (int s = 0; s < 2; ++s)
#pragma unroll
        for (int j = 0; j < 8; ++j) tri[s][j] = (16 * s + 8 * (j >> 2) + 4 * hi + (j & 3) >= r32) ? (short)0x3F80 : (short)0;
    f32x16 o0 = {}, o1 = {}; float C = 0.f;
    Tile4 tk = tile_load(Kb + (size_t)(32 * qb) * DIN, lane), tv = tile_load(Vb + (size_t)(32 * qb) * DIN, lane);
    for (int kt = qb; kt >= 0; --kt) {
        tile_store(wl + ATT_K_OFF, KPITCH, tk, lane); tile_store(wl + ATT_V_OFF, VPITCH, tv, lane);
        { const int kn = kt > 0 ? kt - 1 : 0; tk = tile_load(Kb + (size_t)(32 * kn) * DIN, lane); tv = tile_load(Vb + (size_t)(32 * kn) * DIN, lane); }
        bf16x8 kf[4];
#pragma unroll
        for (int d0 = 0; d0 < 4; ++d0) kf[d0] = kfrag(wl + ATT_K_OFF, d0, lane);
        f32x16 z = {};
#pragma unroll
        for (int d0 = 0; d0 < 4; ++d0) z = __builtin_amdgcn_mfma_f32_32x32x16_bf16(kf[d0], qr[d0], z, 0, 0, 0);
        const int lim = r32 + 32 * (qb - kt);
        f32x16 l, ls;
#pragma unroll
        for (int r = 0; r < 16; ++r) {
            const float zz = z[r] * 0.125f;
            const float e = __builtin_amdgcn_exp2f(-__builtin_fabsf(zz) * LOG2E);
            const float sp = __builtin_fmaxf(zz, 0.f) + LN2 * __builtin_amdgcn_logf(1.0f + e);
            const bool valid = crow(r, hi) < lim;
            l[r] = valid ? -sp : 0.f;
            ls[r] = zz - sp;
        }
        f32x16 lo;
        bf16x8 lh[2], ll[2];
#pragma unroll
        for (int s = 0; s < 2; ++s) {
            u32x4 wh, wlw;
#pragma unroll
            for (int p = 0; p < 4; ++p) { const float a = l[8 * s + 2 * p], c = l[8 * s + 2 * p + 1]; const unsigned w = pk2(a, c); wh[p] = w; lo[8 * s + 2 * p] = a - bf_lo(w); lo[8 * s + 2 * p + 1] = c - bf_hi(w); }
#pragma unroll
            for (int p = 0; p < 4; ++p) wlw[p] = pk2(lo[8 * s + 2 * p], lo[8 * s + 2 * p + 1]);
            lh[s] = __builtin_bit_cast(bf16x8, wh); ll[s] = __builtin_bit_cast(bf16x8, wlw);
        }
        f32x16 Y = {};
        Y = __builtin_amdgcn_mfma_f32_32x32x16_bf16(tri[0], lh[0], Y, 0, 0, 0);
        Y = __builtin_amdgcn_mfma_f32_32x32x16_bf16(tri[1], lh[1], Y, 0, 0, 0);
        Y = __builtin_amdgcn_mfma_f32_32x32x16_bf16(tri[0], ll[0], Y, 0, 0, 0);
        Y = __builtin_amdgcn_mfma_f32_32x32x16_bf16(tri[1], ll[1], Y, 0, 0, 0);
        f32x16 a;
#pragma unroll
        for (int r = 0; r < 16; ++r) {
            const bool valid = crow(r, hi) < lim;
            const float later = C + (Y[r] - l[r]);
            const float av = __builtin_amdgcn_exp2f((ls[r] + later) * LOG2E);
            a[r] = valid ? av : 0.f;
        }
        float tot; { const float y0_ = Y[0]; const auto r_ = __builtin_amdgcn_permlane32_swap(f_bits(y0_), f_bits(y0_), false, false); tot = hi ? bits_f(r_[0]) : y0_; }
        C += tot;
        const bf16x8 a0 = pack8(a, 0), a1 = pack8(a, 1);
        o0 = __builtin_amdgcn_mfma_f32_32x32x16_bf16(vfrag(wl + ATT_V_OFF, 0, 0, lane), a0, o0, 0, 0, 0);
        o0 = __builtin_amdgcn_mfma_f32_32x32x16_bf16(vfrag(wl + ATT_V_OFF, 0, 1, lane), a1, o0, 0, 0, 0);
        o1 = __builtin_amdgcn_mfma_f32_32x32x16_bf16(vfrag(wl + ATT_V_OFF, 1, 0, lane), a0, o1, 0, 0, 0);
        o1 = __builtin_amdgcn_mfma_f32_32x32x16_bf16(vfrag(wl + ATT_V_OFF, 1, 1, lane), a1, o1, 0, 0, 0);
        if (__all(C < SB_EXIT)) break;
    }
    head_norm_store(o0, o1, 1.0f, F.sb_g + h * 64, F.MIX + (rowbase + 32 * qb + r32) * D + h * 64, hi);
}

#define SWA_HEAD(z, qslope, m_, den_, oa, ob) do { \
        float tmax_ = -INFINITY; f32x16 s_; \
        _Pragma("unroll") for (int r = 0; r < 16; ++r) { const int dist = dq - ((r & 3) + 8 * (r >> 2)); const float sv = z[r] * 0.125f - qslope * (float)dist; s_[r] = ((unsigned)dist < 128u) ? sv : -INFINITY; tmax_ = __builtin_fmaxf(tmax_, s_[r]); } \
        tmax_ = __builtin_fmaxf(tmax_, bits_f(partner32(f_bits(tmax_)))); \
        const float mn_ = __builtin_fmaxf(m_, tmax_); const float al_ = __builtin_amdgcn_exp2f((m_ - mn_) * LOG2E); m_ = mn_; \
        f32x16 p_; float ps_ = 0.f; \
        _Pragma("unroll") for (int r = 0; r < 16; ++r) { p_[r] = __builtin_amdgcn_exp2f((s_[r] - mn_) * LOG2E); ps_ += p_[r]; } \
        den_ = den_ * al_ + ps_; \
        _Pragma("unroll") for (int r = 0; r < 16; ++r) { oa[r] *= al_; ob[r] *= al_; } \
        const bf16x8 a0_ = pack8(p_, 0), a1_ = pack8(p_, 1); \
        oa = __builtin_amdgcn_mfma_f32_32x32x16_bf16(vf00, a0_, oa, 0, 0, 0); oa = __builtin_amdgcn_mfma_f32_32x32x16_bf16(vf01, a1_, oa, 0, 0, 0); \
        ob = __builtin_amdgcn_mfma_f32_32x32x16_bf16(vf10, a0_, ob, 0, 0, 0); ob = __builtin_amdgcn_mfma_f32_32x32x16_bf16(vf11, a1_, ob, 0, 0, 0); } while (0)
__device__ __forceinline__ void swa_item2(Frame& F, int b, int kv, int hp, int qb, LAS unsigned char* wl) {
    const int lane = F.lane, r32 = lane & 31, hi = lane >> 5, hqA = kv * 4 + 2 * hp, hqB = hqA + 1;
    const size_t rowbase = (size_t)b * SEQ;
    const bf16* QpA = F.QKV + (rowbase + 32 * qb) * DIN + C_SWQ + hqA * 64;
    const bf16* Kb = F.QKV + rowbase * DIN + C_SWK + kv * 64;
    const bf16* Vb = F.QKV + rowbase * DIN + C_SWV + kv * 64;
    const float slopeA = __builtin_amdgcn_exp2f(-(float)(hqA + 1)), slopeB = __builtin_amdgcn_exp2f(-(float)(hqB + 1));
    float mA = F.sinks[hqA], mB = F.sinks[hqB];
    bf16x8 qrA[4];
    { const Tile4 tq = tile_load(QpA, lane); tile_store(wl + ATT_K_OFF, KPITCH, tq, lane);
#pragma unroll
      for (int d0 = 0; d0 < 4; ++d0) qrA[d0] = kfrag(wl + ATT_K_OFF, d0, lane); }
    { const Tile4 tq = tile_load(QpA + 64, lane); tile_store(wl + ATT_Q_OFF, KPITCH, tq, lane); }
    float denA = hi == 0 ? 1.f : 0.f, denB = denA;
    f32x16 oA0 = {}, oA1 = {}, oB0 = {}, oB1 = {};
    const int kt0 = qb - 4 < 0 ? 0 : qb - 4;
    for (int kt = kt0; kt <= qb; ++kt) {
        { const Tile4 tk = tile_load(Kb + (size_t)(32 * kt) * DIN, lane), tv = tile_load(Vb + (size_t)(32 * kt) * DIN, lane);
          tile_store(wl + ATT_K_OFF, KPITCH, tk, lane); tile_store(wl + ATT_V_OFF, VPITCH, tv, lane); }
        const bf16x8 vf00 = vfrag(wl + ATT_V_OFF, 0, 0, lane), vf01 = vfrag(wl + ATT_V_OFF, 0, 1, lane), vf10 = vfrag(wl + ATT_V_OFF, 1, 0, lane), vf11 = vfrag(wl + ATT_V_OFF, 1, 1, lane);
        const int dq = 32 * (qb - kt) + r32 - 4 * hi;
        { f32x16 zA = {};
#pragma unroll
          for (int d0 = 0; d0 < 4; ++d0) zA = __builtin_amdgcn_mfma_f32_32x32x16_bf16(kfrag(wl + ATT_K_OFF, d0, lane), qrA[d0], zA, 0, 0, 0);
          SWA_HEAD(zA, slopeA, mA, denA, oA0, oA1); }
        { f32x16 zB = {};
#pragma unroll
          for (int d0 = 0; d0 < 4; ++d0) zB = __builtin_amdgcn_mfma_f32_32x32x16_bf16(kfrag(wl + ATT_K_OFF, d0, lane), kfrag(wl + ATT_Q_OFF, d0, lane), zB, 0, 0, 0);
          SWA_HEAD(zB, slopeB, mB, denB, oB0, oB1); }
    }
    denA += bits_f(partner32(f_bits(denA))); denB += bits_f(partner32(f_bits(denB)));
    bf16* dst = F.MIX + (rowbase + 32 * qb + r32) * D + 512 + hqA * 64;
    head_norm_store(oA0, oA1, 1.0f / denA, F.sw_g + hqA * 64, dst, hi);
    head_norm_store(oB0, oB1, 1.0f / denB, F.sw_g + hqB * 64, dst + 64, hi);
}
__device__ __forceinline__ void p2_attention(Frame& F) {
    LAS unsigned char* wl = F.lds + F.wave * 16384;
    static_assert(ATT_WAVE_BYTES <= 16384 && NWAVES * 16384 <= RING_BYTES, "attention LDS");
    const int gw = F.vcu * NWAVES + F.wave, NGW = F.G * NWAVES;
    constexpr int NSB = NB * 8 * 128, NSW = NB * 4 * 128;
    for (int it = gw; it < NSB + NSW; it += NGW) {
        if (it < NSB) { const int qb = it & 127, h = (it >> 7) & 7, b = it >> 10; sb_item(F, b, h, qb, wl); }
        else { const int r = it - NSB; const int qb = r & 127, hp = (r >> 7) & 1, kv = (r >> 8) & 1, b = r >> 9; swa_item2(F, b, kv, hp, qb, wl); }
    }
}

__device__ __forceinline__ int f2ord(unsigned bits) { int x = (int)bits; return x ^ ((x >> 31) & 0x7fffffff); }
template <int N> __device__ __forceinline__ void bitonic_desc(int (&v)[N]) {
#pragma unroll
    for (int k = 2; k <= N; k <<= 1) {
#pragma unroll
        for (int j = k >> 1; j > 0; j >>= 1) {
#pragma unroll
            for (int i = 0; i < N; ++i) {
                const int l = i ^ j;
                if (l > i) { const bool up = ((i & k) == 0); const int a = v[i], b = v[l]; const int mx = a > b ? a : b, mn = a > b ? b : a; v[i] = up ? mx : mn; v[l] = up ? mn : mx; }
            }
        }
    }
}
template <int N> __device__ __forceinline__ void bitonic_merge_desc(int (&v)[N]) {
#pragma unroll
    for (int j = N >> 1; j > 0; j >>= 1) {
#pragma unroll
        for (int i = 0; i < N; ++i) { const int l = i ^ j; if (l > i) { const int a = v[i], b = v[l]; v[i] = a > b ? a : b; v[l] = a > b ? b : a; } }
    }
}
template <int N> __device__ __forceinline__ void bitonic_desc_kv(int (&k)[N], int (&p)[N]) {
#pragma unroll
    for (int kk = 2; kk <= N; kk <<= 1) {
#pragma unroll
        for (int j = kk >> 1; j > 0; j >>= 1) {
#pragma unroll
            for (int i = 0; i < N; ++i) {
                const int l = i ^ j;
                if (l > i) { const bool up = ((i & kk) == 0); const bool sw = up ? (k[i] < k[l]) : (k[i] > k[l]);
                    const int ka = k[i], kb = k[l], pa = p[i], pb = p[l]; k[i] = sw ? kb : ka; k[l] = sw ? ka : kb; p[i] = sw ? pb : pa; p[l] = sw ? pa : pb; }
            }
        }
    }
}
struct Cand { unsigned char i, j; };
struct CandTable { Cand c[64]; int n; };
constexpr CandTable make_cands() { CandTable t{}; int n = 0; for (int i = 0; i < 16; ++i) for (int j = 0; j < 16; ++j) if ((i + 1) * (j + 1) <= 16) { t.c[n].i = (unsigned char)i; t.c[n].j = (unsigned char)j; ++n; } t.n = n; return t; }
constexpr CandTable CANDS = make_cands();
static_assert(CANDS.n == 50, "candidate count");

constexpr int P6_PITCH = 272, P6_KEYS_BYTES = 128 * P6_PITCH, P6_Q_BYTES = 32 * P6_PITCH;
static_assert(2 * P6_KEYS_BYTES + NWAVES * P6_Q_BYTES <= RING_BYTES, "P6 LDS map");
__device__ __forceinline__ void p6_item(Frame& F, int tb, int h, LAS unsigned char* keys_lds, LAS unsigned char* qw) {
    const int lane = F.lane, r32 = lane & 31, hi = lane >> 5;
    const bf16* QP = F.QKV;
    int top0[16], top1[16];
#pragma unroll 1
    for (int half = 0; half < 2; ++half) {
        { const bf16* qsrc = QP + (size_t)(32 * tb + (lane >> 4)) * DQ + h * 256 + half * 128 + 8 * (lane & 15);
          u32x4 t_[8];
#pragma unroll
          for (int i = 0; i < 8; ++i) t_[i] = *(const GAS u32x4*)(qsrc + (size_t)(4 * i) * DQ);
#pragma unroll
          for (int i = 0; i < 8; ++i) *(LAS u32x4*)(qw + (4 * i + (lane >> 4)) * P6_PITCH + 16 * (lane & 15)) = t_[i]; }
        bf16x8 qf[8];
#pragma unroll
        for (int ks = 0; ks < 8; ++ks) { const u32x4 w_ = *(const LAS u32x4*)(qw + r32 * P6_PITCH + 32 * ks + 16 * hi); qf[ks] = __builtin_bit_cast(bf16x8, w_); }
        const LAS unsigned char* kb = keys_lds + half * P6_KEYS_BYTES + r32 * P6_PITCH + 16 * hi;
        int v[64];
#pragma unroll
        for (int nt = 0; nt < 4; ++nt) {
            f32x16 acc = {};
#pragma unroll
            for (int ks = 0; ks < 8; ++ks) { const u32x4 w_ = *(const LAS u32x4*)(kb + (32 * nt) * P6_PITCH + 32 * ks); acc = __builtin_amdgcn_mfma_f32_32x32x16_bf16(__builtin_bit_cast(bf16x8, w_), qf[ks], acc, 0, 0, 0); }
#pragma unroll
            for (int r = 0; r < 16; ++r) { const float av = acc[r]; const unsigned bits = (f_bits(av) & ~0x7Fu) | (unsigned)(32 * nt + crow(r, hi)); v[16 * nt + r] = f2ord(bits); }
        }
        bitonic_desc<64>(v);
        int m[16];
#pragma unroll
        for (int i = 0; i < 16; ++i) { const int o = (int)partner32((unsigned)v[15 - i]); m[i] = v[i] > o ? v[i] : o; }
        bitonic_merge_desc<16>(m);
#pragma unroll
        for (int i = 0; i < 16; ++i) { if (half == 0) top0[i] = m[i]; else top1[i] = m[i]; }
    }
    float f1[16], f2[16]; int i1[16], i2[16];
#pragma unroll
    for (int i = 0; i < 16; ++i) { const unsigned b1 = (unsigned)f2ord((unsigned)top0[i]), b2 = (unsigned)f2ord((unsigned)top1[i]);
        f1[i] = bits_f(b1 & ~0x7Fu); i1[i] = (int)(b1 & 0x7Fu); f2[i] = bits_f(b2 & ~0x7Fu); i2[i] = (int)(b2 & 0x7Fu); }
    int ck[32], cp[32];
#pragma unroll
    for (int s = 0; s < 32; ++s) {
        if (s < 25) { constexpr int dummy = 0; (void)dummy;
            const int ia = CANDS.c[2 * s].i, ja = CANDS.c[2 * s].j, ib = CANDS.c[2 * s + 1].i, jb = CANDS.c[2 * s + 1].j;
            const float sa = f1[ia] + f2[ja], sb = f1[ib] + f2[jb]; const int pa = (i1[ia] << 7) | i2[ja], pb = (i1[ib] << 7) | i2[jb];
            ck[s] = f2ord(f_bits(hi ? sb : sa)); cp[s] = hi ? pb : pa;
        } else { ck[s] = (int)0x80000000; cp[s] = 0; }
    }
    bitonic_desc_kv<32>(ck, cp);
    int wk[16], wp[16];
#pragma unroll
    for (int i = 0; i < 16; ++i) { const int ok = (int)partner32((unsigned)ck[15 - i]), op = (int)partner32((unsigned)cp[15 - i]); const bool t = ck[i] >= ok; wk[i] = t ? ck[i] : ok; wp[i] = t ? cp[i] : op; }
    float vals[16]; float mxv = -INFINITY;
#pragma unroll
    for (int i = 0; i < 16; ++i) { vals[i] = bits_f((unsigned)f2ord((unsigned)wk[i])); mxv = __builtin_fmaxf(mxv, vals[i]); }
    float se = 0.f;
#pragma unroll
    for (int i = 0; i < 16; ++i) { vals[i] = __builtin_amdgcn_exp2f((vals[i] - mxv) * LOG2E); se += vals[i]; }
    const float inv = 1.0f / se;
    const size_t ob = (size_t)(32 * tb + r32) * 128 + h * 16 + hi * 8;
    { u32x4 a; a.x = (unsigned)wp[0] | ((unsigned)wp[1] << 16); a.y = (unsigned)wp[2] | ((unsigned)wp[3] << 16); a.z = (unsigned)wp[4] | ((unsigned)wp[5] << 16); a.w = (unsigned)wp[6] | ((unsigned)wp[7] << 16);
      *(GAS u32x4*)(F.IDX + ob) = a;
      f32x4 ga = {vals[0] * inv, vals[1] * inv, vals[2] * inv, vals[3] * inv}, gb = {vals[4] * inv, vals[5] * inv, vals[6] * inv, vals[7] * inv};
      *(GAS f32x4*)(F.GATE + ob) = ga; *(GAS f32x4*)(F.GATE + ob + 4) = gb; }
}
template <class Sched> __device__ __forceinline__ void p6_topk_own(Frame& F, const Sched& S) {
    LAS unsigned char* keys_lds = F.lds; LAS unsigned char* qw = F.lds + 2 * P6_KEYS_BYTES + F.wave * P6_Q_BYTES;
    pg8::Unit u; int hprev = -1;
    for (int i = 0; S.next(i, u); ++i) {
        const int h = u.pn;
        if (h != hprev) {
            __syncthreads();
#pragma unroll
            for (int half = 0; half < 2; ++half) {
                const bf16* ksrc = F.KEYS + (size_t)(half * 8 + h) * 128 * 128 + (size_t)(F.tid >> 4) * 128 + 8 * (F.tid & 15);
                u32x4 t_[4];
#pragma unroll
                for (int q = 0; q < 4; ++q) t_[q] = *(const GAS u32x4*)(ksrc + (size_t)(32 * q) * 128);
#pragma unroll
                for (int q = 0; q < 4; ++q) *(LAS u32x4*)(keys_lds + half * P6_KEYS_BYTES + ((F.tid >> 4) + 32 * q) * P6_PITCH + 16 * (F.tid & 15)) = t_[q];
            }
            __syncthreads(); hprev = h;
        }
        p6_item(F, 8 * u.pm + F.wave, h, keys_lds, qw);
    }
    { const int gw_ = F.vcu * NWAVES + F.wave, NGW_ = F.G * NWAVES; for (int r = NEXP + gw_; r < 2 * NEXP; r += 4 * NGW_) cvt_rows_fp8<4>(F, r, NGW_, 2 * NEXP, F.lane); }
    __syncthreads();
}

__device__ __forceinline__ float dpp_xor1(float v) { return v + bits_f((unsigned)__builtin_amdgcn_update_dpp(0, (int)f_bits(v), 0xB1, 0xf, 0xf, false)); }
__device__ __forceinline__ float dpp_xor2(float v) { return v + bits_f((unsigned)__builtin_amdgcn_update_dpp(0, (int)f_bits(v), 0x4E, 0xf, 0xf, false)); }
__device__ __forceinline__ float dpp_hmir(float v) { return v + bits_f((unsigned)__builtin_amdgcn_update_dpp(0, (int)f_bits(v), 0x141, 0xf, 0xf, false)); }
__device__ __forceinline__ float dpp_max_xor1(float v) { return __builtin_fmaxf(v, bits_f((unsigned)__builtin_amdgcn_update_dpp(0, (int)f_bits(v), 0xB1, 0xf, 0xf, false))); }
__device__ __forceinline__ float dpp_max_xor2(float v) { return __builtin_fmaxf(v, bits_f((unsigned)__builtin_amdgcn_update_dpp(0, (int)f_bits(v), 0x4E, 0xf, 0xf, false))); }
__device__ __forceinline__ float dpp_max_hmir(float v) { return __builtin_fmaxf(v, bits_f((unsigned)__builtin_amdgcn_update_dpp(0, (int)f_bits(v), 0x141, 0xf, 0xf, false))); }
__device__ __forceinline__ float dpp_rmir(float v) { return v + bits_f((unsigned)__builtin_amdgcn_update_dpp(0, (int)f_bits(v), 0x140, 0xf, 0xf, false)); }
__device__ __forceinline__ f32x2_t fp8x2(unsigned w, bool hi) { return hi ? __builtin_amdgcn_cvt_pk_f32_fp8((int)w, true) : __builtin_amdgcn_cvt_pk_f32_fp8((int)w, false); }
__device__ __forceinline__ float gelu_tanh(float x) {
    const float y2 = 1.5957691216057308f * (x + 0.044715f * x * x * x);
    return x / (1.0f + __builtin_amdgcn_exp2f(-y2 * LOG2E));
}
__device__ __forceinline__ unsigned vsel16(const u32x4 (&v)[2], int k) { const u32x4 q = v[k >> 3]; const int j = (k >> 1) & 3; const unsigned w = j == 0 ? q.x : j == 1 ? q.y : j == 2 ? q.z : q.w; return (k & 1) ? (w >> 16) : (w & 0xffffu); }
struct TokIn { u32x4 id[2]; u32x4 x0, x1; };
__device__ __forceinline__ int vsel(const u32x4 (&v)[4], int k) { const u32x4 q = v[k >> 2]; const int j = k & 3; return (int)(j == 0 ? q.x : j == 1 ? q.y : j == 2 ? q.z : q.w); }
__device__ __forceinline__ void p7_udots(Frame& F) {
    const int lane = F.lane, g = lane >> 3, c = lane & 7;
    const int s = blockIdx.x & 7, rank = blockIdx.x >> 3, nloc = F.G >> 3;
    const unsigned char* tab = F.U8 + (size_t)s * TAB8_SLICE; const unsigned coff16 = 16u * (unsigned)c;
    bf16* pd = F.PD + (size_t)s * T * 128;
    const int t0 = rank * NWAVES + F.wave, tstride = nloc * NWAVES;
#define P7_IDS(dst, tt) do { const int t_ = (tt) < T ? (tt) : t0; const GAS u32x4* ip_ = (const GAS u32x4*)(F.IDX + (size_t)t_ * 128 + 16 * g); dst.id[0] = ip_[0]; dst.id[1] = ip_[1]; } while (0)
#define P7_X(dst, tt) do { const int t_ = (tt) < T ? (tt) : t0; const bf16* xr_ = F.H + (size_t)t_ * D + 128 * s + 16 * c; dst.x0 = *(const GAS u32x4*)xr_; dst.x1 = *(const GAS u32x4*)(xr_ + 8); } while (0)
#define P7_PCS(pc, in) do { _Pragma("unroll") for (int k = 0; k < 16; ++k) pc[k] = *(const GAS u32x4*)(tab + ((vsel16(in.id, k) << 7) | coff16)); } while (0)
#define P7_MATH(pc, in, tt) do { if ((tt) < T) { \
        float xv[16]; { const unsigned a0 = in.x0.x, a1 = in.x0.y, a2 = in.x0.z, a3 = in.x0.w, b0 = in.x1.x, b1 = in.x1.y, b2 = in.x1.z, b3 = in.x1.w; \
          xv[0] = bf_lo(a0); xv[1] = bf_hi(a0); xv[2] = bf_lo(a1); xv[3] = bf_hi(a1); xv[4] = bf_lo(a2); xv[5] = bf_hi(a2); xv[6] = bf_lo(a3); xv[7] = bf_hi(a3); \
          xv[8] = bf_lo(b0); xv[9] = bf_hi(b0); xv[10] = bf_lo(b1); xv[11] = bf_hi(b1); xv[12] = bf_lo(b2); xv[13] = bf_hi(b2); xv[14] = bf_lo(b3); xv[15] = bf_hi(b3); } \
          \
        float xm = 0.f; _Pragma("unroll") for (int i = 0; i < 16; ++i) xm = __builtin_fmaxf(xm, __builtin_fabsf(xv[i])); \
        xm = dpp_max_hmir(dpp_max_xor2(dpp_max_xor1(xm))); \
        const float sx = xm > 0.f ? 127.0f / xm : 0.f, isx = xm * (1.0f / 127.0f); \
        const int xq0 = pack_i8(xv[0] * sx, xv[1] * sx, xv[2] * sx, xv[3] * sx), xq1 = pack_i8(xv[4] * sx, xv[5] * sx, xv[6] * sx, xv[7] * sx), \
                  xq2 = pack_i8(xv[8] * sx, xv[9] * sx, xv[10] * sx, xv[11] * sx), xq3 = pack_i8(xv[12] * sx, xv[13] * sx, xv[14] * sx, xv[15] * sx); \
        float r0 = 0.f, r1 = 0.f; \
        _Pragma("unroll") for (int k = 0; k < 16; ++k) { \
            const unsigned w0 = pc[k].x, w1 = pc[k].y, w2 = pc[k].z, w3 = pc[k].w; \
            int ia = __builtin_amdgcn_sdot4((int)w0, xq0, 0, false); ia = __builtin_amdgcn_sdot4((int)w1, xq1, ia, false); ia = __builtin_amdgcn_sdot4((int)w2, xq2, ia, false); ia = __builtin_amdgcn_sdot4((int)w3, xq3, ia, false); \
            float p = (float)ia; p = dpp_hmir(dpp_xor2(dpp_xor1(p))); \
            if (k < 8) r0 = (c == k) ? p : r0; else r1 = (c == (k - 8)) ? p : r1; } \
        r0 *= isx; r1 *= isx; \
        pd[(size_t)(tt) * 128 + 16 * g + c] = (bf16)(pk2(r0, r0) & 0xffffu); pd[(size_t)(tt) * 128 + 16 * g + 8 + c] = (bf16)(pk2(r1, r1) & 0xffffu); } } while (0)
    TokIn inA, inB, inC, inN; u32x4 pcA[16], pcB[16], pcC[16];
    P7_IDS(inA, t0); P7_X(inA, t0); P7_PCS(pcA, inA); P7_IDS(inB, t0 + tstride); P7_X(inB, t0 + tstride); P7_PCS(pcB, inB); P7_IDS(inC, t0 + 2 * tstride);
    for (int t = t0; t < T; t += 3 * tstride) {
        P7_X(inC, t + 2 * tstride); P7_PCS(pcC, inC); P7_IDS(inN, t + 3 * tstride); __builtin_amdgcn_sched_barrier(0);
        P7_MATH(pcA, inA, t); __builtin_amdgcn_sched_barrier(0);
        inA.id[0] = inN.id[0]; inA.id[1] = inN.id[1];
        P7_X(inA, t + 3 * tstride); P7_PCS(pcA, inA); P7_IDS(inN, t + 4 * tstride); __builtin_amdgcn_sched_barrier(0);
        P7_MATH(pcB, inB, t + tstride); __builtin_amdgcn_sched_barrier(0);
        inB.id[0] = inN.id[0]; inB.id[1] = inN.id[1];
        P7_X(inB, t + 4 * tstride); P7_PCS(pcB, inB); P7_IDS(inN, t + 5 * tstride); __builtin_amdgcn_sched_barrier(0);
        P7_MATH(pcC, inC, t + 2 * tstride); __builtin_amdgcn_sched_barrier(0);
        inC.id[0] = inN.id[0]; inC.id[1] = inN.id[1];
    }
#undef P7_IDS
#undef P7_X
#undef P7_PCS
#undef P7_MATH
}
__device__ __forceinline__ void p8_combine(Frame& F) {
    const int gw = F.vcu * NWAVES + F.wave, NGW = F.G * NWAVES, lane = F.lane;
    constexpr int NU = 4;
    for (int t0 = gw; t0 < T; t0 += NU * NGW) {
        unsigned pdw[NU][8], idw[NU]; f32x2_t gt[NU];
#pragma unroll
        for (int u = 0; u < NU; ++u) { const int t = t0 + u * NGW < T ? t0 + u * NGW : t0; const size_t o = (size_t)t * 128 + 2 * lane;
#pragma unroll
            for (int s = 0; s < 8; ++s) pdw[u][s] = __builtin_nontemporal_load((const GAS unsigned*)(F.PD + (size_t)s * T * 128 + o));
            idw[u] = *(const GAS unsigned*)(F.IDX + o); gt[u] = __builtin_nontemporal_load((const GAS f32x2_t*)(F.GATE + o)); }
        float ru0[NU], ru1[NU], rv0[NU], rv1[NU], r2[NU];
#pragma unroll
        for (int u = 0; u < NU; ++u) { const int t = t0 + u * NGW < T ? t0 + u * NGW : t0; const int i0 = (int)(idw[u] & 0xffffu), i1 = (int)(idw[u] >> 16);
            ru0[u] = F.RSU[i0]; ru1[u] = F.RSU[i1]; rv0[u] = F.RSV[i0]; rv1[u] = F.RSV[i1]; r2[u] = F.RS2[t]; }
#pragma unroll
        for (int u = 0; u < NU; ++u) { const int t = t0 + u * NGW;
            float d0 = 0.f, d1 = 0.f;
#pragma unroll
            for (int s = 0; s < 8; ++s) { const unsigned w = pdw[u][s]; d0 += bf_lo(w); d1 += bf_hi(w); }
            const float c0 = gt[u].x * gelu_tanh(d0 * ru0[u] * r2[u]) * rv0[u], c1 = gt[u].y * gelu_tanh(d1 * ru1[u] * r2[u]) * rv1[u];
            const float m = wave_max(__builtin_fmaxf(__builtin_fabsf(c0), __builtin_fabsf(c1)));
            const float sq = m > 0.f ? 127.0f / m : 0.f;
            const int q0 = (int)__builtin_rintf(c0 * sq), q1 = (int)__builtin_rintf(c1 * sq);
            if (t < T) { *(GAS unsigned short*)(F.C8 + (size_t)t * 128 + 2 * lane) = (unsigned short)((q0 & 0xff) | ((q1 & 0xff) << 8)); if (lane == 0) F.CS[t] = m * (1.0f / 127.0f); } }
    }
}
typedef int v2i_t __attribute__((ext_vector_type(2)));
typedef int v4i_t __attribute__((ext_vector_type(4)));
constexpr int P9_PITCH = 144, P9_WAVE_BYTES = 128 * P9_PITCH, P9_OSC_OFF = LDSCTL_OFF + 512;
static_assert(NWAVES * P9_WAVE_BYTES <= RING_BYTES && P9_OSC_OFF + NWAVES * 512 <= LDS_BYTES, "P9 LDS map");
struct TokInV { u32x4 id[2]; u32x4 a0, a1; u32x2 xb; float cs; };
__device__ __forceinline__ void p9_vacc(Frame& F) {
    const int lane = F.lane, g = lane >> 3, c = lane & 7, m16 = lane & 15, q = lane >> 4;
    const int s = blockIdx.x & 7, rank = blockIdx.x >> 3, nloc = F.G >> 3;
    const unsigned char* tab = F.V8 + (size_t)s * TAB8_SLICE; const unsigned coff16 = 16u * (unsigned)c;
    const int t0 = rank * NWAVES + F.wave, tstride = nloc * NWAVES;
    LAS unsigned char* wl = F.lds + F.wave * P9_WAVE_BYTES;
    LAS float* osc = (LAS float*)(F.lds + P9_OSC_OFF + F.wave * 512);
    LAS unsigned char* wst = wl + (16 * g) * P9_PITCH + 16 * c;
    const LAS unsigned char* wrd = wl + (16 * q + (m16 >> 1)) * P9_PITCH + 8 * (m16 & 1);
    const int coff = 128 * s + 4 * (lane & 31);
#define P9_IN(dst, tt) do { const int t_ = (tt) < T ? (tt) : t0; const GAS u32x4* ip_ = (const GAS u32x4*)(F.IDX + (size_t)t_ * 128 + 16 * g); dst.id[0] = ip_[0]; dst.id[1] = ip_[1]; \
        const GAS u32x4* cp_ = (const GAS u32x4*)(F.C8 + (size_t)t_ * 128 + 16 * q); const u32x4 z_ = {0u, 0u, 0u, 0u}; dst.a0 = cp_[0]; dst.a1 = cp_[4]; if (m16 != 0) { dst.a0 = z_; dst.a1 = z_; } \
        dst.xb = *(const GAS u32x2*)(F.H + (size_t)t_ * D + coff); dst.cs = F.CS[t_]; } while (0)
#define P9_PCS(pc, in) do { _Pragma("unroll") for (int k = 0; k < 16; ++k) pc[k] = *(const GAS u32x4*)(tab + ((vsel16(in.id, k) << 7) | coff16)); } while (0)
#define P9_STAGE(pc) do { _Pragma("unroll") for (int k = 0; k < 16; ++k) *(LAS u32x4*)(wst + k * P9_PITCH) = pc[k]; } while (0)
#define P9_MATH(in, tt) do { if ((tt) < T) { \
        v4i_t acc[8]; _Pragma("unroll") for (int nb = 0; nb < 8; ++nb) acc[nb] = (v4i_t){0, 0, 0, 0}; \
        _Pragma("unroll") for (int s2 = 0; s2 < 2; ++s2) { const v4i_t av = __builtin_bit_cast(v4i_t, s2 ? in.a1 : in.a0); \
            _Pragma("unroll") for (int nb = 0; nb < 8; ++nb) { \
                const v2i_t lo = __builtin_amdgcn_ds_read_tr8_b64_v2i32((LAS v2i_t*)(wrd + (64 * s2) * P9_PITCH + 16 * nb)); \
                const v2i_t hi = __builtin_amdgcn_ds_read_tr8_b64_v2i32((LAS v2i_t*)(wrd + (64 * s2 + 8) * P9_PITCH + 16 * nb)); \
                const v4i_t bv = {lo.x, lo.y, hi.x, hi.y}; \
                acc[nb] = __builtin_amdgcn_mfma_i32_16x16x64_i8(av, bv, acc[nb], 0, 0, 0); } } \
          \
        if (lane < 16) { _Pragma("unroll") for (int nb = 0; nb < 8; ++nb) osc[16 * nb + lane] = (float)acc[nb][0] * in.cs; } \
        asm volatile("" ::: "memory"); \
        float ss = 0.f; \
        if (lane < 32) { const f32x4 d_ = *(const LAS f32x4*)(osc + 4 * lane); bf16* op_ = F.X2 + (size_t)(tt) * D + coff; const unsigned xb0_ = in.xb.x, xb1_ = in.xb.y; \
            const f32x4 y = {bf_lo(xb0_) + d_[0], bf_hi(xb0_) + d_[1], bf_lo(xb1_) + d_[2], bf_hi(xb1_) + d_[3]}; \
            ss = (y.x * y.x + y.y * y.y) + (y.z * y.z + y.w * y.w); u32x2 yw_; yw_.x = pk2(y.x, y.y); yw_.y = pk2(y.z, y.w); *(GAS u32x2*)op_ = yw_; } \
        ss = dpp_rmir(dpp_hmir(dpp_xor2(dpp_xor1(ss)))); if ((lane & 47) == 0) F.SSP[((size_t)s * T + (tt)) * 2 + (lane >> 4)] = ss; } } while (0)
    TokInV inA, inB, inC; u32x4 pcA[16], pcB[16];
    P9_IN(inA, t0); P9_PCS(pcA, inA); P9_IN(inB, t0 + tstride); P9_PCS(pcB, inB); P9_IN(inC, t0 + 2 * tstride);
    for (int t = t0; t < T; t += 2 * tstride) {
        TokInV inD, inE;
        P9_STAGE(pcA); P9_PCS(pcA, inC); P9_IN(inD, t + 3 * tstride); __builtin_amdgcn_sched_barrier(0);
        P9_MATH(inA, t); __builtin_amdgcn_sched_barrier(0);
        P9_STAGE(pcB); P9_PCS(pcB, inD); P9_IN(inE, t + 4 * tstride); __builtin_amdgcn_sched_barrier(0);
        P9_MATH(inB, t + tstride); __builtin_amdgcn_sched_barrier(0);
        inA = inC; inB = inD; inC = inE;
    }
#undef P9_IN
#undef P9_PCS
#undef P9_STAGE
#undef P9_MATH
}
__device__ __forceinline__ void p10_final(Frame& F) {
    const int gw = F.vcu * NWAVES + F.wave, NGW = F.G * NWAVES, lane = F.lane;
    for (int t = gw; t < T; t += NGW) {
        float ss = 0.f;
#pragma unroll
        for (int s = 0; s < 8; ++s) ss += F.SSP[((size_t)s * T + t) * 2] + F.SSP[((size_t)s * T + t) * 2 + 1];
        const float rs = __builtin_amdgcn_rsqf(ss * (1.f / D) + EPS);
        GAS f32x4* xr = (GAS f32x4*)(F.out + (size_t)t * D) + lane; const GAS f32x4* gr = (const GAS f32x4*)F.gf + lane; const GAS u32x2* br = (const GAS u32x2*)(F.X2 + (size_t)t * D) + lane;
#pragma unroll
        for (int j = 0; j < 4; ++j) { const u32x2 w = __builtin_nontemporal_load(br + 64 * j); const unsigned w0 = w.x, w1 = w.y; const f32x4 gg = gr[64 * j]; __builtin_nontemporal_store((f32x4){bf_lo(w0) * rs * gg.x, bf_hi(w0) * rs * gg.y, bf_lo(w1) * rs * gg.z, bf_hi(w1) * rs * gg.w}, xr + 64 * j); }
    }
}
struct Args { const float* in[14]; float* out; unsigned char* ws; int ph_lo, ph_hi, li, pad; };
__global__ void __launch_bounds__(NWAVES * 64, 2) mk_fwd(Args args) {
    extern __shared__ __attribute__((aligned(16))) unsigned char lds[];
#ifdef PROBE_LO
    unsigned long long pmk_lo = 0, pmk_hi = 0;
    if (PROBE_LO == -1) { asm volatile("s_memrealtime %0\n\ts_waitcnt lgkmcnt(0)" : "=s"(pmk_lo) :: "memory"); }
#endif
    Frame F;
    F.lds = (LAS unsigned char*)lds;
    F.MISC = (volatile LAS unsigned*)(F.lds + MISC_OFF);
    F.tid = threadIdx.x; F.lane = F.tid & 63; F.wave = __builtin_amdgcn_readfirstlane(F.tid >> 6);
    F.G = gridDim.x; { const int bx = blockIdx.x; F.vcu = (F.G % 8 == 0) ? (bx % 8) * (F.G / 8) + bx / 8 : bx; }
    unsigned char* ws = args.ws;
    F.ctl = (gu32*)(ws + WS_CTL);
    F.x = args.in[0]; F.g1 = args.in[1]; F.w_in = args.in[2]; F.sb_g = args.in[3]; F.sw_g = args.in[4]; F.sinks = args.in[5]; F.w_out = args.in[6]; F.g2 = args.in[7];
    F.w_q = args.in[8]; F.keys1 = args.in[9]; F.keys2 = args.in[10]; F.pu = args.in[11]; F.pv = args.in[12]; F.gf = args.in[13]; F.out = args.out;
    F.Wt_in = (bf16*)(ws + WS_WIN); F.Wt_out = (bf16*)(ws + WS_WOUT); F.Wt_q = (bf16*)(ws + WS_WQ); F.KEYS = (bf16*)(ws + WS_KEYS);
    F.H = (bf16*)(ws + WS_H); F.MIX = (bf16*)(ws + WS_MIX); F.QKV = (bf16*)(ws + WS_QKV); F.U8 = ws + WS_U8; F.V8 = ws + WS_V8; F.RSU = (float*)(ws + WS_RSU); F.RSV = (float*)(ws + WS_RSV);
    F.IRS1 = (float*)(ws + WS_IRS1); F.SSQP = (float*)(ws + WS_SSQP); F.RS2 = (float*)(ws + WS_RS2); F.PD = (bf16*)(ws + WS_PD); F.X2 = (bf16*)(ws + WS_X2); F.C8 = ws + WS_C; F.CS = (float*)(ws + WS_C + 6 * MiB); F.SSP = (float*)(ws + WS_SSP);
    F.IDX = (unsigned short*)(ws + WS_IDX); F.GATE = (float*)(ws + WS_GATE);
    for (int u = F.tid; u < (LDS_BYTES - LDSCTL_OFF) / 4; u += NWAVES * 64) ((LAS unsigned*)(F.lds + LDSCTL_OFF))[u] = 0u;
    __syncthreads();
    const int lo = args.ph_lo, hi = args.ph_hi;
    const bool use_bar = (hi - lo) > 1;
    XcdBarrier bar; bar.bar = (unsigned*)(F.ctl + CW_BAR) + args.li * XCD_BAR_WORDS; bar.x = 0; bar.st = nullptr;
    if (use_bar) bar = xcd_barrier_post((unsigned*)(F.ctl + CW_BAR) + args.li * XCD_BAR_WORDS, F.MISC + 8);
#ifndef PHMASK
#define PHMASK 2047
#endif
#define IN(k) (((PHMASK >> (k)) & 1) && lo <= (k) && (k) < hi)
#define SEAM(k) do { if (IN(k) && IN((k) + 1)) xcd_barrier(bar); } while (0)
    const int gw = F.vcu * NWAVES + F.wave, NGW = F.G * NWAVES;
#ifdef PROBE_LO
#define PSTAMP(v) asm volatile("s_memrealtime %0\n\ts_waitcnt lgkmcnt(0)" : "=s"(v) :: "memory")
#define PMARK(k) do { if ((k) == PROBE_LO) { PSTAMP(pmk_lo); } if ((k) == PROBE_HI + 1) { PSTAMP(pmk_hi); } } while (0)
#else
#define PMARK(k) do {} while (0)
#endif

    PMARK(0);
    if (IN(0)) { p0_prologue(F); } SEAM(0);
    PMARK(1);
    if (IN(1)) { pg8::Gemm g{F.H, F.Wt_in, T, DIN, D}; pg8::StaticOrder S; S.init(T, DIN, F.G, (int)blockIdx.x); pg8::EpiBf16 E{F.QKV, DIN};
        pg8::gemm_phase<pg8::EpiBf16, pg8::StaticOrder>(F.lds, g, S, E);
        { const int nfull = (T / 256) * (DIN / 256) % F.G, nb = F.G - nfull;
          if (nb == F.G) { for (int r = (int)blockIdx.x * NWAVES + F.wave; r < NEXP; r += 4 * F.G * NWAVES) cvt_rows_fp8<4>(F, r, F.G * NWAVES, NEXP, F.lane); }
          else if ((int)blockIdx.x >= nfull) { for (int r = ((int)blockIdx.x - nfull) * NWAVES + F.wave; r < NEXP; r += 4 * nb * NWAVES) cvt_rows_fp8<4>(F, r, nb * NWAVES, NEXP, F.lane); } }
        } SEAM(1);
    PMARK(2);
    if (IN(2)) { p2_attention(F); } SEAM(2);
    PMARK(3);
    if (IN(3)) { pg8::Gemm g{F.MIX, F.Wt_out, T, D, D}; pg8::StaticOrder S; S.init(T, D, F.G, (int)blockIdx.x); pg8::EpiResB E{F.g1, F.IRS1, F.H, D, F.SSQP};
        pg8::gemm_phase<pg8::EpiResB, pg8::StaticOrder>(F.lds, g, S, E); } SEAM(3);
    PMARK(4);
    PMARK(5);
    if (IN(5)) { pg8::Gemm g{F.H, F.Wt_q, T, DQ, D}; pg8::StaticOrder S; S.init(T, DQ, F.G, (int)blockIdx.x); pg8::EpiBf16RS E{F.QKV, DQ, F.SSQP, F.RS2};
        pg8::gemm_phase<pg8::EpiBf16RS, pg8::StaticOrder>(F.lds, g, S, E);
        asm volatile("s_waitcnt vmcnt(0)" ::: "memory"); __syncthreads();
        p6_topk_own(F, S); }
    PMARK(6);
    SEAM(6);
    PMARK(7);
    if (IN(7)) { p7_udots(F); } SEAM(7);
    PMARK(8);
    if (IN(8)) { p8_combine(F); } SEAM(8);
    PMARK(9);
    if (IN(9)) { p9_vacc(F); } SEAM(9);
    PMARK(10);
    if (IN(10)) { p10_final(F); }
#ifdef PROBE_LO
    xcd_barrier(bar);
    PMARK(11);
    if (blockIdx.x == 0 && F.tid == 0) { unsigned long long t0, t1; PSTAMP(t0); const unsigned long long dl = (pmk_hi - pmk_lo) * PROBE_MULT;
        do { __builtin_amdgcn_s_sleep(8); PSTAMP(t1); } while (t1 - t0 < dl); }
#endif
#undef IN
#undef SEAM
}

extern "C" void kernel_launch(void* const* d_in, const int* in_sizes, int n_in, void* d_out, int out_size, void* d_ws, size_t ws_size, hipStream_t stream) {
    static int grid = 0;
    if (grid == 0) {
        if (n_in != 14 || in_sizes[0] != T * D || out_size != T * D || ws_size < WS_END) { fprintf(stderr, "kernel_launch: unexpected shapes (n_in %d, in0 %d, out %d, ws %zu)\n", n_in, n_in > 0 ? in_sizes[0] : -1, out_size, ws_size); grid = -1; return; }
        int dev = 0, cus = 0, per_cu = 0;
        if (hipGetDevice(&dev) != hipSuccess || hipDeviceGetAttribute(&cus, hipDeviceAttributeMultiprocessorCount, dev) != hipSuccess) { grid = -1; return; }
        if (hipFuncSetAttribute((const void*)mk_fwd, hipFuncAttributeMaxDynamicSharedMemorySize, LDS_BYTES) != hipSuccess) { fprintf(stderr, "kernel_launch: hipFuncSetAttribute failed\n"); grid = -1; return; }
        if (hipOccupancyMaxActiveBlocksPerMultiprocessor(&per_cu, (const void*)mk_fwd, NWAVES * 64, LDS_BYTES) != hipSuccess || per_cu < 1)
            fprintf(stderr, "kernel_launch: note: occupancy query reports %d workgroups per CU\n", per_cu);
        (void)hipGetLastError();
        grid = cus;
    }
    if (grid < 0) return;
    if (hipMemsetAsync((char*)d_ws + WS_CTL, 0, CTL_ZERO_BYTES, stream) != hipSuccess) { fprintf(stderr, "kernel_launch: hipMemsetAsync failed\n"); return; }
    Args a{};
    for (int i = 0; i < 14; ++i) a.in[i] = (const float*)d_in[i];
    a.out = (float*)d_out; a.ws = (unsigned char*)d_ws;
#if MK_N_LAUNCHES == 1
    a.ph_lo = 0; a.ph_hi = N_PHASES; a.li = 0;
    hipLaunchKernelGGL(mk_fwd, dim3(grid), dim3(NWAVES * 64), LDS_BYTES, stream, a);
#else
    for (int li = 0; li < N_PHASES; ++li) { a.ph_lo = li; a.ph_hi = li + 1; a.li = 0; hipLaunchKernelGGL(mk_fwd, dim3(grid), dim3(NWAVES * 64), LDS_BYTES, stream, a); }
#endif
    const hipError_t le = hipPeekAtLastError();
    if (le != hipSuccess) fprintf(stderr, "kernel_launch: launch failed: %s\n", hipGetErrorName(le));
}
```

```cpp
#include <hip/hip_runtime.h>
#include <cstdio>
#include <cstdint>

#ifndef MK_N_LAUNCHES
#define MK_N_LAUNCHES 1
#endif

#define LAS __attribute__((address_space(3)))
#define GAS __attribute__((address_space(1)))
typedef unsigned short bf16;
typedef short bf16x8 __attribute__((ext_vector_type(8)));
typedef float f32x4 __attribute__((ext_vector_type(4)));
typedef float f32x16 __attribute__((ext_vector_type(16)));
typedef unsigned u32x4 __attribute__((ext_vector_type(4)));
typedef unsigned u32x2 __attribute__((ext_vector_type(2)));
typedef short v4i16_t __attribute__((ext_vector_type(4)));
typedef float f32x2_t __attribute__((ext_vector_type(2)));
typedef __bf16 bf16x2_t __attribute__((ext_vector_type(2)));
typedef GAS unsigned gu32;

constexpr int T = 16384, SEQ = 4096, NB = 4, D = 1024, DIN = 2304, DQ = 2048;
constexpr int C_SBQ = 0, C_SBK = 512, C_SBV = 1024, C_SWQ = 1536, C_SWK = 2048, C_SWV = 2176;
constexpr int NEXP = 16384;
constexpr float EPS = 1e-6f;
constexpr float LOG2E = 1.4426950408889634f, LN2 = 0.6931471805599453f;
constexpr float SB_EXIT = -40.0f;

namespace pg8 {
constexpr int BM = 256, BK = 64, HALF = 128, HTB = HALF * BK * 2, STAGE_BYTES = 8 * HTB, NXCD = 8, WGM = 8;
__host__ __device__ __forceinline__ int lds_byte(int r, int c) { const int st = (r >> 4) * 2 + (c >> 5), rr = r & 15, cc = c & 31, ob = rr * 64 + cc * 2; return st * 1024 + (ob ^ (((ob >> 9) & 1) << 5)); }
__host__ __device__ __forceinline__ void stage_rc(int b, int& R, int& C) { const int st = b / 1024, sb = b % 1024, swz = sb ^ (((sb >> 9) & 1) << 5); R = (st >> 1) * 16 + swz / 64; C = (st & 1) * 32 + (swz % 64) / 2; }
__host__ __device__ __forceinline__ int perm32(int rho) { const int n = rho >> 4, i = rho & 15; return 8 * (i >> 2) + 4 * n + (i & 3); }
struct Unit { int pm, pn; };
struct Gemm { const bf16* A; const bf16* Bt; int M, N, K; };
struct StaticOrder {
    int nM, nN, nwg, G, c;
    __host__ __device__ void init(int M, int N, int G_, int c_) { nM = M / BM; nN = N / BM; nwg = nM * nN; G = G_; c = c_; }
    __host__ __device__ bool next(int i, Unit& u) const {
        const long L = (long)i * G + c; if (L >= nwg) return false;
        int wgid = (int)L; { const int q = nwg / NXCD, r = nwg % NXCD, xcd = wgid % NXCD, off = wgid / NXCD; wgid = (xcd < r ? xcd * (q + 1) : r * (q + 1) + (xcd - r) * q) + off; }
        const int nig = WGM * nN, gid = wgid / nig, fm = gid * WGM, gsz = (nM - fm) < WGM ? (nM - fm) : WGM;
        u.pm = fm + ((wgid % nig) % gsz); u.pn = (wgid % nig) / gsz; return true;
    }
};
__device__ __forceinline__ unsigned cvt_pk_bf16(float lo, float hi) { f32x2_t v = {lo, hi}; bf16x2_t b = __builtin_convertvector(v, bf16x2_t); return __builtin_bit_cast(unsigned, b); }

struct EpiBf16 {
    static constexpr bool PERM = true;
    bf16* O; int ldc;
    __device__ __forceinline__ void operator()(const f32x4 (&acc)[2][2][4][2], const Unit& u, int wr, int wc, int fr, int fq) const {
        const int row0 = u.pm * BM + wr * 64 + fr; const int col0 = u.pn * BM + wc * 32 + 8 * fq;
        const auto rsrc = __builtin_amdgcn_make_buffer_rsrc((void*)O, 0, 0x7ffffff0, 0x00020000);
#pragma unroll
        for (int ai = 0; ai < 2; ++ai)
#pragma unroll
            for (int m = 0; m < 4; ++m) { const unsigned boff = (unsigned)(((size_t)(row0 + ai * HALF + m * 16) * ldc + col0) * 2);
#pragma unroll
                for (int bj = 0; bj < 2; ++bj) { const f32x4 v0 = acc[ai][bj][m][0], v1 = acc[ai][bj][m][1];
                    u32x4 w; w.x = cvt_pk_bf16(v0[0], v0[1]); w.y = cvt_pk_bf16(v0[2], v0[3]); w.z = cvt_pk_bf16(v1[0], v1[1]); w.w = cvt_pk_bf16(v1[2], v1[3]);
                    __builtin_amdgcn_raw_buffer_store_b128(w, rsrc, boff + bj * HALF * 2, 0, 16); } }
    }
};
struct EpiBf16RS {
    static constexpr bool PERM = true;
    bf16* O; int ldc; const float* ssqp; float* rs2;
    __device__ __forceinline__ void operator()(const f32x4 (&acc)[2][2][4][2], const Unit& u, int wr, int wc, int fr, int fq) const {
        const int row0 = u.pm * BM + wr * 64 + fr; const int col0 = u.pn * BM + wc * 32 + 8 * fq;
#pragma unroll
        for (int ai = 0; ai < 2; ++ai)
#pragma unroll
            for (int m = 0; m < 4; ++m) { const int row = row0 + ai * HALF + m * 16; bf16* rowp = O + (size_t)row * ldc + col0;
                const f32x4* sp = (const f32x4*)(ssqp + (size_t)row * 16); const f32x4 s0 = sp[0], s1 = sp[1], s2 = sp[2], s3 = sp[3];
                const float ss = ((s0[0] + s0[1]) + (s0[2] + s0[3])) + ((s1[0] + s1[1]) + (s1[2] + s1[3])) + ((s2[0] + s2[1]) + (s2[2] + s2[3])) + ((s3[0] + s3[1]) + (s3[2] + s3[3]));
                const float rs = __builtin_amdgcn_rsqf(ss * (1.0f / 1024.0f) + 1e-6f);
                if (u.pn == 0 && wc == 0 && fq == 0) rs2[row] = rs;
#pragma unroll
                for (int bj = 0; bj < 2; ++bj) { const f32x4 v0 = acc[ai][bj][m][0] * rs, v1 = acc[ai][bj][m][1] * rs;
                    u32x4 w; w.x = cvt_pk_bf16(v0[0], v0[1]); w.y = cvt_pk_bf16(v0[2], v0[3]); w.z = cvt_pk_bf16(v1[0], v1[1]); w.w = cvt_pk_bf16(v1[2], v1[3]);
                    *(u32x4*)(rowp + bj * HALF) = w; } }
    }
};
struct EpiResB {
    static constexpr bool PERM = false;
    const float* g1; const float* irs1; bf16* xb; int ldc; float* ssqp;
    __device__ __forceinline__ void operator()(const f32x4 (&acc)[2][2][4][2], const Unit& u, int wr, int wc, int fr, int fq) const {
        const int col0 = u.pn * BM + wc * 32 + 4 * fq;
        f32x4 ig[2][2];
#pragma unroll
        for (int bj = 0; bj < 2; ++bj)
#pragma unroll
            for (int n = 0; n < 2; ++n) { const f32x4 gv = *(const f32x4*)(g1 + col0 + bj * HALF + n * 16); ig[bj][n] = (f32x4){__builtin_amdgcn_rcpf(gv[0]), __builtin_amdgcn_rcpf(gv[1]), __builtin_amdgcn_rcpf(gv[2]), __builtin_amdgcn_rcpf(gv[3])}; }
#pragma unroll
        for (int ai = 0; ai < 2; ++ai)
#pragma unroll
            for (int m = 0; m < 4; ++m) { const int row = u.pm * BM + ai * HALF + wr * 64 + m * 16 + fr; const size_t off = (size_t)row * ldc + col0; float sq = 0.f; const float ir = irs1[row];
#pragma unroll
                for (int bj = 0; bj < 2; ++bj)
#pragma unroll
                    for (int n = 0; n < 2; ++n) { const u32x2 hw = *(const u32x2*)(xb + off + bj * HALF + n * 16); const unsigned h0 = hw.x, h1 = hw.y;
                        const f32x4 bs = {__builtin_bit_cast(float, h0 << 16) * ir * ig[bj][n][0], __builtin_bit_cast(float, h0 & 0xffff0000u) * ir * ig[bj][n][1], __builtin_bit_cast(float, h1 << 16) * ir * ig[bj][n][2], __builtin_bit_cast(float, h1 & 0xffff0000u) * ir * ig[bj][n][3]};
                        const f32x4 y = bs + acc[ai][bj][m][n];
                        sq += (y[0] * y[0] + y[1] * y[1]) + (y[2] * y[2] + y[3] * y[3]);
                        u32x2 w; w.x = cvt_pk_bf16(y[0], y[1]); w.y = cvt_pk_bf16(y[2], y[3]); *(u32x2*)(xb + off + bj * HALF + n * 16) = w; }
                { const auto r16_ = __builtin_amdgcn_permlane16_swap(__builtin_bit_cast(unsigned, sq), __builtin_bit_cast(unsigned, sq), false, false); sq += __builtin_bit_cast(float, (threadIdx.x & 16) ? r16_[0] : r16_[1]); }
                { const auto r32_ = __builtin_amdgcn_permlane32_swap(__builtin_bit_cast(unsigned, sq), __builtin_bit_cast(unsigned, sq), false, false); sq += __builtin_bit_cast(float, (threadIdx.x & 32) ? r32_[0] : r32_[1]); }
                if (fq == 0) ssqp[(size_t)row * 16 + u.pn * 4 + wc] = sq; }
    }
};
struct EpiResF32 {
    static constexpr bool PERM = false;
    const float* base; float* out; int ldc;
    __device__ __forceinline__ void operator()(const f32x4 (&acc)[2][2][4][2], const Unit& u, int wr, int wc, int fr, int fq) const {
        const int col0 = u.pn * BM + wc * 32 + 4 * fq;
#pragma unroll
        for (int ai = 0; ai < 2; ++ai)
#pragma unroll
            for (int m = 0; m < 4; ++m) { const size_t off = (size_t)(u.pm * BM + ai * HALF + wr * 64 + m * 16 + fr) * ldc + col0;
#pragma unroll
                for (int bj = 0; bj < 2; ++bj)
#pragma unroll
                    for (int n = 0; n < 2; ++n) { const f32x4 bs = *(const f32x4*)(base + off + bj * HALF + n * 16); *(f32x4*)(out + off + bj * HALF + n * 16) = bs + acc[ai][bj][m][n]; } }
    }
};

template <class Epi, class Sched>
__device__ __forceinline__ void gemm_phase(LAS unsigned char* lds, const Gemm g, const Sched& S, const Epi& E) {
    const int tid = threadIdx.x, wid = __builtin_amdgcn_readfirstlane(tid >> 6), lane = tid & 63, wr = wid >> 2, wc = wid & 3, fr = lane & 15, fq = lane >> 4;
    const int K = g.K, nt = K / BK;
    unsigned voffA[2], voffB[2];
#pragma unroll
    for (int i = 0; i < 2; ++i) { int R, C; stage_rc(tid * 16 + i * 8192, R, C); const int Rb = Epi::PERM ? ((R & ~31) + perm32(R & 31)) : R;
        voffA[i] = (unsigned)(R * K + C) * 2u; voffB[i] = (unsigned)(Rb * K + C) * 2u; }
    const size_t kstep = (size_t)(BK * 2);
    const size_t hstep = (size_t)HALF * K * 2;
    const size_t tstep = 2 * hstep;
    const unsigned ldsw = (unsigned)wid * 1024u;
    const int aoff = lds_byte(wr * 64 + fr, fq * 8), boff = lds_byte(wc * 32 + fr, fq * 8);
#define PG8_SA(b, h) (((b) * 2 + (h)) * HTB)
#define PG8_SB(b, h) ((4 + (b) * 2 + (h)) * HTB)
#define PG8_STAGE(bufoff, gbase, voff) do { _Pragma("unroll") for (int _i = 0; _i < 2; ++_i) \
        __builtin_amdgcn_global_load_lds((const unsigned*)((const char*)(gbase) + (voff)[_i]), (LAS unsigned*)(lds + (bufoff) + ldsw + _i * 8192), 16, 0, 0); } while (0)
#define PG8_LDA(dst, b, h) do { _Pragma("unroll") for (int m = 0; m < 4; ++m) _Pragma("unroll") for (int k = 0; k < 2; ++k) dst[m][k] = *(const LAS bf16x8*)(lds + PG8_SA(b, h) + aoff + m * 2048 + k * 1024); } while (0)
#define PG8_LDB(dst, b, h) do { _Pragma("unroll") for (int n = 0; n < 2; ++n) _Pragma("unroll") for (int k = 0; k < 2; ++k) dst[n][k] = *(const LAS bf16x8*)(lds + PG8_SB(b, h) + boff + n * 2048 + k * 1024); } while (0)
#define PG8_MMA(ai, bj, At, Bt) do { __builtin_amdgcn_s_setprio(1); _Pragma("unroll") for (int m = 0; m < 4; ++m) _Pragma("unroll") for (int n = 0; n < 2; ++n) _Pragma("unroll") for (int k = 0; k < 2; ++k) \
        acc[ai][bj][m][n] = __builtin_amdgcn_mfma_f32_16x16x32_bf16(Bt[n][k], At[m][k], acc[ai][bj][m][n], 0, 0, 0); __builtin_amdgcn_s_setprio(0); } while (0)
#define PG8_WAIT_V(n) asm volatile("s_waitcnt vmcnt(" #n ")" ::: "memory")
#define PG8_WAIT_L(n) asm volatile("s_waitcnt lgkmcnt(" #n ")" ::: "memory")
#define PG8_BAR __builtin_amdgcn_s_barrier()
#define PG8_SCHED __builtin_amdgcn_sched_barrier(0)
    Unit cur, nxt; int ui = 0;
    if (!S.next(0, cur)) return;
    f32x4 acc[2][2][4][2];
#pragma unroll
    for (int a = 0; a < 2; ++a)
#pragma unroll
        for (int b = 0; b < 2; ++b)
#pragma unroll
            for (int m = 0; m < 4; ++m)
#pragma unroll
                for (int n = 0; n < 2; ++n) acc[a][b][m][n] = (f32x4){0.f, 0.f, 0.f, 0.f};
    bf16x8 At[4][2], B0[2][2], B1[2][2];
    const char* cA = (const char*)g.A + (size_t)cur.pm * tstep; const char* cB = (const char*)g.Bt + (size_t)cur.pn * tstep;
    PG8_STAGE(PG8_SB(0, 0), cB, voffB); PG8_STAGE(PG8_SB(0, 1), cB + hstep, voffB); PG8_STAGE(PG8_SA(0, 0), cA, voffA); PG8_STAGE(PG8_SA(0, 1), cA + hstep, voffA);
    if (wr == 1) PG8_BAR;
    PG8_WAIT_V(2); PG8_BAR;
    PG8_STAGE(PG8_SB(1, 0), cB + kstep, voffB); PG8_STAGE(PG8_SA(1, 0), cA + kstep, voffA); PG8_STAGE(PG8_SB(1, 1), cB + hstep + kstep, voffB);
    PG8_WAIT_V(6); PG8_BAR;
    for (;;) {
        const bool has_next = S.next(ui + 1, nxt);
        const char* nA = has_next ? (const char*)g.A + (size_t)nxt.pm * tstep : cA; const char* nB = has_next ? (const char*)g.Bt + (size_t)nxt.pn * tstep : cB;
        for (int t = 0; t < nt; t += 2) {
            const bool last = (t == nt - 2);
            const char* a1 = cA + (size_t)(t + 1) * kstep;
            const char* a2 = last ? nA : cA + (size_t)(t + 2) * kstep; const char* b2 = last ? nB : cB + (size_t)(t + 2) * kstep;
            const char* a3 = a2 + kstep; const char* b3 = b2 + kstep;
            PG8_LDB(B0, 0, 0); PG8_LDB(B1, 0, 1); PG8_SCHED; PG8_LDA(At, 0, 0); PG8_STAGE(PG8_SA(1, 1), a1 + hstep, voffA);
            PG8_WAIT_V(8); PG8_WAIT_L(0); PG8_BAR; PG8_MMA(0, 0, At, B0); PG8_MMA(0, 1, At, B1); PG8_BAR; PG8_SCHED;
            PG8_LDA(At, 0, 1); PG8_STAGE(PG8_SB(0, 0), b2, voffB); PG8_STAGE(PG8_SB(0, 1), b2 + hstep, voffB); PG8_STAGE(PG8_SA(0, 0), a2, voffA);
            PG8_WAIT_V(8); PG8_WAIT_L(0); PG8_BAR; PG8_MMA(1, 0, At, B0); PG8_MMA(1, 1, At, B1); PG8_BAR; PG8_SCHED;
            PG8_LDB(B0, 1, 0); PG8_LDB(B1, 1, 1); PG8_SCHED; PG8_LDA(At, 1, 0); PG8_STAGE(PG8_SA(0, 1), a2 + hstep, voffA);
            PG8_WAIT_V(8); PG8_WAIT_L(0); PG8_BAR; PG8_MMA(0, 0, At, B0); PG8_MMA(0, 1, At, B1); PG8_BAR; PG8_SCHED;
            PG8_LDA(At, 1, 1); PG8_STAGE(PG8_SB(1, 0), b3, voffB); PG8_STAGE(PG8_SB(1, 1), b3 + hstep, voffB); PG8_STAGE(PG8_SA(1, 0), a3, voffA);
            PG8_WAIT_V(8); PG8_WAIT_L(0); PG8_BAR; PG8_MMA(1, 0, At, B0); PG8_MMA(1, 1, At, B1); PG8_BAR; PG8_SCHED;
        }
        if (wr == 0) PG8_BAR;
        E(acc, cur, wr, wc, fr, fq);
        if (!has_next) break;
#pragma unroll
        for (int a = 0; a < 2; ++a)
#pragma unroll
            for (int b = 0; b < 2; ++b)
#pragma unroll
                for (int m = 0; m < 4; ++m)
#pragma unroll
                    for (int n = 0; n < 2; ++n) acc[a][b][m][n] = (f32x4){0.f, 0.f, 0.f, 0.f};
        cur = nxt; cA = nA; cB = nB; ++ui;
        if (wr == 1) PG8_BAR;
    }
    PG8_WAIT_V(0);
    PG8_BAR;
#undef PG8_SA
#undef PG8_SB
#undef PG8_STAGE
#undef PG8_LDA
#undef PG8_LDB
#undef PG8_MMA
#undef PG8_WAIT_V
#undef PG8_WAIT_L
#undef PG8_BAR
#undef PG8_SCHED
}
}

constexpr int NWAVES = 8;
constexpr int N_PHASES = 11;
constexpr size_t MiB = 1u << 20;
constexpr size_t WS_CTL = 0, CTL_ZERO_BYTES = 32 * 1024;
constexpr size_t WS_WIN = 1 * MiB;
constexpr size_t WS_WOUT = 6 * MiB;
constexpr size_t WS_WQ = 8 * MiB;
constexpr size_t WS_KEYS = 12 * MiB;
constexpr size_t WS_RSU = 12 * MiB + 512 * 1024, WS_RSV = 12 * MiB + 768 * 1024;
constexpr size_t WS_RS2 = 12 * MiB + 896 * 1024;
constexpr size_t WS_IRS1 = 12 * MiB + 960 * 1024;
constexpr size_t WS_IDX = 13 * MiB;
constexpr size_t WS_GATE = 21 * MiB;
constexpr size_t WS_SSQP = WS_GATE;
constexpr size_t WS_H = 29 * MiB;
constexpr size_t WS_MIX = 61 * MiB;
constexpr size_t WS_C = WS_MIX, WS_SSP = WS_MIX + 8 * MiB;
constexpr size_t WS_X2 = 165 * MiB - 32 * MiB;
constexpr size_t WS_QKV = 93 * MiB;
constexpr size_t WS_PD = WS_QKV;
constexpr size_t WS_U8 = 165 * MiB;
constexpr size_t WS_V8 = 181 * MiB;
constexpr size_t WS_END = 197 * MiB;
constexpr size_t TAB8_SLICE = (size_t)NEXP * 128;
constexpr int CW_BAR = 4096;
static_assert((CW_BAR + 3456) * 4 <= 32 * 1024, "barrier words inside the per-call memset");
constexpr int RING_BYTES = 147456;
constexpr int LDSCTL_OFF = RING_BYTES, MISC_OFF = LDSCTL_OFF + 320;
constexpr int LDS_BYTES = 155648;

#define RLX_AGENT __ATOMIC_RELAXED, __HIP_MEMORY_SCOPE_AGENT
#define LDS_WAIT() asm volatile("s_waitcnt lgkmcnt(0)" ::: "memory")
__device__ __forceinline__ unsigned f2bf(float f) { unsigned u = __builtin_bit_cast(unsigned, f); return (u + 0x7fffu + ((u >> 16) & 1u)) >> 16; }
__device__ __forceinline__ unsigned pk2(float lo, float hi) { return pg8::cvt_pk_bf16(lo, hi); }
__device__ __forceinline__ unsigned f_bits(float f) { return __builtin_bit_cast(unsigned, f); }
__device__ __forceinline__ float bits_f(unsigned u) { return __builtin_bit_cast(float, u); }
__device__ __forceinline__ float bf_lo(unsigned w) { return __builtin_bit_cast(float, w << 16); }
__device__ __forceinline__ float bf_hi(unsigned w) { return __builtin_bit_cast(float, w & 0xffff0000u); }

#define XB_TMO      128
#define XB_XCNT(j)  (256  + 64 * (j))
#define XB_XSUB(j)  (1280 + 64 * (j))
#define XB_XGEN(j)  (2304 + 64 * (j))
#define XB_TOP      3328
#define XB_TOPGEN   3392
#define XCD_BAR_WORDS 3456
#define XB_SPIN_CAP (1u << 18)
__device__ __forceinline__ unsigned xb_ld(unsigned* p)              { return __hip_atomic_load(p, __ATOMIC_RELAXED, __HIP_MEMORY_SCOPE_AGENT); }
__device__ __forceinline__ unsigned xb_add(unsigned* p, unsigned v) { return __hip_atomic_fetch_add(p, v, __ATOMIC_RELAXED, __HIP_MEMORY_SCOPE_AGENT); }
__device__ __forceinline__ unsigned xb_xcc_id() { return (unsigned)__builtin_amdgcn_s_getreg((3 << 11) | 20) & 0xFu; }
#define XB_SPIN(cond, bar) do { unsigned _sp = 0; while (cond) { __builtin_amdgcn_s_sleep(1); \
    if ((++_sp & 255u) == 0u) { if (xb_ld(&(bar)[XB_TMO])) break; if (_sp > XB_SPIN_CAP) { atomicAdd(&(bar)[XB_TMO], 1u); break; } } } } while (0)
struct XcdBarrier { unsigned* bar; unsigned x; volatile LAS unsigned* st; };
__device__ __forceinline__ XcdBarrier xcd_barrier_post(unsigned* bar, volatile LAS unsigned* st) {
    XcdBarrier b; b.bar = bar; b.x = xb_xcc_id(); b.st = st;
    if (threadIdx.x == 0) (void)xb_add(&bar[XB_XCNT(b.x)], 1u);
    return b;
}
__device__ __forceinline__ void xcd_barrier_complete(unsigned* bar, unsigned x, unsigned& nloc, unsigned& nx) {
    const unsigned G = gridDim.x * gridDim.y * gridDim.z;
    unsigned sum, cnt, mine, sp = 0u;
    for (;;) {
        sum = 0u; cnt = 0u; mine = 0u;
#pragma unroll
        for (unsigned j = 0; j < 16; ++j) { const unsigned c = xb_ld(&bar[XB_XCNT(j)]); sum += c; cnt += (c > 0u) ? 1u : 0u; mine = (j == x) ? c : mine; }
        if (sum == G) break;
        __builtin_amdgcn_s_sleep(1);
        if ((++sp & 255u) == 0u) { if (xb_ld(&bar[XB_TMO])) break; if (sp > XB_SPIN_CAP) { atomicAdd(&bar[XB_TMO], 1u); break; } }
    }
    nloc = mine > 0u ? mine : 1u; nx = cnt > 0u ? cnt : 1u;
}
__device__ __forceinline__ void xcd_barrier(const XcdBarrier& b) {
    asm volatile("s_waitcnt vmcnt(0)" ::: "memory");
    __syncthreads();
    if (threadIdx.x == 0) {
        unsigned* bar = b.bar;
        __builtin_amdgcn_s_waitcnt(0);
        unsigned nloc = b.st[0], nx = b.st[1];
        if (nloc == 0u) { xcd_barrier_complete(bar, b.x, nloc, nx); b.st[0] = nloc; b.st[1] = nx; }
        const unsigned old = xb_add(&bar[XB_XSUB(b.x)], 1u);
        const unsigned gen = old / nloc;
        if (old + 1u == (gen + 1u) * nloc) {
            __builtin_amdgcn_fence(__ATOMIC_RELEASE, "agent");
            asm volatile("s_waitcnt vmcnt(0)" ::: "memory");
            const unsigned og = xb_add(&bar[XB_TOP], 1u);
            const unsigned tg = og / nx;
            if (og + 1u == (tg + 1u) * nx) xb_add(&bar[XB_TOPGEN], 1u);
            else XB_SPIN(xb_ld(&bar[XB_TOPGEN]) == tg, bar);
            __builtin_amdgcn_fence(__ATOMIC_ACQUIRE, "agent");
            xb_add(&bar[XB_XGEN(b.x)], 1u);
            asm volatile("s_waitcnt vmcnt(0)" ::: "memory");
        } else {
            XB_SPIN(xb_ld(&bar[XB_XGEN(b.x)]) == gen, bar);
            __builtin_amdgcn_fence(__ATOMIC_ACQUIRE, "agent");
            asm volatile("s_waitcnt vmcnt(0)" ::: "memory");
        }
    }
    __syncthreads();
}

struct Frame {
    LAS unsigned char* lds;
    volatile LAS unsigned* MISC;
    gu32* ctl;
    int tid, lane, wave;
    int vcu, G;
    const float *x, *g1, *w_in, *sb_g, *sw_g, *sinks, *w_out, *g2, *w_q, *keys1, *keys2, *pu, *pv, *gf;
    float* out;
    bf16 *Wt_in, *Wt_out, *Wt_q, *KEYS, *H, *MIX, *QKV;
    unsigned char *U8, *V8, *C8; float *RSU, *RSV, *SSP, *SSQP, *RS2, *CS, *IRS1; bf16 *PD, *X2;
    unsigned short* IDX; float* GATE;
};

__device__ __forceinline__ unsigned partner32(unsigned x) { const auto r = __builtin_amdgcn_permlane32_swap(x, x, false, false); return (threadIdx.x & 32) ? r[0] : r[1]; }
__device__ __forceinline__ unsigned partner16(unsigned x) { const auto r = __builtin_amdgcn_permlane16_swap(x, x, false, false); return (threadIdx.x & 16) ? r[0] : r[1]; }
#define DPPF(v, ctl) bits_f((unsigned)__builtin_amdgcn_update_dpp(0, (int)f_bits(v), (ctl), 0xf, 0xf, false))
__device__ __forceinline__ float wave_sum(float v) {
    v += DPPF(v, 0xB1); v += DPPF(v, 0x4E); v += DPPF(v, 0x141); v += DPPF(v, 0x140);
    v += bits_f(partner16(f_bits(v))); v += bits_f(partner32(f_bits(v)));
    return v;
}

__device__ __forceinline__ void p0_transpose_item(const float* W, int K, int N, bf16* WT, LAS float* scr, int item, int lane, const float* gk = nullptr) {
    const int nblk = N / 32, kb = item / nblk, nb = item % nblk, k0 = 64 * kb, n0 = 32 * nb;
#pragma unroll 8
    for (int i = 0; i < 32; ++i) { const int kk = 2 * i + (lane >> 5); const float gq = gk ? gk[k0 + kk] : 1.0f; scr[kk * 33 + (lane & 31)] = __builtin_nontemporal_load(W + (size_t)(k0 + kk) * N + n0 + (lane & 31)) * gq; }
    LDS_WAIT(); asm volatile("" ::: "memory");
    const int c = lane & 7;
#pragma unroll
    for (int j = 0; j < 4; ++j) { const int n = (lane >> 3) + 8 * j; const LAS float* s = scr + (8 * c) * 33 + n;
        u32x4 o; o.x = pk2(s[0 * 33], s[1 * 33]); o.y = pk2(s[2 * 33], s[3 * 33]); o.z = pk2(s[4 * 33], s[5 * 33]); o.w = pk2(s[6 * 33], s[7 * 33]);
        *(GAS u32x4*)(WT + (size_t)(n0 + n) * K + k0 + 8 * c) = o; }
    LDS_WAIT(); asm volatile("" ::: "memory");
}
template <int NR> __device__ __forceinline__ void rms_rows_to_bf16(const float* xbase, const float* g, bf16* obase, float* irs, int m0, int mstride, int lane) {
    f32x4 v[NR][4];
#pragma unroll
    for (int i = 0; i < NR; ++i) { const int m = m0 + i * mstride; const GAS f32x4* xr = (const GAS f32x4*)(xbase + (size_t)(m < T ? m : m0) * D) + lane;
#pragma unroll
        for (int j = 0; j < 4; ++j) v[i][j] = __builtin_nontemporal_load(xr + 64 * j); }
    const GAS f32x4* gr = (const GAS f32x4*)g + lane;
    f32x4 gg[4];
#pragma unroll
    for (int j = 0; j < 4; ++j) gg[j] = gr[64 * j];
#pragma unroll
    for (int i = 0; i < NR; ++i) { const int m = m0 + i * mstride;
        float s = 0.f;
#pragma unroll
        for (int j = 0; j < 4; ++j) s += (v[i][j].x * v[i][j].x + v[i][j].y * v[i][j].y) + (v[i][j].z * v[i][j].z + v[i][j].w * v[i][j].w);
        const float ms_ = wave_sum(s) * (1.f / D) + EPS; const float rs = __builtin_amdgcn_rsqf(ms_);
        if (m < T) { if (lane == 0) irs[m] = __builtin_sqrtf(ms_); GAS u32x2* o8 = (GAS u32x2*)(obase + (size_t)m * D) + lane;
#pragma unroll
            for (int j = 0; j < 4; ++j) { u32x2 w; w.x = pk2(v[i][j].x * rs * gg[j].x, v[i][j].y * rs * gg[j].y); w.y = pk2(v[i][j].z * rs * gg[j].z, v[i][j].w * rs * gg[j].w); o8[64 * j] = w; } } }
}
__device__ __forceinline__ void cvt_array_bf16(const float* src, bf16* dst, size_t n8, int gtid, int gthreads) {
    for (size_t i = gtid; i < n8; i += gthreads) {
        const f32x4 a = __builtin_nontemporal_load((const GAS f32x4*)(src + i * 8)), b = __builtin_nontemporal_load((const GAS f32x4*)(src + i * 8 + 4));
        u32x4 o; o.x = pk2(a.x, a.y); o.y = pk2(a.z, a.w); o.z = pk2(b.x, b.y); o.w = pk2(b.z, b.w);
        *(GAS u32x4*)(dst + i * 8) = o;
    }
}
__device__ __forceinline__ void p0_prologue(Frame& F) {
    LAS float* scr = (LAS float*)(F.lds + F.wave * 16384);
    const int gw = F.vcu * NWAVES + F.wave, NGW = F.G * NWAVES;
    constexpr int I_IN = (D / 64) * (DIN / 32), I_OUT = (D / 64) * (D / 32), I_Q = (D / 64) * (DQ / 32);
    constexpr int NITEMS = I_IN + I_OUT + I_Q;
    for (int it = gw; it < NITEMS; it += NGW) {
        int r = it;
        if (r < I_IN) { p0_transpose_item(F.w_in, D, DIN, F.Wt_in, scr, r, F.lane); continue; } r -= I_IN;
        if (r < I_OUT) { p0_transpose_item(F.w_out, D, D, F.Wt_out, scr, r, F.lane); continue; } r -= I_OUT;
        p0_transpose_item(F.w_q, D, DQ, F.Wt_q, scr, r, F.lane, F.g2);
    }
    for (int m = gw; m < T; m += 4 * NGW) rms_rows_to_bf16<4>(F.x, F.g1, F.H, F.IRS1, m, NGW, F.lane);
    const int gtid = F.vcu * NWAVES * 64 + F.tid, gthreads = F.G * NWAVES * 64;
    cvt_array_bf16(F.keys1, F.KEYS, (size_t)8 * 128 * 128 / 8, gtid, gthreads);
    cvt_array_bf16(F.keys2, F.KEYS + 8 * 128 * 128, (size_t)8 * 128 * 128 / 8, gtid, gthreads);
}

__device__ __forceinline__ int pack_i8(float a, float b, float c, float d) {
    const int qa = (int)__builtin_rintf(a), qb = (int)__builtin_rintf(b), qc = (int)__builtin_rintf(c), qd = (int)__builtin_rintf(d);
    return (qa & 0xff) | ((qb & 0xff) << 8) | ((qc & 0xff) << 16) | (qd << 24);
}
__device__ __forceinline__ float wave_max(float v) {
    v = __builtin_fmaxf(v, DPPF(v, 0xB1)); v = __builtin_fmaxf(v, DPPF(v, 0x4E)); v = __builtin_fmaxf(v, DPPF(v, 0x141)); v = __builtin_fmaxf(v, DPPF(v, 0x140));
    v = __builtin_fmaxf(v, bits_f(partner16(f_bits(v)))); v = __builtin_fmaxf(v, bits_f(partner32(f_bits(v))));
    return v;
}
template <int NR> __device__ __forceinline__ void cvt_rows_fp8(Frame& F, int r0, int rstride, int rlimit, int lane) {
    f32x4 v[NR][4];
#pragma unroll
    for (int i = 0; i < NR; ++i) { int r = r0 + i * rstride; r = r < rlimit ? r : r0; const float* src = r < NEXP ? F.pu + (size_t)r * D : F.pv + (size_t)(r - NEXP) * D;
        const GAS f32x4* xr = (const GAS f32x4*)src + lane;
#pragma unroll
        for (int j = 0; j < 4; ++j) v[i][j] = __builtin_nontemporal_load(xr + 64 * j); }
    f32x4 g2v[4];
#pragma unroll
    for (int j = 0; j < 4; ++j) g2v[j] = ((const GAS f32x4*)F.g2)[lane + 64 * j];
#pragma unroll
    for (int i = 0; i < NR; ++i) { const int r = r0 + i * rstride;
        if (r < NEXP) {
#pragma unroll
            for (int j = 0; j < 4; ++j) v[i][j] = v[i][j] * g2v[j]; }
        float amax = 0.f;
#pragma unroll
        for (int j = 0; j < 4; ++j) amax = __builtin_fmaxf(amax, __builtin_fmaxf(__builtin_fmaxf(__builtin_fabsf(v[i][j].x), __builtin_fabsf(v[i][j].y)), __builtin_fmaxf(__builtin_fabsf(v[i][j].z), __builtin_fabsf(v[i][j].w))));
        amax = wave_max(amax);
        int k = 6 - ((int)((f_bits(amax) >> 23) & 0xffu) - 127);
        k = k > 100 ? 100 : (k < -100 ? -100 : k);
        const float sc = bits_f((unsigned)(k + 127) << 23), inv = bits_f((unsigned)(127 - k) << 23);
        if (r < rlimit) { const int e = r < NEXP ? r : r - NEXP; unsigned char* tab8 = r < NEXP ? F.U8 : F.V8; float* rs = r < NEXP ? F.RSU : F.RSV;
            const float sq = amax > 0.f ? 127.0f / amax : 0.f;
#pragma unroll
            for (int j = 0; j < 4; ++j) {
                const int w = pack_i8(v[i][j].x * sq, v[i][j].y * sq, v[i][j].z * sq, v[i][j].w * sq);
                const int s = 2 * j + (lane >> 5);
                *(GAS unsigned*)(tab8 + (size_t)s * TAB8_SLICE + (size_t)e * 128 + 4 * (lane & 31)) = (unsigned)w;
            }
            if (lane == 0) rs[e] = amax * (1.0f / 127.0f); } }
}
__device__ __forceinline__ int crow(int r, int hi) { return (r & 3) + 8 * (r >> 2) + 4 * hi; }
constexpr int VPITCH = 192;
constexpr int KPITCH = 144;
constexpr int ATT_K_OFF = 0, ATT_V_OFF = 32 * KPITCH, ATT_Q_OFF = 32 * KPITCH + 32 * VPITCH, ATT_WAVE_BYTES = 64 * KPITCH + 32 * VPITCH;
struct Tile4 { u32x4 a, b, c, d; };
__device__ __forceinline__ Tile4 tile_load(const bf16* t0, int lane) {
    const bf16* p = t0 + (size_t)(lane >> 3) * DIN + 8 * (lane & 7);
    Tile4 t; t.a = *(const GAS u32x4*)p; t.b = *(const GAS u32x4*)(p + (size_t)8 * DIN); t.c = *(const GAS u32x4*)(p + (size_t)16 * DIN); t.d = *(const GAS u32x4*)(p + (size_t)24 * DIN); return t;
}
__device__ __forceinline__ void tile_store(LAS unsigned char* dst, int pitch, const Tile4& t, int lane) {
    LAS unsigned char* p = dst + (lane >> 3) * pitch + 16 * (lane & 7);
    *(LAS u32x4*)p = t.a; *(LAS u32x4*)(p + 8 * pitch) = t.b; *(LAS u32x4*)(p + 16 * pitch) = t.c; *(LAS u32x4*)(p + 24 * pitch) = t.d;
}
__device__ __forceinline__ bf16x8 kfrag(const LAS unsigned char* kt, int d0, int lane) { const u32x4 w = *(const LAS u32x4*)(kt + (lane & 31) * KPITCH + 32 * d0 + 16 * (lane >> 5)); return __builtin_bit_cast(bf16x8, w); }
__device__ __forceinline__ bf16x8 vfrag(const LAS unsigned char* wl, int dblk, int s, int lane) {
    const int hi = lane >> 5, i = lane & 15, g1 = (lane >> 4) & 1;
    const LAS unsigned char* p = wl + (16 * s + 4 * hi + (i >> 2)) * VPITCH + (32 * dblk + 16 * g1 + 4 * (i & 3)) * 2;
    const v4i16_t lo = __builtin_amdgcn_ds_read_tr16_b64_v4i16((LAS v4i16_t*)p);
    const v4i16_t hh = __builtin_amdgcn_ds_read_tr16_b64_v4i16((LAS v4i16_t*)(p + 8 * VPITCH));
    return (bf16x8){lo[0], lo[1], lo[2], lo[3], hh[0], hh[1], hh[2], hh[3]};
}
__device__ __forceinline__ bf16x8 pack8(const f32x16& a, int s) {
    u32x4 w; w.x = pk2(a[8 * s + 0], a[8 * s + 1]); w.y = pk2(a[8 * s + 2], a[8 * s + 3]); w.z = pk2(a[8 * s + 4], a[8 * s + 5]); w.w = pk2(a[8 * s + 6], a[8 * s + 7]);
    return __builtin_bit_cast(bf16x8, w);
}
__device__ __forceinline__ void head_norm_store(const f32x16& o0, const f32x16& o1, float scale, const float* g, bf16* dstrow, int hi) {
    float ss = 0.f;
#pragma unroll
    for (int r = 0; r < 16; ++r) { const float a = o0[r] * scale, b = o1[r] * scale; ss += a * a + b * b; }
    ss += bits_f(partner32(f_bits(ss)));
    const float rs = __builtin_amdgcn_rsqf(ss * (1.f / 64.f) + EPS) * scale;
#pragma unroll
    for (int dblk = 0; dblk < 2; ++dblk)
#pragma unroll
        for (int q4 = 0; q4 < 4; ++q4) { const int d0 = 32 * dblk + 8 * q4 + 4 * hi; const f32x4 gg = *(const GAS f32x4*)(g + d0);
            const f32x16& o = dblk ? o1 : o0;
            u32x2 w; w.x = pk2(o[4 * q4 + 0] * rs * gg.x, o[4 * q4 + 1] * rs * gg.y); w.y = pk2(o[4 * q4 + 2] * rs * gg.z, o[4 * q4 + 3] * rs * gg.w);
            *(GAS u32x2*)(dstrow + d0) = w; }
}

__device__ __forceinline__ void sb_item(Frame& F, int b, int h, int qb, LAS unsigned char* wl) {
    const int lane = F.lane, r32 = lane & 31, hi = lane >> 5;
    const size_t rowbase = (size_t)b * SEQ;
    const bf16* Qp = F.QKV + (rowbase + 32 * qb) * DIN + C_SBQ + h * 64;
    const bf16* Kb = F.QKV + rowbase * DIN + C_SBK + h * 64;
    const bf16* Vb = F.QKV + rowbase * DIN + C_SBV + h * 64;
    bf16x8 qr[4];
    { const Tile4 tq = tile_load(Qp, lane); tile_store(wl + ATT_K_OFF, KPITCH, tq, lane);
#pragma unroll
      for (int d0 = 0; d0 < 4; ++d0) qr[d0] = kfrag(wl + ATT_K_OFF, d0, lane); }
    bf16x8 tri[2];
#pragma unroll
    for (int s = 0; s < 2; ++s)
#pragma unroll
        for (int j = 0; j < 8; ++j) tri[s][j] = (16 * s + 8 * (j >> 2) + 4 * hi + (j & 3) >= r32) ? (short)0x3F80 : (short)0;
    f32x16 o0 = {}, o1 = {}; float C = 0.f;
    Tile4 tk = tile_load(Kb + (size_t)(32 * qb) * DIN, lane), tv = tile_load(Vb + (size_t)(32 * qb) * DIN, lane);
    for (int kt = qb; kt >= 0; --kt) {
        tile_store(wl + ATT_K_OFF, KPITCH, tk, lane); tile_store(wl + ATT_V_OFF, VPITCH, tv, lane);
        { const int kn = kt > 0 ? kt - 1 : 0; tk = tile_load(Kb + (size_t)(32 * kn) * DIN, lane); tv = tile_load(Vb + (size_t)(32 * kn) * DIN, lane); }
        bf16x8 kf[4];
#pragma unroll
        for (int d0 = 0; d0 < 4; ++d0) kf[d0] = kfrag(wl + ATT_K_OFF, d0, lane);
        f32x16 z = {};
#pragma unroll
        for (int d0 = 0; d0 < 4; ++d0) z = __builtin_amdgcn_mfma_f32_32x32x16_bf16(kf[d0], qr[d0], z, 0, 0, 0);
        const int lim = r32 + 32 * (qb - kt);
        f32x16 l, ls;
#pragma unroll
        for (int r = 0; r < 16; ++r) {
            const float zz = z[r] * 0.125f;
            const float e = __builtin_amdgcn_exp2f(-__builtin_fabsf(zz) * LOG2E);
            const float sp = __builtin_fmaxf(zz, 0.f) + LN2 * __builtin_amdgcn_logf(1.0f + e);
            const bool valid = crow(r, hi) < lim;
            l[r] = valid ? -sp : 0.f;
            ls[r] = zz - sp;
        }
        f32x16 lo;
        bf16x8 lh[2], ll[2];
#pragma unroll
        for (int s = 0; s < 2; ++s) {
            u32x4 wh, wlw;
#pragma unroll
            for (int p = 0; p < 4; ++p) { const float a = l[8 * s + 2 * p], c = l[8 * s + 2 * p + 1]; const unsigned w = pk2(a, c); wh[p] = w; lo[8 * s + 2 * p] = a - bf_lo(w); lo[8 * s + 2 * p + 1] = c - bf_hi(w); }
#pragma unroll
            for (int p = 0; p < 4; ++p) wlw[p] = pk2(lo[8 * s + 2 * p], lo[8 * s + 2 * p + 1]);
            lh[s] = __builtin_bit_cast(bf16x8, wh); ll[s] = __builtin_bit_cast(bf16x8, wlw);
        }
        f32x16 Y = {};
        Y = __builtin_amdgcn_mfma_f32_32x32x16_bf16(tri[0], lh[0], Y, 0, 0, 0);
        Y = __builtin_amdgcn_mfma_f32_32x32x16_bf16(tri[1], lh[1], Y, 0, 0, 0);
        Y = __builtin_amdgcn_mfma_f32_32x32x16_bf16(tri[0], ll[0], Y, 0, 0, 0);
        Y = __builtin_amdgcn_mfma_f32_32x32x16_bf16(tri[1], ll[1], Y, 0, 0, 0);
        f32x16 a;
#pragma unroll
        for (int r = 0; r < 16; ++r) {
            const bool valid = crow(r, hi) < lim;
            const float later = C + (Y[r] - l[r]);
            const float av = __builtin_amdgcn_exp2f((ls[r] + later) * LOG2E);
            a[r] = valid ? av : 0.f;
        }
        float tot; { const float y0_ = Y[0]; const auto r_ = __builtin_amdgcn_permlane32_swap(f_bits(y0_), f_bits(y0_), false, false); tot = hi ? bits_f(r_[0]) : y0_; }
        C += tot;
        const bf16x8 a0 = pack8(a, 0), a1 = pack8(a, 1);
        o0 = __builtin_amdgcn_mfma_f32_32x32x16_bf16(vfrag(wl + ATT_V_OFF, 0, 0, lane), a0, o0, 0, 0, 0);
        o0 = __builtin_amdgcn_mfma_f32_32x32x16_bf16(vfrag(wl + ATT_V_OFF, 0, 1, lane), a1, o0, 0, 0, 0);
        o1 = __builtin_amdgcn_mfma_f32_32x32x16_bf16(vfrag(wl + ATT_V_OFF, 1, 0, lane), a0, o1, 0, 0, 0);
        o1 = __builtin_amdgcn_mfma_f32_32x32x16_bf16(vfrag(wl + ATT_V_OFF, 1, 1, lane), a1, o1, 0, 0, 0);
        if (__all(C < SB_EXIT)) break;
    }
    head_norm_store(o0, o1, 1.0f, F.sb_g + h * 64, F.MIX + (rowbase + 32 * qb + r32) * D + h * 64, hi);
}

#define SWA_HEAD(z, qslope, m_, den_, oa, ob) do { \
        float tmax_ = -INFINITY; f32x16 s_; \
        _Pragma("unroll") for (int r = 0; r < 16; ++r) { const int dist = dq - ((r & 3) + 8 * (r >> 2)); const float sv = z[r] * 0.125f - qslope * (float)dist; s_[r] = ((unsigned)dist < 128u) ? sv : -INFINITY; tmax_ = __builtin_fmaxf(tmax_, s_[r]); } \
        tmax_ = __builtin_fmaxf(tmax_, bits_f(partner32(f_bits(tmax_)))); \
        const float mn_ = __builtin_fmaxf(m_, tmax_); const float al_ = __builtin_amdgcn_exp2f((m_ - mn_) * LOG2E); m_ = mn_; \
        f32x16 p_; float ps_ = 0.f; \
        _Pragma("unroll") for (int r = 0; r < 16; ++r) { p_[r] = __builtin_amdgcn_exp2f((s_[r] - mn_) * LOG2E); ps_ += p_[r]; } \
        den_ = den_ * al_ + ps_; \
        _Pragma("unroll") for (int r = 0; r < 16; ++r) { oa[r] *= al_; ob[r] *= al_; } \
        const bf16x8 a0_ = pack8(p_, 0), a1_ = pack8(p_, 1); \
        oa = __builtin_amdgcn_mfma_f32_32x32x16_bf16(vf00, a0_, oa, 0, 0, 0); oa = __builtin_amdgcn_mfma_f32_32x32x16_bf16(vf01, a1_, oa, 0, 0, 0); \
        ob = __builtin_amdgcn_mfma_f32_32x32x16_bf16(vf10, a0_, ob, 0, 0, 0); ob = __builtin_amdgcn_mfma_f32_32x32x16_bf16(vf11, a1_, ob, 0, 0, 0); } while (0)
__device__ __forceinline__ void swa_item2(Frame& F, int b, int kv, int hp, int qb, LAS unsigned char* wl) {
    const int lane = F.lane, r32 = lane & 31, hi = lane >> 5, hqA = kv * 4 + 2 * hp, hqB = hqA + 1;
    const size_t rowbase = (size_t)b * SEQ;
    const bf16* QpA = F.QKV + (rowbase + 32 * qb) * DIN + C_SWQ + hqA * 64;
    const bf16* Kb = F.QKV + rowbase * DIN + C_SWK + kv * 64;
    const bf16* Vb = F.QKV + rowbase * DIN + C_SWV + kv * 64;
    const float slopeA = __builtin_amdgcn_exp2f(-(float)(hqA + 1)), slopeB = __builtin_amdgcn_exp2f(-(float)(hqB + 1));
    float mA = F.sinks[hqA], mB = F.sinks[hqB];
    bf16x8 qrA[4];
    { const Tile4 tq = tile_load(QpA, lane); tile_store(wl + ATT_K_OFF, KPITCH, tq, lane);
#pragma unroll
      for (int d0 = 0; d0 < 4; ++d0) qrA[d0] = kfrag(wl + ATT_K_OFF, d0, lane); }
    { const Tile4 tq = tile_load(QpA + 64, lane); tile_store(wl + ATT_Q_OFF, KPITCH, tq, lane); }
    float denA = hi == 0 ? 1.f : 0.f, denB = denA;
    f32x16 oA0 = {}, oA1 = {}, oB0 = {}, oB1 = {};
    const int kt0 = qb - 4 < 0 ? 0 : qb - 4;
    for (int kt = kt0; kt <= qb; ++kt) {
        { const Tile4 tk = tile_load(Kb + (size_t)(32 * kt) * DIN, lane), tv = tile_load(Vb + (size_t)(32 * kt) * DIN, lane);
          tile_store(wl + ATT_K_OFF, KPITCH, tk, lane); tile_store(wl + ATT_V_OFF, VPITCH, tv, lane); }
        const bf16x8 vf00 = vfrag(wl + ATT_V_OFF, 0, 0, lane), vf01 = vfrag(wl + ATT_V_OFF, 0, 1, lane), vf10 = vfrag(wl + ATT_V_OFF, 1, 0, lane), vf11 = vfrag(wl + ATT_V_OFF, 1, 1, lane);
        const int dq = 32 * (qb - kt) + r32 - 4 * hi;
        { f32x16 zA = {};
#pragma unroll
          for (int d0 = 0; d0 < 4; ++d0) zA = __builtin_amdgcn_mfma_f32_32x32x16_bf16(kfrag(wl + ATT_K_OFF, d0, lane), qrA[d0], zA, 0, 0, 0);
          SWA_HEAD(zA, slopeA, mA, denA, oA0, oA1); }
        { f32x16 zB = {};
#pragma unroll
          for (int d0 = 0; d0 < 4; ++d0) zB = __builtin_amdgcn_mfma_f32_32x32x16_bf16(kfrag(wl + ATT_K_OFF, d0, lane), kfrag(wl + ATT_Q_OFF, d0, lane), zB, 0, 0, 0);
          SWA_HEAD(zB, slopeB, mB, denB, oB0, oB1); }
    }
    denA += bits_f(partner32(f_bits(denA))); denB += bits_f(partner32(f_bits(denB)));
    bf16* dst = F.MIX + (rowbase + 32 * qb + r32) * D + 512 + hqA * 64;
    head_norm_store(oA0, oA1, 1.0f / denA, F.sw_g + hqA * 64, dst, hi);
    head_norm_store(oB0, oB1, 1.0f / denB, F.sw_g + hqB * 64, dst + 64, hi);
}
__device__ __forceinline__ void p2_attention(Frame& F) {
    LAS unsigned char* wl = F.lds + F.wave * 16384;
    static_assert(ATT_WAVE_BYTES <= 16384 && NWAVES * 16384 <= RING_BYTES, "attention LDS");
    const int gw = F.vcu * NWAVES + F.wave, NGW = F.G * NWAVES;
    constexpr int NSB = NB * 8 * 128, NSW = NB * 4 * 128;
    for (int it = gw; it < NSB + NSW; it += NGW) {
        if (it < NSB) { const int qb = it & 127, h = (it >> 7) & 7, b = it >> 10; sb_item(F, b, h, qb, wl); }
        else { const int r = it - NSB; const int qb = r & 127, hp = (r >> 7) & 1, kv = (r >> 8) & 1, b = r >> 9; swa_item2(F, b, kv, hp, qb, wl); }
    }
}

__device__ __forceinline__ int f2ord(unsigned bits) { int x = (int)bits; return x ^ ((x >> 31) & 0x7fffffff); }
template <int N> __device__ __forceinline__ void bitonic_desc(int (&v)[N]) {
#pragma unroll
    for (int k = 2; k <= N; k <<= 1) {
#pragma unroll
        for (int j = k >> 1; j > 0; j >>= 1) {
#pragma unroll
            for (int i = 0; i < N; ++i) {
                const int l = i ^ j;
                if (l > i) { const bool up = ((i & k) == 0); const int a = v[i], b = v[l]; const int mx = a > b ? a : b, mn = a > b ? b : a; v[i] = up ? mx : mn; v[l] = up ? mn : mx; }
            }
        }
    }
}
template <int N> __device__ __forceinline__ void bitonic_merge_desc(int (&v)[N]) {
#pragma unroll
    for (int j = N >> 1; j > 0; j >>= 1) {
#pragma unroll
        for (int i = 0; i < N; ++i) { const int l = i ^ j; if (l > i) { const int a = v[i], b = v[l]; v[i] = a > b ? a : b; v[l] = a > b ? b : a; } }
    }
}
template <int N> __device__ __forceinline__ void bitonic_desc_kv(int (&k)[N], int (&p)[N]) {
#pragma unroll
    for (int kk = 2; kk <= N; kk <<= 1) {
#pragma unroll
        for (int j = kk >> 1; j > 0; j >>= 1) {
#pragma unroll
            for (int i = 0; i < N; ++i) {
                const int l = i ^ j;
                if (l > i) { const bool up = ((i & kk) == 0); const bool sw = up ? (k[i] < k[l]) : (k[i] > k[l]);
                    const int ka = k[i], kb = k[l], pa = p[i], pb = p[l]; k[i] = sw ? kb : ka; k[l] = sw ? ka : kb; p[i] = sw ? pb : pa; p[l] = sw ? pa : pb; }
            }
        }
    }
}
struct Cand { unsigned char i, j; };
struct CandTable { Cand c[64]; int n; };
constexpr CandTable make_cands() { CandTable t{}; int n = 0; for (int i = 0; i < 16; ++i) for (int j = 0; j < 16; ++j) if ((i + 1) * (j + 1) <= 16) { t.c[n].i = (unsigned char)i; t.c[n].j = (unsigned char)j; ++n; } t.n = n; return t; }
constexpr CandTable CANDS = make_cands();
static_assert(CANDS.n == 50, "candidate count");

struct Ce16 { unsigned char a, b; };
constexpr Ce16 NET16[63] = { {0,1}, {2,3}, {0,2}, {1,3}, {1,2}, {4,5}, {6,7}, {4,6}, {5,7}, {5,6}, {0,4}, {2,6}, {2,4}, {1,5}, {3,7}, {3,5}, {1,2}, {3,4}, {5,6}, {8,9}, {10,11}, {8,10}, {9,11}, {9,10}, {12,13}, {14,15}, {12,14}, {13,15}, {13,14}, {8,12}, {10,14}, {10,12}, {9,13}, {11,15}, {11,13}, {9,10}, {11,12}, {13,14}, {0,8}, {4,12}, {4,8}, {2,10}, {6,14}, {6,10}, {2,4}, {6,8}, {10,12}, {1,9}, {5,13}, {5,9}, {3,11}, {7,15}, {7,11}, {3,5}, {7,9}, {11,13}, {1,2}, {3,4}, {5,6}, {7,8}, {9,10}, {11,12}, {13,14} };
template <int B> __device__ __forceinline__ void sort16_desc(int (&v)[64]) {
#pragma unroll
    for (int c = 0; c < 63; ++c) { const int i = B + NET16[c].a, j = B + NET16[c].b; const int x = v[i], y = v[j]; v[i] = x > y ? x : y; v[j] = x > y ? y : x; }
}
__device__ __forceinline__ void top16_of_64(int (&v)[64], int (&c)[16]) {
    sort16_desc<0>(v); sort16_desc<16>(v); sort16_desc<32>(v); sort16_desc<48>(v);
    int x[16], y[16];
#pragma unroll
    for (int i = 0; i < 16; ++i) { x[i] = v[i] > v[31 - i] ? v[i] : v[31 - i]; y[i] = v[32 + i] > v[63 - i] ? v[32 + i] : v[63 - i]; }
    bitonic_merge_desc<16>(x); bitonic_merge_desc<16>(y);
#pragma unroll
    for (int i = 0; i < 16; ++i) c[i] = x[i] > y[15 - i] ? x[i] : y[15 - i];
    bitonic_merge_desc<16>(c);
}
constexpr int P6_PITCH = 272, P6_KEYS_BYTES = 128 * P6_PITCH, P6_Q_BYTES = 32 * P6_PITCH;
static_assert(2 * P6_KEYS_BYTES + NWAVES * P6_Q_BYTES <= RING_BYTES, "P6 LDS map");
__device__ __forceinline__ void p6_item(Frame& F, int tb, int h, LAS unsigned char* keys_lds, LAS unsigned char* qw) {
    const int lane = F.lane, r32 = lane & 31, hi = lane >> 5;
    const bf16* QP = F.QKV;
    int top0[16], top1[16];
#pragma unroll 1
    for (int half = 0; half < 2; ++half) {
        { const bf16* qsrc = QP + (size_t)(32 * tb + (lane >> 4)) * DQ + h * 256 + half * 128 + 8 * (lane & 15);
          u32x4 t_[8];
#pragma unroll
          for (int i = 0; i < 8; ++i) t_[i] = *(const GAS u32x4*)(qsrc + (size_t)(4 * i) * DQ);
#pragma unroll
          for (int i = 0; i < 8; ++i) *(LAS u32x4*)(qw + (4 * i + (lane >> 4)) * P6_PITCH + 16 * (lane & 15)) = t_[i]; }
        bf16x8 qf[8];
#pragma unroll
        for (int ks = 0; ks < 8; ++ks) { const u32x4 w_ = *(const LAS u32x4*)(qw + r32 * P6_PITCH + 32 * ks + 16 * hi); qf[ks] = __builtin_bit_cast(bf16x8, w_); }
        const LAS unsigned char* kb = keys_lds + half * P6_KEYS_BYTES + r32 * P6_PITCH + 16 * hi;
        int v[64];
#pragma unroll
        for (int nt = 0; nt < 4; ++nt) {
            f32x16 acc = {};
#pragma unroll
            for (int ks = 0; ks < 8; ++ks) { const u32x4 w_ = *(const LAS u32x4*)(kb + (32 * nt) * P6_PITCH + 32 * ks); acc = __builtin_amdgcn_mfma_f32_32x32x16_bf16(__builtin_bit_cast(bf16x8, w_), qf[ks], acc, 0, 0, 0); }
#pragma unroll
            for (int r = 0; r < 16; ++r) { const float av = acc[r]; const unsigned bits = (f_bits(av) & ~0x7Fu) | (unsigned)(32 * nt + crow(r, hi)); v[16 * nt + r] = f2ord(bits); }
        }
        int c16[16]; top16_of_64(v, c16);
        int m[16];
#pragma unroll
        for (int i = 0; i < 16; ++i) { const int o = (int)partner32((unsigned)c16[15 - i]); m[i] = c16[i] > o ? c16[i] : o; }
        bitonic_merge_desc<16>(m);
#pragma unroll
        for (int i = 0; i < 16; ++i) { if (half == 0) top0[i] = m[i]; else top1[i] = m[i]; }
    }
    float f1[16], f2[16]; int i1[16], i2[16];
#pragma unroll
    for (int i = 0; i < 16; ++i) { const unsigned b1 = (unsigned)f2ord((unsigned)top0[i]), b2 = (unsigned)f2ord((unsigned)top1[i]);
        f1[i] = bits_f(b1 & ~0x7Fu); i1[i] = (int)(b1 & 0x7Fu); f2[i] = bits_f(b2 & ~0x7Fu); i2[i] = (int)(b2 & 0x7Fu); }
    int ck[32], cp[32];
#pragma unroll
    for (int s = 0; s < 32; ++s) {
        if (s < 25) { constexpr int dummy = 0; (void)dummy;
            const int ia = CANDS.c[2 * s].i, ja = CANDS.c[2 * s].j, ib = CANDS.c[2 * s + 1].i, jb = CANDS.c[2 * s + 1].j;
            const float sa = f1[ia] + f2[ja], sb = f1[ib] + f2[jb]; const int pa = (i1[ia] << 7) | i2[ja], pb = (i1[ib] << 7) | i2[jb];
            ck[s] = f2ord(f_bits(hi ? sb : sa)); cp[s] = hi ? pb : pa;
        } else { ck[s] = (int)0x80000000; cp[s] = 0; }
    }
    bitonic_desc_kv<32>(ck, cp);
    int wk[16], wp[16];
#pragma unroll
    for (int i = 0; i < 16; ++i) { const int ok = (int)partner32((unsigned)ck[15 - i]), op = (int)partner32((unsigned)cp[15 - i]); const bool t = ck[i] >= ok; wk[i] = t ? ck[i] : ok; wp[i] = t ? cp[i] : op; }
    float vals[16]; float mxv = -INFINITY;
#pragma unroll
    for (int i = 0; i < 16; ++i) { vals[i] = bits_f((unsigned)f2ord((unsigned)wk[i])); mxv = __builtin_fmaxf(mxv, vals[i]); }
    float se = 0.f;
#pragma unroll
    for (int i = 0; i < 16; ++i) { vals[i] = __builtin_amdgcn_exp2f((vals[i] - mxv) * LOG2E); se += vals[i]; }
    const float inv = 1.0f / se;
    const size_t ob = (size_t)(32 * tb + r32) * 128 + h * 16 + hi * 8;
    { u32x4 a; a.x = (unsigned)wp[0] | ((unsigned)wp[1] << 16); a.y = (unsigned)wp[2] | ((unsigned)wp[3] << 16); a.z = (unsigned)wp[4] | ((unsigned)wp[5] << 16); a.w = (unsigned)wp[6] | ((unsigned)wp[7] << 16);
      *(GAS u32x4*)(F.IDX + ob) = a;
      f32x4 ga = {vals[0] * inv, vals[1] * inv, vals[2] * inv, vals[3] * inv}, gb = {vals[4] * inv, vals[5] * inv, vals[6] * inv, vals[7] * inv};
      *(GAS f32x4*)(F.GATE + ob) = ga; *(GAS f32x4*)(F.GATE + ob + 4) = gb; }
}
template <class Sched> __device__ __forceinline__ void p6_topk_own(Frame& F, const Sched& S) {
    LAS unsigned char* keys_lds = F.lds; LAS unsigned char* qw = F.lds + 2 * P6_KEYS_BYTES + F.wave * P6_Q_BYTES;
    pg8::Unit u; int hprev = -1;
    for (int i = 0; S.next(i, u); ++i) {
        const int h = u.pn;
        if (h != hprev) {
            __syncthreads();
#pragma unroll
            for (int half = 0; half < 2; ++half) {
                const bf16* ksrc = F.KEYS + (size_t)(half * 8 + h) * 128 * 128 + (size_t)(F.tid >> 4) * 128 + 8 * (F.tid & 15);
                u32x4 t_[4];
#pragma unroll
                for (int q = 0; q < 4; ++q) t_[q] = *(const GAS u32x4*)(ksrc + (size_t)(32 * q) * 128);
#pragma unroll
                for (int q = 0; q < 4; ++q) *(LAS u32x4*)(keys_lds + half * P6_KEYS_BYTES + ((F.tid >> 4) + 32 * q) * P6_PITCH + 16 * (F.tid & 15)) = t_[q];
            }
            __syncthreads(); hprev = h;
        }
        p6_item(F, 8 * u.pm + F.wave, h, keys_lds, qw);
    }
    { const int gw_ = F.vcu * NWAVES + F.wave, NGW_ = F.G * NWAVES; for (int r = NEXP + gw_; r < 2 * NEXP; r += 4 * NGW_) cvt_rows_fp8<4>(F, r, NGW_, 2 * NEXP, F.lane); }
    __syncthreads();
}

__device__ __forceinline__ float dpp_xor1(float v) { return v + bits_f((unsigned)__builtin_amdgcn_update_dpp(0, (int)f_bits(v), 0xB1, 0xf, 0xf, false)); }
__device__ __forceinline__ float dpp_xor2(float v) { return v + bits_f((unsigned)__builtin_amdgcn_update_dpp(0, (int)f_bits(v), 0x4E, 0xf, 0xf, false)); }
__device__ __forceinline__ float dpp_hmir(float v) { return v + bits_f((unsigned)__builtin_amdgcn_update_dpp(0, (int)f_bits(v), 0x141, 0xf, 0xf, false)); }
__device__ __forceinline__ float dpp_max_xor1(float v) { return __builtin_fmaxf(v, bits_f((unsigned)__builtin_amdgcn_update_dpp(0, (int)f_bits(v), 0xB1, 0xf, 0xf, false))); }
__device__ __forceinline__ float dpp_max_xor2(float v) { return __builtin_fmaxf(v, bits_f((unsigned)__builtin_amdgcn_update_dpp(0, (int)f_bits(v), 0x4E, 0xf, 0xf, false))); }
__device__ __forceinline__ float dpp_max_hmir(float v) { return __builtin_fmaxf(v, bits_f((unsigned)__builtin_amdgcn_update_dpp(0, (int)f_bits(v), 0x141, 0xf, 0xf, false))); }
__device__ __forceinline__ float dpp_rmir(float v) { return v + bits_f((unsigned)__builtin_amdgcn_update_dpp(0, (int)f_bits(v), 0x140, 0xf, 0xf, false)); }
__device__ __forceinline__ f32x2_t fp8x2(unsigned w, bool hi) { return hi ? __builtin_amdgcn_cvt_pk_f32_fp8((int)w, true) : __builtin_amdgcn_cvt_pk_f32_fp8((int)w, false); }
__device__ __forceinline__ float gelu_tanh(float x) {
    const float y2 = 1.5957691216057308f * (x + 0.044715f * x * x * x);
    return x / (1.0f + __builtin_amdgcn_exp2f(-y2 * LOG2E));
}
__device__ __forceinline__ unsigned vsel16(const u32x4 (&v)[2], int k) { const u32x4 q = v[k >> 3]; const int j = (k >> 1) & 3; const unsigned w = j == 0 ? q.x : j == 1 ? q.y : j == 2 ? q.z : q.w; return (k & 1) ? (w >> 16) : (w & 0xffffu); }
struct TokIn { u32x4 id[2]; u32x4 x0, x1; };
__device__ __forceinline__ int vsel(const u32x4 (&v)[4], int k) { const u32x4 q = v[k >> 2]; const int j = k & 3; return (int)(j == 0 ? q.x : j == 1 ? q.y : j == 2 ? q.z : q.w); }
__device__ __forceinline__ void p7_udots(Frame& F) {
    const int lane = F.lane, g = lane >> 3, c = lane & 7;
    const int s = blockIdx.x & 7, rank = blockIdx.x >> 3, nloc = F.G >> 3;
    const unsigned char* tab = F.U8 + (size_t)s * TAB8_SLICE; const unsigned coff16 = 16u * (unsigned)c;
    bf16* pd = F.PD + (size_t)s * T * 128;
    const int t0 = rank * NWAVES + F.wave, tstride = nloc * NWAVES;
#define P7_IDS(dst, tt) do { const int t_ = (tt) < T ? (tt) : t0; const GAS u32x4* ip_ = (const GAS u32x4*)(F.IDX + (size_t)t_ * 128 + 16 * g); dst.id[0] = ip_[0]; dst.id[1] = ip_[1]; } while (0)
#define P7_X(dst, tt) do { const int t_ = (tt) < T ? (tt) : t0; const bf16* xr_ = F.H + (size_t)t_ * D + 128 * s + 16 * c; dst.x0 = *(const GAS u32x4*)xr_; dst.x1 = *(const GAS u32x4*)(xr_ + 8); } while (0)
#define P7_PCS(pc, in) do { _Pragma("unroll") for (int k = 0; k < 16; ++k) pc[k] = *(const GAS u32x4*)(tab + ((vsel16(in.id, k) << 7) | coff16)); } while (0)
#define P7_MATH(pc, in, tt) do { if ((tt) < T) { \
        float xv[16]; { const unsigned a0 = in.x0.x, a1 = in.x0.y, a2 = in.x0.z, a3 = in.x0.w, b0 = in.x1.x, b1 = in.x1.y, b2 = in.x1.z, b3 = in.x1.w; \
          xv[0] = bf_lo(a0); xv[1] = bf_hi(a0); xv[2] = bf_lo(a1); xv[3] = bf_hi(a1); xv[4] = bf_lo(a2); xv[5] = bf_hi(a2); xv[6] = bf_lo(a3); xv[7] = bf_hi(a3); \
          xv[8] = bf_lo(b0); xv[9] = bf_hi(b0); xv[10] = bf_lo(b1); xv[11] = bf_hi(b1); xv[12] = bf_lo(b2); xv[13] = bf_hi(b2); xv[14] = bf_lo(b3); xv[15] = bf_hi(b3); } \
          \
        float xm = 0.f; _Pragma("unroll") for (int i = 0; i < 16; ++i) xm = __builtin_fmaxf(xm, __builtin_fabsf(xv[i])); \
        xm = dpp_max_hmir(dpp_max_xor2(dpp_max_xor1(xm))); \
        const float sx = xm > 0.f ? 127.0f / xm : 0.f, isx = xm * (1.0f / 127.0f); \
        const int xq0 = pack_i8(xv[0] * sx, xv[1] * sx, xv[2] * sx, xv[3] * sx), xq1 = pack_i8(xv[4] * sx, xv[5] * sx, xv[6] * sx, xv[7] * sx), \
                  xq2 = pack_i8(xv[8] * sx, xv[9] * sx, xv[10] * sx, xv[11] * sx), xq3 = pack_i8(xv[12] * sx, xv[13] * sx, xv[14] * sx, xv[15] * sx); \
        float r0 = 0.f, r1 = 0.f; \
        _Pragma("unroll") for (int k = 0; k < 16; ++k) { \
            const unsigned w0 = pc[k].x, w1 = pc[k].y, w2 = pc[k].z, w3 = pc[k].w; \
            int ia = __builtin_amdgcn_sdot4((int)w0, xq0, 0, false); ia = __builtin_amdgcn_sdot4((int)w1, xq1, ia, false); ia = __builtin_amdgcn_sdot4((int)w2, xq2, ia, false); ia = __builtin_amdgcn_sdot4((int)w3, xq3, ia, false); \
            float p = (float)ia; p = dpp_hmir(dpp_xor2(dpp_xor1(p))); \
            if (k < 8) r0 = (c == k) ? p : r0; else r1 = (c == (k - 8)) ? p : r1; } \
        r0 *= isx; r1 *= isx; \
        pd[(size_t)(tt) * 128 + 16 * g + c] = (bf16)(pk2(r0, r0) & 0xffffu); pd[(size_t)(tt) * 128 + 16 * g + 8 + c] = (bf16)(pk2(r1, r1) & 0xffffu); } } while (0)
    TokIn inA, inB, inC, inN; u32x4 pcA[16], pcB[16], pcC[16];
    P7_IDS(inA, t0); P7_X(inA, t0); P7_PCS(pcA, inA); P7_IDS(inB, t0 + tstride); P7_X(inB, t0 + tstride); P7_PCS(pcB, inB); P7_IDS(inC, t0 + 2 * tstride);
    for (int t = t0; t < T; t += 3 * tstride) {
        P7_X(inC, t + 2 * tstride); P7_PCS(pcC, inC); P7_IDS(inN, t + 3 * tstride); __builtin_amdgcn_sched_barrier(0);
        P7_MATH(pcA, inA, t); __builtin_amdgcn_sched_barrier(0);
        inA.id[0] = inN.id[0]; inA.id[1] = inN.id[1];
        P7_X(inA, t + 3 * tstride); P7_PCS(pcA, inA); P7_IDS(inN, t + 4 * tstride); __builtin_amdgcn_sched_barrier(0);
        P7_MATH(pcB, inB, t + tstride); __builtin_amdgcn_sched_barrier(0);
        inB.id[0] = inN.id[0]; inB.id[1] = inN.id[1];
        P7_X(inB, t + 4 * tstride); P7_PCS(pcB, inB); P7_IDS(inN, t + 5 * tstride); __builtin_amdgcn_sched_barrier(0);
        P7_MATH(pcC, inC, t + 2 * tstride); __builtin_amdgcn_sched_barrier(0);
        inC.id[0] = inN.id[0]; inC.id[1] = inN.id[1];
    }
#undef P7_IDS
#undef P7_X
#undef P7_PCS
#undef P7_MATH
}
__device__ __forceinline__ void p8_combine(Frame& F) {
    const int gw = F.vcu * NWAVES + F.wave, NGW = F.G * NWAVES, lane = F.lane;
    constexpr int NU = 4;
    for (int t0 = gw; t0 < T; t0 += NU * NGW) {
        unsigned pdw[NU][8], idw[NU]; f32x2_t gt[NU];
#pragma unroll
        for (int u = 0; u < NU; ++u) { const int t = t0 + u * NGW < T ? t0 + u * NGW : t0; const size_t o = (size_t)t * 128 + 2 * lane;
#pragma unroll
            for (int s = 0; s < 8; ++s) pdw[u][s] = __builtin_nontemporal_load((const GAS unsigned*)(F.PD + (size_t)s * T * 128 + o));
            idw[u] = *(const GAS unsigned*)(F.IDX + o); gt[u] = __builtin_nontemporal_load((const GAS f32x2_t*)(F.GATE + o)); }
        float ru0[NU], ru1[NU], rv0[NU], rv1[NU], r2[NU];
#pragma unroll
        for (int u = 0; u < NU; ++u) { const int t = t0 + u * NGW < T ? t0 + u * NGW : t0; const int i0 = (int)(idw[u] & 0xffffu), i1 = (int)(idw[u] >> 16);
            ru0[u] = F.RSU[i0]; ru1[u] = F.RSU[i1]; rv0[u] = F.RSV[i0]; rv1[u] = F.RSV[i1]; r2[u] = F.RS2[t]; }
#pragma unroll
        for (int u = 0; u < NU; ++u) { const int t = t0 + u * NGW;
            float d0 = 0.f, d1 = 0.f;
#pragma unroll
            for (int s = 0; s < 8; ++s) { const unsigned w = pdw[u][s]; d0 += bf_lo(w); d1 += bf_hi(w); }
            const float c0 = gt[u].x * gelu_tanh(d0 * ru0[u] * r2[u]) * rv0[u], c1 = gt[u].y * gelu_tanh(d1 * ru1[u] * r2[u]) * rv1[u];
            const float m = wave_max(__builtin_fmaxf(__builtin_fabsf(c0), __builtin_fabsf(c1)));
            const float sq = m > 0.f ? 127.0f / m : 0.f;
            const int q0 = (int)__builtin_rintf(c0 * sq), q1 = (int)__builtin_rintf(c1 * sq);
            if (t < T) { *(GAS unsigned short*)(F.C8 + (size_t)t * 128 + 2 * lane) = (unsigned short)((q0 & 0xff) | ((q1 & 0xff) << 8)); if (lane == 0) F.CS[t] = m * (1.0f / 127.0f); } }
    }
}
typedef int v2i_t __attribute__((ext_vector_type(2)));
typedef int v4i_t __attribute__((ext_vector_type(4)));
constexpr int P9_PITCH = 144, P9_WAVE_BYTES = 128 * P9_PITCH, P9_OSC_OFF = LDSCTL_OFF + 512;
static_assert(NWAVES * P9_WAVE_BYTES <= RING_BYTES && P9_OSC_OFF + NWAVES * 512 <= LDS_BYTES, "P9 LDS map");
struct TokInV { u32x4 id[2]; u32x4 a0, a1; u32x2 xb; float cs; };
__device__ __forceinline__ void p9_vacc(Frame& F) {
    const int lane = F.lane, g = lane >> 3, c = lane & 7, m16 = lane & 15, q = lane >> 4;
    const int s = blockIdx.x & 7, rank = blockIdx.x >> 3, nloc = F.G >> 3;
    const unsigned char* tab = F.V8 + (size_t)s * TAB8_SLICE; const unsigned coff16 = 16u * (unsigned)c;
    const int t0 = rank * NWAVES + F.wave, tstride = nloc * NWAVES;
    LAS unsigned char* wl = F.lds + F.wave * P9_WAVE_BYTES;
    LAS float* osc = (LAS float*)(F.lds + P9_OSC_OFF + F.wave * 512);
    LAS unsigned char* wst = wl + (16 * g) * P9_PITCH + 16 * c;
    const LAS unsigned char* wrd = wl + (16 * q + (m16 >> 1)) * P9_PITCH + 8 * (m16 & 1);
    const int coff = 128 * s + 4 * (lane & 31);
#define P9_IN(dst, tt) do { const int t_ = (tt) < T ? (tt) : t0; const GAS u32x4* ip_ = (const GAS u32x4*)(F.IDX + (size_t)t_ * 128 + 16 * g); dst.id[0] = ip_[0]; dst.id[1] = ip_[1]; \
        const GAS u32x4* cp_ = (const GAS u32x4*)(F.C8 + (size_t)t_ * 128 + 16 * q); const u32x4 z_ = {0u, 0u, 0u, 0u}; dst.a0 = cp_[0]; dst.a1 = cp_[4]; if (m16 != 0) { dst.a0 = z_; dst.a1 = z_; } \
        dst.xb = *(const GAS u32x2*)(F.H + (size_t)t_ * D + coff); dst.cs = F.CS[t_]; } while (0)
#define P9_PCS(pc, in) do { _Pragma("unroll") for (int k = 0; k < 16; ++k) pc[k] = *(const GAS u32x4*)(tab + ((vsel16(in.id, k) << 7) | coff16)); } while (0)
#define P9_STAGE(pc) do { _Pragma("unroll") for (int k = 0; k < 16; ++k) *(LAS u32x4*)(wst + k * P9_PITCH) = pc[k]; } while (0)
#define P9_MATH(in, tt) do { if ((tt) < T) { \
        v4i_t acc[8]; _Pragma("unroll") for (int nb = 0; nb < 8; ++nb) acc[nb] = (v4i_t){0, 0, 0, 0}; \
        _Pragma("unroll") for (int s2 = 0; s2 < 2; ++s2) { const v4i_t av = __builtin_bit_cast(v4i_t, s2 ? in.a1 : in.a0); \
            _Pragma("unroll") for (int nb = 0; nb < 8; ++nb) { \
                const v2i_t lo = __builtin_amdgcn_ds_read_tr8_b64_v2i32((LAS v2i_t*)(wrd + (64 * s2) * P9_PITCH + 16 * nb)); \
                const v2i_t hi = __builtin_amdgcn_ds_read_tr8_b64_v2i32((LAS v2i_t*)(wrd + (64 * s2 + 8) * P9_PITCH + 16 * nb)); \
                const v4i_t bv = {lo.x, lo.y, hi.x, hi.y}; \
                acc[nb] = __builtin_amdgcn_mfma_i32_16x16x64_i8(av, bv, acc[nb], 0, 0, 0); } } \
          \
        if (lane < 16) { _Pragma("unroll") for (int nb = 0; nb < 8; ++nb) osc[16 * nb + lane] = (float)acc[nb][0] * in.cs; } \
        asm volatile("" ::: "memory"); \
        float ss = 0.f; \
        if (lane < 32) { const f32x4 d_ = *(const LAS f32x4*)(osc + 4 * lane); bf16* op_ = F.X2 + (size_t)(tt) * D + coff; const unsigned xb0_ = in.xb.x, xb1_ = in.xb.y; \
            const f32x4 y = {bf_lo(xb0_) + d_[0], bf_hi(xb0_) + d_[1], bf_lo(xb1_) + d_[2], bf_hi(xb1_) + d_[3]}; \
            ss = (y.x * y.x + y.y * y.y) + (y.z * y.z + y.w * y.w); u32x2 yw_; yw_.x = pk2(y.x, y.y); yw_.y = pk2(y.z, y.w); *(GAS u32x2*)op_ = yw_; } \
        ss = dpp_rmir(dpp_hmir(dpp_xor2(dpp_xor1(ss)))); if ((lane & 47) == 0) F.SSP[((size_t)s * T + (tt)) * 2 + (lane >> 4)] = ss; } } while (0)
    TokInV inA, inB, inC; u32x4 pcA[16], pcB[16];
    P9_IN(inA, t0); P9_PCS(pcA, inA); P9_IN(inB, t0 + tstride); P9_PCS(pcB, inB); P9_IN(inC, t0 + 2 * tstride);
    for (int t = t0; t < T; t += 2 * tstride) {
        TokInV inD, inE;
        P9_STAGE(pcA); P9_PCS(pcA, inC); P9_IN(inD, t + 3 * tstride); __builtin_amdgcn_sched_barrier(0);
        P9_MATH(inA, t); __builtin_amdgcn_sched_barrier(0);
        P9_STAGE(pcB); P9_PCS(pcB, inD); P9_IN(inE, t + 4 * tstride); __builtin_amdgcn_sched_barrier(0);
        P9_MATH(inB, t + tstride); __builtin_amdgcn_sched_barrier(0);
        inA = inC; inB = inD; inC = inE;
    }
#undef P9_IN
#undef P9_PCS
#undef P9_STAGE
#undef P9_MATH
}
__device__ __forceinline__ void p10_final(Frame& F) {
    const int gw = F.vcu * NWAVES + F.wave, NGW = F.G * NWAVES, lane = F.lane;
    for (int t = gw; t < T; t += NGW) {
        float ss = 0.f;
#pragma unroll
        for (int s = 0; s < 8; ++s) ss += F.SSP[((size_t)s * T + t) * 2] + F.SSP[((size_t)s * T + t) * 2 + 1];
        const float rs = __builtin_amdgcn_rsqf(ss * (1.f / D) + EPS);
        GAS f32x4* xr = (GAS f32x4*)(F.out + (size_t)t * D) + lane; const GAS f32x4* gr = (const GAS f32x4*)F.gf + lane; const GAS u32x2* br = (const GAS u32x2*)(F.X2 + (size_t)t * D) + lane;
#pragma unroll
        for (int j = 0; j < 4; ++j) { const u32x2 w = __builtin_nontemporal_load(br + 64 * j); const unsigned w0 = w.x, w1 = w.y; const f32x4 gg = gr[64 * j]; __builtin_nontemporal_store((f32x4){bf_lo(w0) * rs * gg.x, bf_hi(w0) * rs * gg.y, bf_lo(w1) * rs * gg.z, bf_hi(w1) * rs * gg.w}, xr + 64 * j); }
    }
}
struct Args { const float* in[14]; float* out; unsigned char* ws; int ph_lo, ph_hi, li, pad; };
__global__ void __launch_bounds__(NWAVES * 64, 2) mk_fwd(Args args) {
    extern __shared__ __attribute__((aligned(16))) unsigned char lds[];
#ifdef PROBE_LO
    unsigned long long pmk_lo = 0, pmk_hi = 0;
    if (PROBE_LO == -1) { asm volatile("s_memrealtime %0\n\ts_waitcnt lgkmcnt(0)" : "=s"(pmk_lo) :: "memory"); }
#endif
    Frame F;
    F.lds = (LAS unsigned char*)lds;
    F.MISC = (volatile LAS unsigned*)(F.lds + MISC_OFF);
    F.tid = threadIdx.x; F.lane = F.tid & 63; F.wave = __builtin_amdgcn_readfirstlane(F.tid >> 6);
    F.G = gridDim.x; { const int bx = blockIdx.x; F.vcu = (F.G % 8 == 0) ? (bx % 8) * (F.G / 8) + bx / 8 : bx; }
    unsigned char* ws = args.ws;
    F.ctl = (gu32*)(ws + WS_CTL);
    F.x = args.in[0]; F.g1 = args.in[1]; F.w_in = args.in[2]; F.sb_g = args.in[3]; F.sw_g = args.in[4]; F.sinks = args.in[5]; F.w_out = args.in[6]; F.g2 = args.in[7];
    F.w_q = args.in[8]; F.keys1 = args.in[9]; F.keys2 = args.in[10]; F.pu = args.in[11]; F.pv = args.in[12]; F.gf = args.in[13]; F.out = args.out;
    F.Wt_in = (bf16*)(ws + WS_WIN); F.Wt_out = (bf16*)(ws + WS_WOUT); F.Wt_q = (bf16*)(ws + WS_WQ); F.KEYS = (bf16*)(ws + WS_KEYS);
    F.H = (bf16*)(ws + WS_H); F.MIX = (bf16*)(ws + WS_MIX); F.QKV = (bf16*)(ws + WS_QKV); F.U8 = ws + WS_U8; F.V8 = ws + WS_V8; F.RSU = (float*)(ws + WS_RSU); F.RSV = (float*)(ws + WS_RSV);
    F.IRS1 = (float*)(ws + WS_IRS1); F.SSQP = (float*)(ws + WS_SSQP); F.RS2 = (float*)(ws + WS_RS2); F.PD = (bf16*)(ws + WS_PD); F.X2 = (bf16*)(ws + WS_X2); F.C8 = ws + WS_C; F.CS = (float*)(ws + WS_C + 6 * MiB); F.SSP = (float*)(ws + WS_SSP);
    F.IDX = (unsigned short*)(ws + WS_IDX); F.GATE = (float*)(ws + WS_GATE);
    for (int u = F.tid; u < (LDS_BYTES - LDSCTL_OFF) / 4; u += NWAVES * 64) ((LAS unsigned*)(F.lds + LDSCTL_OFF))[u] = 0u;
    __syncthreads();
    const int lo = args.ph_lo, hi = args.ph_hi;
    const bool use_bar = (hi - lo) > 1;
    XcdBarrier bar; bar.bar = (unsigned*)(F.ctl + CW_BAR) + args.li * XCD_BAR_WORDS; bar.x = 0; bar.st = nullptr;
    if (use_bar) bar = xcd_barrier_post((unsigned*)(F.ctl + CW_BAR) + args.li * XCD_BAR_WORDS, F.MISC + 8);
#ifndef PHMASK
#define PHMASK 2047
#endif
#define IN(k) (((PHMASK >> (k)) & 1) && lo <= (k) && (k) < hi)
#define SEAM(k) do { if (IN(k) && IN((k) + 1)) xcd_barrier(bar); } while (0)
    const int gw = F.vcu * NWAVES + F.wave, NGW = F.G * NWAVES;
#ifdef PROBE_LO
#define PSTAMP(v) asm volatile("s_memrealtime %0\n\ts_waitcnt lgkmcnt(0)" : "=s"(v) :: "memory")
#define PMARK(k) do { if ((k) == PROBE_LO) { PSTAMP(pmk_lo); } if ((k) == PROBE_HI + 1) { PSTAMP(pmk_hi); } } while (0)
#else
#define PMARK(k) do {} while (0)
#endif

    PMARK(0);
    if (IN(0)) { p0_prologue(F); } SEAM(0);
    PMARK(1);
    if (IN(1)) { pg8::Gemm g{F.H, F.Wt_in, T, DIN, D}; pg8::StaticOrder S; S.init(T, DIN, F.G, (int)blockIdx.x); pg8::EpiBf16 E{F.QKV, DIN};
        pg8::gemm_phase<pg8::EpiBf16, pg8::StaticOrder>(F.lds, g, S, E);
        { const int nfull = (T / 256) * (DIN / 256) % F.G, nb = F.G - nfull;
          if (nb == F.G) { for (int r = (int)blockIdx.x * NWAVES + F.wave; r < NEXP; r += 4 * F.G * NWAVES) cvt_rows_fp8<4>(F, r, F.G * NWAVES, NEXP, F.lane); }
          else if ((int)blockIdx.x >= nfull) { for (int r = ((int)blockIdx.x - nfull) * NWAVES + F.wave; r < NEXP; r += 4 * nb * NWAVES) cvt_rows_fp8<4>(F, r, nb * NWAVES, NEXP, F.lane); } }
        } SEAM(1);
    PMARK(2);
    if (IN(2)) { p2_attention(F); } SEAM(2);
    PMARK(3);
    if (IN(3)) { pg8::Gemm g{F.MIX, F.Wt_out, T, D, D}; pg8::StaticOrder S; S.init(T, D, F.G, (int)blockIdx.x); pg8::EpiResB E{F.g1, F.IRS1, F.H, D, F.SSQP};
        pg8::gemm_phase<pg8::EpiResB, pg8::StaticOrder>(F.lds, g, S, E); } SEAM(3);
    PMARK(4);
    PMARK(5);
    if (IN(5)) { pg8::Gemm g{F.H, F.Wt_q, T, DQ, D}; pg8::StaticOrder S; S.init(T, DQ, F.G, (int)blockIdx.x); pg8::EpiBf16RS E{F.QKV, DQ, F.SSQP, F.RS2};
        pg8::gemm_phase<pg8::EpiBf16RS, pg8::StaticOrder>(F.lds, g, S, E);
        asm volatile("s_waitcnt vmcnt(0)" ::: "memory"); __syncthreads();
        p6_topk_own(F, S); }
    PMARK(6);
    SEAM(6);
    PMARK(7);
    if (IN(7)) { p7_udots(F); } SEAM(7);
    PMARK(8);
    if (IN(8)) { p8_combine(F); } SEAM(8);
    PMARK(9);
    if (IN(9)) { p9_vacc(F); } SEAM(9);
    PMARK(10);
    if (IN(10)) { p10_final(F); }
#ifdef PROBE_LO
    xcd_barrier(bar);
    PMARK(11);
    if (blockIdx.x == 0 && F.tid == 0) { unsigned long long t0, t1; PSTAMP(t0); const unsigned long long dl = (pmk_hi - pmk_lo) * PROBE_MULT;
        do { __builtin_amdgcn_s_sleep(8); PSTAMP(t1); } while (t1 - t0 < dl); }
#endif
#undef IN
#undef SEAM
}

extern "C" void kernel_launch(void* const* d_in, const int* in_sizes, int n_in, void* d_out, int out_size, void* d_ws, size_t ws_size, hipStream_t stream) {
    static int grid = 0;
    if (grid == 0) {
        if (n_in != 14 || in_sizes[0] != T * D || out_size != T * D || ws_size < WS_END) { fprintf(stderr, "kernel_launch: unexpected shapes (n_in %d, in0 %d, out %d, ws %zu)\n", n_in, n_in > 0 ? in_sizes[0] : -1, out_size, ws_size); grid = -1; return; }
        int dev = 0, cus = 0, per_cu = 0;
        if (hipGetDevice(&dev) != hipSuccess || hipDeviceGetAttribute(&cus, hipDeviceAttributeMultiprocessorCount, dev) != hipSuccess) { grid = -1; return; }
        if (hipFuncSetAttribute((const void*)mk_fwd, hipFuncAttributeMaxDynamicSharedMemorySize, LDS_BYTES) != hipSuccess) { fprintf(stderr, "kernel_launch: hipFuncSetAttribute failed\n"); grid = -1; return; }
        if (hipOccupancyMaxActiveBlocksPerMultiprocessor(&per_cu, (const void*)mk_fwd, NWAVES * 64, LDS_BYTES) != hipSuccess || per_cu < 1)
            fprintf(stderr, "kernel_launch: note: occupancy query reports %d workgroups per CU\n", per_cu);
        (void)hipGetLastError();
        grid = cus;
    }
    if (grid < 0) return;
    if (hipMemsetAsync((char*)d_ws + WS_CTL, 0, CTL_ZERO_BYTES, stream) != hipSuccess) { fprintf(stderr, "kernel_launch: hipMemsetAsync failed\n"); return; }
    Args a{};
    for (int i = 0; i < 14; ++i) a.in[i] = (const float*)d_in[i];
    a.out = (float*)d_out; a.ws = (unsigned char*)d_ws;
#if MK_N_LAUNCHES == 1
    a.ph_lo = 0; a.ph_hi = N_PHASES; a.li = 0;
    hipLaunchKernelGGL(mk_fwd, dim3(grid), dim3(NWAVES * 64), LDS_BYTES, stream, a);
#else
    for (int li = 0; li < N_PHASES; ++li) { a.ph_lo = li; a.ph_hi = li + 1; a.li = 0; hipLaunchKernelGGL(mk_fwd, dim3(grid), dim3(NWAVES * 64), LDS_BYTES, stream, a); }
#endif
    const hipError_t le = hipPeekAtLastError();
    if (le != hipSuccess) fprintf(stderr, "kernel_launch: launch failed: %s\n", hipGetErrorName(le));
}
```

```cpp
#include <hip/hip_runtime.h>
#include <cstdio>
#include <cstdint>

#ifndef MK_N_LAUNCHES
#define MK_N_LAUNCHES 1
#endif

#define LAS __attribute__((address_space(3)))
#define GAS __attribute__((address_space(1)))
typedef unsigned short bf16;
typedef short bf16x8 __attribute__((ext_vector_type(8)));
typedef float f32x4 __attribute__((ext_vector_type(4)));
typedef float f32x16 __attribute__((ext_vector_type(16)));
typedef unsigned u32x4 __attribute__((ext_vector_type(4)));
typedef unsigned u32x2 __attribute__((ext_vector_type(2)));
typedef short v4i16_t __attribute__((ext_vector_type(4)));
typedef float f32x2_t __attribute__((ext_vector_type(2)));
typedef __bf16 bf16x2_t __attribute__((ext_vector_type(2)));
typedef GAS unsigned gu32;

constexpr int T = 16384, SEQ = 4096, NB = 4, D = 1024, DIN = 2304, DQ = 2048;
constexpr int C_SBQ = 0, C_SBK = 512, C_SBV = 1024, C_SWQ = 1536, C_SWK = 2048, C_SWV = 2176;
constexpr int NEXP = 16384;
constexpr float EPS = 1e-6f;
constexpr float LOG2E = 1.4426950408889634f, LN2 = 0.6931471805599453f;
constexpr float SB_EXIT = -24.0f;

namespace pg8 {
constexpr int BM = 256, BK = 64, HALF = 128, HTB = HALF * BK * 2, STAGE_BYTES = 8 * HTB, NXCD = 8, WGM = 8;
__host__ __device__ __forceinline__ int lds_byte(int r, int c) { const int st = (r >> 4) * 2 + (c >> 5), rr = r & 15, cc = c & 31, ob = rr * 64 + cc * 2; return st * 1024 + (ob ^ (((ob >> 9) & 1) << 5)); }
__host__ __device__ __forceinline__ void stage_rc(int b, int& R, int& C) { const int st = b / 1024, sb = b % 1024, swz = sb ^ (((sb >> 9) & 1) << 5); R = (st >> 1) * 16 + swz / 64; C = (st & 1) * 32 + (swz % 64) / 2; }
__host__ __device__ __forceinline__ int perm32(int rho) { const int n = rho >> 4, i = rho & 15; return 8 * (i >> 2) + 4 * n + (i & 3); }
struct Unit { int pm, pn; };
struct Gemm { const bf16* A; const bf16* Bt; int M, N, K; };
struct StaticOrder {
    int nM, nN, nwg, G, c; bool pair = false;
    __host__ __device__ void init(int M, int N, int G_, int c_) { nM = M / BM; nN = N / BM; nwg = nM * nN; G = G_; c = c_; }
    __host__ __device__ void init_pairs() { pair = (G == 256 && nM == 64 && nN == 8); }
    __host__ __device__ bool next(int i, Unit& u) const {
        if (pair) { if (i > 1) return false; const int x = c & 7, j = c >> 3; u.pm = 8 * x + (j & 3) + 4 * i; u.pn = j >> 2; return true; }
        const long L = (long)i * G + c; if (L >= nwg) return false;
        int wgid = (int)L; { const int q = nwg / NXCD, r = nwg % NXCD, xcd = wgid % NXCD, off = wgid / NXCD; wgid = (xcd < r ? xcd * (q + 1) : r * (q + 1) + (xcd - r) * q) + off; }
        const int nig = WGM * nN, gid = wgid / nig, fm = gid * WGM, gsz = (nM - fm) < WGM ? (nM - fm) : WGM;
        u.pm = fm + ((wgid % nig) % gsz); u.pn = (wgid % nig) / gsz; return true;
    }
};
__device__ __forceinline__ unsigned cvt_pk_bf16(float lo, float hi) { f32x2_t v = {lo, hi}; bf16x2_t b = __builtin_convertvector(v, bf16x2_t); return __builtin_bit_cast(unsigned, b); }

struct EpiBf16 {
    static constexpr bool PERM = true;
    bf16* O; int ldc;
    __device__ __forceinline__ void operator()(const f32x4 (&acc)[2][2][4][2], const Unit& u, int wr, int wc, int fr, int fq) const {
        const int row0 = u.pm * BM + wr * 64 + fr; const int col0 = u.pn * BM + wc * 32 + 8 * fq;
        const auto rsrc = __builtin_amdgcn_make_buffer_rsrc((void*)O, 0, 0x7ffffff0, 0x00020000);
#pragma unroll
        for (int ai = 0; ai < 2; ++ai)
#pragma unroll
            for (int m = 0; m < 4; ++m) { const unsigned boff = (unsigned)(((size_t)(row0 + ai * HALF + m * 16) * ldc + col0) * 2);
#pragma unroll
                for (int bj = 0; bj < 2; ++bj) { const f32x4 v0 = acc[ai][bj][m][0], v1 = acc[ai][bj][m][1];
                    u32x4 w; w.x = cvt_pk_bf16(v0[0], v0[1]); w.y = cvt_pk_bf16(v0[2], v0[3]); w.z = cvt_pk_bf16(v1[0], v1[1]); w.w = cvt_pk_bf16(v1[2], v1[3]);
                    __builtin_amdgcn_raw_buffer_store_b128(w, rsrc, boff + bj * HALF * 2, 0, 16); } }
    }
};
struct EpiBf16RS {
    static constexpr bool PERM = true;
    bf16* O; int ldc; const float* ssqp; float* rs2; const LAS float* rsl; int pm_l, pm_l1;
    __device__ __forceinline__ void operator()(const f32x4 (&acc)[2][2][4][2], const Unit& u, int wr, int wc, int fr, int fq) const {
        const int row0 = u.pm * BM + wr * 64 + fr; const int col0 = u.pn * BM + wc * 32 + 8 * fq;
#pragma unroll
        for (int ai = 0; ai < 2; ++ai)
#pragma unroll
            for (int m = 0; m < 4; ++m) { const int row = row0 + ai * HALF + m * 16; bf16* rowp = O + (size_t)row * ldc + col0;
                float rs;
                if (u.pm == pm_l) rs = rsl[wr * 64 + fr + ai * HALF + m * 16];
                else if (u.pm == pm_l1) rs = rsl[256 + wr * 64 + fr + ai * HALF + m * 16];
                else { const f32x4* sp = (const f32x4*)(ssqp + (size_t)row * 16); const f32x4 s0 = sp[0], s1 = sp[1], s2 = sp[2], s3 = sp[3];
                    const float ss = ((s0[0] + s0[1]) + (s0[2] + s0[3])) + ((s1[0] + s1[1]) + (s1[2] + s1[3])) + ((s2[0] + s2[1]) + (s2[2] + s2[3])) + ((s3[0] + s3[1]) + (s3[2] + s3[3]));
                    rs = __builtin_amdgcn_rsqf(ss * (1.0f / 1024.0f) + 1e-6f); }
                if (u.pn == 0 && wc == 0 && fq == 0) rs2[row] = rs;
#pragma unroll
                for (int bj = 0; bj < 2; ++bj) { const f32x4 v0 = acc[ai][bj][m][0] * rs, v1 = acc[ai][bj][m][1] * rs;
                    u32x4 w; w.x = cvt_pk_bf16(v0[0], v0[1]); w.y = cvt_pk_bf16(v0[2], v0[3]); w.z = cvt_pk_bf16(v1[0], v1[1]); w.w = cvt_pk_bf16(v1[2], v1[3]);
                    *(u32x4*)(rowp + bj * HALF) = w; } }
    }
};
struct EpiResB {
    static constexpr bool PERM = true;
    const float* g1; const float* irs1; const unsigned char* a8; const float* sa; bf16* xb; int ldc; float* ssqp;
    __device__ __forceinline__ void operator()(const f32x4 (&acc)[2][2][4][2], const Unit& u, int wr, int wc, int fr, int fq) const {
        const int row0 = u.pm * BM + wr * 64 + fr; const int col0 = u.pn * BM + wc * 32 + 8 * fq;
        f32x4 ig[2][2];
#pragma unroll
        for (int bj = 0; bj < 2; ++bj)
#pragma unroll
            for (int n = 0; n < 2; ++n) { const f32x4 gv = *(const f32x4*)(g1 + col0 + bj * HALF + 4 * n); ig[bj][n] = (f32x4){__builtin_amdgcn_rcpf(gv[0]), __builtin_amdgcn_rcpf(gv[1]), __builtin_amdgcn_rcpf(gv[2]), __builtin_amdgcn_rcpf(gv[3])}; }
#pragma unroll
        for (int ai = 0; ai < 2; ++ai)
#pragma unroll
            for (int m = 0; m < 4; ++m) { const int row = row0 + ai * HALF + m * 16; const size_t off = (size_t)row * ldc + col0; float sq = 0.f; const float ir = irs1[row] * sa[row];
#pragma unroll
                for (int bj = 0; bj < 2; ++bj) { const u32x2 qw = *(const u32x2*)(a8 + off + bj * HALF); const int q0 = (int)qw.x, q1 = (int)qw.y;
                    const f32x4 x0 = {(float)((q0 << 24) >> 24), (float)((q0 << 16) >> 24), (float)((q0 << 8) >> 24), (float)(q0 >> 24)}, x1 = {(float)((q1 << 24) >> 24), (float)((q1 << 16) >> 24), (float)((q1 << 8) >> 24), (float)(q1 >> 24)};
                    const f32x4 y0 = x0 * ir * ig[bj][0] + acc[ai][bj][m][0], y1 = x1 * ir * ig[bj][1] + acc[ai][bj][m][1];
                    sq += ((y0[0] * y0[0] + y0[1] * y0[1]) + (y0[2] * y0[2] + y0[3] * y0[3])) + ((y1[0] * y1[0] + y1[1] * y1[1]) + (y1[2] * y1[2] + y1[3] * y1[3]));
                    u32x4 w; w.x = cvt_pk_bf16(y0[0], y0[1]); w.y = cvt_pk_bf16(y0[2], y0[3]); w.z = cvt_pk_bf16(y1[0], y1[1]); w.w = cvt_pk_bf16(y1[2], y1[3]); *(u32x4*)(xb + off + bj * HALF) = w; }
                { const auto r16_ = __builtin_amdgcn_permlane16_swap(__builtin_bit_cast(unsigned, sq), __builtin_bit_cast(unsigned, sq), false, false); sq += __builtin_bit_cast(float, (threadIdx.x & 16) ? r16_[0] : r16_[1]); }
                { const auto r32_ = __builtin_amdgcn_permlane32_swap(__builtin_bit_cast(unsigned, sq), __builtin_bit_cast(unsigned, sq), false, false); sq += __builtin_bit_cast(float, (threadIdx.x & 32) ? r32_[0] : r32_[1]); }
                if (fq == 0) ssqp[(size_t)row * 16 + u.pn * 4 + wc] = sq; }
    }
};
struct EpiResF32 {
    static constexpr bool PERM = false;
    const float* base; float* out; int ldc;
    __device__ __forceinline__ void operator()(const f32x4 (&acc)[2][2][4][2], const Unit& u, int wr, int wc, int fr, int fq) const {
        const int col0 = u.pn * BM + wc * 32 + 4 * fq;
#pragma unroll
        for (int ai = 0; ai < 2; ++ai)
#pragma unroll
            for (int m = 0; m < 4; ++m) { const size_t off = (size_t)(u.pm * BM + ai * HALF + wr * 64 + m * 16 + fr) * ldc + col0;
#pragma unroll
                for (int bj = 0; bj < 2; ++bj)
#pragma unroll
                    for (int n = 0; n < 2; ++n) { const f32x4 bs = *(const f32x4*)(base + off + bj * HALF + n * 16); *(f32x4*)(out + off + bj * HALF + n * 16) = bs + acc[ai][bj][m][n]; } }
    }
};

typedef int v4i __attribute__((ext_vector_type(4)));
template <bool I8> struct AccSel { typedef f32x4 type; };
template <> struct AccSel<true> { typedef v4i type; };
struct EpiI8 {
    static constexpr bool PERM = true;
    bf16* O; int ldc; const float* sa; const float* sb;
    __device__ __forceinline__ void operator()(const v4i (&acc)[2][2][4][2], const Unit& u, int wr, int wc, int fr, int fq) const {
        const int row0 = u.pm * BM + wr * 64 + fr; const int col0 = u.pn * BM + wc * 32 + 8 * fq;
        const auto rsrc = __builtin_amdgcn_make_buffer_rsrc((void*)O, 0, 0x7ffffff0, 0x00020000);
        f32x4 cs0[2], cs1[2];
#pragma unroll
        for (int bj = 0; bj < 2; ++bj) { cs0[bj] = *(const f32x4*)(sb + col0 + bj * HALF); cs1[bj] = *(const f32x4*)(sb + col0 + bj * HALF + 4); }
#pragma unroll
        for (int ai = 0; ai < 2; ++ai)
#pragma unroll
            for (int m = 0; m < 4; ++m) { const int row = row0 + ai * HALF + m * 16; const unsigned boff = (unsigned)(((size_t)row * ldc + col0) * 2); const float ra = sa[row];
#pragma unroll
                for (int bj = 0; bj < 2; ++bj) { const v4i i0 = acc[ai][bj][m][0], i1 = acc[ai][bj][m][1];
                    const f32x4 v0 = (f32x4){(float)i0[0], (float)i0[1], (float)i0[2], (float)i0[3]} * ra * cs0[bj], v1 = (f32x4){(float)i1[0], (float)i1[1], (float)i1[2], (float)i1[3]} * ra * cs1[bj];
                    u32x4 w; w.x = cvt_pk_bf16(v0[0], v0[1]); w.y = cvt_pk_bf16(v0[2], v0[3]); w.z = cvt_pk_bf16(v1[0], v1[1]); w.w = cvt_pk_bf16(v1[2], v1[3]);
                    __builtin_amdgcn_raw_buffer_store_b128(w, rsrc, boff + bj * HALF * 2, 0, 16); } }
    }
};
template <class Epi, class Sched, bool I8 = false>
__device__ __forceinline__ void gemm_phase(LAS unsigned char* lds, const Gemm g, const Sched& S, const Epi& E) {
    const int tid = threadIdx.x, wid = __builtin_amdgcn_readfirstlane(tid >> 6), lane = tid & 63, wr = wid >> 2, wc = wid & 3, fr = lane & 15, fq = lane >> 4;
    const int K = g.K, nt = K / BK;
    unsigned voffA[2], voffB[2];
#pragma unroll
    for (int i = 0; i < 2; ++i) { int R, C; stage_rc(tid * 16 + i * 8192, R, C); const int Rb = Epi::PERM ? ((R & ~31) + perm32(R & 31)) : R;
        voffA[i] = (unsigned)(R * K + C) * 2u; voffB[i] = (unsigned)(Rb * K + C) * 2u; }
    const size_t kstep = (size_t)(BK * 2);
    const size_t hstep = (size_t)HALF * K * 2;
    const size_t tstep = 2 * hstep;
    const unsigned ldsw = (unsigned)wid * 1024u;
    const int aoff = lds_byte(wr * 64 + fr, fq * 8), boff = lds_byte(wc * 32 + fr, fq * 8);
#define PG8_SA(b, h) (((b) * 2 + (h)) * HTB)
#define PG8_SB(b, h) ((4 + (b) * 2 + (h)) * HTB)
#define PG8_STAGE(bufoff, gbase, voff) do { _Pragma("unroll") for (int _i = 0; _i < 2; ++_i) \
        __builtin_amdgcn_global_load_lds((const unsigned*)((const char*)(gbase) + (voff)[_i]), (LAS unsigned*)(lds + (bufoff) + ldsw + _i * 8192), 16, 0, 0); } while (0)
#define PG8_LDA(dst, b, h) do { _Pragma("unroll") for (int m = 0; m < 4; ++m) _Pragma("unroll") for (int k = 0; k < 2; ++k) dst[m][k] = *(const LAS bf16x8*)(lds + PG8_SA(b, h) + aoff + m * 2048 + k * 1024); } while (0)
#define PG8_LDB(dst, b, h) do { _Pragma("unroll") for (int n = 0; n < 2; ++n) _Pragma("unroll") for (int k = 0; k < 2; ++k) dst[n][k] = *(const LAS bf16x8*)(lds + PG8_SB(b, h) + boff + n * 2048 + k * 1024); } while (0)
#define PG8_MMA(ai, bj, At, Bt) do { __builtin_amdgcn_s_setprio(1); _Pragma("unroll") for (int m = 0; m < 4; ++m) _Pragma("unroll") for (int n = 0; n < 2; ++n) _Pragma("unroll") for (int k = 0; k < 2; ++k) \
        { if constexpr (I8) acc[ai][bj][m][n] = __builtin_amdgcn_mfma_i32_16x16x64_i8(__builtin_bit_cast(v4i, Bt[n][k]), __builtin_bit_cast(v4i, At[m][k]), acc[ai][bj][m][n], 0, 0, 0); \
          else acc[ai][bj][m][n] = __builtin_amdgcn_mfma_f32_16x16x32_bf16(Bt[n][k], At[m][k], acc[ai][bj][m][n], 0, 0, 0); } __builtin_amdgcn_s_setprio(0); } while (0)
#define PG8_WAIT_V(n) asm volatile("s_waitcnt vmcnt(" #n ")" ::: "memory")
#define PG8_WAIT_L(n) asm volatile("s_waitcnt lgkmcnt(" #n ")" ::: "memory")
#define PG8_BAR __builtin_amdgcn_s_barrier()
#define PG8_SCHED __builtin_amdgcn_sched_barrier(0)
    Unit cur, nxt; int ui = 0;
    if (!S.next(0, cur)) return;
    using AccT = typename AccSel<I8>::type;
    AccT acc[2][2][4][2];
#pragma unroll
    for (int a = 0; a < 2; ++a)
#pragma unroll
        for (int b = 0; b < 2; ++b)
#pragma unroll
            for (int m = 0; m < 4; ++m)
#pragma unroll
                for (int n = 0; n < 2; ++n) acc[a][b][m][n] = AccT{};
    bf16x8 At[4][2], B0[2][2], B1[2][2];
    const char* cA = (const char*)g.A + (size_t)cur.pm * tstep; const char* cB = (const char*)g.Bt + (size_t)cur.pn * tstep;
    PG8_STAGE(PG8_SB(0, 0), cB, voffB); PG8_STAGE(PG8_SB(0, 1), cB + hstep, voffB); PG8_STAGE(PG8_SA(0, 0), cA, voffA); PG8_STAGE(PG8_SA(0, 1), cA + hstep, voffA);
    if (wr == 1) PG8_BAR;
    PG8_WAIT_V(2); PG8_BAR;
    PG8_STAGE(PG8_SB(1, 0), cB + kstep, voffB); PG8_STAGE(PG8_SA(1, 0), cA + kstep, voffA); PG8_STAGE(PG8_SB(1, 1), cB + hstep + kstep, voffB);
    PG8_WAIT_V(6); PG8_BAR;
    for (;;) {
        const bool has_next = S.next(ui + 1, nxt);
        const char* nA = has_next ? (const char*)g.A + (size_t)nxt.pm * tstep : cA; const char* nB = has_next ? (const char*)g.Bt + (size_t)nxt.pn * tstep : cB;
        for (int t = 0; t < nt; t += 2) {
            const bool last = (t == nt - 2);
            const char* a1 = cA + (size_t)(t + 1) * kstep;
            const char* a2 = last ? nA : cA + (size_t)(t + 2) * kstep; const char* b2 = last ? nB : cB + (size_t)(t + 2) * kstep;
            const char* a3 = a2 + kstep; const char* b3 = b2 + kstep;
            PG8_LDB(B0, 0, 0); PG8_LDB(B1, 0, 1); PG8_SCHED; PG8_LDA(At, 0, 0); PG8_STAGE(PG8_SA(1, 1), a1 + hstep, voffA);
            PG8_WAIT_V(8); PG8_WAIT_L(0); PG8_BAR; PG8_MMA(0, 0, At, B0); PG8_MMA(0, 1, At, B1); PG8_BAR; PG8_SCHED;
            PG8_LDA(At, 0, 1); PG8_STAGE(PG8_SB(0, 0), b2, voffB); PG8_STAGE(PG8_SB(0, 1), b2 + hstep, voffB); PG8_STAGE(PG8_SA(0, 0), a2, voffA);
            PG8_WAIT_V(8); PG8_WAIT_L(0); PG8_BAR; PG8_MMA(1, 0, At, B0); PG8_MMA(1, 1, At, B1); PG8_BAR; PG8_SCHED;
            PG8_LDB(B0, 1, 0); PG8_LDB(B1, 1, 1); PG8_SCHED; PG8_LDA(At, 1, 0); PG8_STAGE(PG8_SA(0, 1), a2 + hstep, voffA);
            PG8_WAIT_V(8); PG8_WAIT_L(0); PG8_BAR; PG8_MMA(0, 0, At, B0); PG8_MMA(0, 1, At, B1); PG8_BAR; PG8_SCHED;
            PG8_LDA(At, 1, 1); PG8_STAGE(PG8_SB(1, 0), b3, voffB); PG8_STAGE(PG8_SB(1, 1), b3 + hstep, voffB); PG8_STAGE(PG8_SA(1, 0), a3, voffA);
            PG8_WAIT_V(8); PG8_WAIT_L(0); PG8_BAR; PG8_MMA(1, 0, At, B0); PG8_MMA(1, 1, At, B1); PG8_BAR; PG8_SCHED;
        }
        if (wr == 0) PG8_BAR;
        E(acc, cur, wr, wc, fr, fq);
        if (!has_next) break;
#pragma unroll
        for (int a = 0; a < 2; ++a)
#pragma unroll
            for (int b = 0; b < 2; ++b)
#pragma unroll
                for (int m = 0; m < 4; ++m)
#pragma unroll
                    for (int n = 0; n < 2; ++n) acc[a][b][m][n] = AccT{};
        cur = nxt; cA = nA; cB = nB; ++ui;
        if (wr == 1) PG8_BAR;
    }
    PG8_WAIT_V(0);
    PG8_BAR;
#undef PG8_SA
#undef PG8_SB
#undef PG8_STAGE
#undef PG8_LDA
#undef PG8_LDB
#undef PG8_MMA
#undef PG8_WAIT_V
#undef PG8_WAIT_L
#undef PG8_BAR
#undef PG8_SCHED
}
}

constexpr int NWAVES = 8;
constexpr int N_PHASES = 11;
constexpr size_t MiB = 1u << 20;
constexpr size_t WS_CTL = 0, CTL_ZERO_BYTES = 32 * 1024;
constexpr size_t WS_WIN = 1 * MiB;
constexpr size_t WS_WOUT = 6 * MiB;
constexpr size_t WS_WQ = 8 * MiB;
constexpr size_t WS_KEYS = 12 * MiB;
constexpr size_t WS_RSU = 12 * MiB + 512 * 1024, WS_RSV = 12 * MiB + 768 * 1024;
constexpr size_t WS_RS2 = 12 * MiB + 896 * 1024;
constexpr size_t WS_IRS1 = 12 * MiB + 960 * 1024;
constexpr size_t WS_IDX = 13 * MiB;
constexpr size_t WS_GATE = 21 * MiB;
constexpr size_t WS_SSQP = WS_GATE;
constexpr size_t WS_H = 29 * MiB;
constexpr size_t WS_MIX = 61 * MiB;
constexpr size_t WS_C = WS_MIX, WS_SSP = WS_MIX + 8 * MiB;
constexpr size_t WS_X2 = 165 * MiB - 32 * MiB;
constexpr size_t WS_QKV = 93 * MiB;
constexpr size_t WS_PD = WS_QKV;
constexpr size_t WS_U8 = 165 * MiB;
constexpr size_t WS_V8 = 181 * MiB;
constexpr size_t WS_A8 = 197 * MiB;
constexpr size_t WS_W8 = 213 * MiB;
constexpr size_t WS_SA = 216 * MiB, WS_SB = 216 * MiB + 64 * 1024;
constexpr size_t WS_END = 217 * MiB;
constexpr size_t TAB8_SLICE = (size_t)NEXP * 128;
constexpr int CW_BAR = 4096;
static_assert((CW_BAR + 3456) * 4 <= 32 * 1024, "barrier words inside the per-call memset");
constexpr int RING_BYTES = 147456;
constexpr int LDSCTL_OFF = RING_BYTES, MISC_OFF = LDSCTL_OFF + 320;
constexpr int LDS_BYTES = 155648;

#define RLX_AGENT __ATOMIC_RELAXED, __HIP_MEMORY_SCOPE_AGENT
#define LDS_WAIT() asm volatile("s_waitcnt lgkmcnt(0)" ::: "memory")
__device__ __forceinline__ unsigned f2bf(float f) { unsigned u = __builtin_bit_cast(unsigned, f); return (u + 0x7fffu + ((u >> 16) & 1u)) >> 16; }
__device__ __forceinline__ unsigned pk2(float lo, float hi) { return pg8::cvt_pk_bf16(lo, hi); }
__device__ __forceinline__ unsigned f_bits(float f) { return __builtin_bit_cast(unsigned, f); }
__device__ __forceinline__ float bits_f(unsigned u) { return __builtin_bit_cast(float, u); }
__device__ __forceinline__ float bf_lo(unsigned w) { return __builtin_bit_cast(float, w << 16); }
__device__ __forceinline__ float bf_hi(unsigned w) { return __builtin_bit_cast(float, w & 0xffff0000u); }

#define XB_TMO      128
#define XB_XCNT(j)  (256  + 64 * (j))
#define XB_XSUB(j)  (1280 + 64 * (j))
#define XB_XGEN(j)  (2304 + 64 * (j))
#define XB_TOP      3328
#define XB_TOPGEN   3392
#define XCD_BAR_WORDS 3456
#define XB_SPIN_CAP (1u << 18)
__device__ __forceinline__ unsigned xb_ld(unsigned* p)              { return __hip_atomic_load(p, __ATOMIC_RELAXED, __HIP_MEMORY_SCOPE_AGENT); }
__device__ __forceinline__ unsigned xb_add(unsigned* p, unsigned v) { return __hip_atomic_fetch_add(p, v, __ATOMIC_RELAXED, __HIP_MEMORY_SCOPE_AGENT); }
__device__ __forceinline__ unsigned xb_xcc_id() { return (unsigned)__builtin_amdgcn_s_getreg((3 << 11) | 20) & 0xFu; }
#define XB_SPIN(cond, bar) do { unsigned _sp = 0; while (cond) { __builtin_amdgcn_s_sleep(1); \
    if ((++_sp & 255u) == 0u) { if (xb_ld(&(bar)[XB_TMO])) break; if (_sp > XB_SPIN_CAP) { atomicAdd(&(bar)[XB_TMO], 1u); break; } } } } while (0)
struct XcdBarrier { unsigned* bar; unsigned x; volatile LAS unsigned* st; };
__device__ __forceinline__ XcdBarrier xcd_barrier_post(unsigned* bar, volatile LAS unsigned* st) {
    XcdBarrier b; b.bar = bar; b.x = xb_xcc_id(); b.st = st;
    if (threadIdx.x == 0) (void)xb_add(&bar[XB_XCNT(b.x)], 1u);
    return b;
}
__device__ __forceinline__ void xcd_barrier_complete(unsigned* bar, unsigned x, unsigned& nloc, unsigned& nx) {
    const unsigned G = gridDim.x * gridDim.y * gridDim.z;
    unsigned sum, cnt, mine, sp = 0u;
    for (;;) {
        sum = 0u; cnt = 0u; mine = 0u;
#pragma unroll
        for (unsigned j = 0; j < 16; ++j) { const unsigned c = xb_ld(&bar[XB_XCNT(j)]); sum += c; cnt += (c > 0u) ? 1u : 0u; mine = (j == x) ? c : mine; }
        if (sum == G) break;
        __builtin_amdgcn_s_sleep(1);
        if ((++sp & 255u) == 0u) { if (xb_ld(&bar[XB_TMO])) break; if (sp > XB_SPIN_CAP) { atomicAdd(&bar[XB_TMO], 1u); break; } }
    }
    nloc = mine > 0u ? mine : 1u; nx = cnt > 0u ? cnt : 1u;
}
__device__ __forceinline__ void xcd_barrier(const XcdBarrier& b, const unsigned char* pf = nullptr) {
    asm volatile("s_waitcnt vmcnt(0)" ::: "memory");
    __syncthreads();
    unsigned pf0 = 0u, pf1 = 0u;
    if (pf != nullptr && threadIdx.x >= 64) { const int l0 = (int)threadIdx.x - 64; pf0 = *(const GAS unsigned*)(pf + (size_t)l0 * 128); if (l0 < 64) pf1 = *(const GAS unsigned*)(pf + (size_t)(l0 + 448) * 128); }
    if (threadIdx.x == 0) {
        unsigned* bar = b.bar;
        __builtin_amdgcn_s_waitcnt(0);
        __builtin_amdgcn_fence(__ATOMIC_ACQUIRE, "agent");
        unsigned nloc = b.st[0], nx = b.st[1];
        if (nloc == 0u) { xcd_barrier_complete(bar, b.x, nloc, nx); b.st[0] = nloc; b.st[1] = nx; }
        const unsigned old = xb_add(&bar[XB_XSUB(b.x)], 1u);
        const unsigned gen = old / nloc;
        if (old + 1u == (gen + 1u) * nloc) {
            __builtin_amdgcn_fence(__ATOMIC_RELEASE, "agent");
            asm volatile("s_waitcnt vmcnt(0)" ::: "memory");
            const unsigned og = xb_add(&bar[XB_TOP], 1u);
            const unsigned target = (og / nx + 1u) * nx;
            if (og + 1u != target) XB_SPIN(xb_ld(&bar[XB_TOP]) < target, bar);
            xb_add(&bar[XB_XGEN(b.x)], 1u);
            asm volatile("s_waitcnt vmcnt(0)" ::: "memory");
        } else {
            XB_SPIN(xb_ld(&bar[XB_XGEN(b.x)]) == gen, bar);
            asm volatile("s_waitcnt vmcnt(0)" ::: "memory");
        }
    }
    asm volatile("" :: "v"(pf0), "v"(pf1));
    __syncthreads();
}

struct Frame {
    LAS unsigned char* lds;
    volatile LAS unsigned* MISC;
    gu32* ctl;
    int tid, lane, wave;
    int vcu, G;
    const float *x, *g1, *w_in, *sb_g, *sw_g, *sinks, *w_out, *g2, *w_q, *keys1, *keys2, *pu, *pv, *gf;
    float* out;
    bf16 *Wt_in, *Wt_out, *Wt_q, *KEYS, *H, *MIX, *QKV;
    unsigned char *U8, *V8, *C8; float *RSU, *RSV, *SSP, *SSQP, *RS2, *CS, *IRS1; bf16 *PD, *X2;
    unsigned short* IDX; float* GATE;
    unsigned char *A8, *W8; float *SA, *SB;
};

__device__ __forceinline__ unsigned partner32(unsigned x) { const auto r = __builtin_amdgcn_permlane32_swap(x, x, false, false); return (threadIdx.x & 32) ? r[0] : r[1]; }
__device__ __forceinline__ unsigned partner16(unsigned x) { const auto r = __builtin_amdgcn_permlane16_swap(x, x, false, false); return (threadIdx.x & 16) ? r[0] : r[1]; }
#define DPPF(v, ctl) bits_f((unsigned)__builtin_amdgcn_update_dpp(0, (int)f_bits(v), (ctl), 0xf, 0xf, false))
__device__ __forceinline__ float wave_sum(float v) {
    v += DPPF(v, 0xB1); v += DPPF(v, 0x4E); v += DPPF(v, 0x141); v += DPPF(v, 0x140);
    v += bits_f(partner16(f_bits(v))); v += bits_f(partner32(f_bits(v)));
    return v;
}

__device__ __forceinline__ int pack_i8(float a, float b, float c, float d) {
    const unsigned fa = f_bits(a + 12582912.0f), fb = f_bits(b + 12582912.0f), fc = f_bits(c + 12582912.0f), fd = f_bits(d + 12582912.0f);
    return (int)(__builtin_amdgcn_perm(fb, fa, 0x0c0c0400u) | __builtin_amdgcn_perm(fd, fc, 0x04000c0cu));
}
__device__ __forceinline__ float wave_max(float v) {
    v = __builtin_fmaxf(v, DPPF(v, 0xB1)); v = __builtin_fmaxf(v, DPPF(v, 0x4E)); v = __builtin_fmaxf(v, DPPF(v, 0x141)); v = __builtin_fmaxf(v, DPPF(v, 0x140));
    v = __builtin_fmaxf(v, bits_f(partner16(f_bits(v)))); v = __builtin_fmaxf(v, bits_f(partner32(f_bits(v))));
    return v;
}
__device__ __forceinline__ void p0_transpose_item(const float* W, int K, int N, bf16* WT, LAS float* scr, int item, int lane, const float* gk = nullptr) {
    const int nblk = N / 32, kb = item / nblk, nb = item % nblk, k0 = 64 * kb, n0 = 32 * nb;
    float t_[32];
#pragma unroll
    for (int i = 0; i < 32; ++i) { const int kk = 2 * i + (lane >> 5); t_[i] = __builtin_nontemporal_load(W + (size_t)(k0 + kk) * N + n0 + (lane & 31)); }
#pragma unroll
    for (int i = 0; i < 32; ++i) { const int kk = 2 * i + (lane >> 5); const float gq = gk ? gk[k0 + kk] : 1.0f; scr[kk * 33 + (lane & 31)] = t_[i] * gq; }
    LDS_WAIT(); asm volatile("" ::: "memory");
    const int c = lane & 7;
#pragma unroll
    for (int j = 0; j < 4; ++j) { const int n = (lane >> 3) + 8 * j; const LAS float* s = scr + (8 * c) * 33 + n;
        u32x4 o; o.x = pk2(s[0 * 33], s[1 * 33]); o.y = pk2(s[2 * 33], s[3 * 33]); o.z = pk2(s[4 * 33], s[5 * 33]); o.w = pk2(s[6 * 33], s[7 * 33]);
        *(GAS u32x4*)(WT + (size_t)(n0 + n) * K + k0 + 8 * c) = o; }
    LDS_WAIT(); asm volatile("" ::: "memory");
}
template <int NR> __device__ __forceinline__ void rms_rows_to_bf16(const float* xbase, const float* g, bf16* obase, float* irs, unsigned char* a8, float* sa, int m0, int mstride, int lane) {
    f32x4 v[NR][4];
#pragma unroll
    for (int i = 0; i < NR; ++i) { const int m = m0 + i * mstride; const GAS f32x4* xr = (const GAS f32x4*)(xbase + (size_t)(m < T ? m : m0) * D) + lane;
#pragma unroll
        for (int j = 0; j < 4; ++j) v[i][j] = __builtin_nontemporal_load(xr + 64 * j); }
    const GAS f32x4* gr = (const GAS f32x4*)g + lane;
    f32x4 gg[4];
#pragma unroll
    for (int j = 0; j < 4; ++j) gg[j] = gr[64 * j];
#pragma unroll
    for (int i = 0; i < NR; ++i) { const int m = m0 + i * mstride;
        float s = 0.f;
#pragma unroll
        for (int j = 0; j < 4; ++j) s += (v[i][j].x * v[i][j].x + v[i][j].y * v[i][j].y) + (v[i][j].z * v[i][j].z + v[i][j].w * v[i][j].w);
        const float ms_ = wave_sum(s) * (1.f / D) + EPS; const float rs = __builtin_amdgcn_rsqf(ms_);
        float am = 0.f;
#pragma unroll
        for (int j = 0; j < 4; ++j) { v[i][j] = v[i][j] * rs * gg[j]; am = __builtin_fmaxf(am, __builtin_fmaxf(__builtin_fmaxf(__builtin_fabsf(v[i][j].x), __builtin_fabsf(v[i][j].y)), __builtin_fmaxf(__builtin_fabsf(v[i][j].z), __builtin_fabsf(v[i][j].w)))); }
        am = wave_max(am); const float sq = am > 0.f ? 127.0f / am : 0.f;
        if (m < T) { if (lane == 0) { irs[m] = __builtin_sqrtf(ms_); sa[m] = am * (1.0f / 127.0f); } GAS unsigned* q8 = (GAS unsigned*)(a8 + (size_t)m * D) + lane;
#pragma unroll
            for (int j = 0; j < 4; ++j) q8[64 * j] = (unsigned)pack_i8(v[i][j].x * sq, v[i][j].y * sq, v[i][j].z * sq, v[i][j].w * sq); } }
}
__device__ __forceinline__ void cvt_array_bf16(const float* src, bf16* dst, size_t n8, int gtid, int gthreads) {
    for (size_t i = gtid; i < n8; i += gthreads) {
        const f32x4 a = __builtin_nontemporal_load((const GAS f32x4*)(src + i * 8)), b = __builtin_nontemporal_load((const GAS f32x4*)(src + i * 8 + 4));
        u32x4 o; o.x = pk2(a.x, a.y); o.y = pk2(a.z, a.w); o.z = pk2(b.x, b.y); o.w = pk2(b.z, b.w);
        *(GAS u32x4*)(dst + i * 8) = o;
    }
}
__device__ __forceinline__ void p0_win_i8_item(Frame& F, int item) {
    const int lane = F.lane, r = lane >> 3, c = lane & 7, n0 = 32 * item, k0 = 128 * F.wave;
    LAS unsigned char* scr = F.lds + F.wave * 16384;
    LAS float* cmx = (LAS float*)(F.lds + 8 * 16384);
    f32x4 v[16];
#pragma unroll
    for (int a = 0; a < 4; ++a)
#pragma unroll
        for (int b = 0; b < 4; ++b) v[4 * a + b] = __builtin_nontemporal_load((const GAS f32x4*)(F.w_in + (size_t)(k0 + 32 * a + 4 * r + b) * DIN + n0 + 4 * c));
    f32x4 mx = {0.f, 0.f, 0.f, 0.f};
#pragma unroll
    for (int i = 0; i < 16; ++i) { mx.x = __builtin_fmaxf(mx.x, __builtin_fabsf(v[i].x)); mx.y = __builtin_fmaxf(mx.y, __builtin_fabsf(v[i].y)); mx.z = __builtin_fmaxf(mx.z, __builtin_fabsf(v[i].z)); mx.w = __builtin_fmaxf(mx.w, __builtin_fabsf(v[i].w)); }
    float mxs[4] = {mx.x, mx.y, mx.z, mx.w};
#pragma unroll
    for (int j = 0; j < 4; ++j) { float m_ = mxs[j]; m_ = __builtin_fmaxf(m_, DPPF(m_, 0x128)); m_ = __builtin_fmaxf(m_, bits_f(partner16(f_bits(m_)))); m_ = __builtin_fmaxf(m_, bits_f(partner32(f_bits(m_)))); mxs[j] = m_; }
    if (lane < 8) { f32x4 o = {mxs[0], mxs[1], mxs[2], mxs[3]}; *(LAS f32x4*)(cmx + F.wave * 32 + 4 * c) = o; }
    __syncthreads();
    f32x4 cm = *(const LAS f32x4*)(cmx + 4 * c);
#pragma unroll
    for (int w = 1; w < 8; ++w) { const f32x4 t_ = *(const LAS f32x4*)(cmx + w * 32 + 4 * c); cm.x = __builtin_fmaxf(cm.x, t_.x); cm.y = __builtin_fmaxf(cm.y, t_.y); cm.z = __builtin_fmaxf(cm.z, t_.z); cm.w = __builtin_fmaxf(cm.w, t_.w); }
    const f32x4 sq = {cm.x > 0.f ? 127.0f / cm.x : 0.f, cm.y > 0.f ? 127.0f / cm.y : 0.f, cm.z > 0.f ? 127.0f / cm.z : 0.f, cm.w > 0.f ? 127.0f / cm.w : 0.f};
    if (F.wave == 0 && lane < 8) { const f32x4 o = cm * (1.0f / 127.0f); *(GAS f32x4*)(F.SB + n0 + 4 * c) = o; }
    constexpr int WP = 144;
#pragma unroll
    for (int a = 0; a < 4; ++a) {
        const f32x4 q0 = v[4 * a] * sq, q1 = v[4 * a + 1] * sq, q2 = v[4 * a + 2] * sq, q3 = v[4 * a + 3] * sq;
        *(LAS unsigned*)(scr + (4 * c + 0) * WP + 32 * a + 4 * r) = (unsigned)pack_i8(q0.x, q1.x, q2.x, q3.x);
        *(LAS unsigned*)(scr + (4 * c + 1) * WP + 32 * a + 4 * r) = (unsigned)pack_i8(q0.y, q1.y, q2.y, q3.y);
        *(LAS unsigned*)(scr + (4 * c + 2) * WP + 32 * a + 4 * r) = (unsigned)pack_i8(q0.z, q1.z, q2.z, q3.z);
        *(LAS unsigned*)(scr + (4 * c + 3) * WP + 32 * a + 4 * r) = (unsigned)pack_i8(q0.w, q1.w, q2.w, q3.w);
    }
    LDS_WAIT(); asm volatile("" ::: "memory");
    { const int n = lane >> 1, hf = lane & 1; const LAS u32x4* sp = (const LAS u32x4*)(scr + n * WP + 64 * hf); GAS u32x4* dp = (GAS u32x4*)(F.W8 + (size_t)(n0 + n) * D + k0 + 64 * hf);
#pragma unroll
      for (int q = 0; q < 4; ++q) dp[q] = sp[q]; }
    LDS_WAIT(); asm volatile("" ::: "memory");
    __syncthreads();
}
#ifndef P0_WROWS
#define P0_WROWS 2
#endif
__device__ __forceinline__ void p0_prologue(Frame& F) {
    LAS float* scr = (LAS float*)(F.lds + F.wave * 16384);
    const int gw = F.vcu * NWAVES + F.wave, NGW = F.G * NWAVES;
    const int bx = (int)blockIdx.x;
    for (int it = bx; it < DIN / 32; it += F.G) p0_win_i8_item(F, it);
    constexpr int I_OUT = (D / 64) * (D / 32), I_Q = (D / 64) * (DQ / 32);
    constexpr int NITEMS = I_OUT + I_Q;
    const int nW = DIN / 32, nbq = F.G - nW; const bool split = nbq * NWAVES * 2 >= NITEMS;
    const int tb = split ? bx - nW : bx, tn = split ? nbq : F.G;
    if (tb >= 0) for (int it = tb * NWAVES + F.wave; it < NITEMS; it += tn * NWAVES) {
        int r = it;
        if (r < I_OUT) { p0_transpose_item(F.w_out, D, D, F.Wt_out, scr, r, F.lane); continue; } r -= I_OUT;
        p0_transpose_item(F.w_q, D, DQ, F.Wt_q, scr, r, F.lane, F.g2);
    }
    if (split && nW * NWAVES * P0_WROWS < T) {
        const int nww = nW * NWAVES, nnw = nbq * NWAVES, w0 = nww * P0_WROWS;
        if (bx < nW) rms_rows_to_bf16<P0_WROWS>(F.x, F.g1, F.H, F.IRS1, F.A8, F.SA, bx * NWAVES + F.wave, nww, F.lane);
        else { const int m0 = w0 + (bx - nW) * NWAVES + F.wave;
            for (int m = m0; m < T; m += 11 * nnw) { rms_rows_to_bf16<8>(F.x, F.g1, F.H, F.IRS1, F.A8, F.SA, m, nnw, F.lane); if (m + 8 * nnw < T) rms_rows_to_bf16<3>(F.x, F.g1, F.H, F.IRS1, F.A8, F.SA, m + 8 * nnw, nnw, F.lane); } }
    } else
    for (int m = gw; m < T; m += 8 * NGW) rms_rows_to_bf16<8>(F.x, F.g1, F.H, F.IRS1, F.A8, F.SA, m, NGW, F.lane);
    const int gtid = F.vcu * NWAVES * 64 + F.tid, gthreads = F.G * NWAVES * 64;
    cvt_array_bf16(F.keys1, F.KEYS, (size_t)8 * 128 * 128 / 8, gtid, gthreads);
    cvt_array_bf16(F.keys2, F.KEYS + 8 * 128 * 128, (size_t)8 * 128 * 128 / 8, gtid, gthreads);
}

template <int NR> __device__ __forceinline__ void cvt_rows_fp8(Frame& F, int r0, int rstride, int rlimit, int lane) {
    f32x4 v[NR][4];
#pragma unroll
    for (int i = 0; i < NR; ++i) { int r = r0 + i * rstride; r = r < rlimit ? r : r0; const float* src = r < NEXP ? F.pu + (size_t)r * D : F.pv + (size_t)(r - NEXP) * D;
        const GAS f32x4* xr = (const GAS f32x4*)src + lane;
#pragma unroll
        for (int j = 0; j < 4; ++j) v[i][j] = __builtin_nontemporal_load(xr + 64 * j); }
    f32x4 g2v[4];
#pragma unroll
    for (int j = 0; j < 4; ++j) g2v[j] = ((const GAS f32x4*)F.g2)[lane + 64 * j];
#pragma unroll
    for (int i = 0; i < NR; ++i) { const int r = r0 + i * rstride;
        if (r < NEXP) {
#pragma unroll
            for (int j = 0; j < 4; ++j) v[i][j] = v[i][j] * g2v[j]; }
        float amax = 0.f;
#pragma unroll
        for (int j = 0; j < 4; ++j) amax = __builtin_fmaxf(amax, __builtin_fmaxf(__builtin_fmaxf(__builtin_fabsf(v[i][j].x), __builtin_fabsf(v[i][j].y)), __builtin_fmaxf(__builtin_fabsf(v[i][j].z), __builtin_fabsf(v[i][j].w))));
        amax = wave_max(amax);
        int k = 6 - ((int)((f_bits(amax) >> 23) & 0xffu) - 127);
        k = k > 100 ? 100 : (k < -100 ? -100 : k);
        const float sc = bits_f((unsigned)(k + 127) << 23), inv = bits_f((unsigned)(127 - k) << 23);
        if (r < rlimit) { const int e = r < NEXP ? r : r - NEXP; unsigned char* tab8 = r < NEXP ? F.U8 : F.V8; float* rs = r < NEXP ? F.RSU : F.RSV;
            const float sq = amax > 0.f ? 127.0f / amax : 0.f;
#pragma unroll
            for (int j = 0; j < 4; ++j) {
                const int w = pack_i8(v[i][j].x * sq, v[i][j].y * sq, v[i][j].z * sq, v[i][j].w * sq);
                const int s = 2 * j + (lane >> 5);
                *(GAS unsigned*)(tab8 + (size_t)s * TAB8_SLICE + (size_t)e * 128 + 4 * (lane & 31)) = (unsigned)w;
            }
            if (lane == 0) rs[e] = amax * (1.0f / 127.0f); } }
}
__device__ __forceinline__ int crow(int r, int hi) { return (r & 3) + 8 * (r >> 2) + 4 * hi; }
constexpr int VPITCH = 192;
constexpr int KPITCH = 144;
constexpr int ATT_K_OFF = 0, ATT_V_OFF = 32 * KPITCH, ATT_Q_OFF = 32 * KPITCH + 32 * VPITCH, ATT_WAVE_BYTES = 64 * KPITCH + 32 * VPITCH;
struct Tile4 { u32x4 a, b, c, d; };
__device__ __forceinline__ Tile4 tile_load(const bf16* t0, int lane) {
    const bf16* p = t0 + (size_t)(lane >> 3) * DIN + 8 * (lane & 7);
    Tile4 t; t.a = *(const GAS u32x4*)p; t.b = *(const GAS u32x4*)(p + (size_t)8 * DIN); t.c = *(const GAS u32x4*)(p + (size_t)16 * DIN); t.d = *(const GAS u32x4*)(p + (size_t)24 * DIN); return t;
}
__device__ __forceinline__ void tile_store(LAS unsigned char* dst, int pitch, const Tile4& t, int lane) {
    LAS unsigned char* p = dst + (lane >> 3) * pitch + 16 * (lane & 7);
    *(LAS u32x4*)p = t.a; *(LAS u32x4*)(p + 8 * pitch) = t.b; *(LAS u32x4*)(p + 16 * pitch) = t.c; *(LAS u32x4*)(p + 24 * pitch) = t.d;
}
__device__ __forceinline__ bf16x8 kfrag(const LAS unsigned char* kt, int d0, int lane) { const u32x4 w = *(const LAS u32x4*)(kt + (lane & 31) * KPITCH + 32 * d0 + 16 * (lane >> 5)); return __builtin_bit_cast(bf16x8, w); }
__device__ __forceinline__ bf16x8 vfrag(const LAS unsigned char* wl, int dblk, int s, int lane) {
    const int hi = lane >> 5, i = lane & 15, g1 = (lane >> 4) & 1;
    const LAS unsigned char* p = wl + (16 * s + 4 * hi + (i >> 2)) * VPITCH + (32 * dblk + 16 * g1 + 4 * (i & 3)) * 2;
    const v4i16_t lo = __builtin_amdgcn_ds_read_tr16_b64_v4i16((LAS v4i16_t*)p);
    const v4i16_t hh = __builtin_amdgcn_ds_read_tr16_b64_v4i16((LAS v4i16_t*)(p + 8 * VPITCH));
    return (bf16x8){lo[0], lo[1], lo[2], lo[3], hh[0], hh[1], hh[2], hh[3]};
}
__device__ __forceinline__ bf16x8 pack8(const f32x16& a, int s) {
    u32x4 w; w.x = pk2(a[8 * s + 0], a[8 * s + 1]); w.y = pk2(a[8 * s + 2], a[8 * s + 3]); w.z = pk2(a[8 * s + 4], a[8 * s + 5]); w.w = pk2(a[8 * s + 6], a[8 * s + 7]);
    return __builtin_bit_cast(bf16x8, w);
}
__device__ __forceinline__ void head_norm_store(const f32x16& o0, const f32x16& o1, float scale, const float* g, bf16* dstrow, int hi) {
    float ss = 0.f;
#pragma unroll
    for (int r = 0; r < 16; ++r) { const float a = o0[r] * scale, b = o1[r] * scale; ss += a * a + b * b; }
    ss += bits_f(partner32(f_bits(ss)));
    const float rs = __builtin_amdgcn_rsqf(ss * (1.f / 64.f) + EPS) * scale;
#pragma unroll
    for (int dblk = 0; dblk < 2; ++dblk)
#pragma unroll
        for (int q4 = 0; q4 < 4; ++q4) { const int d0 = 32 * dblk + 8 * q4 + 4 * hi; const f32x4 gg = *(const GAS f32x4*)(g + d0);
            const f32x16& o = dblk ? o1 : o0;
            u32x2 w; w.x = pk2(o[4 * q4 + 0] * rs * gg.x, o[4 * q4 + 1] * rs * gg.y); w.y = pk2(o[4 * q4 + 2] * rs * gg.z, o[4 * q4 + 3] * rs * gg.w);
            *(GAS u32x2*)(dstrow + d0) = w; }
}

__device__ __forceinline__ void sb_item(Frame& F, int b, int h, int qb, LAS unsigned char* wl) {
    const int lane = F.lane, r32 = lane & 31, hi = lane >> 5;
    const size_t rowbase = (size_t)b * SEQ;
    const bf16* Qp = F.QKV + (rowbase + 32 * qb) * DIN + C_SBQ + h * 64;
    const bf16* Kb = F.QKV + rowbase * DIN + C_SBK + h * 64;
    const bf16* Vb = F.QKV + rowbase * DIN + C_SBV + h * 64;
    bf16x8 qr[4];
    const Tile4 tq = tile_load(Qp, lane);
    Tile4 tk = tile_load(Kb + (size_t)(32 * qb) * DIN, lane), tv = tile_load(Vb + (size_t)(32 * qb) * DIN, lane);
    { tile_store(wl + ATT_K_OFF, KPITCH, tq, lane);
#pragma unroll
      for (int d0 = 0; d0 < 4; ++d0) qr[d0] = kfrag(wl + ATT_K_OFF, d0, lane); }
    bf16x8 tri[2];
#pragma unroll
    for (int s = 0; s < 2; ++s)
#pragma unroll
        for (int j = 0; j < 8; ++j) tri[s][j] = (16 * s + 8 * (j >> 2) + 4 * hi + (j & 3) >= r32) ? (short)0x3F80 : (short)0;
    f32x16 o0 = {}, o1 = {}; float C = 0.f;
    for (int kt = qb; kt >= 0; --kt) {
        tile_store(wl + ATT_K_OFF, KPITCH, tk, lane); tile_store(wl + ATT_V_OFF, VPITCH, tv, lane);
        { const int kn = kt > 0 ? kt - 1 : 0; tk = tile_load(Kb + (size_t)(32 * kn) * DIN, lane); tv = tile_load(Vb + (size_t)(32 * kn) * DIN, lane); }
        bf16x8 kf[4];
#pragma unroll
        for (int d0 = 0; d0 < 4; ++d0) kf[d0] = kfrag(wl + ATT_K_OFF, d0, lane);
        f32x16 z = {};
#pragma unroll
        for (int d0 = 0; d0 < 4; ++d0) z = __builtin_amdgcn_mfma_f32_32x32x16_bf16(kf[d0], qr[d0], z, 0, 0, 0);
        const int lim = r32 + 32 * (qb - kt);
        f32x16 l, ls;
#pragma unroll
        for (int r = 0; r < 16; ++r) {
            const float zz = z[r] * (0.125f * LOG2E);
            const float e = __builtin_amdgcn_exp2f(-__builtin_fabsf(zz));
            const float sp = __builtin_fmaxf(zz, 0.f) + __builtin_amdgcn_logf(1.0f + e);
            const bool valid = crow(r, hi) < lim;
            l[r] = valid ? -sp : 0.f;
            ls[r] = zz - sp;
        }
        f32x16 lo;
        bf16x8 lh[2], ll[2];
#pragma unroll
        for (int s = 0; s < 2; ++s) {
            u32x4 wh, wlw;
#pragma unroll
            for (int p = 0; p < 4; ++p) { const float a = l[8 * s + 2 * p], c = l[8 * s + 2 * p + 1]; const unsigned w = pk2(a, c); wh[p] = w; lo[8 * s + 2 * p] = a - bf_lo(w); lo[8 * s + 2 * p + 1] = c - bf_hi(w); }
#pragma unroll
            for (int p = 0; p < 4; ++p) wlw[p] = pk2(lo[8 * s + 2 * p], lo[8 * s + 2 * p + 1]);
            lh[s] = __builtin_bit_cast(bf16x8, wh); ll[s] = __builtin_bit_cast(bf16x8, wlw);
        }
        f32x16 Y = {};
        Y = __builtin_amdgcn_mfma_f32_32x32x16_bf16(tri[0], lh[0], Y, 0, 0, 0);
        Y = __builtin_amdgcn_mfma_f32_32x32x16_bf16(tri[1], lh[1], Y, 0, 0, 0);
        Y = __builtin_amdgcn_mfma_f32_32x32x16_bf16(tri[0], ll[0], Y, 0, 0, 0);
        Y = __builtin_amdgcn_mfma_f32_32x32x16_bf16(tri[1], ll[1], Y, 0, 0, 0);
        f32x16 a;
#pragma unroll
        for (int r = 0; r < 16; ++r) {
            const bool valid = crow(r, hi) < lim;
            const float later = C + (Y[r] - l[r]);
            const float av = __builtin_amdgcn_exp2f(ls[r] + later);
            a[r] = valid ? av : 0.f;
        }
        float tot; { const float y0_ = Y[0]; const auto r_ = __builtin_amdgcn_permlane32_swap(f_bits(y0_), f_bits(y0_), false, false); tot = hi ? bits_f(r_[0]) : y0_; }
        C += tot;
        const bf16x8 a0 = pack8(a, 0), a1 = pack8(a, 1);
        o0 = __builtin_amdgcn_mfma_f32_32x32x16_bf16(vfrag(wl + ATT_V_OFF, 0, 0, lane), a0, o0, 0, 0, 0);
        o0 = __builtin_amdgcn_mfma_f32_32x32x16_bf16(vfrag(wl + ATT_V_OFF, 0, 1, lane), a1, o0, 0, 0, 0);
        o1 = __builtin_amdgcn_mfma_f32_32x32x16_bf16(vfrag(wl + ATT_V_OFF, 1, 0, lane), a0, o1, 0, 0, 0);
        o1 = __builtin_amdgcn_mfma_f32_32x32x16_bf16(vfrag(wl + ATT_V_OFF, 1, 1, lane), a1, o1, 0, 0, 0);
        if (__all(C < SB_EXIT)) break;
    }
    head_norm_store(o0, o1, 1.0f, F.sb_g + h * 64, F.MIX + (rowbase + 32 * qb + r32) * D + h * 64, hi);
}

#define SWA_HEAD(z, qslope, m_, den_, oa, ob) do { \
        float tmax_ = -INFINITY; f32x16 s_; \
        _Pragma("unroll") for (int r = 0; r < 16; ++r) { const int dist = dq - ((r & 3) + 8 * (r >> 2)); const float sv = z[r] * (0.125f * LOG2E) - qslope * (float)dist; s_[r] = ((unsigned)dist < 128u) ? sv : -INFINITY; tmax_ = __builtin_fmaxf(tmax_, s_[r]); } \
        tmax_ = __builtin_fmaxf(tmax_, bits_f(partner32(f_bits(tmax_)))); \
        const float mn_ = __builtin_fmaxf(m_, tmax_); const float al_ = __builtin_amdgcn_exp2f(m_ - mn_); m_ = mn_; \
        f32x16 p_; float ps_ = 0.f; \
        _Pragma("unroll") for (int r = 0; r < 16; ++r) { p_[r] = __builtin_amdgcn_exp2f(s_[r] - mn_); ps_ += p_[r]; } \
        den_ = den_ * al_ + ps_; \
        _Pragma("unroll") for (int r = 0; r < 16; ++r) { oa[r] *= al_; ob[r] *= al_; } \
        const bf16x8 a0_ = pack8(p_, 0), a1_ = pack8(p_, 1); \
        oa = __builtin_amdgcn_mfma_f32_32x32x16_bf16(vf00, a0_, oa, 0, 0, 0); oa = __builtin_amdgcn_mfma_f32_32x32x16_bf16(vf01, a1_, oa, 0, 0, 0); \
        ob = __builtin_amdgcn_mfma_f32_32x32x16_bf16(vf10, a0_, ob, 0, 0, 0); ob = __builtin_amdgcn_mfma_f32_32x32x16_bf16(vf11, a1_, ob, 0, 0, 0); } while (0)
__device__ __forceinline__ void swa_item2(Frame& F, int b, int kv, int hp, int qb, LAS unsigned char* wl) {
    const int lane = F.lane, r32 = lane & 31, hi = lane >> 5, hqA = kv * 4 + 2 * hp, hqB = hqA + 1;
    const size_t rowbase = (size_t)b * SEQ;
    const bf16* QpA = F.QKV + (rowbase + 32 * qb) * DIN + C_SWQ + hqA * 64;
    const bf16* Kb = F.QKV + rowbase * DIN + C_SWK + kv * 64;
    const bf16* Vb = F.QKV + rowbase * DIN + C_SWV + kv * 64;
    const float slopeA = __builtin_amdgcn_exp2f(-(float)(hqA + 1)) * LOG2E, slopeB = __builtin_amdgcn_exp2f(-(float)(hqB + 1)) * LOG2E;
    float mA = F.sinks[hqA] * LOG2E, mB = F.sinks[hqB] * LOG2E;
    bf16x8 qrA[4];
    const int kt0 = qb - 4 < 0 ? 0 : qb - 4;
    Tile4 tkn;
    { const Tile4 tqa = tile_load(QpA, lane), tqb = tile_load(QpA + 64, lane); tkn = tile_load(Kb + (size_t)(32 * kt0) * DIN, lane);
      tile_store(wl + ATT_K_OFF, KPITCH, tqa, lane);
#pragma unroll
      for (int d0 = 0; d0 < 4; ++d0) qrA[d0] = kfrag(wl + ATT_K_OFF, d0, lane);
      tile_store(wl + ATT_Q_OFF, KPITCH, tqb, lane); }
    float denA = hi == 0 ? 1.f : 0.f, denB = denA;
    f32x16 oA0 = {}, oA1 = {}, oB0 = {}, oB1 = {};
    for (int kt = kt0; kt <= qb; ++kt) {
        { const Tile4 tv = tile_load(Vb + (size_t)(32 * kt) * DIN, lane);
          tile_store(wl + ATT_K_OFF, KPITCH, tkn, lane);
          { const int kn = kt < qb ? kt + 1 : kt; tkn = tile_load(Kb + (size_t)(32 * kn) * DIN, lane); }
          tile_store(wl + ATT_V_OFF, VPITCH, tv, lane); }
        const bf16x8 vf00 = vfrag(wl + ATT_V_OFF, 0, 0, lane), vf01 = vfrag(wl + ATT_V_OFF, 0, 1, lane), vf10 = vfrag(wl + ATT_V_OFF, 1, 0, lane), vf11 = vfrag(wl + ATT_V_OFF, 1, 1, lane);
        const int dq = 32 * (qb - kt) + r32 - 4 * hi;
        { f32x16 zA = {};
#pragma unroll
          for (int d0 = 0; d0 < 4; ++d0) zA = __builtin_amdgcn_mfma_f32_32x32x16_bf16(kfrag(wl + ATT_K_OFF, d0, lane), qrA[d0], zA, 0, 0, 0);
          SWA_HEAD(zA, slopeA, mA, denA, oA0, oA1); }
        { f32x16 zB = {};
#pragma unroll
          for (int d0 = 0; d0 < 4; ++d0) zB = __builtin_amdgcn_mfma_f32_32x32x16_bf16(kfrag(wl + ATT_K_OFF, d0, lane), kfrag(wl + ATT_Q_OFF, d0, lane), zB, 0, 0, 0);
          SWA_HEAD(zB, slopeB, mB, denB, oB0, oB1); }
    }
    denA += bits_f(partner32(f_bits(denA))); denB += bits_f(partner32(f_bits(denB)));
    bf16* dst = F.MIX + (rowbase + 32 * qb + r32) * D + 512 + hqA * 64;
    head_norm_store(oA0, oA1, 1.0f / denA, F.sw_g + hqA * 64, dst, hi);
    head_norm_store(oB0, oB1, 1.0f / denB, F.sw_g + hqB * 64, dst + 64, hi);
}
__device__ __forceinline__ void p2_attention(Frame& F) {
    LAS unsigned char* wl = F.lds + F.wave * 16384;
    static_assert(ATT_WAVE_BYTES <= 16384 && NWAVES * 16384 <= RING_BYTES, "attention LDS");
    const int gw = F.vcu * NWAVES + F.wave, NGW = F.G * NWAVES;
    constexpr int NSB = NB * 8 * 128, NSW = NB * 4 * 128;
    const int nit = (NSB + NSW - gw + NGW - 1) / NGW;
    for (int k = 0; k < nit; ++k) {
        const int it = gw + ((F.wave & 4) ? (nit - 1 - k) : k) * NGW;
        if (it < NSB) { const int qb = it & 127, h = (it >> 7) & 7, b = it >> 10; sb_item(F, b, h, qb, wl); }
        else { const int r = it - NSB; const int qb = r & 127, hp = (r >> 7) & 1, kv = (r >> 8) & 1, b = r >> 9; swa_item2(F, b, kv, hp, qb, wl); }
    }
}

__device__ __forceinline__ int f2ord(unsigned bits) { int x = (int)bits; return x ^ ((x >> 31) & 0x7fffffff); }
template <int N> __device__ __forceinline__ void bitonic_desc(int (&v)[N]) {
#pragma unroll
    for (int k = 2; k <= N; k <<= 1) {
#pragma unroll
        for (int j = k >> 1; j > 0; j >>= 1) {
#pragma unroll
            for (int i = 0; i < N; ++i) {
                const int l = i ^ j;
                if (l > i) { const bool up = ((i & k) == 0); const int a = v[i], b = v[l]; const int mx = a > b ? a : b, mn = a > b ? b : a; v[i] = up ? mx : mn; v[l] = up ? mn : mx; }
            }
        }
    }
}
template <int N> __device__ __forceinline__ void bitonic_merge_desc(int (&v)[N]) {
#pragma unroll
    for (int j = N >> 1; j > 0; j >>= 1) {
#pragma unroll
        for (int i = 0; i < N; ++i) { const int l = i ^ j; if (l > i) { const int a = v[i], b = v[l]; v[i] = a > b ? a : b; v[l] = a > b ? b : a; } }
    }
}
template <int N> __device__ __forceinline__ void bitonic_desc_kv(int (&k)[N], int (&p)[N]) {
#pragma unroll
    for (int kk = 2; kk <= N; kk <<= 1) {
#pragma unroll
        for (int j = kk >> 1; j > 0; j >>= 1) {
#pragma unroll
            for (int i = 0; i < N; ++i) {
                const int l = i ^ j;
                if (l > i) { const bool up = ((i & kk) == 0); const bool sw = up ? (k[i] < k[l]) : (k[i] > k[l]);
                    const int ka = k[i], kb = k[l], pa = p[i], pb = p[l]; k[i] = sw ? kb : ka; k[l] = sw ? ka : kb; p[i] = sw ? pb : pa; p[l] = sw ? pa : pb; }
            }
        }
    }
}
struct Cand { unsigned char i, j; };
struct CandTable { Cand c[64]; int n; };
constexpr CandTable make_cands() { CandTable t{}; int n = 0; for (int i = 0; i < 16; ++i) for (int j = 0; j < 16; ++j) if ((i + 1) * (j + 1) <= 16) { t.c[n].i = (unsigned char)i; t.c[n].j = (unsigned char)j; ++n; } t.n = n; return t; }
constexpr CandTable CANDS = make_cands();
static_assert(CANDS.n == 50, "candidate count");

struct Ce16 { unsigned char a, b; };
constexpr Ce16 NET16[63] = { {0,1}, {2,3}, {0,2}, {1,3}, {1,2}, {4,5}, {6,7}, {4,6}, {5,7}, {5,6}, {0,4}, {2,6}, {2,4}, {1,5}, {3,7}, {3,5}, {1,2}, {3,4}, {5,6}, {8,9}, {10,11}, {8,10}, {9,11}, {9,10}, {12,13}, {14,15}, {12,14}, {13,15}, {13,14}, {8,12}, {10,14}, {10,12}, {9,13}, {11,15}, {11,13}, {9,10}, {11,12}, {13,14}, {0,8}, {4,12}, {4,8}, {2,10}, {6,14}, {6,10}, {2,4}, {6,8}, {10,12}, {1,9}, {5,13}, {5,9}, {3,11}, {7,15}, {7,11}, {3,5}, {7,9}, {11,13}, {1,2}, {3,4}, {5,6}, {7,8}, {9,10}, {11,12}, {13,14} };
template <int B> __device__ __forceinline__ void sort16_desc(int (&v)[64]) {
#pragma unroll
    for (int c = 0; c < 63; ++c) { const int i = B + NET16[c].a, j = B + NET16[c].b; const int x = v[i], y = v[j]; v[i] = x > y ? x : y; v[j] = x > y ? y : x; }
}
template <int B> __device__ __forceinline__ void sort16_desc_kv(int (&k)[32], int (&p)[32]) {
#pragma unroll
    for (int c = 0; c < 63; ++c) { const int i = B + NET16[c].a, j = B + NET16[c].b; const bool sw = k[i] < k[j];
        const int ka = k[i], kb = k[j], pa = p[i], pb = p[j]; k[i] = sw ? kb : ka; k[j] = sw ? ka : kb; p[i] = sw ? pb : pa; p[j] = sw ? pa : pb; }
}
constexpr Ce16 NET9[25] = { {0,3}, {1,7}, {2,5}, {4,8}, {0,7}, {2,4}, {3,8}, {5,6}, {0,2}, {1,3}, {4,5}, {7,8}, {1,4}, {3,6}, {5,7}, {0,1}, {2,4}, {3,5}, {6,8}, {2,3}, {4,5}, {6,7}, {1,2}, {3,4}, {5,6} };
__device__ __forceinline__ void sort9_desc_kv(int (&k)[32], int (&p)[32]) {
#pragma unroll
    for (int c = 0; c < 25; ++c) { const int i = 16 + NET9[c].a, j = 16 + NET9[c].b; const bool sw = k[i] < k[j];
        const int ka = k[i], kb = k[j], pa = p[i], pb = p[j]; k[i] = sw ? kb : ka; k[j] = sw ? ka : kb; p[i] = sw ? pb : pa; p[j] = sw ? pa : pb; }
}
__device__ __forceinline__ void bitonic_merge_desc_kv16(int (&k)[16], int (&p)[16]) {
#pragma unroll
    for (int j = 8; j > 0; j >>= 1) {
#pragma unroll
        for (int i = 0; i < 16; ++i) { const int l = i ^ j; if (l > i) { const bool sw = k[i] < k[l];
            const int ka = k[i], kb = k[l], pa = p[i], pb = p[l]; k[i] = sw ? kb : ka; k[l] = sw ? ka : kb; p[i] = sw ? pb : pa; p[l] = sw ? pa : pb; } }
    }
}
__device__ __forceinline__ void top16_of_64(int (&v)[64], int (&c)[16]) {
    int x[16], y[16];
#pragma unroll
    for (int i = 0; i < 16; ++i) { x[i] = v[i] > v[31 - i] ? v[i] : v[31 - i]; y[i] = v[32 + i] > v[63 - i] ? v[32 + i] : v[63 - i]; }
    bitonic_merge_desc<16>(x); bitonic_merge_desc<16>(y);
#pragma unroll
    for (int i = 0; i < 16; ++i) c[i] = x[i] > y[15 - i] ? x[i] : y[15 - i];
    bitonic_merge_desc<16>(c);
}
constexpr int P6_PITCH = 272, P6_KEYS_BYTES = 128 * P6_PITCH, P6_Q_BYTES = 32 * P6_PITCH;
static_assert(2 * P6_KEYS_BYTES + NWAVES * P6_Q_BYTES <= RING_BYTES, "P6 LDS map");
__device__ __forceinline__ void p6_item(Frame& F, int tb, int h, LAS unsigned char* keys_lds, LAS unsigned char* qw) {
    const int lane = F.lane, r32 = lane & 31, hi = lane >> 5;
    const bf16* QP = F.QKV;
    int top0[16], top1[16];
#pragma unroll 1
    for (int half = 0; half < 2; ++half) {
        { const bf16* qsrc = QP + (size_t)(32 * tb + (lane >> 4)) * DQ + h * 256 + half * 128 + 8 * (lane & 15);
          u32x4 t_[8];
#pragma unroll
          for (int i = 0; i < 8; ++i) t_[i] = *(const GAS u32x4*)(qsrc + (size_t)(4 * i) * DQ);
#pragma unroll
          for (int i = 0; i < 8; ++i) *(LAS u32x4*)(qw + (4 * i + (lane >> 4)) * P6_PITCH + 16 * (lane & 15)) = t_[i]; }
        bf16x8 qf[8];
#pragma unroll
        for (int ks = 0; ks < 8; ++ks) { const u32x4 w_ = *(const LAS u32x4*)(qw + r32 * P6_PITCH + 32 * ks + 16 * hi); qf[ks] = __builtin_bit_cast(bf16x8, w_); }
        const LAS unsigned char* kb = keys_lds + half * P6_KEYS_BYTES + r32 * P6_PITCH + 16 * hi;
        int v[64];
#define P6_TILE(dst, nt_) do { dst = (f32x16){}; _Pragma("unroll") for (int ks = 0; ks < 8; ++ks) { const u32x4 w_ = *(const LAS u32x4*)(kb + (32 * (nt_)) * P6_PITCH + 32 * ks); \
            dst = __builtin_amdgcn_mfma_f32_32x32x16_bf16(__builtin_bit_cast(bf16x8, w_), qf[ks], dst, 0, 0, 0); } } while (0)
#define P6_PACK(acc_, nt_) do { _Pragma("unroll") for (int r = 0; r < 16; ++r) { const float av = acc_[r]; const unsigned bits = (f_bits(av) & ~0x7Fu) | (unsigned)(32 * (nt_) + crow(r, hi)); v[16 * (nt_) + r] = f2ord(bits); } } while (0)
        f32x16 t0_, t1_;
        P6_TILE(t0_, 0); P6_TILE(t1_, 1); __builtin_amdgcn_sched_barrier(0);
        P6_PACK(t0_, 0); sort16_desc<0>(v); __builtin_amdgcn_sched_barrier(0);
        P6_TILE(t0_, 2); __builtin_amdgcn_sched_barrier(0);
        P6_PACK(t1_, 1); sort16_desc<16>(v); __builtin_amdgcn_sched_barrier(0);
        P6_TILE(t1_, 3); __builtin_amdgcn_sched_barrier(0);
        P6_PACK(t0_, 2); sort16_desc<32>(v); __builtin_amdgcn_sched_barrier(0);
        P6_PACK(t1_, 3); sort16_desc<48>(v);
#undef P6_TILE
#undef P6_PACK
        int c16[16]; top16_of_64(v, c16);
        int m[16];
#pragma unroll
        for (int i = 0; i < 16; ++i) { const int o = (int)partner32((unsigned)c16[15 - i]); m[i] = c16[i] > o ? c16[i] : o; }
        bitonic_merge_desc<16>(m);
#pragma unroll
        for (int i = 0; i < 16; ++i) { if (half == 0) top0[i] = m[i]; else top1[i] = m[i]; }
    }
    float f1[16], f2[16]; int i1[16], i2[16];
#pragma unroll
    for (int i = 0; i < 16; ++i) { const unsigned b1 = (unsigned)f2ord((unsigned)top0[i]), b2 = (unsigned)f2ord((unsigned)top1[i]);
        f1[i] = bits_f(b1 & ~0x7Fu); i1[i] = (int)(b1 & 0x7Fu); f2[i] = bits_f(b2 & ~0x7Fu); i2[i] = (int)(b2 & 0x7Fu); }
    int ck[32], cp[32];
#pragma unroll
    for (int s = 0; s < 32; ++s) {
        if (s < 25) { constexpr int dummy = 0; (void)dummy;
            const int ia = CANDS.c[2 * s].i, ja = CANDS.c[2 * s].j, ib = CANDS.c[2 * s + 1].i, jb = CANDS.c[2 * s + 1].j;
            const float sa = f1[ia] + f2[ja], sb = f1[ib] + f2[jb]; const int pa = (i1[ia] << 7) | i2[ja], pb = (i1[ib] << 7) | i2[jb];
            ck[s] = f2ord(f_bits(hi ? sb : sa)); cp[s] = hi ? pb : pa;
        } else { ck[s] = (int)0x80000000; cp[s] = 0; }
    }
    static_assert(CANDS.n == 50, "25 candidates per lane: entries 0..24 real, 25..31 padding");
    sort16_desc_kv<0>(ck, cp); sort9_desc_kv(ck, cp);
    int xk[16], xp[16];
#pragma unroll
    for (int i = 0; i < 16; ++i) { if (i < 7) { xk[i] = ck[i]; xp[i] = cp[i]; }
        else { const bool t = ck[i] >= ck[31 - i]; xk[i] = t ? ck[i] : ck[31 - i]; xp[i] = t ? cp[i] : cp[31 - i]; } }
    bitonic_merge_desc_kv16(xk, xp);
    int wk[16], wp[16];
#pragma unroll
    for (int i = 0; i < 16; ++i) { const int ok = (int)partner32((unsigned)xk[15 - i]), op = (int)partner32((unsigned)xp[15 - i]); const bool t = xk[i] >= ok; wk[i] = t ? xk[i] : ok; wp[i] = t ? xp[i] : op; }
    float vals[16]; float mxv = -INFINITY;
#pragma unroll
    for (int i = 0; i < 16; ++i) { vals[i] = bits_f((unsigned)f2ord((unsigned)wk[i])); mxv = __builtin_fmaxf(mxv, vals[i]); }
    float se = 0.f;
#pragma unroll
    for (int i = 0; i < 16; ++i) { vals[i] = __builtin_amdgcn_exp2f((vals[i] - mxv) * LOG2E); se += vals[i]; }
    const float inv = 1.0f / se;
    const size_t ob = (size_t)(32 * tb + r32) * 128 + h * 16 + hi * 8;
    { u32x4 a; a.x = (unsigned)wp[0] | ((unsigned)wp[1] << 16); a.y = (unsigned)wp[2] | ((unsigned)wp[3] << 16); a.z = (unsigned)wp[4] | ((unsigned)wp[5] << 16); a.w = (unsigned)wp[6] | ((unsigned)wp[7] << 16);
      *(GAS u32x4*)(F.IDX + ob) = a;
      f32x4 ga = {vals[0] * inv, vals[1] * inv, vals[2] * inv, vals[3] * inv}, gb = {vals[4] * inv, vals[5] * inv, vals[6] * inv, vals[7] * inv};
      *(GAS f32x4*)(F.GATE + ob) = ga; *(GAS f32x4*)(F.GATE + ob + 4) = gb; }
}
__device__ __forceinline__ bool cvt_early(const Frame& F) { return ((F.vcu >> 3) & 1) != 0; }
__device__ __forceinline__ void cvt_v_rows(Frame& F) { const int gw_ = F.vcu * NWAVES + F.wave, NGW_ = F.G * NWAVES; for (int r = NEXP + gw_; r < 2 * NEXP; r += 4 * NGW_) cvt_rows_fp8<4>(F, r, NGW_, 2 * NEXP, F.lane); }
__device__ __forceinline__ void p1_cvt_u(Frame& F) {
    const int nfull = (T / 256) * (DIN / 256) % F.G, nb = F.G - nfull;
    if (nb == F.G) { for (int r = (int)blockIdx.x * NWAVES + F.wave; r < NEXP; r += 4 * F.G * NWAVES) cvt_rows_fp8<4>(F, r, F.G * NWAVES, NEXP, F.lane); }
    else if ((int)blockIdx.x >= nfull) { for (int r = ((int)blockIdx.x - nfull) * NWAVES + F.wave; r < NEXP; r += 4 * nb * NWAVES) cvt_rows_fp8<4>(F, r, nb * NWAVES, NEXP, F.lane); }
}
template <class Sched> __device__ __forceinline__ void p6_topk_own(Frame& F, const Sched& S) {
    LAS unsigned char* keys_lds = F.lds; LAS unsigned char* qw = F.lds + 2 * P6_KEYS_BYTES + F.wave * P6_Q_BYTES;
    pg8::Unit u; int hprev = -1;
    for (int i = 0; S.next(i, u); ++i) {
        const int h = u.pn;
        if (h != hprev) {
            __syncthreads();
#pragma unroll
            for (int half = 0; half < 2; ++half) {
                const bf16* ksrc = F.KEYS + (size_t)(half * 8 + h) * 128 * 128 + (size_t)(F.tid >> 4) * 128 + 8 * (F.tid & 15);
                u32x4 t_[4];
#pragma unroll
                for (int q = 0; q < 4; ++q) t_[q] = *(const GAS u32x4*)(ksrc + (size_t)(32 * q) * 128);
#pragma unroll
                for (int q = 0; q < 4; ++q) *(LAS u32x4*)(keys_lds + half * P6_KEYS_BYTES + ((F.tid >> 4) + 32 * q) * P6_PITCH + 16 * (F.tid & 15)) = t_[q];
            }
            __syncthreads(); hprev = h;
        }
        p6_item(F, 8 * u.pm + F.wave, h, keys_lds, qw);
    }
    if (!cvt_early(F)) cvt_v_rows(F);
    __syncthreads();
}

__device__ __forceinline__ float dpp_xor1(float v) { return v + bits_f((unsigned)__builtin_amdgcn_update_dpp(0, (int)f_bits(v), 0xB1, 0xf, 0xf, false)); }
__device__ __forceinline__ float dpp_xor2(float v) { return v + bits_f((unsigned)__builtin_amdgcn_update_dpp(0, (int)f_bits(v), 0x4E, 0xf, 0xf, false)); }
__device__ __forceinline__ float dpp_hmir(float v) { return v + bits_f((unsigned)__builtin_amdgcn_update_dpp(0, (int)f_bits(v), 0x141, 0xf, 0xf, false)); }
__device__ __forceinline__ float dpp_max_xor1(float v) { return __builtin_fmaxf(v, bits_f((unsigned)__builtin_amdgcn_update_dpp(0, (int)f_bits(v), 0xB1, 0xf, 0xf, false))); }
__device__ __forceinline__ float dpp_max_xor2(float v) { return __builtin_fmaxf(v, bits_f((unsigned)__builtin_amdgcn_update_dpp(0, (int)f_bits(v), 0x4E, 0xf, 0xf, false))); }
__device__ __forceinline__ float dpp_max_hmir(float v) { return __builtin_fmaxf(v, bits_f((unsigned)__builtin_amdgcn_update_dpp(0, (int)f_bits(v), 0x141, 0xf, 0xf, false))); }
__device__ __forceinline__ float dpp_rmir(float v) { return v + bits_f((unsigned)__builtin_amdgcn_update_dpp(0, (int)f_bits(v), 0x140, 0xf, 0xf, false)); }
__device__ __forceinline__ f32x2_t fp8x2(unsigned w, bool hi) { return hi ? __builtin_amdgcn_cvt_pk_f32_fp8((int)w, true) : __builtin_amdgcn_cvt_pk_f32_fp8((int)w, false); }
__device__ __forceinline__ float gelu_tanh(float x) {
    const float y2 = 1.5957691216057308f * (x + 0.044715f * x * x * x);
    return x / (1.0f + __builtin_amdgcn_exp2f(-y2 * LOG2E));
}
__device__ __forceinline__ unsigned vsel16(const u32x4 (&v)[2], int k) { const u32x4 q = v[k >> 3]; const int j = (k >> 1) & 3; const unsigned w = j == 0 ? q.x : j == 1 ? q.y : j == 2 ? q.z : q.w; return (k & 1) ? (w >> 16) : (w & 0xffffu); }
struct TokIn { u32x4 id[2]; u32x4 x0, x1; };
__device__ __forceinline__ int vsel(const u32x4 (&v)[4], int k) { const u32x4 q = v[k >> 2]; const int j = k & 3; return (int)(j == 0 ? q.x : j == 1 ? q.y : j == 2 ? q.z : q.w); }
#define DPPI(v, ctl) __builtin_amdgcn_update_dpp(0, (v), (ctl), 0xf, 0xf, false)
__device__ __forceinline__ void p7_udots(Frame& F) {
    const int lane = F.lane, g = lane >> 3, c = lane & 7;
    const int s = blockIdx.x & 7, rank = blockIdx.x >> 3, nloc = F.G >> 3;
    const unsigned char* tab = F.U8 + (size_t)s * TAB8_SLICE; const unsigned coff16 = 16u * (unsigned)c;
    bf16* pd = F.PD + (size_t)s * T * 128;
    const int t0 = rank * NWAVES + F.wave, tstride = nloc * NWAVES;
#define P7_IDS(dst, tt) do { const int t_ = (tt) < T ? (tt) : t0; const GAS u32x4* ip_ = (const GAS u32x4*)(F.IDX + (size_t)t_ * 128 + 16 * g); dst.id[0] = ip_[0]; dst.id[1] = ip_[1]; } while (0)
#define P7_X(dst, tt) do { const int t_ = (tt) < T ? (tt) : t0; const bf16* xr_ = F.H + (size_t)t_ * D + 128 * s + 16 * c; dst.x0 = *(const GAS u32x4*)xr_; dst.x1 = *(const GAS u32x4*)(xr_ + 8); } while (0)
#define P7_PCS(pc, in) do { _Pragma("unroll") for (int k = 0; k < 16; ++k) pc[k] = *(const GAS u32x4*)(tab + ((vsel16(in.id, k) << 7) | coff16)); } while (0)
#define P7_MATH(pc, in, tt) do { if ((tt) < T) { \
        float xv[16]; { const unsigned a0 = in.x0.x, a1 = in.x0.y, a2 = in.x0.z, a3 = in.x0.w, b0 = in.x1.x, b1 = in.x1.y, b2 = in.x1.z, b3 = in.x1.w; \
          xv[0] = bf_lo(a0); xv[1] = bf_hi(a0); xv[2] = bf_lo(a1); xv[3] = bf_hi(a1); xv[4] = bf_lo(a2); xv[5] = bf_hi(a2); xv[6] = bf_lo(a3); xv[7] = bf_hi(a3); \
          xv[8] = bf_lo(b0); xv[9] = bf_hi(b0); xv[10] = bf_lo(b1); xv[11] = bf_hi(b1); xv[12] = bf_lo(b2); xv[13] = bf_hi(b2); xv[14] = bf_lo(b3); xv[15] = bf_hi(b3); } \
          \
        float xm = 0.f; _Pragma("unroll") for (int i = 0; i < 16; ++i) xm = __builtin_fmaxf(xm, __builtin_fabsf(xv[i])); \
        xm = dpp_max_hmir(dpp_max_xor2(dpp_max_xor1(xm))); \
        const float sx = xm > 0.f ? 127.0f / xm : 0.f, isx = xm * (1.0f / 127.0f); \
        const int xq0 = pack_i8(xv[0] * sx, xv[1] * sx, xv[2] * sx, xv[3] * sx), xq1 = pack_i8(xv[4] * sx, xv[5] * sx, xv[6] * sx, xv[7] * sx), \
                  xq2 = pack_i8(xv[8] * sx, xv[9] * sx, xv[10] * sx, xv[11] * sx), xq3 = pack_i8(xv[12] * sx, xv[13] * sx, xv[14] * sx, xv[15] * sx); \
        int ia_[16]; \
        _Pragma("unroll") for (int k = 0; k < 16; ++k) { \
            const unsigned w0 = pc[k].x, w1 = pc[k].y, w2 = pc[k].z, w3 = pc[k].w; \
            int ia = __builtin_amdgcn_sdot4((int)w0, xq0, 0, false); ia = __builtin_amdgcn_sdot4((int)w1, xq1, ia, false); ia = __builtin_amdgcn_sdot4((int)w2, xq2, ia, false); ia = __builtin_amdgcn_sdot4((int)w3, xq3, ia, false); ia_[k] = ia; } \
          \
          \
        int t1_[2][4], t2_[4]; \
        _Pragma("unroll") for (int ql = 0; ql < 2; ++ql) _Pragma("unroll") for (int j = 0; j < 4; ++j) { const int a_ = ia_[4 * ql + j], b_ = ia_[8 + 4 * ql + j]; \
            const int sa_ = a_ + DPPI(a_, 0x141), sb_ = b_ + DPPI(b_, 0x141); t1_[ql][j] = __builtin_amdgcn_update_dpp(sa_, sb_, 0xE4, 0xf, 0xA, false); } \
        _Pragma("unroll") for (int j = 0; j < 4; ++j) { const int a_ = t1_[0][j], b_ = t1_[1][j]; const int sa_ = a_ + DPPI(a_, 0xB1), sb_ = b_ + DPPI(b_, 0xB1); t2_[j] = (c & 1) ? sb_ : sa_; } \
        float rr_[4]; _Pragma("unroll") for (int j = 0; j < 4; ++j) { const int a_ = t2_[j]; rr_[j] = (float)(a_ + DPPI(a_, 0x4E)) * isx; } \
        if ((c & 2) == 0) { u32x2 o_; o_.x = pk2(rr_[0], rr_[1]); o_.y = pk2(rr_[2], rr_[3]); *(GAS u32x2*)(pd + (size_t)(tt) * 128 + 16 * g + 4 * ((c & 1) + ((c >> 1) & 2))) = o_; } } } while (0)
    TokIn inA, inB, inC; u32x4 pcA[16], pcB[16], pcC[16];
    P7_IDS(inA, t0); P7_IDS(inB, t0 + tstride); __builtin_amdgcn_sched_barrier(0);
    P7_X(inA, t0); P7_PCS(pcA, inA); __builtin_amdgcn_sched_barrier(0);
    P7_IDS(inC, t0 + 2 * tstride); __builtin_amdgcn_sched_barrier(0);
    P7_X(inB, t0 + tstride); P7_PCS(pcB, inB); __builtin_amdgcn_sched_barrier(0);
    for (int t = t0; t < T; t += 3 * tstride) {
        P7_IDS(inA, t + 3 * tstride); __builtin_amdgcn_sched_barrier(0);
        P7_X(inC, t + 2 * tstride); P7_PCS(pcC, inC); __builtin_amdgcn_sched_barrier(0);
        P7_MATH(pcA, inA, t); __builtin_amdgcn_sched_barrier(0);
        P7_IDS(inB, t + 4 * tstride); __builtin_amdgcn_sched_barrier(0);
        P7_X(inA, t + 3 * tstride); P7_PCS(pcA, inA); __builtin_amdgcn_sched_barrier(0);
        P7_MATH(pcB, inB, t + tstride); __builtin_amdgcn_sched_barrier(0);
        P7_IDS(inC, t + 5 * tstride); __builtin_amdgcn_sched_barrier(0);
        P7_X(inB, t + 4 * tstride); P7_PCS(pcB, inB); __builtin_amdgcn_sched_barrier(0);
        P7_MATH(pcC, inC, t + 2 * tstride); __builtin_amdgcn_sched_barrier(0);
    }
#undef P7_IDS
#undef P7_X
#undef P7_PCS
#undef P7_MATH
}
__device__ __forceinline__ void p8_combine(Frame& F) {
    const int gw = F.vcu * NWAVES + F.wave, NGW = F.G * NWAVES, lane = F.lane;
    constexpr int NU = 2;
    for (int t0 = gw; t0 < T; t0 += NU * NGW) {
        unsigned pdw[NU][8], idw[NU]; f32x2_t gt[NU];
#pragma unroll
        for (int u = 0; u < NU; ++u) { const int t = t0 + u * NGW < T ? t0 + u * NGW : t0; const size_t o = (size_t)t * 128 + 2 * lane;
#pragma unroll
            for (int s = 0; s < 8; ++s) pdw[u][s] = __builtin_nontemporal_load((const GAS unsigned*)(F.PD + (size_t)s * T * 128 + o));
            idw[u] = *(const GAS unsigned*)(F.IDX + o); gt[u] = __builtin_nontemporal_load((const GAS f32x2_t*)(F.GATE + o)); }
        float ru0[NU], ru1[NU], rv0[NU], rv1[NU], r2[NU];
#pragma unroll
        for (int u = 0; u < NU; ++u) { const int t = t0 + u * NGW < T ? t0 + u * NGW : t0; const int i0 = (int)(idw[u] & 0xffffu), i1 = (int)(idw[u] >> 16);
            ru0[u] = F.RSU[i0]; ru1[u] = F.RSU[i1]; rv0[u] = F.RSV[i0]; rv1[u] = F.RSV[i1]; r2[u] = F.RS2[t]; }
#pragma unroll
        for (int u = 0; u < NU; ++u) { const int t = t0 + u * NGW;
            float d0 = 0.f, d1 = 0.f;
#pragma unroll
            for (int s = 0; s < 8; ++s) { const unsigned w = pdw[u][s]; d0 += bf_lo(w); d1 += bf_hi(w); }
            const float c0 = gt[u].x * gelu_tanh(d0 * ru0[u] * r2[u]) * rv0[u], c1 = gt[u].y * gelu_tanh(d1 * ru1[u] * r2[u]) * rv1[u];
            const float m = wave_max(__builtin_fmaxf(__builtin_fabsf(c0), __builtin_fabsf(c1)));
            const float sq = m > 0.f ? 127.0f / m : 0.f;
            const int q0 = (int)__builtin_rintf(c0 * sq), q1 = (int)__builtin_rintf(c1 * sq);
            if (t < T) { *(GAS unsigned short*)(F.C8 + (size_t)t * 128 + 2 * lane) = (unsigned short)((q0 & 0xff) | ((q1 & 0xff) << 8)); if (lane == 0) F.CS[t] = m * (1.0f / 127.0f); } }
    }
}
typedef int v2i_t __attribute__((ext_vector_type(2)));
typedef int v4i_t __attribute__((ext_vector_type(4)));
constexpr int P9_PITCH = 144, P9_WAVE_BYTES = 128 * P9_PITCH, P9_OSC_OFF = LDSCTL_OFF + 512;
static_assert(NWAVES * P9_WAVE_BYTES <= RING_BYTES && P9_OSC_OFF + NWAVES * 512 <= LDS_BYTES, "P9 LDS map");
struct TokInV { u32x4 id[2]; u32x4 a0, a1; u32x2 xb; float cs; };
__device__ __forceinline__ void p9_vacc(Frame& F) {
    const int lane = F.lane, g = lane >> 3, c = lane & 7, m16 = lane & 15, q = lane >> 4;
    const int s = blockIdx.x & 7, rank = blockIdx.x >> 3, nloc = F.G >> 3;
    const unsigned char* tab = F.V8 + (size_t)s * TAB8_SLICE; const unsigned coff16 = 16u * (unsigned)c;
    const int t0 = rank * NWAVES + F.wave, tstride = nloc * NWAVES;
    LAS unsigned char* wl = F.lds + F.wave * P9_WAVE_BYTES;
    LAS float* osc = (LAS float*)(F.lds + P9_OSC_OFF + F.wave * 512);
    LAS unsigned char* wst = wl + (16 * g) * P9_PITCH + 16 * c;
    const LAS unsigned char* wrd = wl + (16 * q + (m16 >> 1)) * P9_PITCH + 8 * (m16 & 1);
    const int coff = 128 * s + 4 * (lane & 31);
#define P9_IDS(dst, tt) do { const int t_ = (tt) < T ? (tt) : t0; const GAS u32x4* ip_ = (const GAS u32x4*)(F.IDX + (size_t)t_ * 128 + 16 * g); dst.id[0] = ip_[0]; dst.id[1] = ip_[1]; } while (0)
#define P9_LATE(dst, tt) do { const int t_ = (tt) < T ? (tt) : t0; const GAS u32x4* cp_ = (const GAS u32x4*)(F.C8 + (size_t)t_ * 128 + 16 * q); dst.a0 = cp_[0]; dst.a1 = cp_[4]; \
        dst.xb = *(const GAS u32x2*)(F.H + (size_t)t_ * D + coff); dst.cs = F.CS[t_]; } while (0)
#define P9_PCS(pc, in) do { _Pragma("unroll") for (int k = 0; k < 16; ++k) pc[k] = *(const GAS u32x4*)(tab + ((vsel16(in.id, k) << 7) | coff16)); } while (0)
#define P9_STAGE(pc) do { _Pragma("unroll") for (int k = 0; k < 16; ++k) *(LAS u32x4*)(wst + k * P9_PITCH) = pc[k]; } while (0)
#define P9_MATH(in, tt) do { if ((tt) < T) { \
        v4i_t acc[8]; _Pragma("unroll") for (int nb = 0; nb < 8; ++nb) acc[nb] = (v4i_t){0, 0, 0, 0}; \
        _Pragma("unroll") for (int s2 = 0; s2 < 2; ++s2) { const v4i_t av = __builtin_bit_cast(v4i_t, s2 ? in.a1 : in.a0); \
            _Pragma("unroll") for (int nb = 0; nb < 8; ++nb) { \
                const v2i_t lo = __builtin_amdgcn_ds_read_tr8_b64_v2i32((LAS v2i_t*)(wrd + (64 * s2) * P9_PITCH + 16 * nb)); \
                const v2i_t hi = __builtin_amdgcn_ds_read_tr8_b64_v2i32((LAS v2i_t*)(wrd + (64 * s2 + 8) * P9_PITCH + 16 * nb)); \
                const v4i_t bv = {lo.x, lo.y, hi.x, hi.y}; \
                acc[nb] = __builtin_amdgcn_mfma_i32_16x16x64_i8(av, bv, acc[nb], 0, 0, 0); } } \
          \
        if (lane < 16) { _Pragma("unroll") for (int nb = 0; nb < 8; ++nb) osc[16 * nb + lane] = (float)acc[nb][0] * in.cs; } \
        asm volatile("" ::: "memory"); \
          \
        if (lane < 32) { const f32x4 d_ = *(const LAS f32x4*)(osc + 4 * lane); bf16* op_ = F.X2 + (size_t)(tt) * D + coff; const unsigned xb0_ = in.xb.x, xb1_ = in.xb.y; \
            const f32x4 y = {bf_lo(xb0_) + d_[0], bf_hi(xb0_) + d_[1], bf_lo(xb1_) + d_[2], bf_hi(xb1_) + d_[3]}; \
            u32x2 yw_; yw_.x = pk2(y.x, y.y); yw_.y = pk2(y.z, y.w); *(GAS u32x2*)op_ = yw_; } } } while (0)
    TokInV inA, inB; u32x4 pcA[16], pcB[16];
    P9_IDS(inA, t0); P9_IDS(inB, t0 + tstride); P9_PCS(pcA, inA); __builtin_amdgcn_sched_barrier(0);
    P9_IDS(inA, t0 + 2 * tstride); P9_LATE(inA, t0); __builtin_amdgcn_sched_barrier(0);
    P9_PCS(pcB, inB); __builtin_amdgcn_sched_barrier(0);
    for (int t = t0; t < T; t += 2 * tstride) {
        P9_IDS(inB, t + 3 * tstride); P9_LATE(inB, t + tstride); __builtin_amdgcn_sched_barrier(0);
        P9_STAGE(pcA); P9_PCS(pcA, inA); __builtin_amdgcn_sched_barrier(0);
        P9_MATH(inA, t); __builtin_amdgcn_sched_barrier(0);
        P9_IDS(inA, t + 4 * tstride); P9_LATE(inA, t + 2 * tstride); __builtin_amdgcn_sched_barrier(0);
        P9_STAGE(pcB); P9_PCS(pcB, inB); __builtin_amdgcn_sched_barrier(0);
        P9_MATH(inB, t + tstride); __builtin_amdgcn_sched_barrier(0);
    }
#undef P9_IDS
#undef P9_LATE
#undef P9_PCS
#undef P9_STAGE
#undef P9_MATH
}
__device__ __forceinline__ void p10_final(Frame& F) {
    const int gw = F.vcu * NWAVES + F.wave, NGW = F.G * NWAVES, lane = F.lane;
    const GAS f32x4* gr = (const GAS f32x4*)F.gf + lane; f32x4 gg[4];
#pragma unroll
    for (int j = 0; j < 4; ++j) gg[j] = gr[64 * j];
    constexpr int NR = 2;
    for (int t0 = gw; t0 < T; t0 += NR * NGW) {
        u32x2 w[NR][4];
#pragma unroll
        for (int i = 0; i < NR; ++i) { const int t = t0 + i * NGW < T ? t0 + i * NGW : t0; const GAS u32x2* br = (const GAS u32x2*)(F.X2 + (size_t)t * D) + lane;
#pragma unroll
            for (int j = 0; j < 4; ++j) w[i][j] = __builtin_nontemporal_load(br + 64 * j); }
#pragma unroll
        for (int i = 0; i < NR; ++i) { const int t = t0 + i * NGW;
            float v[16]; float ss = 0.f;
#pragma unroll
            for (int j = 0; j < 4; ++j) { const unsigned w0 = w[i][j].x, w1 = w[i][j].y; v[4 * j] = bf_lo(w0); v[4 * j + 1] = bf_hi(w0); v[4 * j + 2] = bf_lo(w1); v[4 * j + 3] = bf_hi(w1);
                ss += (v[4 * j] * v[4 * j] + v[4 * j + 1] * v[4 * j + 1]) + (v[4 * j + 2] * v[4 * j + 2] + v[4 * j + 3] * v[4 * j + 3]); }
            const float rs = __builtin_amdgcn_rsqf(wave_sum(ss) * (1.f / D) + EPS);
            if (t < T) { GAS f32x4* xr = (GAS f32x4*)(F.out + (size_t)t * D) + lane;
#pragma unroll
                for (int j = 0; j < 4; ++j) __builtin_nontemporal_store((f32x4){v[4 * j] * rs * gg[j].x, v[4 * j + 1] * rs * gg[j].y, v[4 * j + 2] * rs * gg[j].z, v[4 * j + 3] * rs * gg[j].w}, xr + 64 * j); } }
    }
}
struct Args { const float* in[14]; float* out; unsigned char* ws; int ph_lo, ph_hi, li, pad; };
__global__ void __launch_bounds__(NWAVES * 64, 2) mk_fwd(Args args) {
    extern __shared__ __attribute__((aligned(16))) unsigned char lds[];
#ifdef PROBE_LO
    unsigned long long pmk_lo = 0, pmk_hi = 0;
    if (PROBE_LO == -1) { asm volatile("s_memrealtime %0\n\ts_waitcnt lgkmcnt(0)" : "=s"(pmk_lo) :: "memory"); }
#endif
    Frame F;
    F.lds = (LAS unsigned char*)lds;
    F.MISC = (volatile LAS unsigned*)(F.lds + MISC_OFF);
    F.tid = threadIdx.x; F.lane = F.tid & 63; F.wave = __builtin_amdgcn_readfirstlane(F.tid >> 6);
    F.G = gridDim.x; { const int bx = blockIdx.x; F.vcu = (F.G % 8 == 0) ? (bx % 8) * (F.G / 8) + bx / 8 : bx; }
    unsigned char* ws = args.ws;
    F.ctl = (gu32*)(ws + WS_CTL);
    F.x = args.in[0]; F.g1 = args.in[1]; F.w_in = args.in[2]; F.sb_g = args.in[3]; F.sw_g = args.in[4]; F.sinks = args.in[5]; F.w_out = args.in[6]; F.g2 = args.in[7];
    F.w_q = args.in[8]; F.keys1 = args.in[9]; F.keys2 = args.in[10]; F.pu = args.in[11]; F.pv = args.in[12]; F.gf = args.in[13]; F.out = args.out;
    F.Wt_in = (bf16*)(ws + WS_WIN); F.Wt_out = (bf16*)(ws + WS_WOUT); F.Wt_q = (bf16*)(ws + WS_WQ); F.KEYS = (bf16*)(ws + WS_KEYS);
    F.H = (bf16*)(ws + WS_H); F.MIX = (bf16*)(ws + WS_MIX); F.QKV = (bf16*)(ws + WS_QKV); F.U8 = ws + WS_U8; F.V8 = ws + WS_V8; F.RSU = (float*)(ws + WS_RSU); F.RSV = (float*)(ws + WS_RSV);
    F.A8 = ws + WS_A8; F.W8 = ws + WS_W8; F.SA = (float*)(ws + WS_SA); F.SB = (float*)(ws + WS_SB);
    F.IRS1 = (float*)(ws + WS_IRS1); F.SSQP = (float*)(ws + WS_SSQP); F.RS2 = (float*)(ws + WS_RS2); F.PD = (bf16*)(ws + WS_PD); F.X2 = (bf16*)(ws + WS_X2); F.C8 = ws + WS_C; F.CS = (float*)(ws + WS_C + 6 * MiB); F.SSP = (float*)(ws + WS_SSP);
    F.IDX = (unsigned short*)(ws + WS_IDX); F.GATE = (float*)(ws + WS_GATE);
    for (int u = F.tid; u < (LDS_BYTES - LDSCTL_OFF) / 4; u += NWAVES * 64) ((LAS unsigned*)(F.lds + LDSCTL_OFF))[u] = 0u;
    __syncthreads();
    const int lo = args.ph_lo, hi = args.ph_hi;
    const bool use_bar = (hi - lo) > 1;
    XcdBarrier bar; bar.bar = (unsigned*)(F.ctl + CW_BAR) + args.li * XCD_BAR_WORDS; bar.x = 0; bar.st = nullptr;
    if (use_bar) bar = xcd_barrier_post((unsigned*)(F.ctl + CW_BAR) + args.li * XCD_BAR_WORDS, F.MISC + 8);
#ifndef PHMASK
#define PHMASK 2047
#endif
#define IN(k) (((PHMASK >> (k)) & 1) && lo <= (k) && (k) < hi)
#define SEAM(k) do { if (IN(k) && IN((k) + 1)) xcd_barrier(bar); } while (0)
    const int gw = F.vcu * NWAVES + F.wave, NGW = F.G * NWAVES;
#ifdef PROBE_LO
#define PSTAMP(v) asm volatile("s_memrealtime %0\n\ts_waitcnt lgkmcnt(0)" : "=s"(v) :: "memory")
#define PMARK(k) do { if ((k) == PROBE_LO) { PSTAMP(pmk_lo); } if ((k) == PROBE_HI + 1) { PSTAMP(pmk_hi); } } while (0)
#else
#define PMARK(k) do {} while (0)
#endif

    PMARK(0);
    if (IN(0)) { p0_prologue(F); } SEAM(0);
    PMARK(1);
    if (IN(1)) { pg8::Gemm g{(const bf16*)F.A8, (const bf16*)F.W8, T, DIN, D / 2}; pg8::StaticOrder S; S.init(T, DIN, F.G, (int)blockIdx.x); pg8::EpiI8 E{F.QKV, DIN, F.SA, F.SB};
        const bool u_early = cvt_early(F) && (int)blockIdx.x >= (T / 256) * (DIN / 256) % F.G;
        if (u_early) { p1_cvt_u(F); asm volatile("s_waitcnt vmcnt(0)" ::: "memory"); __syncthreads(); }
        pg8::gemm_phase<pg8::EpiI8, pg8::StaticOrder, true>(F.lds, g, S, E);
        if (!u_early) p1_cvt_u(F);
        } SEAM(1);
    PMARK(2);
    if (IN(2)) { p2_attention(F); } SEAM(2);
    PMARK(3);
    if (IN(3)) { pg8::Gemm g{F.MIX, F.Wt_out, T, D, D}; pg8::StaticOrder S; S.init(T, D, F.G, (int)blockIdx.x); pg8::EpiResB E{F.g1, F.IRS1, F.A8, F.SA, F.H, D, F.SSQP};
        pg8::gemm_phase<pg8::EpiResB, pg8::StaticOrder>(F.lds, g, S, E); } SEAM(3);
    PMARK(4);
    PMARK(5);
    if (IN(5)) { pg8::Gemm g{F.H, F.Wt_q, T, DQ, D}; pg8::StaticOrder S; S.init(T, DQ, F.G, (int)blockIdx.x); S.init_pairs();
        LAS float* rsl = (LAS float*)(F.lds + LDSCTL_OFF + 512); int pm_l = -1, pm_l1 = -1;
        { pg8::Unit u0, u1; if (S.next(0, u0)) pm_l = u0.pm; if (S.next(1, u1)) pm_l1 = u1.pm;
          const int pmt = F.tid < 256 ? pm_l : pm_l1;
          if (pmt >= 0) { const f32x4* sp = (const f32x4*)(F.SSQP + (size_t)(pmt * 256 + (F.tid & 255)) * 16); const f32x4 s0 = sp[0], s1 = sp[1], s2 = sp[2], s3 = sp[3];
                const float ss = ((s0[0] + s0[1]) + (s0[2] + s0[3])) + ((s1[0] + s1[1]) + (s1[2] + s1[3])) + ((s2[0] + s2[1]) + (s2[2] + s2[3])) + ((s3[0] + s3[1]) + (s3[2] + s3[3]));
                rsl[F.tid] = __builtin_amdgcn_rsqf(ss * (1.0f / 1024.0f) + 1e-6f); } }
        __syncthreads();
        pg8::EpiBf16RS E{F.QKV, DQ, F.SSQP, F.RS2, rsl, pm_l, pm_l1};
        if (cvt_early(F)) { cvt_v_rows(F); asm volatile("s_waitcnt vmcnt(0)" ::: "memory"); __syncthreads(); }
        pg8::gemm_phase<pg8::EpiBf16RS, pg8::StaticOrder>(F.lds, g, S, E);
        asm volatile("s_waitcnt vmcnt(0)" ::: "memory"); __syncthreads();
        p6_topk_own(F, S); }
    PMARK(6);
    if (IN(6) && IN(7)) xcd_barrier(bar, F.U8 + (size_t)(blockIdx.x & 7) * TAB8_SLICE + (size_t)(blockIdx.x >> 3) * 65536);
    PMARK(7);
    if (IN(7)) { p7_udots(F); } SEAM(7);
    PMARK(8);
    if (IN(8)) { p8_combine(F); } if (IN(8) && IN(9)) xcd_barrier(bar, F.V8 + (size_t)(blockIdx.x & 7) * TAB8_SLICE + (size_t)(blockIdx.x >> 3) * 65536);
    PMARK(9);
    if (IN(9)) { p9_vacc(F); } SEAM(9);
    PMARK(10);
    if (IN(10)) { p10_final(F); }
#ifdef PROBE_LO
    xcd_barrier(bar);
    PMARK(11);
    if (blockIdx.x == 0 && F.tid == 0) { unsigned long long t0, t1; PSTAMP(t0); const unsigned long long dl = (pmk_hi - pmk_lo) * PROBE_MULT;
        do { __builtin_amdgcn_s_sleep(8); PSTAMP(t1); } while (t1 - t0 < dl); }
#endif
#undef IN
#undef SEAM
}

extern "C" void kernel_launch(void* const* d_in, const int* in_sizes, int n_in, void* d_out, int out_size, void* d_ws, size_t ws_size, hipStream_t stream) {
    static int grid = 0;
    if (grid == 0) {
        if (n_in != 14 || in_sizes[0] != T * D || out_size != T * D || ws_size < WS_END) { fprintf(stderr, "kernel_launch: unexpected shapes (n_in %d, in0 %d, out %d, ws %zu)\n", n_in, n_in > 0 ? in_sizes[0] : -1, out_size, ws_size); grid = -1; return; }
        int dev = 0, cus = 0, per_cu = 0;
        if (hipGetDevice(&dev) != hipSuccess || hipDeviceGetAttribute(&cus, hipDeviceAttributeMultiprocessorCount, dev) != hipSuccess) { grid = -1; return; }
        if (hipFuncSetAttribute((const void*)mk_fwd, hipFuncAttributeMaxDynamicSharedMemorySize, LDS_BYTES) != hipSuccess) { fprintf(stderr, "kernel_launch: hipFuncSetAttribute failed\n"); grid = -1; return; }
        if (hipOccupancyMaxActiveBlocksPerMultiprocessor(&per_cu, (const void*)mk_fwd, NWAVES * 64, LDS_BYTES) != hipSuccess || per_cu < 1)
            fprintf(stderr, "kernel_launch: note: occupancy query reports %d workgroups per CU\n", per_cu);
        (void)hipGetLastError();
        grid = cus;
    }
    if (grid < 0) return;
    if (hipMemsetAsync((char*)d_ws + WS_CTL, 0, CTL_ZERO_BYTES, stream) != hipSuccess) { fprintf(stderr, "kernel_launch: hipMemsetAsync failed\n"); return; }
    Args a{};
    for (int i = 0; i < 14; ++i) a.in[i] = (const float*)d_in[i];
    a.out = (float*)d_out; a.ws = (unsigned char*)d_ws;
#if MK_N_LAUNCHES == 1
    a.ph_lo = 0; a.ph_hi = N_PHASES; a.li = 0;
    hipLaunchKernelGGL(mk_fwd, dim3(grid), dim3(NWAVES * 64), LDS_BYTES, stream, a);
#else
    for (int li = 0; li < N_PHASES; ++li) { a.ph_lo = li; a.ph_hi = li + 1; a.li = 0; hipLaunchKernelGGL(mk_fwd, dim3(grid), dim3(NWAVES * 64), LDS_BYTES, stream, a); }
#endif
    const hipError_t le = hipPeekAtLastError();
    if (le != hipSuccess) fprintf(stderr, "kernel_launch: launch failed: %s\n", hipGetErrorName(le));
}
```
